# Optimizing an MI355X kernel written in HIP

```python
import math
import jax, jax.numpy as jnp
from jax import lax
import numpy as np

D_MODEL = 2048
BATCH = 4
SEQ = 2048
DEPTH = 2

DN_ALPHA = (2.0 * DEPTH) ** 0.25
DN_BETA = (8.0 * DEPTH) ** -0.25
N_EVEN = (DEPTH + 1) // 2
N_ODD = DEPTH // 2

GDN_HEAD_DIM = 128
GDN_HEADS = D_MODEL // (2 * GDN_HEAD_DIM)
GDN_WIDTH = GDN_HEADS * GDN_HEAD_DIM
GDN_CONV = 4
GDN_CHUNK = 64
SC_WIDTH = D_MODEL - GDN_WIDTH
SC_CONV = 3
HYB_SPLITS = [3 * GDN_WIDTH, 4 * GDN_WIDTH, 4 * GDN_WIDTH + GDN_HEADS,
              4 * GDN_WIDTH + 2 * GDN_HEADS, 4 * GDN_WIDTH + 2 * GDN_HEADS + SC_WIDTH,
              4 * GDN_WIDTH + 2 * GDN_HEADS + 2 * SC_WIDTH]
HYB_IN = 4 * GDN_WIDTH + 2 * GDN_HEADS + 3 * SC_WIDTH
HYB_OUT = GDN_WIDTH + SC_WIDTH

MLA_HEADS = 16
MLA_Q_RANK = 512
MLA_KV_RANK = 512
MLA_NOPE = 128
MLA_ROPE = 64
MLA_V = 128
MLA_IN = MLA_Q_RANK + MLA_KV_RANK + MLA_ROPE
ROPE_THETA = 10000.0
Q_BLOCK = 128
MAX_POS_OFFSET = 4096

MOE_GROUPS = 8
MOE_PER_GROUP = 8
MOE_EXPERTS = MOE_GROUPS * MOE_PER_GROUP
MOE_TOPK = 2
MOE_FF = 512
MOE_BLOCK = 128

kernel_name = "hybrid_gdn_shortconv_mla_hmoe_deepnorm_adaln"

F32 = jnp.float32


def _layer_norm(x, g, b, eps=1e-5):
    xf = x.astype(F32)
    mu = jnp.mean(xf, -1, keepdims=True)
    var = jnp.mean(jnp.square(xf - mu), -1, keepdims=True)
    return ((xf - mu) * lax.rsqrt(var + eps) * g.astype(F32) + b.astype(F32)).astype(x.dtype)


def _rms_norm(x, w, eps=1e-6):
    xf = x.astype(F32)
    return (xf * lax.rsqrt(jnp.mean(xf * xf, -1, keepdims=True) + eps) * w.astype(F32)).astype(x.dtype)


def _l2norm(x, eps=1e-6):
    xf = x.astype(F32)
    return xf * lax.rsqrt(jnp.sum(xf * xf, -1, keepdims=True) + eps)


def _causal_dwconv(x, w):
    k, s = w.shape[0], x.shape[1]
    xp = jnp.pad(x, ((0, 0), (k - 1, 0), (0, 0)))
    y = w[0] * xp[:, 0:s]
    for j in range(1, k):
        y = y + w[j] * xp[:, j:j + s]
    return y


def _gated_delta_rule(q, k, v, g, beta):
    b, s, h, dk = q.shape
    dv = v.shape[-1]
    L = GDN_CHUNK
    n = s // L

    def chunks(t):
        t = t.astype(F32).reshape(b, n, L, h, *t.shape[3:])
        return jnp.moveaxis(t, (1, 3), (0, 2))

    qc = chunks(q) * (dk ** -0.5)
    kc, vc, bc = chunks(k), chunks(v), chunks(beta)
    gc = jnp.cumsum(chunks(g), -1)
    causal = jnp.tril(jnp.ones((L, L), bool))
    strict = jnp.tril(jnp.ones((L, L), bool), -1)
    diff = gc[..., :, None] - gc[..., None, :]
    decay = jnp.where(causal, jnp.exp(jnp.where(causal, diff, 0.0)), 0.0)
    kb = kc * bc[..., None]
    m = jnp.where(strict, jnp.einsum('nbhid,nbhjd->nbhij', kb, kc) * decay, 0.0)
    a = m + jnp.eye(L, dtype=F32)
    rhs = jnp.concatenate([vc * bc[..., None], kb * jnp.exp(gc)[..., None]], -1)
    sol = lax.linalg.triangular_solve(a, rhs, left_side=True, lower=True, unit_diagonal=True)
    u, w = sol[..., :dv], sol[..., dv:]
    qk = jnp.where(causal, jnp.einsum('nbhid,nbhjd->nbhij', qc, kc) * decay, 0.0)
    g_last = gc[..., -1]

    def step(state, inp):
        q_i, k_i, u_i, w_i, qk_i, g_i, gl_i = inp
        v_new = u_i - jnp.einsum('bhld,bhde->bhle', w_i, state)
        o = (jnp.einsum('bhld,bhde->bhle', q_i * jnp.exp(g_i)[..., None], state)
             + jnp.einsum('bhij,bhje->bhie', qk_i, v_new))
        k_dec = k_i * jnp.exp(gl_i[..., None] - g_i)[..., None]
        state = state * jnp.exp(gl_i)[..., None, None] + jnp.einsum('bhld,bhle->bhde', k_dec, v_new)
        return state, o

    state0 = jnp.zeros((b, h, dk, dv), F32)
    _, o = lax.scan(step, state0, (qc, kc, u, w, qk, gc, g_last))
    return jnp.moveaxis(o, (0, 2), (1, 3)).reshape(b, s, h, dv)


def _gdn_shortconv_mixer(h, w_in, conv_w, a_log, dt_bias, norm_w, sc_w, w_out):
    b, s, _ = h.shape
    qkv, z, beta_raw, a_raw, sc_b, sc_c, sc_h = jnp.split(h @ w_in, HYB_SPLITS, -1)
    qkv = jax.nn.silu(_causal_dwconv(qkv, conv_w))
    q, k, v = jnp.split(qkv.reshape(b, s, 3 * GDN_HEADS, GDN_HEAD_DIM), 3, axis=2)
    beta = jax.nn.sigmoid(beta_raw.astype(F32))
    g = -jnp.exp(a_log.astype(F32)) * jax.nn.softplus(a_raw.astype(F32) + dt_bias.astype(F32))
    o = _gated_delta_rule(_l2norm(q), _l2norm(k), v, g, beta)
    o = _rms_norm(o, norm_w) * jax.nn.silu(z.reshape(b, s, GDN_HEADS, GDN_HEAD_DIM).astype(F32))
    y_a = o.reshape(b, s, GDN_WIDTH).astype(h.dtype)
    y_b = sc_b * _causal_dwconv(sc_c * sc_h, sc_w)
    return jnp.concatenate([y_a, y_b], -1) @ w_out


def _rope_tables(pos):
    half = MLA_ROPE // 2
    inv = ROPE_THETA ** (-jnp.arange(half, dtype=F32) * (2.0 / MLA_ROPE))
    ang = pos.astype(F32)[..., None] * inv
    return jnp.cos(ang), jnp.sin(ang)


def _rope(x, cos, sin):
    x1, x2 = jnp.split(x.astype(F32), 2, -1)
    return jnp.concatenate([x1 * cos - x2 * sin, x1 * sin + x2 * cos], -1).astype(x.dtype)


def _mla_attention(q_nope, q_pe, k_nope, k_pe, v):
    b, s, h, _ = q_nope.shape
    nb = s // Q_BLOCK
    scale = (MLA_NOPE + MLA_ROPE) ** -0.5
    kpos = jnp.arange(s)

    def to_blocks(t):
        return jnp.moveaxis(t.reshape(b, nb, Q_BLOCK, *t.shape[2:]), 1, 0)

    def attend(args):
        i, qn, qp = args
        sc = (jnp.einsum('bqhd,bkhd->bhqk', qn, k_nope, preferred_element_type=F32)
              + jnp.einsum('bqhr,bkr->bhqk', qp, k_pe, preferred_element_type=F32)) * scale
        qpos = i * Q_BLOCK + jnp.arange(Q_BLOCK)
        sc = jnp.where(qpos[:, None] >= kpos[None, :], sc, -jnp.inf)
        p = jax.nn.softmax(sc, -1)
        return jnp.einsum('bhqk,bkhd->bqhd', p.astype(v.dtype), v)

    o = lax.map(attend, (jnp.arange(nb), to_blocks(q_nope), to_blocks(q_pe)))
    return jnp.moveaxis(o, 0, 1).reshape(b, s, h, MLA_V)


def _mla_mixer(h, positions, w_in, q_norm, kv_norm, w_uq, w_ukv, w_out):
    b, s, _ = h.shape
    cq, ckv, k_pe = jnp.split(h @ w_in, [MLA_Q_RANK, MLA_Q_RANK + MLA_KV_RANK], -1)
    q = (_rms_norm(cq, q_norm) @ w_uq).reshape(b, s, MLA_HEADS, MLA_NOPE + MLA_ROPE)
    kv = (_rms_norm(ckv, kv_norm) @ w_ukv).reshape(b, s, MLA_HEADS, MLA_NOPE + MLA_V)
    q_nope, q_pe = jnp.split(q, [MLA_NOPE], -1)
    k_nope, v = jnp.split(kv, [MLA_NOPE], -1)
    cos, sin = _rope_tables(positions)
    q_pe = _rope(q_pe, cos[:, :, None], sin[:, :, None])
    k_pe = _rope(k_pe, cos, sin)
    o = _mla_attention(q_nope, q_pe, k_nope, k_pe, v)
    return o.reshape(b, s, MLA_HEADS * MLA_V) @ w_out


def _hier_moe(h, wr_g, br_g, wr_e, br_e, w_gate, w_up, w_down):
    b, s, d = h.shape
    t = b * s
    xt = h.reshape(t, d)
    lg = (xt @ wr_g).astype(F32) + br_g.astype(F32)
    pg = jax.nn.softmax(lg, -1)
    grp = jnp.argmax(lg, -1).astype(jnp.int32)
    pg_sel = jnp.take_along_axis(pg, grp[:, None], -1)
    le = ((xt @ wr_e).astype(F32) + br_e.astype(F32)).reshape(t, MOE_GROUPS, MOE_PER_GROUP)
    le = jnp.take_along_axis(le, grp[:, None, None], 1)[:, 0]
    top_p, top_i = lax.top_k(jax.nn.softmax(le, -1), MOE_TOPK)
    gates = pg_sel * top_p / jnp.sum(top_p, -1, keepdims=True)
    experts = grp[:, None] * MOE_PER_GROUP + top_i.astype(jnp.int32)
    n_assign = t * MOE_TOPK
    e_flat = experts.reshape(-1)
    g_flat = gates.reshape(-1)
    tok_flat = jnp.repeat(jnp.arange(t, dtype=jnp.int32), MOE_TOPK)
    order = jnp.argsort(e_flat)
    e_sorted = e_flat[order]
    counts = jnp.bincount(e_flat, length=MOE_EXPERTS)
    padded = (counts + MOE_BLOCK - 1) // MOE_BLOCK * MOE_BLOCK
    pad_end = jnp.cumsum(padded)
    pad_start = pad_end - padded
    start = jnp.cumsum(counts) - counts
    dest = pad_start[e_sorted] + jnp.arange(n_assign) - start[e_sorted]
    n_rows = n_assign + MOE_EXPERTS * MOE_BLOCK
    n_blocks = n_rows // MOE_BLOCK
    row_tok = jnp.full((n_rows,), t, jnp.int32).at[dest].set(tok_flat[order])
    row_gate = jnp.zeros((n_rows,), F32).at[dest].set(g_flat[order])
    block_expert = jnp.minimum(
        jnp.searchsorted(pad_end, jnp.arange(n_blocks) * MOE_BLOCK, side='right'), MOE_EXPERTS - 1)
    x_pad = jnp.concatenate([xt, jnp.zeros((1, d), xt.dtype)], 0)
    xs = x_pad[row_tok].reshape(n_blocks, MOE_BLOCK, d)

    def expert_block(args):
        e, xb = args
        hid = jax.nn.silu(xb @ w_gate[e]) * (xb @ w_up[e])
        return hid @ w_down[e]

    ys = lax.map(expert_block, (block_expert, xs)).reshape(n_rows, d)
    ys = ys * row_gate[:, None].astype(ys.dtype)
    out = jax.ops.segment_sum(ys, row_tok, num_segments=t + 1)[:t]
    return out.reshape(b, s, d)


def setup_inputs(seed: int = 0) -> dict:
    key = jax.random.key(seed)
    ks = iter(jax.random.split(key, 48))

    def nrm(shape, std):
        return jax.random.normal(next(ks), shape, F32) * std

    ne, no, D = N_EVEN, N_ODD, D_MODEL
    x = nrm((BATCH, SEQ, D), 1.0)
    c = nrm((BATCH, D), 1.0)
    positions = (jax.random.randint(next(ks), (BATCH, 1), 0, MAX_POS_OFFSET, jnp.int32)
                 + jnp.arange(SEQ, dtype=jnp.int32)[None, :])
    ada_w = nrm((DEPTH, D, 6 * D), 0.1 * D ** -0.5)
    ada_b = nrm((DEPTH, 6 * D), 0.01)
    ln_g = 1.0 + nrm((DEPTH, 2, D), 0.02)
    ln_b = nrm((DEPTH, 2, D), 0.02)
    hyb_w_in = nrm((ne, D, HYB_IN), D ** -0.5)
    gdn_conv_w = nrm((ne, GDN_CONV, 3 * GDN_WIDTH), GDN_CONV ** -0.5)
    gdn_a_log = jnp.log(jax.random.uniform(next(ks), (ne, GDN_HEADS), F32, 1.0, 16.0))
    dt = jnp.exp(jax.random.uniform(next(ks), (ne, GDN_HEADS), F32, math.log(1e-3), math.log(1e-1)))
    gdn_dt_bias = dt + jnp.log(-jnp.expm1(-dt))
    gdn_norm_w = 1.0 + nrm((ne, GDN_HEAD_DIM), 0.02)
    sc_conv_w = nrm((ne, SC_CONV, SC_WIDTH), SC_CONV ** -0.5)
    hyb_w_out = nrm((ne, HYB_OUT, D), DN_BETA * HYB_OUT ** -0.5)
    mla_w_in = nrm((no, D, MLA_IN), D ** -0.5)
    mla_q_norm = 1.0 + nrm((no, MLA_Q_RANK), 0.02)
    mla_kv_norm = 1.0 + nrm((no, MLA_KV_RANK), 0.02)
    mla_w_uq = nrm((no, MLA_Q_RANK, MLA_HEADS * (MLA_NOPE + MLA_ROPE)), MLA_Q_RANK ** -0.5)
    mla_w_ukv = nrm((no, MLA_KV_RANK, MLA_HEADS * (MLA_NOPE + MLA_V)), MLA_KV_RANK ** -0.5)
    mla_w_out = nrm((no, MLA_HEADS * MLA_V, D), DN_BETA * (MLA_HEADS * MLA_V) ** -0.5)
    moe_router_g = nrm((DEPTH, D, MOE_GROUPS), D ** -0.5)
    moe_bias_g = nrm((DEPTH, MOE_GROUPS), 0.01)
    moe_router_e = nrm((DEPTH, D, MOE_EXPERTS), D ** -0.5)
    moe_bias_e = nrm((DEPTH, MOE_EXPERTS), 0.01)
    moe_w_gate = nrm((DEPTH, MOE_EXPERTS, D, MOE_FF), D ** -0.5)
    moe_w_up = nrm((DEPTH, MOE_EXPERTS, D, MOE_FF), D ** -0.5)
    moe_w_down = nrm((DEPTH, MOE_EXPERTS, MOE_FF, D), DN_BETA * MOE_FF ** -0.5)
    return {"x": x, "c": c, "positions": positions, "ada_w": ada_w, "ada_b": ada_b,
            "ln_g": ln_g, "ln_b": ln_b, "hyb_w_in": hyb_w_in, "gdn_conv_w": gdn_conv_w,
            "gdn_a_log": gdn_a_log, "gdn_dt_bias": gdn_dt_bias, "gdn_norm_w": gdn_norm_w,
            "sc_conv_w": sc_conv_w, "hyb_w_out": hyb_w_out, "mla_w_in": mla_w_in,
            "mla_q_norm": mla_q_norm, "mla_kv_norm": mla_kv_norm, "mla_w_uq": mla_w_uq,
            "mla_w_ukv": mla_w_ukv, "mla_w_out": mla_w_out, "moe_router_g": moe_router_g,
            "moe_bias_g": moe_bias_g, "moe_router_e": moe_router_e, "moe_bias_e": moe_bias_e,
            "moe_w_gate": moe_w_gate, "moe_w_up": moe_w_up, "moe_w_down": moe_w_down}


def reference(x, c, positions, ada_w, ada_b, ln_g, ln_b, hyb_w_in, gdn_conv_w, gdn_a_log,
              gdn_dt_bias, gdn_norm_w, sc_conv_w, hyb_w_out, mla_w_in, mla_q_norm, mla_kv_norm,
              mla_w_uq, mla_w_ukv, mla_w_out, moe_router_g, moe_bias_g, moe_router_e, moe_bias_e,
              moe_w_gate, moe_w_up, moe_w_down):
    c_act = jax.nn.silu(c)
    for layer in range(DEPTH):
        mod = (c_act @ ada_w[layer] + ada_b[layer])[:, None, :]
        sh1, sc1, g1, sh2, sc2, g2 = jnp.split(mod, 6, -1)
        hin = x * (1.0 + sc1) + sh1
        i = layer // 2
        if layer % 2 == 0:
            y = _gdn_shortconv_mixer(hin, hyb_w_in[i], gdn_conv_w[i], gdn_a_log[i], gdn_dt_bias[i],
                                     gdn_norm_w[i], sc_conv_w[i], hyb_w_out[i])
        else:
            y = _mla_mixer(hin, positions, mla_w_in[i], mla_q_norm[i], mla_kv_norm[i],
                           mla_w_uq[i], mla_w_ukv[i], mla_w_out[i])
        x = _layer_norm(DN_ALPHA * x + (1.0 + g1) * y, ln_g[layer, 0], ln_b[layer, 0])
        hin = x * (1.0 + sc2) + sh2
        y = _hier_moe(hin, moe_router_g[layer], moe_bias_g[layer], moe_router_e[layer],
                      moe_bias_e[layer], moe_w_gate[layer], moe_w_up[layer], moe_w_down[layer])
        x = _layer_norm(DN_ALPHA * x + (1.0 + g2) * y, ln_g[layer, 1], ln_b[layer, 1])
    return x
```

```cpp
#include <hip/hip_runtime.h>
#include <cstdio>
#include <cstdint>

#ifndef MK_ONE_LAUNCH
#define MK_ONE_LAUNCH 1
#endif

#define DI __device__ __forceinline__
#define GAS __attribute__((address_space(1)))
#define LAS __attribute__((address_space(3)))
typedef unsigned short bf16;
typedef float f32x4 __attribute__((ext_vector_type(4)));
typedef float f32x2 __attribute__((ext_vector_type(2)));
typedef float f32x16 __attribute__((ext_vector_type(16)));
typedef short bf16x8 __attribute__((ext_vector_type(8)));
typedef short s16x4 __attribute__((ext_vector_type(4)));
typedef unsigned u32x4 __attribute__((ext_vector_type(4)));
typedef unsigned u32x2 __attribute__((ext_vector_type(2)));
typedef __bf16 bf16x2_t __attribute__((ext_vector_type(2)));
typedef GAS unsigned gu32;
#define RLX_AGENT __ATOMIC_RELAXED, __HIP_MEMORY_SCOPE_AGENT
#define LDS_WAIT() asm volatile("s_waitcnt lgkmcnt(0)" ::: "memory")
#define VM_WAIT() asm volatile("s_waitcnt vmcnt(0)" ::: "memory")
#define MFMA32(a, b, c) __builtin_amdgcn_mfma_f32_32x32x16_bf16((a), (b), (c), 0, 0, 0)

DI unsigned cvtpk(float lo, float hi) { f32x2 v = {lo, hi}; bf16x2_t b = __builtin_convertvector(v, bf16x2_t); return __builtin_bit_cast(unsigned, b); }
DI bf16 f2bf(float f) { return (bf16)(cvtpk(f, 0.f) & 0xffffu); }
DI float bf2f(bf16 b) { return __uint_as_float(((unsigned)b) << 16); }
DI float bflo(unsigned w) { return __uint_as_float(w << 16); }
DI float bfhi(unsigned w) { return __uint_as_float(w & 0xffff0000u); }
DI int crow(int reg, int h) { return (reg & 3) + 8 * (reg >> 2) + 4 * h; }
DI int kperm(int j, int h) { return 8 * (j >> 2) + 4 * h + (j & 3); }
DI float wave_sum(float v) {
#pragma unroll
    for (int o = 1; o < 64; o <<= 1) v += __shfl_xor(v, o);
    return v;
}
DI bf16x8 pack_acc(const f32x16& x, int s) {
    u32x4 p; p.x = cvtpk(x[8 * s + 0], x[8 * s + 1]); p.y = cvtpk(x[8 * s + 2], x[8 * s + 3]); p.z = cvtpk(x[8 * s + 4], x[8 * s + 5]); p.w = cvtpk(x[8 * s + 6], x[8 * s + 7]);
    return __builtin_bit_cast(bf16x8, p);
}
DI float silu_f(float x) { return x / (1.f + __expf(-x)); }
template <class P> DI P* opaque_ptr(P* p) { asm volatile("" : "+v"(p)); return p; }

constexpr int D = 2048, BATCH = 4, SEQ = 2048, T = BATCH * SEQ;
constexpr int GH = 8, GD = 128, NCHK = 32, CHK = 64, NCH = BATCH * GH * NCHK;
constexpr int HYB_IN = 7184, NIN = 7424, NP = 7168;
constexpr int MH = 16, MLA_IN = 1088, NMLA = 1280, QD = 192;
constexpr int NE = 64, FF = 512, MAXBLK = 128;
constexpr float DN_ALPHA = 1.41421356237f;
constexpr float QSCALE = 0.10411754627697264f;
constexpr int NPH = 27;

constexpr size_t MiB = 1u << 20;
constexpr size_t WS_CTL = 0, CTL_ZERO_BYTES = 1 * MiB;
constexpr size_t WS_MOD = 1 * MiB;
constexpr size_t WS_ROPE = 2 * MiB;
constexpr size_t WS_PBA = 4 * MiB;
constexpr size_t WS_LOGITS = 5 * MiB;
constexpr size_t WS_ROUTE = 9 * MiB;
constexpr size_t WS_EG = 10 * MiB;
constexpr size_t WS_WIN0 = 16 * MiB;
constexpr size_t WS_WOUT0 = 46 * MiB;
constexpr size_t WS_WMIN = 54 * MiB;
constexpr size_t WS_WUQ = 59 * MiB;
constexpr size_t WS_WUKV = 62 * MiB;
constexpr size_t WS_WMOUT = 66 * MiB;
constexpr size_t WS_WRT = 74 * MiB;
constexpr size_t WS_WGU = 80 * MiB;
constexpr size_t WS_WDN = 592 * MiB;
constexpr size_t WS_HIN = 848 * MiB;
constexpr size_t WS_XA = 880 * MiB;
constexpr size_t WS_XB = 944 * MiB;
constexpr size_t WS_R = 1008 * MiB;
constexpr size_t WS_P = 1072 * MiB;
constexpr size_t WS_GF = 1184 * MiB;
constexpr size_t WS_GU = 1240 * MiB;
constexpr size_t WS_GO = 1272 * MiB;
constexpr size_t WS_YAB = 1304 * MiB;
constexpr size_t WS_XS = 1336 * MiB;
constexpr size_t WS_HID = 1464 * MiB;
constexpr size_t WS_YS = 1496 * MiB;
constexpr size_t WS_C1 = 1624 * MiB;
constexpr size_t WS_CQN = 1664 * MiB;
constexpr size_t WS_CKVN = 1672 * MiB;
constexpr size_t WS_KPE = 1680 * MiB;
constexpr size_t WS_Q = 1684 * MiB;
constexpr size_t WS_K = 1732 * MiB;
constexpr size_t WS_V = 1780 * MiB;
constexpr size_t WS_VT = 1812 * MiB;
constexpr size_t WS_END = 1844 * MiB;
constexpr int CW_BAR = 4096;
constexpr int CW_CNT = 8192;
constexpr int CW_BLK = 8448;

constexpr int RING_BYTES = 131072;
constexpr int LDSCTL_OFF = 143360, MISC_OFF = LDSCTL_OFF + 320;
constexpr int TAB_OFF = LDSCTL_OFF + 512;
constexpr int SC_OFF = LDSCTL_OFF + 1536;
constexpr int LDS_BYTES = 147456;

namespace pg8 {
constexpr int BM = 256, BK = 64, HALF = 128, HTB = HALF * BK * 2, STAGE_BYTES = 8 * HTB, NXCD = 8, WGM = 8;
__host__ __device__ __forceinline__ int lds_byte(int r, int c) { const int st = (r >> 4) * 2 + (c >> 5), rr = r & 15, cc = c & 31, ob = rr * 64 + cc * 2; return st * 1024 + (ob ^ (((ob >> 9) & 1) << 5)); }
__host__ __device__ __forceinline__ void stage_rc(int b, int& R, int& C) { const int st = b / 1024, sb = b % 1024, swz = sb ^ (((sb >> 9) & 1) << 5); R = (st >> 1) * 16 + swz / 64; C = (st & 1) * 32 + (swz % 64) / 2; }
__host__ __device__ __forceinline__ int perm32(int rho) { const int n = rho >> 4, i = rho & 15; return 8 * (i >> 2) + 4 * n + (i & 3); }

struct Unit { int pm, pn, ex; };

struct StaticOrder {
    int nM, nN, nwg, G, c; const char* A; const char* Bt; size_t tstep;
    __device__ void init(const bf16* A_, const bf16* Bt_, int M, int N, int K, int G_, int c_) { nM = M / BM; nN = N / BM; nwg = nM * nN; G = G_; c = c_; A = (const char*)A_; Bt = (const char*)Bt_; tstep = (size_t)BM * K * 2; }
    __device__ bool next(int i, Unit& u) const {
        const long L = (long)i * G + c; if (L >= nwg) return false;
        int wgid = (int)L; { const int q = nwg / NXCD, r = nwg % NXCD, xcd = wgid % NXCD, off = wgid / NXCD; wgid = (xcd < r ? xcd * (q + 1) : r * (q + 1) + (xcd - r) * q) + off; }
        const int nig = WGM * nN, gid = wgid / nig, fm = gid * WGM, gsz = (nM - fm) < WGM ? (nM - fm) : WGM;
        u.pm = fm + ((wgid % nig) % gsz); u.pn = (wgid % nig) / gsz; u.ex = 0; return true;
    }
    __device__ __forceinline__ const char* aptr(const Unit& u) const { return A + (size_t)u.pm * tstep; }
    __device__ __forceinline__ const char* bptr(const Unit& u) const { return Bt + (size_t)u.pn * tstep; }
};
struct MoeOrder {
    int nunits, NT, G, c; const LAS int* blk_e; const char* A; const char* W; size_t a_tstep, w_estride, w_tstep;
    __device__ bool next(int i, Unit& u) const {
        const long L = (long)i * G + c; if (L >= nunits) return false;
        u.pm = (int)L / NT; u.pn = (int)L % NT; u.ex = blk_e[u.pm]; return true;
    }
    __device__ __forceinline__ const char* aptr(const Unit& u) const { return A + (size_t)u.pm * a_tstep; }
    __device__ __forceinline__ const char* bptr(const Unit& u) const { return W + (size_t)u.ex * w_estride + (size_t)u.pn * w_tstep; }
};

template <class Epi, class Sched, bool ALIGN_EPI = true, bool SP2 = true>
__device__ __forceinline__ void gemm_phase(LAS unsigned char* lds, const int K_, const Sched& S, const Epi& E, const int tid, const int wid) {
    const int lane = tid & 63, wr = wid >> 2, wc = wid & 3, fr = lane & 15, fq = lane >> 4;
    int K = K_; asm volatile("" : "+s"(K));
    const int nt = K / BK;
    unsigned voffA[2], voffB[2];
#pragma unroll
    for (int i = 0; i < 2; ++i) { int R, C; stage_rc(tid * 16 + i * 8192, R, C); const int Rb = Epi::PERM ? ((R & ~31) + perm32(R & 31)) : R;
        voffA[i] = (unsigned)(R * K + C) * 2u; voffB[i] = (unsigned)(Rb * K + C) * 2u; }
    const size_t kstep = (size_t)(BK * 2);
    const size_t hstep = (size_t)HALF * K * 2;
    const unsigned ldsw = (unsigned)wid * 1024u;
    const int aoff = lds_byte(wr * 64 + fr, fq * 8), boff = lds_byte(wc * 32 + fr, fq * 8);
#define PG8_SA(b, h) (((b) * 2 + (h)) * HTB)
#define PG8_SB(b, h) ((4 + (b) * 2 + (h)) * HTB)
#define PG8_STAGE(bufoff, gbase, voff) do { _Pragma("unroll") for (int _i = 0; _i < 2; ++_i) \
        __builtin_amdgcn_global_load_lds((const unsigned*)((const char*)(gbase) + (voff)[_i]), (LAS unsigned*)(lds + (bufoff) + ldsw + _i * 8192), 16, 0, 0); } while (0)
#define PG8_LDA(dst, b, h) do { _Pragma("unroll") for (int m = 0; m < 4; ++m) _Pragma("unroll") for (int k = 0; k < 2; ++k) dst[m][k] = *(const LAS bf16x8*)(lds + PG8_SA(b, h) + aoff + m * 2048 + k * 1024); } while (0)
#define PG8_LDB(dst, b, h) do { _Pragma("unroll") for (int n = 0; n < 2; ++n) _Pragma("unroll") for (int k = 0; k < 2; ++k) dst[n][k] = *(const LAS bf16x8*)(lds + PG8_SB(b, h) + boff + n * 2048 + k * 1024); } while (0)
#define PG8_MMA(ai, bj, At, Bt) do { __builtin_amdgcn_s_setprio(1); _Pragma("unroll") for (int m = 0; m < 4; ++m) _Pragma("unroll") for (int n = 0; n < 2; ++n) _Pragma("unroll") for (int k = 0; k < 2; ++k) \
        acc[ai][bj][m][n] = __builtin_amdgcn_mfma_f32_16x16x32_bf16(Bt[n][k], At[m][k], acc[ai][bj][m][n], 0, 0, 0); __builtin_amdgcn_s_setprio(0); } while (0)
#define PG8_WAIT_V(n) asm volatile("s_waitcnt vmcnt(" #n ")" ::: "memory")
#define PG8_WAIT_L(n) asm volatile("s_waitcnt lgkmcnt(" #n ")" ::: "memory")
#define PG8_BAR __builtin_amdgcn_s_barrier()
#define PG8_SCHED __builtin_amdgcn_sched_barrier(0)
    Unit cur, nxt; int ui = 0;
    if (!S.next(0, cur)) return;
    f32x4 acc[2][2][4][2];
#pragma unroll
    for (int a = 0; a < 2; ++a)
#pragma unroll
        for (int b = 0; b < 2; ++b)
#pragma unroll
            for (int m = 0; m < 4; ++m)
#pragma unroll
                for (int n = 0; n < 2; ++n) acc[a][b][m][n] = (f32x4){0.f, 0.f, 0.f, 0.f};
    bf16x8 At[4][2], B0[2][2], B1[2][2];
    const char* cA = S.aptr(cur); const char* cB = S.bptr(cur);
    if constexpr (SP2) {
        PG8_STAGE(PG8_SB(0, 0), cB, voffB); PG8_STAGE(PG8_SB(0, 1), cB + hstep, voffB); PG8_STAGE(PG8_SA(0, 0), cA, voffA); PG8_STAGE(PG8_SA(0, 1), cA + hstep, voffA);
        if (wr == 1) PG8_BAR;
        PG8_WAIT_V(2); PG8_BAR;
        PG8_STAGE(PG8_SB(1, 0), cB + kstep, voffB); PG8_STAGE(PG8_SA(1, 0), cA + kstep, voffA); PG8_STAGE(PG8_SB(1, 1), cB + hstep + kstep, voffB);
        PG8_WAIT_V(6); PG8_BAR;
    } else {
        PG8_STAGE(PG8_SB(0, 0), cB, voffB); PG8_STAGE(PG8_SA(0, 0), cA, voffA); PG8_STAGE(PG8_SB(0, 1), cB + hstep, voffB); PG8_STAGE(PG8_SA(0, 1), cA + hstep, voffA);
        if (wr == 1) PG8_BAR;
        PG8_WAIT_V(4); PG8_BAR;
        PG8_STAGE(PG8_SB(1, 0), cB + kstep, voffB); PG8_STAGE(PG8_SA(1, 0), cA + kstep, voffA); PG8_STAGE(PG8_SB(1, 1), cB + hstep + kstep, voffB);
        PG8_WAIT_V(6); PG8_BAR;
    }
    for (;;) {
        const bool has_next = S.next(ui + 1, nxt);
        const char* nA = has_next ? S.aptr(nxt) : cA; const char* nB = has_next ? S.bptr(nxt) : cB;
        for (int t = 0; t < nt; t += 2) {
            const bool last = (t == nt - 2);
            const char* a1 = cA + (size_t)(t + 1) * kstep;
            const char* a2 = last ? nA : cA + (size_t)(t + 2) * kstep; const char* b2 = last ? nB : cB + (size_t)(t + 2) * kstep;
            const char* a3 = a2 + kstep; const char* b3 = b2 + kstep;
            if constexpr (SP2) {
            PG8_LDB(B0, 0, 0); PG8_LDB(B1, 0, 1); PG8_SCHED; PG8_LDA(At, 0, 0); PG8_STAGE(PG8_SA(1, 1), a1 + hstep, voffA);
            PG8_WAIT_V(8); PG8_WAIT_L(0); PG8_BAR; PG8_MMA(0, 0, At, B0); PG8_MMA(0, 1, At, B1); PG8_BAR; PG8_SCHED;
            PG8_LDA(At, 0, 1); PG8_STAGE(PG8_SB(0, 0), b2, voffB); PG8_STAGE(PG8_SB(0, 1), b2 + hstep, voffB); PG8_STAGE(PG8_SA(0, 0), a2, voffA);
            PG8_WAIT_V(8); PG8_WAIT_L(0); PG8_BAR; PG8_MMA(1, 0, At, B0); PG8_MMA(1, 1, At, B1); PG8_BAR; PG8_SCHED;
            PG8_LDB(B0, 1, 0); PG8_LDB(B1, 1, 1); PG8_SCHED; PG8_LDA(At, 1, 0); PG8_STAGE(PG8_SA(0, 1), a2 + hstep, voffA);
            PG8_WAIT_V(8); PG8_WAIT_L(0); PG8_BAR; PG8_MMA(0, 0, At, B0); PG8_MMA(0, 1, At, B1); PG8_BAR; PG8_SCHED;
            PG8_LDA(At, 1, 1); PG8_STAGE(PG8_SB(1, 0), b3, voffB); PG8_STAGE(PG8_SB(1, 1), b3 + hstep, voffB); PG8_STAGE(PG8_SA(1, 0), a3, voffA);
            PG8_WAIT_V(8); PG8_WAIT_L(0); PG8_BAR; PG8_MMA(1, 0, At, B0); PG8_MMA(1, 1, At, B1); PG8_BAR; PG8_SCHED;
            } else {
            PG8_LDB(B0, 0, 0); PG8_SCHED; PG8_LDA(At, 0, 0); PG8_STAGE(PG8_SA(1, 1), a1 + hstep, voffA);
            PG8_WAIT_L(8); PG8_BAR; PG8_WAIT_L(0); PG8_MMA(0, 0, At, B0); PG8_BAR; PG8_SCHED;
            PG8_LDB(B1, 0, 1); PG8_STAGE(PG8_SB(0, 0), b2, voffB);
            PG8_BAR; PG8_WAIT_L(0); PG8_MMA(0, 1, At, B1); PG8_BAR;
            PG8_LDA(At, 0, 1); PG8_STAGE(PG8_SA(0, 0), a2, voffA);
            PG8_BAR; PG8_WAIT_L(0); PG8_MMA(1, 0, At, B0); PG8_BAR; PG8_SCHED;
            PG8_STAGE(PG8_SB(0, 1), b2 + hstep, voffB);
            PG8_WAIT_V(6); PG8_BAR; PG8_MMA(1, 1, At, B1); PG8_BAR;
            PG8_LDB(B0, 1, 0); PG8_SCHED; PG8_LDA(At, 1, 0); PG8_STAGE(PG8_SA(0, 1), a2 + hstep, voffA);
            PG8_WAIT_L(8); PG8_BAR; PG8_WAIT_L(0); PG8_MMA(0, 0, At, B0); PG8_BAR; PG8_SCHED;
            PG8_LDB(B1, 1, 1); PG8_STAGE(PG8_SB(1, 0), b3, voffB);
            PG8_BAR; PG8_WAIT_L(0); PG8_MMA(0, 1, At, B1); PG8_BAR;
            PG8_LDA(At, 1, 1); PG8_STAGE(PG8_SA(1, 0), a3, voffA);
            PG8_BAR; PG8_WAIT_L(0); PG8_MMA(1, 0, At, B0); PG8_BAR; PG8_SCHED;
            PG8_STAGE(PG8_SB(1, 1), b3 + hstep, voffB);
            PG8_WAIT_V(6); PG8_BAR; PG8_MMA(1, 1, At, B1); PG8_BAR;
            }
        }
        if constexpr (ALIGN_EPI) { if (wr == 0) PG8_BAR; }
        E(acc, cur, wr, wc, fr, fq);
        if (!has_next) break;
#pragma unroll
        for (int a = 0; a < 2; ++a)
#pragma unroll
            for (int b = 0; b < 2; ++b)
#pragma unroll
                for (int m = 0; m < 4; ++m)
#pragma unroll
                    for (int n = 0; n < 2; ++n) acc[a][b][m][n] = (f32x4){0.f, 0.f, 0.f, 0.f};
        cur = nxt; cA = nA; cB = nB; ++ui;
        if constexpr (ALIGN_EPI) { if (wr == 1) PG8_BAR; }
    }
    PG8_WAIT_V(0);
    if constexpr (!ALIGN_EPI) { if (wr == 0) PG8_BAR; }
    PG8_BAR;
#undef PG8_SA
#undef PG8_SB
#undef PG8_STAGE
#undef PG8_LDA
#undef PG8_LDB
#undef PG8_MMA
#undef PG8_WAIT_V
#undef PG8_WAIT_L
#undef PG8_BAR
#undef PG8_SCHED
}

typedef const f32x4 (&AccRef)[2][2][4][2];
DI u32x4 pack8(const f32x4& v0, const f32x4& v1) { u32x4 w; w.x = cvtpk(v0[0], v0[1]); w.y = cvtpk(v0[2], v0[3]); w.z = cvtpk(v1[0], v1[1]); w.w = cvtpk(v1[2], v1[3]); return w; }

struct EpiBf16 {
    static constexpr bool PERM = true;
    bf16* O; int ldc;
    DI void operator()(AccRef acc, const Unit& u, int wr, int wc, int fr, int fq) const {
        const int row0 = u.pm * BM + wr * 64 + fr, col0 = u.pn * BM + wc * 32 + 8 * fq;
#pragma unroll
        for (int ai = 0; ai < 2; ++ai)
#pragma unroll
            for (int m = 0; m < 4; ++m) { bf16* rowp = O + (size_t)(row0 + ai * HALF + m * 16) * ldc + col0;
#pragma unroll
                for (int bj = 0; bj < 2; ++bj) *(u32x4*)(rowp + bj * HALF) = pack8(acc[ai][bj][m][0], acc[ai][bj][m][1]); }
    }
};
struct EpiF32 {
    static constexpr bool PERM = false;
    float* C; int ldc;
    DI void operator()(AccRef acc, const Unit& u, int wr, int wc, int fr, int fq) const {
        const int row0 = u.pm * BM + wr * 64 + fr, col0 = u.pn * BM + wc * 32 + 4 * fq;
#pragma unroll
        for (int ai = 0; ai < 2; ++ai)
#pragma unroll
            for (int m = 0; m < 4; ++m) { float* rowp = C + (size_t)(row0 + ai * HALF + m * 16) * ldc + col0;
#pragma unroll
                for (int bj = 0; bj < 2; ++bj)
#pragma unroll
                    for (int n = 0; n < 2; ++n) *(f32x4*)(rowp + bj * HALF + n * 16) = acc[ai][bj][m][n]; }
    }
};
struct EpiInProj {
    static constexpr bool PERM = true;
    bf16* P; float* PBA;
    DI void operator()(AccRef acc, const Unit& u, int wr, int wc, int fr, int fq) const {
        const int row0 = u.pm * BM + wr * 64 + fr;
        if (u.pn < 28) {
            const int col0 = u.pn * BM + wc * 32 + 8 * fq;
#pragma unroll
            for (int ai = 0; ai < 2; ++ai)
#pragma unroll
                for (int m = 0; m < 4; ++m) { bf16* rowp = P + (size_t)(row0 + ai * HALF + m * 16) * NP + col0;
#pragma unroll
                    for (int bj = 0; bj < 2; ++bj) *(u32x4*)(rowp + bj * HALF) = pack8(acc[ai][bj][m][0], acc[ai][bj][m][1]); }
        } else if (wc == 0 && fq < 2) {
#pragma unroll
            for (int ai = 0; ai < 2; ++ai)
#pragma unroll
                for (int m = 0; m < 4; ++m) { float* rp = PBA + (size_t)(row0 + ai * HALF + m * 16) * 16 + 8 * fq;
                    *(f32x4*)rp = acc[ai][0][m][0]; *(f32x4*)(rp + 4) = acc[ai][0][m][1]; }
        }
    }
};
struct EpiResid {
    static constexpr bool PERM = false;
    const float* x; const float* g; float* R;
    DI void operator()(AccRef acc, const Unit& u, int wr, int wc, int fr, int fq) const {
        const int row0 = u.pm * BM + wr * 64 + fr, col0 = u.pn * BM + wc * 32 + 4 * fq;
        const float* gb = g + (size_t)((u.pm * BM) / SEQ) * 12288 + col0;
        f32x4 gv[2][2];
#pragma unroll
        for (int bj = 0; bj < 2; ++bj)
#pragma unroll
            for (int n = 0; n < 2; ++n) gv[bj][n] = *(const f32x4*)(gb + bj * HALF + n * 16) + 1.0f;
#pragma unroll
        for (int ai = 0; ai < 2; ++ai)
#pragma unroll
            for (int m = 0; m < 4; ++m) { const size_t off = (size_t)(row0 + ai * HALF + m * 16) * D + col0;
#pragma unroll
                for (int bj = 0; bj < 2; ++bj)
#pragma unroll
                    for (int n = 0; n < 2; ++n) { const f32x4 xv = *(const f32x4*)(x + off + bj * HALF + n * 16);
                        *(f32x4*)(R + off + bj * HALF + n * 16) = xv * DN_ALPHA + gv[bj][n] * acc[ai][bj][m][n]; } }
    }
};
struct EpiLogits {
    static constexpr bool PERM = false;
    float* L;
    DI void operator()(AccRef acc, const Unit& u, int wr, int wc, int fr, int fq) const {
        const int row0 = u.pm * BM + wr * 64 + fr, col0 = wc * 32 + 4 * fq;
#pragma unroll
        for (int ai = 0; ai < 2; ++ai)
#pragma unroll
            for (int m = 0; m < 4; ++m) { float* rowp = L + (size_t)(row0 + ai * HALF + m * 16) * 128 + col0;
#pragma unroll
                for (int n = 0; n < 2; ++n) *(f32x4*)(rowp + n * 16) = acc[ai][0][m][n]; }
    }
};
struct EpiGateUp {
    static constexpr bool PERM = true;
    bf16* H;
    DI void operator()(AccRef acc, const Unit& u, int wr, int wc, int fr, int fq) const {
        const int row0 = u.pm * BM + wr * 64 + fr, col0 = u.pn * HALF + wc * 32 + 8 * fq;
#pragma unroll
        for (int ai = 0; ai < 2; ++ai)
#pragma unroll
            for (int m = 0; m < 4; ++m) { bf16* rowp = H + (size_t)(row0 + ai * HALF + m * 16) * FF + col0;
                f32x4 h0, h1;
#pragma unroll
                for (int j = 0; j < 4; ++j) { h0[j] = silu_f(acc[ai][0][m][0][j]) * acc[ai][1][m][0][j]; h1[j] = silu_f(acc[ai][0][m][1][j]) * acc[ai][1][m][1][j]; }
                *(u32x4*)rowp = pack8(h0, h1); }
    }
};
struct EpiQup {
    static constexpr bool PERM = true;
    bf16* Q;
    DI void operator()(AccRef acc, const Unit& u, int wr, int wc, int fr, int fq) const {
        const int row0 = u.pm * BM + wr * 64 + fr, b = (u.pm * BM) / SEQ, s0 = row0 - b * SEQ;
        const int cg0 = u.pn * BM + wc * 32 + 8 * fq, cg1 = cg0 + HALF;
        const int h0 = cg0 / QD, w0 = cg0 - h0 * QD, h1 = cg1 / QD, w1 = cg1 - h1 * QD;
        bf16* d0 = Q + ((size_t)((b * MH + h0) * SEQ + s0)) * QD + w0; bf16* d1 = Q + ((size_t)((b * MH + h1) * SEQ + s0)) * QD + w1;
#pragma unroll
        for (int ai = 0; ai < 2; ++ai)
#pragma unroll
            for (int m = 0; m < 4; ++m) { const int dr = (ai * HALF + m * 16) * QD;
                *(u32x4*)(d0 + dr) = pack8(acc[ai][0][m][0] * QSCALE, acc[ai][0][m][1] * QSCALE);
                *(u32x4*)(d1 + dr) = pack8(acc[ai][1][m][0] * QSCALE, acc[ai][1][m][1] * QSCALE);
                asm volatile("" ::: "memory"); }
    }
};
struct EpiKVup {
    static constexpr bool PERM = true;
    bf16* Kp; bf16* V;
    DI void operator()(AccRef acc, const Unit& u, int wr, int wc, int fr, int fq) const {
        const int row0 = u.pm * BM + wr * 64 + fr, c0 = wc * 32 + 8 * fq, head = u.pn, b = (u.pm * BM) / SEQ, s0 = row0 - b * SEQ;
        bf16* dk = Kp + ((size_t)((b * MH + head) * SEQ + s0)) * QD + c0; bf16* dv = V + (size_t)row0 * D + head * 128 + c0;
#pragma unroll
        for (int ai = 0; ai < 2; ++ai)
#pragma unroll
            for (int m = 0; m < 4; ++m) { const int dr = ai * HALF + m * 16;
                *(u32x4*)(dk + dr * QD) = pack8(acc[ai][0][m][0], acc[ai][0][m][1]);
                *(u32x4*)(dv + dr * D) = pack8(acc[ai][1][m][0], acc[ai][1][m][1]);
                asm volatile("" ::: "memory"); }
    }
};
}

#define XB_TMO      128
#define XB_XCNT(j)  (256  + 64 * (j))
#define XB_XSUB(j)  (1280 + 64 * (j))
#define XB_XGEN(j)  (2304 + 64 * (j))
#define XB_TOP      3328
#define XB_TOPGEN   3392
#define XCD_BAR_WORDS 3456
#define XB_SPIN_CAP (1u << 18)
__device__ __forceinline__ unsigned xb_ld(unsigned* p)              { return __hip_atomic_load(p, __ATOMIC_RELAXED, __HIP_MEMORY_SCOPE_AGENT); }
__device__ __forceinline__ unsigned xb_add(unsigned* p, unsigned v) { return __hip_atomic_fetch_add(p, v, __ATOMIC_RELAXED, __HIP_MEMORY_SCOPE_AGENT); }
__device__ __forceinline__ unsigned xb_xcc_id() { return (unsigned)__builtin_amdgcn_s_getreg((3 << 11) | 20) & 0xFu; }
#define XB_SPIN(cond, bar) do { unsigned _sp = 0; while (cond) { __builtin_amdgcn_s_sleep(1); \
    if ((++_sp & 255u) == 0u) { if (xb_ld(&(bar)[XB_TMO])) break; if (_sp > XB_SPIN_CAP) { atomicAdd(&(bar)[XB_TMO], 1u); break; } } } } while (0)
struct XcdBarrier { unsigned* bar; unsigned x; volatile LAS unsigned* st; };
__device__ __forceinline__ XcdBarrier xcd_barrier_post(unsigned* bar, volatile LAS unsigned* st, const bool leader  ) {
    XcdBarrier b; b.bar = bar; b.x = xb_xcc_id(); b.st = st;
    if (leader) (void)xb_add(&bar[XB_XCNT(b.x)], 1u);
    return b;
}
__device__ __forceinline__ void xcd_barrier_complete(unsigned* bar, unsigned x, unsigned& nloc, unsigned& nx) {
    const unsigned G = gridDim.x * gridDim.y * gridDim.z;
    unsigned sum, cnt, mine, sp = 0u;
    for (;;) {
        sum = 0u; cnt = 0u; mine = 0u;
#pragma unroll
        for (unsigned j = 0; j < 16; ++j) { const unsigned c = xb_ld(&bar[XB_XCNT(j)]); sum += c; cnt += (c > 0u) ? 1u : 0u; mine = (j == x) ? c : mine; }
        if (sum == G) break;
        __builtin_amdgcn_s_sleep(1);
        if ((++sp & 255u) == 0u) { if (xb_ld(&bar[XB_TMO])) break; if (sp > XB_SPIN_CAP) { atomicAdd(&bar[XB_TMO], 1u); break; } }
    }
    nloc = mine > 0u ? mine : 1u; nx = cnt > 0u ? cnt : 1u;
}
__device__ __forceinline__ void xcd_barrier(const XcdBarrier& b, const bool leader  ) {
    asm volatile("s_waitcnt vmcnt(0)" ::: "memory");
    __syncthreads();
    if (leader) {
        unsigned* bar = b.bar;
        __builtin_amdgcn_s_waitcnt(0);
        unsigned nloc = b.st[0], nx = b.st[1];
        if (nloc == 0u) { xcd_barrier_complete(bar, b.x, nloc, nx); b.st[0] = nloc; b.st[1] = nx; }
        const unsigned old = xb_add(&bar[XB_XSUB(b.x)], 1u);
        const unsigned gen = old / nloc;
        if (old + 1u == (gen + 1u) * nloc) {
            __builtin_amdgcn_fence(__ATOMIC_RELEASE, "agent");
            asm volatile("s_waitcnt vmcnt(0)" ::: "memory");
            const unsigned og = xb_add(&bar[XB_TOP], 1u);
            const unsigned tg = og / nx;
            if (og + 1u == (tg + 1u) * nx) xb_add(&bar[XB_TOPGEN], 1u);
            else XB_SPIN(xb_ld(&bar[XB_TOPGEN]) == tg, bar);
            __builtin_amdgcn_fence(__ATOMIC_ACQUIRE, "agent");
            xb_add(&bar[XB_XGEN(b.x)], 1u);
            asm volatile("s_waitcnt vmcnt(0)" ::: "memory");
        } else {
            XB_SPIN(xb_ld(&bar[XB_XGEN(b.x)]) == gen, bar);
            __builtin_amdgcn_fence(__ATOMIC_ACQUIRE, "agent");
            asm volatile("s_waitcnt vmcnt(0)" ::: "memory");
        }
    }
    __syncthreads();
}

struct Frame {
    LAS unsigned char* lds;
    int tid, lane, wave, vcu, G, gw, NGW;
    unsigned* ctl;
};
struct Args { const void* in[27]; float* out; unsigned char* ws; int ph_lo, ph_hi; };

__device__ const double ROPE_INVF[32] = {1, 0.74989420933245587, 0.56234132519034907, 0.42169650342858223, 0.31622776601683794, 0.23713737056616552, 0.17782794100389229, 0.1333521432163324,
    0.10000000000000001, 0.074989420933245579, 0.056234132519034911, 0.042169650342858224, 0.031622776601683791, 0.023713737056616554, 0.017782794100389229, 0.013335214321633241,
    0.01, 0.0074989420933245579, 0.005623413251903491, 0.0042169650342858229, 0.0031622776601683794, 0.0023713737056616554, 0.0017782794100389228, 0.0013335214321633241,
    0.001, 0.00074989420933245586, 0.0005623413251903491, 0.00042169650342858224, 0.00031622776601683794, 0.00023713737056616554, 0.00017782794100389227, 0.0001333521432163324};

DI void tr_item(const float* W, size_t ld, int k0, int n0, int nvalid, bf16* WT, int Kd, int drow0, LAS float* scr, int lane) {
    const int n = lane & 31;
#pragma unroll 8
    for (int i = 0; i < 32; ++i) { const int kk = 2 * i + (lane >> 5); scr[kk * 33 + n] = (n < nvalid) ? W[(size_t)(k0 + kk) * ld + n0 + n] : 0.f; }
    LDS_WAIT(); asm volatile("" ::: "memory");
    const int c = lane & 7;
#pragma unroll
    for (int j = 0; j < 4; ++j) { const int nn = (lane >> 3) + 8 * j; const LAS float* s = scr + (8 * c) * 33 + nn;
        u32x4 o; o.x = cvtpk(s[0 * 33], s[1 * 33]); o.y = cvtpk(s[2 * 33], s[3 * 33]); o.z = cvtpk(s[4 * 33], s[5 * 33]); o.w = cvtpk(s[6 * 33], s[7 * 33]);
        if (nn < nvalid) *(u32x4*)(WT + (size_t)(drow0 + nn) * Kd + k0 + 8 * c) = o; }
    LDS_WAIT(); asm volatile("" ::: "memory");
}
DI void tr_job(const Frame& F, const float* W, size_t smat, int nmat, int ld, int K, int col0, int ncols, bf16* WT, size_t dmat, int Kd, int row_off, int mode, LAS float* scr) {
    const int nblk = (ncols + 31) / 32, kbs = K / 64, per = nblk * kbs; const long items = (long)nmat * per;
    for (long it = F.gw; it < items; it += F.NGW) {
        const int mat = (int)(it / per), rem = (int)(it - (long)mat * per), kb = rem / nblk, nb = rem - kb * nblk;
        const int nvalid = (ncols - nb * 32) < 32 ? (ncols - nb * 32) : 32;
        const int drow0 = (mode == 0) ? (row_off + nb * 32) : ((nb >> 2) * 256 + row_off + (nb & 3) * 32);
        tr_item(W + (size_t)mat * smat, (size_t)ld, kb * 64, col0 + nb * 32, nvalid, WT + (size_t)mat * dmat, Kd, drow0, scr, F.lane);
    }
}
DI void zero_fill(const Frame& F, void* p, size_t bytes) {
    u32x4* q = (u32x4*)p; const size_t n = bytes / 16;
    for (size_t i = (size_t)F.gw * 64 + F.lane; i < n; i += (size_t)F.NGW * 64) q[i] = (u32x4){0u, 0u, 0u, 0u};
}

DI const void* arg_in(int k) { unsigned o = (unsigned)k * 8u; asm volatile("" : "+s"(o));
    return *(const void* const __attribute__((address_space(4)))*)((const __attribute__((address_space(4))) unsigned char*)__builtin_amdgcn_kernarg_segment_ptr() + o); }
#define WSB (args.ws)
#define in_x ((const float*)arg_in(0))
#define in_c ((const float*)arg_in(1))
#define in_pos ((const int*)arg_in(2))
#define ada_w ((const float*)arg_in(3))
#define ada_b ((const float*)arg_in(4))
#define ln_g ((const float*)arg_in(5))
#define ln_b ((const float*)arg_in(6))
#define hyb_w_in ((const float*)arg_in(7))
#define gdn_conv_w ((const float*)arg_in(8))
#define gdn_a_log ((const float*)arg_in(9))
#define gdn_dt_bias ((const float*)arg_in(10))
#define gdn_norm_w ((const float*)arg_in(11))
#define sc_conv_w ((const float*)arg_in(12))
#define hyb_w_out ((const float*)arg_in(13))
#define mla_w_in ((const float*)arg_in(14))
#define mla_q_norm ((const float*)arg_in(15))
#define mla_kv_norm ((const float*)arg_in(16))
#define mla_w_uq ((const float*)arg_in(17))
#define mla_w_ukv ((const float*)arg_in(18))
#define mla_w_out ((const float*)arg_in(19))
#define moe_router_g ((const float*)arg_in(20))
#define moe_bias_g ((const float*)arg_in(21))
#define moe_router_e ((const float*)arg_in(22))
#define moe_bias_e ((const float*)arg_in(23))
#define moe_w_gate ((const float*)arg_in(24))
#define moe_w_up ((const float*)arg_in(25))
#define moe_w_down ((const float*)arg_in(26))
#define MOD ((float*)(WSB + WS_MOD))
#define ROPE_C ((float*)(WSB + WS_ROPE))
#define ROPE_S ((float*)(ROPE_C + (size_t)T * 32))
#define PBA ((float*)(WSB + WS_PBA))
#define LOGITS ((float*)(WSB + WS_LOGITS))
#define TOK_E ((int*)(WSB + WS_ROUTE))
#define TOK_POS ((int*)(TOK_E + 2 * T))
#define TOK_GATE ((float*)(TOK_POS + 2 * T))
#define EG ((float*)(WSB + WS_EG))
#define WIN0 ((bf16*)(WSB + WS_WIN0))
#define WOUT0 ((bf16*)(WSB + WS_WOUT0))
#define WMIN ((bf16*)(WSB + WS_WMIN))
#define WUQ ((bf16*)(WSB + WS_WUQ))
#define WUKV ((bf16*)(WSB + WS_WUKV))
#define WMOUT ((bf16*)(WSB + WS_WMOUT))
#define WRT ((bf16*)(WSB + WS_WRT))
#define WGU ((bf16*)(WSB + WS_WGU))
#define WDN ((bf16*)(WSB + WS_WDN))
#define HIN ((bf16*)(WSB + WS_HIN))
#define XA ((float*)(WSB + WS_XA))
#define XB ((float*)(WSB + WS_XB))
#define RB ((float*)(WSB + WS_R))
#define PB ((bf16*)(WSB + WS_P))
#define GF ((unsigned char*)(WSB + WS_GF))
#define GU ((unsigned char*)(WSB + WS_GU))
#define GO ((float*)(WSB + WS_GO))
#define YAB ((bf16*)(WSB + WS_YAB))
#define XS ((bf16*)(WSB + WS_XS))
#define HID ((bf16*)(WSB + WS_HID))
#define YS ((bf16*)(WSB + WS_YS))
#define C1 ((float*)(WSB + WS_C1))
#define CQN ((bf16*)(WSB + WS_CQN))
#define CKVN ((bf16*)(WSB + WS_CKVN))
#define KPE ((float*)(WSB + WS_KPE))
#define QB_ ((bf16*)(WSB + WS_Q))
#define KB_ ((bf16*)(WSB + WS_K))
#define VB_ ((bf16*)(WSB + WS_V))
#define VT ((bf16*)(WSB + WS_VT))


#define LN_ROW(v, gptr, bptr) do { float _s = 0.f; _Pragma("unroll") for (int _j = 0; _j < 8; ++_j) _s += (v[_j][0] + v[_j][1]) + (v[_j][2] + v[_j][3]); \
        const float _mean = wave_sum(_s) * (1.f / D); float _q = 0.f; \
        _Pragma("unroll") for (int _j = 0; _j < 8; ++_j) { v[_j] = v[_j] - _mean; _q += (v[_j][0] * v[_j][0] + v[_j][1] * v[_j][1]) + (v[_j][2] * v[_j][2] + v[_j][3] * v[_j][3]); } \
        const float _rstd = rsqrtf(wave_sum(_q) * (1.f / D) + 1e-5f); \
        _Pragma("unroll") for (int _j = 0; _j < 8; ++_j) v[_j] = v[_j] * _rstd * ((const f32x4*)(gptr))[F.lane + 64 * _j] + ((const f32x4*)(bptr))[F.lane + 64 * _j]; } while (0)
#define WRITE_X_HIN(v, xrow, hrow, shp, scp) do { _Pragma("unroll") for (int _j = 0; _j < 8; ++_j) { ((f32x4*)(xrow))[F.lane + 64 * _j] = v[_j]; \
        if ((hrow) != nullptr) { const f32x4 _h = v[_j] * (((const f32x4*)(scp))[F.lane + 64 * _j] + 1.0f) + ((const f32x4*)(shp))[F.lane + 64 * _j]; \
            u32x2 _w; _w.x = cvtpk(_h[0], _h[1]); _w.y = cvtpk(_h[2], _h[3]); ((u32x2*)(hrow))[F.lane + 64 * _j] = _w; } } } while (0)


#ifndef PHMASK
#define PHMASK 0xFFFFFFFFull
#endif
#define PH_EN(k) (((PHMASK) >> (k)) & 1ull)
#define IN(k) (PH_EN(k) && lo <= (k) && (k) < hi)
#define INL(k0, k1) ((L == 0) ? IN(k0) : IN(k1))
#define PHASE_FRESH() do { int _l; asm volatile("v_mbcnt_lo_u32_b32 %0, -1, 0\n\tv_mbcnt_hi_u32_b32 %0, -1, %0" : "=v"(_l)); F.lane = _l; F.tid = F.wave * 64 + _l; } while (0)
#define SEAM(k) do { if (IN(k) && IN((k) + 1)) { PHASE_FRESH(); xcd_barrier(bar, F.tid == 0); } } while (0)

template <int L> DI void moe_phases(Frame& F, const Args& args, const XcdBarrier& bar, const int lo, const int hi, LAS int* TAB) {
        unsigned* cnt = F.ctl + CW_CNT + L * 64;
    if (INL(8, 21)) { PHASE_FRESH();
        pg8::StaticOrder S; S.init(HIN, WRT + (size_t)L * 256 * D, T, 256, D, F.G, (int)blockIdx.x);
        pg8::EpiLogits E{LOGITS};
        pg8::gemm_phase<pg8::EpiLogits, pg8::StaticOrder>(F.lds, D, S, E, F.tid, F.wave);
    }
    if (L == 0) SEAM(8); else SEAM(21);
    if (INL(9, 22)) { PHASE_FRESH();
        const float* bg = moe_bias_g + L * 8; const float* be = moe_bias_e + L * 64;
        for (int t = blockIdx.x * 512 + F.tid; t < T; t += F.G * 512) {
            const float* lg = LOGITS + (size_t)t * 128;
            float l8[8]; float mx = -3.0e38f; int grp = 0;
#pragma unroll
            for (int g = 0; g < 8; ++g) { l8[g] = lg[g] + bg[g]; if (l8[g] > mx) { mx = l8[g]; grp = g; } }
            float se = 0.f;
#pragma unroll
            for (int g = 0; g < 8; ++g) se += __expf(l8[g] - mx);
            const float pg = 1.f / se;
            float e8[8];
#pragma unroll
            for (int j = 0; j < 8; ++j) e8[j] = lg[8 + grp * 8 + j] + be[grp * 8 + j];
            int i1 = 0; float m1 = e8[0];
#pragma unroll
            for (int j = 1; j < 8; ++j) if (e8[j] > m1) { m1 = e8[j]; i1 = j; }
            int i2 = -1; float m2 = -3.0e38f;
#pragma unroll
            for (int j = 0; j < 8; ++j) if (j != i1 && e8[j] > m2) { m2 = e8[j]; i2 = j; }
            const float rr = __expf(m2 - m1), g1 = pg / (1.f + rr), g2 = pg * rr / (1.f + rr);
            const int ex1 = grp * 8 + i1, ex2 = grp * 8 + i2;
            const int p1 = (int)atomicAdd(&cnt[ex1], 1u), p2 = (int)atomicAdd(&cnt[ex2], 1u);
            TOK_E[2 * t] = ex1; TOK_E[2 * t + 1] = ex2; TOK_POS[2 * t] = p1; TOK_POS[2 * t + 1] = p2; TOK_GATE[2 * t] = g1; TOK_GATE[2 * t + 1] = g2;
        }
    }
    if (L == 0) SEAM(9); else SEAM(22);
    if (INL(10, 23)) { PHASE_FRESH();
        if (F.tid == 0) { int a = 0; for (int e = 0; e < NE; ++e) { TAB[128 + e] = a; const int nb = ((int)cnt[e] + 255) >> 8; for (int q = 0; q < nb; ++q) TAB[a + q] = e; a += nb; } TAB[192] = a; }
        __syncthreads();
        if (blockIdx.x == 0 && F.tid < 129) F.ctl[CW_BLK + L * 256 + F.tid] = (unsigned)((F.tid < 128) ? TAB[F.tid] : TAB[192]);
        for (int a = F.gw; a < 2 * T; a += F.NGW) {
            const int t = a >> 1, e = TOK_E[a], pos = TOK_POS[a], row = TAB[128 + e] * 256 + pos;
            const u32x4* src = (const u32x4*)(HIN + (size_t)t * D) + F.lane; u32x4* dst = (u32x4*)(XS + (size_t)row * D) + F.lane;
#pragma unroll
            for (int j = 0; j < 4; ++j) dst[64 * j] = src[64 * j];
        }
    }
    if (L == 0) SEAM(10); else SEAM(23);
    if (INL(11, 24)) { PHASE_FRESH();
        if (F.tid < 129) TAB[F.tid < 128 ? F.tid : 192] = (int)F.ctl[CW_BLK + L * 256 + F.tid];
        __syncthreads();
        pg8::MoeOrder S; S.nunits = TAB[192] * 4; S.NT = 4; S.G = F.G; S.c = F.vcu; S.blk_e = TAB; S.A = (const char*)XS; S.W = (const char*)(WGU + (size_t)L * 64 * 1024 * D);
        S.a_tstep = (size_t)256 * D * 2; S.w_estride = (size_t)1024 * D * 2; S.w_tstep = (size_t)256 * D * 2;
        pg8::EpiGateUp E{HID};
        pg8::gemm_phase<pg8::EpiGateUp, pg8::MoeOrder>(F.lds, D, S, E, F.tid, F.wave);
    }
    if (L == 0) SEAM(11); else SEAM(24);
    if (INL(12, 25)) { PHASE_FRESH();
        if (F.tid < 129) TAB[F.tid < 128 ? F.tid : 192] = (int)F.ctl[CW_BLK + L * 256 + F.tid];
        __syncthreads();
        pg8::MoeOrder S; S.nunits = TAB[192] * 8; S.NT = 8; S.G = F.G; S.c = F.vcu; S.blk_e = TAB; S.A = (const char*)HID; S.W = (const char*)(WDN + (size_t)L * 64 * D * FF);
        S.a_tstep = (size_t)256 * FF * 2; S.w_estride = (size_t)D * FF * 2; S.w_tstep = (size_t)256 * FF * 2;
        pg8::EpiBf16 E{YS, D};
        pg8::gemm_phase<pg8::EpiBf16, pg8::MoeOrder>(F.lds, FF, S, E, F.tid, F.wave);
    }
    if (L == 0) SEAM(12); else SEAM(25);
    if (INL(13, 26)) { PHASE_FRESH();
        if (F.tid == 0) { int a = 0; for (int e = 0; e < NE; ++e) { TAB[128 + e] = a; a += ((int)cnt[e] + 255) >> 8; } }
        __syncthreads();
        float* xout = (L == 0) ? XB : args.out;
        for (int m = F.gw; m < T; m += F.NGW) {
            const int b = m / SEQ; const float* modb = MOD + (size_t)(L * 4 + b) * 12288;
            const int r0 = TAB[128 + TOK_E[2 * m]] * 256 + TOK_POS[2 * m], r1 = TAB[128 + TOK_E[2 * m + 1]] * 256 + TOK_POS[2 * m + 1];
            const float g0 = TOK_GATE[2 * m], g1 = TOK_GATE[2 * m + 1];
            f32x4 v[8];
#pragma unroll
            for (int j = 0; j < 8; ++j) {
                const f32x4 xv = ((const f32x4*)(XA + (size_t)m * D))[F.lane + 64 * j];
                const u32x2 ya = ((const u32x2*)(YS + (size_t)r0 * D))[F.lane + 64 * j], yb = ((const u32x2*)(YS + (size_t)r1 * D))[F.lane + 64 * j];
                const f32x4 gg = ((const f32x4*)(modb + 5 * D))[F.lane + 64 * j] + 1.0f;
                f32x4 y; y[0] = g0 * bflo(ya.x) + g1 * bflo(yb.x); y[1] = g0 * bfhi(ya.x) + g1 * bfhi(yb.x); y[2] = g0 * bflo(ya.y) + g1 * bflo(yb.y); y[3] = g0 * bfhi(ya.y) + g1 * bfhi(yb.y);
                v[j] = xv * DN_ALPHA + gg * y;
            }
            LN_ROW(v, ln_g + (size_t)(L * 2 + 1) * D, ln_b + (size_t)(L * 2 + 1) * D);
            bf16* hrow = (L == 0) ? HIN + (size_t)m * D : nullptr;
            const float* mod1 = MOD + (size_t)(4 + b) * 12288;
            WRITE_X_HIN(v, xout + (size_t)m * D, hrow, mod1, mod1 + D);
        }
    }
    if (L == 0) SEAM(13);
}

__global__ void __launch_bounds__(512, 2) mega(Args args) {
    extern __shared__ __attribute__((aligned(16))) unsigned char lds_raw[];
    Frame F;
    F.lds = (LAS unsigned char*)lds_raw;
    F.wave = __builtin_amdgcn_readfirstlane((int)threadIdx.x >> 6); PHASE_FRESH();
    F.G = gridDim.x; { const int bx = blockIdx.x; F.vcu = (F.G % 8 == 0) ? (bx % 8) * (F.G / 8) + bx / 8 : bx; }
    F.gw = F.vcu * 8 + F.wave; F.NGW = F.G * 8;
    F.ctl = (unsigned*)(args.ws + WS_CTL);
    volatile LAS unsigned* MISC = (volatile LAS unsigned*)(F.lds + MISC_OFF);
    LAS int* TAB = (LAS int*)(F.lds + TAB_OFF);
    for (int u = F.tid; u < (LDS_BYTES - LDSCTL_OFF) / 4; u += 512) ((LAS unsigned*)(F.lds + LDSCTL_OFF))[u] = 0u;
    __syncthreads();
    XcdBarrier bar; bar.bar = F.ctl + CW_BAR; bar.x = 0; bar.st = nullptr;
    if (MK_ONE_LAUNCH) bar = xcd_barrier_post(F.ctl + CW_BAR, MISC + 8, F.tid == 0);
    const int lo = args.ph_lo, hi = args.ph_hi;

    if (IN(0)) { PHASE_FRESH();
        {
            LAS float* cact = (LAS float*)F.lds;
            LAS float* red = (LAS float*)(F.lds + 32768);
            for (int i = F.tid; i < 4 * D; i += 512) cact[i] = silu_f(in_c[i]);
            __syncthreads();
            for (int cg = blockIdx.x; cg < 256; cg += F.G) {
                const int jj0 = cg * 96, l = jj0 / 12288, j0 = jj0 - l * 12288;
                const int rsub = F.lane / 24, c4 = F.lane - rsub * 24;
                f32x4 a0 = {0.f, 0.f, 0.f, 0.f}, a1 = a0, a2 = a0, a3 = a0;
                if (F.lane < 48) {
                    const float* wp = ada_w + ((size_t)l * D) * 12288 + j0 + 4 * c4;
#pragma unroll 8
                    for (int it = 0; it < 128; ++it) { const int k = it * 16 + F.wave * 2 + rsub;
                        const f32x4 w4 = *(const f32x4*)(wp + (size_t)k * 12288);
                        a0 += w4 * cact[k]; a1 += w4 * cact[D + k]; a2 += w4 * cact[2 * D + k]; a3 += w4 * cact[3 * D + k]; }
                    LAS float* rp = red + (F.wave * 2 + rsub) * 384 + 4 * c4;
                    *(LAS f32x4*)(rp) = a0; *(LAS f32x4*)(rp + 96) = a1; *(LAS f32x4*)(rp + 192) = a2; *(LAS f32x4*)(rp + 288) = a3;
                }
                __syncthreads();
                if (F.tid < 384) { const int b = F.tid / 96, col = F.tid - b * 96; float s = ada_b[(size_t)l * 12288 + j0 + col];
#pragma unroll
                    for (int p = 0; p < 16; ++p) s += red[p * 384 + b * 96 + col];
                    MOD[((size_t)l * 4 + b) * 12288 + j0 + col] = s; }
                __syncthreads();
            }
        }
        {
            LAS float* scr = (LAS float*)(F.lds + F.wave * 16384);
            tr_job(F, hyb_w_in, 0, 1, HYB_IN, D, 0, 4096, WIN0, 0, D, 0, 0, scr);
            tr_job(F, hyb_w_in, 0, 1, HYB_IN, D, 4112, 3072, WIN0, 0, D, 4096, 0, scr);
            tr_job(F, hyb_w_in, 0, 1, HYB_IN, D, 4096, 16, WIN0, 0, D, 7168, 0, scr);
            zero_fill(F, WIN0 + (size_t)7184 * D, (size_t)(NIN - 7184) * D * 2);
            tr_job(F, hyb_w_out, 0, 1, D, D, 0, D, WOUT0, 0, D, 0, 0, scr);
            tr_job(F, mla_w_in, 0, 1, MLA_IN, D, 0, MLA_IN, WMIN, 0, D, 0, 0, scr);
            zero_fill(F, WMIN + (size_t)MLA_IN * D, (size_t)(NMLA - MLA_IN) * D * 2);
            tr_job(F, mla_w_uq, 0, 1, 3072, 512, 0, 3072, WUQ, 0, 512, 0, 0, scr);
            tr_job(F, mla_w_ukv, 0, 1, 4096, 512, 0, 4096, WUKV, 0, 512, 0, 0, scr);
            tr_job(F, mla_w_out, 0, 1, D, D, 0, D, WMOUT, 0, D, 0, 0, scr);
            tr_job(F, moe_router_g, (size_t)D * 8, 2, 8, D, 0, 8, WRT, (size_t)256 * D, D, 0, 0, scr);
            tr_job(F, moe_router_e, (size_t)D * 64, 2, 64, D, 0, 64, WRT, (size_t)256 * D, D, 8, 0, scr);
            zero_fill(F, WRT + (size_t)72 * D, (size_t)(256 - 72) * D * 2);
            zero_fill(F, WRT + (size_t)256 * D + (size_t)72 * D, (size_t)(256 - 72) * D * 2);
            tr_job(F, moe_w_gate, (size_t)D * FF, 128, FF, D, 0, FF, WGU, (size_t)1024 * D, D, 0, 1, scr);
            tr_job(F, moe_w_up, (size_t)D * FF, 128, FF, D, 0, FF, WGU, (size_t)1024 * D, D, 128, 1, scr);
            tr_job(F, moe_w_down, (size_t)FF * D, 128, D, FF, 0, D, WDN, (size_t)D * FF, FF, 0, 0, scr);
        }
        for (int idx = blockIdx.x * 512 + F.tid; idx < T * 32; idx += F.G * 512) {
            const int t = idx >> 5, i = idx & 31;
            const double rev = (double)in_pos[t] * ROPE_INVF[i] * 0.15915494309189535;
            const float fr = (float)(rev - __builtin_rint(rev));
            ROPE_C[idx] = __builtin_amdgcn_cosf(fr); ROPE_S[idx] = __builtin_amdgcn_sinf(fr);
        }
    }
    SEAM(0);

    if (IN(1)) { PHASE_FRESH();
        for (int m = F.gw; m < T; m += F.NGW) {
            const int b = m / SEQ; const float* modb = MOD + (size_t)b * 12288;
            const f32x4* xr = (const f32x4*)(in_x + (size_t)m * D) + F.lane; u32x2* o = (u32x2*)(HIN + (size_t)m * D) + F.lane;
#pragma unroll
            for (int j = 0; j < 8; ++j) { const f32x4 v = xr[64 * j]; const f32x4 sh = ((const f32x4*)(modb))[F.lane + 64 * j], sc = ((const f32x4*)(modb + D))[F.lane + 64 * j];
                const f32x4 h = v * (sc + 1.0f) + sh; u32x2 w; w.x = cvtpk(h[0], h[1]); w.y = cvtpk(h[2], h[3]); o[64 * j] = w; }
        }
    }
    SEAM(1);

    if (IN(2)) { PHASE_FRESH();
        pg8::StaticOrder S; S.init(HIN, WIN0, T, NIN, D, F.G, (int)blockIdx.x);
        pg8::EpiInProj E{PB, PBA};
        pg8::gemm_phase<pg8::EpiInProj, pg8::StaticOrder>(F.lds, D, S, E, F.tid, F.wave);
    }
    SEAM(2);

    if (IN(3)) { PHASE_FRESH();
        constexpr int QS = 136;
        LAS float* MT = (LAS float*)(F.lds);
        LAS bf16* QKM = (LAS bf16*)(F.lds + 17408);
        LAS float* RAWK = (LAS float*)(F.lds);
        LAS float* VF = (LAS float*)(F.lds + 32768);
        LAS float* WL = (LAS float*)(F.lds + 65536);
        LAS bf16* QBl = (LAS bf16*)(F.lds + 98304);
        LAS bf16* KBl = (LAS bf16*)(F.lds + 115712);
        int zoff = 0; asm volatile("" : "+v"(zoff));
        LAS float* s_beta = (LAS float*)(F.lds + 133120 + zoff); LAS float* s_gc = s_beta + 64; LAS float* s_egc = s_beta + 128;
        for (int ch = blockIdx.x; ch < NCH; ch += F.G) {
            PHASE_FRESH();
            const int n = ch & 31, bh = ch >> 5, h = bh & 7, b = bh >> 3;
            const int tok0 = b * SEQ + n * CHK;
            if (F.tid < 384) {
                const int mat = F.tid >> 7, d = F.tid & 127, col = mat * 1024 + h * 128 + d;
                const float w0 = gdn_conv_w[col], w1 = gdn_conv_w[3072 + col], w2 = gdn_conv_w[2 * 3072 + col], w3 = gdn_conv_w[3 * 3072 + col];
                const bf16* pc = PB + (size_t)tok0 * NP + col;
                float xm3 = 0.f, xm2 = 0.f, xm1 = 0.f;
                if (n > 0) { xm3 = bf2f(pc[-3 * NP]); xm2 = bf2f(pc[-2 * NP]); xm1 = bf2f(pc[-NP]); }
                LAS float* dst = (mat == 0) ? WL : (mat == 1 ? RAWK : VF);
#pragma unroll 8
                for (int i = 0; i < 64; ++i) { const float xi = bf2f(pc[(size_t)i * NP]); const float y = w0 * xm3 + w1 * xm2 + w2 * xm1 + w3 * xi;
                    dst[i * 128 + d] = silu_f(y); xm3 = xm2; xm2 = xm1; xm1 = xi; }
            }
            if (F.wave == 7) {
                const int tok = tok0 + F.lane;
                const float br = PBA[(size_t)tok * 16 + h], ar = PBA[(size_t)tok * 16 + 8 + h];
                const float beta = 1.f / (1.f + __expf(-br));
                const float xsp = ar + gdn_dt_bias[h];
                const float sp = fmaxf(xsp, 0.f) + log1pf(__expf(-fabsf(xsp)));
                float g = -__expf(gdn_a_log[h]) * sp;
#pragma unroll
                for (int off = 1; off < 64; off <<= 1) { const float v = __shfl_up(g, off); if (F.lane >= off) g += v; }
                s_beta[F.lane] = beta; s_gc[F.lane] = g; s_egc[F.lane] = __expf(g);
            }
            __syncthreads();
#pragma unroll
            for (int rr = 0; rr < 8; ++rr) {
                const int i = F.wave * 8 + rr;
                const float qa = WL[i * 128 + F.lane], qb2 = WL[i * 128 + 64 + F.lane];
                const float ka = RAWK[i * 128 + F.lane], kb2 = RAWK[i * 128 + 64 + F.lane];
                const float rq = rsqrtf(wave_sum(qa * qa + qb2 * qb2) + 1e-6f) * 0.08838834764831845f;
                const float rk = rsqrtf(wave_sum(ka * ka + kb2 * kb2) + 1e-6f);
                QBl[i * QS + F.lane] = f2bf(qa * rq); QBl[i * QS + 64 + F.lane] = f2bf(qb2 * rq);
                KBl[i * QS + F.lane] = f2bf(ka * rk); KBl[i * QS + 64 + F.lane] = f2bf(kb2 * rk);
            }
            __syncthreads();
            {
                const int mat = F.wave >> 2, mi = (F.wave >> 1) & 1, ni = F.wave & 1, r = F.lane & 31, hh = F.lane >> 5;
                const LAS bf16* Am = (mat == 0) ? KBl : QBl;
                f32x16 acc;
#pragma unroll
                for (int i = 0; i < 16; ++i) acc[i] = 0.f;
#pragma unroll
                for (int ks = 0; ks < 8; ++ks) {
                    const bf16x8 a = *(const LAS bf16x8*)(Am + (32 * mi + r) * QS + 16 * ks + 8 * hh);
                    const bf16x8 bb = *(const LAS bf16x8*)(KBl + (32 * ni + r) * QS + 16 * ks + 8 * hh);
                    acc = MFMA32(a, bb, acc);
                }
                const int j = 32 * ni + r; const float gj = s_gc[j];
#pragma unroll
                for (int reg = 0; reg < 16; ++reg) {
                    const int i = 32 * mi + crow(reg, hh);
                    const float gi = s_gc[i];
                    const float dec = __expf(fminf(gi - gj, 0.f));
                    if (mat == 0) MT[j * 68 + i] = (i > j) ? s_beta[i] * acc[reg] * dec : 0.f;
                    else QKM[i * 64 + j] = f2bf((i >= j) ? acc[reg] * dec : 0.f);
                }
            }
            __syncthreads();
            if (F.tid < 256) {
                const int c = F.tid, dcol = c & 127;
                float X[64];
                if (c < 128) {
#pragma unroll
                    for (int i = 0; i < 64; ++i) X[i] = VF[i * 128 + dcol] * s_beta[i];
                } else {
#pragma unroll
                    for (int i = 0; i < 64; ++i) X[i] = bf2f(KBl[i * QS + dcol]) * s_beta[i] * s_egc[i];
                }
#pragma unroll
                for (int j = 0; j < 63; ++j) {
                    asm volatile("" ::: "memory");
                    const float xj = X[j];
#pragma unroll
                    for (int i4 = ((j + 1) & ~3); i4 < 64; i4 += 4) {
                        const f32x4 m4 = *(const LAS f32x4*)(MT + j * 68 + i4);
#pragma unroll
                        for (int q = 0; q < 4; ++q) if (i4 + q > j) X[i4 + q] -= m4[q] * xj;
                    }
                }
                LAS float* dst = (c < 128) ? VF : WL;
#pragma unroll
                for (int i = 0; i < 64; ++i) dst[i * 128 + dcol] = X[i];
            }
            __syncthreads();
            {
                const int r = F.lane & 31, hh = F.lane >> 5;
                const float gl = s_gc[63];
                unsigned char* gf = GF + (size_t)ch * 57344;
                for (int f = F.wave; f < 56; f += 8) {
                    float v[8];
                    if (f < 16) { const int mt = f >> 3, ks = f & 7; const LAS float* src = WL + (32 * mt + r) * 128 + 16 * ks + 4 * hh;
#pragma unroll
                        for (int j = 0; j < 8; ++j) v[j] = -src[8 * (j >> 2) + (j & 3)]; }
                    else if (f < 32) { const int f2 = f - 16, mt = f2 >> 3, ks = f2 & 7, i = 32 * mt + r; const float e = s_egc[i]; const LAS bf16* src = QBl + i * QS + 16 * ks + 4 * hh;
#pragma unroll
                        for (int j = 0; j < 8; ++j) v[j] = bf2f(src[8 * (j >> 2) + (j & 3)]) * e; }
                    else if (f < 40) { const int f2 = f - 32, mt = f2 >> 2, ks = f2 & 3; const LAS bf16* src = QKM + (32 * mt + r) * 64 + 16 * ks + 4 * hh;
#pragma unroll
                        for (int j = 0; j < 8; ++j) v[j] = bf2f(src[8 * (j >> 2) + (j & 3)]); }
                    else { const int f2 = f - 40, mt = f2 >> 2, ks = f2 & 3, dd = 32 * mt + r;
#pragma unroll
                        for (int j = 0; j < 8; ++j) { const int i = 16 * ks + 8 * (j >> 2) + 4 * hh + (j & 3); v[j] = bf2f(KBl[i * QS + dd]) * __expf(gl - s_gc[i]); } }
                    u32x4 o; o.x = cvtpk(v[0], v[1]); o.y = cvtpk(v[2], v[3]); o.z = cvtpk(v[4], v[5]); o.w = cvtpk(v[6], v[7]);
                    *(u32x4*)(gf + f * 1024 + F.lane * 16) = o;
                }
                { const int sl = F.wave >> 1, it = F.wave & 1, col = 32 * sl + r;
                  float* up = (float*)(GU + (size_t)ch * 32768 + (size_t)((sl * 2 + it) * 64 + F.lane) * 64);
#pragma unroll
                  for (int g4 = 0; g4 < 4; ++g4) { f32x4 t4;
#pragma unroll
                      for (int q = 0; q < 4; ++q) t4[q] = VF[(32 * it + crow(4 * g4 + q, hh)) * 128 + col];
                      *(f32x4*)(up + 4 * g4) = t4; } }
                if (F.tid == 0) EG[ch] = __expf(gl);
            }
            __syncthreads();
        }
    }
    SEAM(3);

    if (IN(4)) { PHASE_FRESH();
        for (int bh = blockIdx.x; bh < BATCH * GH; bh += F.G) {
            const int b = bh >> 3, hd = bh & 7, r = F.lane & 31, hh = F.lane >> 5, sl = F.wave;
            f32x16 S[4];
#pragma unroll
            for (int dt = 0; dt < 4; ++dt)
#pragma unroll
                for (int i = 0; i < 16; ++i) S[dt][i] = 0.f;
            f32x16 un[2];
            if (F.wave >= 4) {
                const int t4 = F.tid - 256; const unsigned char* g0 = opaque_ptr(GF + (size_t)(bh * 32) * 57344 + (size_t)t4 * 16);
#pragma unroll
                for (int q = 0; q < 14; ++q) *(LAS u32x4*)(F.lds + (t4 + 256 * q) * 16) = *(const u32x4*)(g0 + (size_t)q * 4096);
            } else {
#pragma unroll
                for (int it = 0; it < 2; ++it) { const f32x4* up = (const f32x4*)opaque_ptr(GU + (size_t)(bh * 32) * 32768 + (size_t)((sl * 2 + it) * 64 + F.lane) * 64);
#pragma unroll
                    for (int g4 = 0; g4 < 4; ++g4) { const f32x4 t4 = up[g4]; un[it][4 * g4] = t4[0]; un[it][4 * g4 + 1] = t4[1]; un[it][4 * g4 + 2] = t4[2]; un[it][4 * g4 + 3] = t4[3]; } }
            }
            __syncthreads();
            for (int n = 0; n < NCHK; ++n) {
                const int ch = bh * 32 + n; const bool more = (n + 1 < NCHK);
                if (F.wave >= 4) {
                    if (more) {
                        const unsigned char* gn = opaque_ptr(GF + (size_t)(ch + 1) * 57344 + (size_t)(F.tid - 256) * 16); LAS unsigned char* nb = F.lds + ((n + 1) & 1) * 57344; const int t4 = F.tid - 256;
#pragma unroll
                        for (int q = 0; q < 14; ++q) *(LAS u32x4*)(nb + (t4 + 256 * q) * 16) = *(const u32x4*)(gn + (size_t)q * 4096);
                    }
                } else {
                    const LAS unsigned char* buf = F.lds + (n & 1) * 57344 + F.lane * 16;
                    const float eg = EG[ch];
                    bf16x8 Sb[8];
#pragma unroll
                    for (int dt = 0; dt < 4; ++dt) { Sb[2 * dt] = pack_acc(S[dt], 0); Sb[2 * dt + 1] = pack_acc(S[dt], 1); }
                    f32x16 vn[2]; vn[0] = un[0]; vn[1] = un[1];
#pragma unroll
                    for (int it = 0; it < 2; ++it)
#pragma unroll
                        for (int ks = 0; ks < 8; ++ks) vn[it] = MFMA32(*(const LAS bf16x8*)(buf + (it * 8 + ks) * 1024), Sb[ks], vn[it]);
                    __builtin_amdgcn_sched_barrier(0);
                    f32x16 oa[2];
#pragma unroll
                    for (int it = 0; it < 2; ++it) {
#pragma unroll
                        for (int i = 0; i < 16; ++i) oa[it][i] = 0.f;
#pragma unroll
                        for (int ks = 0; ks < 8; ++ks) oa[it] = MFMA32(*(const LAS bf16x8*)(buf + (16 + it * 8 + ks) * 1024), Sb[ks], oa[it]);
                    }
                    __builtin_amdgcn_sched_barrier(0);
                    bf16x8 vb[4];
#pragma unroll
                    for (int it = 0; it < 2; ++it) { vb[2 * it] = pack_acc(vn[it], 0); vb[2 * it + 1] = pack_acc(vn[it], 1); }
                    __builtin_amdgcn_sched_barrier(0);
                    {
                        const int chn = more ? ch + 1 : ch;
#pragma unroll
                        for (int it = 0; it < 2; ++it) { const f32x4* up = (const f32x4*)opaque_ptr(GU + (size_t)chn * 32768 + (size_t)((sl * 2 + it) * 64 + F.lane) * 64);
#pragma unroll
                            for (int g4 = 0; g4 < 4; ++g4) { const f32x4 t4 = up[g4]; un[it][4 * g4] = t4[0]; un[it][4 * g4 + 1] = t4[1]; un[it][4 * g4 + 2] = t4[2]; un[it][4 * g4 + 3] = t4[3]; } }
                    }
                    __builtin_amdgcn_sched_barrier(0);
#pragma unroll
                    for (int it = 0; it < 2; ++it)
#pragma unroll
                        for (int ks = 0; ks < 4; ++ks) oa[it] = MFMA32(*(const LAS bf16x8*)(buf + (32 + it * 4 + ks) * 1024), vb[ks], oa[it]);
#pragma unroll
                    for (int it = 0; it < 2; ++it) {
#pragma unroll
                        for (int g4 = 0; g4 < 4; ++g4) { float* op = opaque_ptr(GO + (size_t)(b * SEQ + n * CHK + 32 * it + 8 * g4 + 4 * hh) * 1024 + hd * 128 + sl * 32 + r);
#pragma unroll
                            for (int q = 0; q < 4; ++q) op[q * 1024] = oa[it][4 * g4 + q]; } }
                    __builtin_amdgcn_sched_barrier(0);
#pragma unroll
                    for (int dt = 0; dt < 4; ++dt) {
#pragma unroll
                        for (int i = 0; i < 16; ++i) S[dt][i] *= eg;
#pragma unroll
                        for (int ks = 0; ks < 4; ++ks) S[dt] = MFMA32(*(const LAS bf16x8*)(buf + (40 + dt * 4 + ks) * 1024), vb[ks], S[dt]);
                    }
                }
                __syncthreads();
            }
        }
    }
    SEAM(4);

    if (IN(5)) { PHASE_FRESH();
        for (int m = F.gw; m < T; m += F.NGW) {
            const int s = m & (SEQ - 1), c0 = F.lane * 16;
            const bf16* prow = PB + (size_t)m * NP;
            {
                const f32x4* op = (const f32x4*)(GO + (size_t)m * 1024 + c0);
                f32x4 o[4]; float ss = 0.f;
#pragma unroll
                for (int q = 0; q < 4; ++q) { o[q] = op[q]; ss += o[q][0] * o[q][0] + o[q][1] * o[q][1] + o[q][2] * o[q][2] + o[q][3] * o[q][3]; }
                ss += __shfl_xor(ss, 1); ss += __shfl_xor(ss, 2); ss += __shfl_xor(ss, 4);
                const float rms = rsqrtf(ss * (1.f / 128.f) + 1e-6f);
                const u32x4* zp = (const u32x4*)(prow + 3072 + c0); const u32x4 z0 = zp[0], z1 = zp[1];
                const unsigned zw[8] = {z0.x, z0.y, z0.z, z0.w, z1.x, z1.y, z1.z, z1.w};
                const f32x4* nwp = (const f32x4*)(gdn_norm_w + (c0 & 127));
                unsigned ow[8];
#pragma unroll
                for (int q = 0; q < 4; ++q) { const f32x4 nw = nwp[q];
                    const float y0 = o[q][0] * rms * nw[0] * silu_f(bflo(zw[2 * q])), y1 = o[q][1] * rms * nw[1] * silu_f(bfhi(zw[2 * q]));
                    const float y2 = o[q][2] * rms * nw[2] * silu_f(bflo(zw[2 * q + 1])), y3 = o[q][3] * rms * nw[3] * silu_f(bfhi(zw[2 * q + 1]));
                    ow[2 * q] = cvtpk(y0, y1); ow[2 * q + 1] = cvtpk(y2, y3); }
                u32x4* yp = (u32x4*)(YAB + (size_t)m * D + c0);
                yp[0] = (u32x4){ow[0], ow[1], ow[2], ow[3]}; yp[1] = (u32x4){ow[4], ow[5], ow[6], ow[7]};
            }
            {
                float accv[16];
#pragma unroll
                for (int q = 0; q < 16; ++q) accv[q] = 0.f;
#pragma unroll
                for (int j = 0; j < 3; ++j) {
                    if (s - 2 + j >= 0) {
                        const bf16* pr = prow + (ptrdiff_t)(j - 2) * NP;
                        const u32x4* cp = (const u32x4*)(pr + 5120 + c0); const u32x4* hp = (const u32x4*)(pr + 6144 + c0);
                        const u32x4 ca = cp[0], cb = cp[1], ha = hp[0], hb = hp[1];
                        const unsigned cw[8] = {ca.x, ca.y, ca.z, ca.w, cb.x, cb.y, cb.z, cb.w}, hw[8] = {ha.x, ha.y, ha.z, ha.w, hb.x, hb.y, hb.z, hb.w};
                        const f32x4* wp = (const f32x4*)(sc_conv_w + j * 1024 + c0);
#pragma unroll
                        for (int q = 0; q < 4; ++q) { const f32x4 w4 = wp[q];
                            accv[4 * q] += w4[0] * bflo(cw[2 * q]) * bflo(hw[2 * q]); accv[4 * q + 1] += w4[1] * bfhi(cw[2 * q]) * bfhi(hw[2 * q]);
                            accv[4 * q + 2] += w4[2] * bflo(cw[2 * q + 1]) * bflo(hw[2 * q + 1]); accv[4 * q + 3] += w4[3] * bfhi(cw[2 * q + 1]) * bfhi(hw[2 * q + 1]); }
                    }
                }
                const u32x4* bp = (const u32x4*)(prow + 4096 + c0); const u32x4 ba = bp[0], bb = bp[1];
                const unsigned bw[8] = {ba.x, ba.y, ba.z, ba.w, bb.x, bb.y, bb.z, bb.w};
                unsigned ow[8];
#pragma unroll
                for (int q = 0; q < 8; ++q) ow[q] = cvtpk(bflo(bw[q]) * accv[2 * q], bfhi(bw[q]) * accv[2 * q + 1]);
                u32x4* yp = (u32x4*)(YAB + (size_t)m * D + 1024 + c0);
                yp[0] = (u32x4){ow[0], ow[1], ow[2], ow[3]}; yp[1] = (u32x4){ow[4], ow[5], ow[6], ow[7]};
            }
        }
    }
    SEAM(5);

    if (IN(6)) { PHASE_FRESH();
        pg8::StaticOrder S; S.init(YAB, WOUT0, T, D, D, F.G, (int)blockIdx.x);
        pg8::EpiResid E{in_x, MOD + 2 * D, RB};
        pg8::gemm_phase<pg8::EpiResid, pg8::StaticOrder>(F.lds, D, S, E, F.tid, F.wave);
    }
    SEAM(6);

    if (IN(7)) { PHASE_FRESH();
        for (int m = F.gw; m < T; m += F.NGW) {
            const int b = m / SEQ; const float* modb = MOD + (size_t)b * 12288;
            f32x4 v[8];
#pragma unroll
            for (int j = 0; j < 8; ++j) v[j] = ((const f32x4*)(RB + (size_t)m * D))[F.lane + 64 * j];
            LN_ROW(v, ln_g, ln_b);
            bf16* hrow = HIN + (size_t)m * D;
            WRITE_X_HIN(v, XA + (size_t)m * D, hrow, modb + 3 * D, modb + 4 * D);
        }
    }
    SEAM(7);

    moe_phases<0>(F, args, bar, lo, hi, TAB);

        if (IN(14)) { PHASE_FRESH();
            pg8::StaticOrder S; S.init(HIN, WMIN, T, NMLA, D, F.G, (int)blockIdx.x);
            pg8::EpiF32 E{C1, NMLA};
            pg8::gemm_phase<pg8::EpiF32, pg8::StaticOrder>(F.lds, D, S, E, F.tid, F.wave);
        }
        SEAM(14);
        if (IN(15)) { PHASE_FRESH();
            for (int m = F.gw; m < T; m += F.NGW) {
                const float* c1 = C1 + (size_t)m * NMLA;
#pragma unroll
                for (int part = 0; part < 2; ++part) {
                    const f32x4* p = (const f32x4*)(c1 + part * 512 + 8 * F.lane); const f32x4 a0 = p[0], a1 = p[1];
                    const float ss = wave_sum((a0[0] * a0[0] + a0[1] * a0[1]) + (a0[2] * a0[2] + a0[3] * a0[3]) + (a1[0] * a1[0] + a1[1] * a1[1]) + (a1[2] * a1[2] + a1[3] * a1[3]));
                    const float rn = rsqrtf(ss * (1.f / 512.f) + 1e-6f);
                    const f32x4* wp = (const f32x4*)((part == 0 ? mla_q_norm : mla_kv_norm) + 8 * F.lane); const f32x4 w0 = wp[0], w1 = wp[1];
                    u32x4 o; o.x = cvtpk(a0[0] * rn * w0[0], a0[1] * rn * w0[1]); o.y = cvtpk(a0[2] * rn * w0[2], a0[3] * rn * w0[3]);
                    o.z = cvtpk(a1[0] * rn * w1[0], a1[1] * rn * w1[1]); o.w = cvtpk(a1[2] * rn * w1[2], a1[3] * rn * w1[3]);
                    *(u32x4*)((part == 0 ? CQN : CKVN) + (size_t)m * 512 + 8 * F.lane) = o;
                }
                if (F.lane < 32) { const float x1 = c1[1024 + F.lane], x2 = c1[1056 + F.lane], cs = ROPE_C[(size_t)m * 32 + F.lane], sn = ROPE_S[(size_t)m * 32 + F.lane];
                    KPE[(size_t)m * 64 + F.lane] = x1 * cs - x2 * sn; KPE[(size_t)m * 64 + 32 + F.lane] = x1 * sn + x2 * cs; }
            }
        }
        SEAM(15);
        if (IN(16)) { PHASE_FRESH();
            { pg8::StaticOrder S; S.init(CQN, WUQ, T, 3072, 512, F.G, (int)blockIdx.x); pg8::EpiQup E{QB_};
              pg8::gemm_phase<pg8::EpiQup, pg8::StaticOrder>(F.lds, 512, S, E, F.tid, F.wave); }
            { pg8::StaticOrder S; S.init(CKVN, WUKV, T, 4096, 512, F.G, (int)blockIdx.x); pg8::EpiKVup E{KB_, VB_};
              pg8::gemm_phase<pg8::EpiKVup, pg8::StaticOrder>(F.lds, 512, S, E, F.tid, F.wave); }
        }
        SEAM(16);
        if (IN(17)) { PHASE_FRESH();
            for (int m = F.gw; m < T; m += F.NGW) {
                const int b = m / SEQ, s = m - b * SEQ, hd = F.lane >> 2, i0 = (F.lane & 3) * 8;
                const size_t rowoff = ((size_t)((b * MH + hd) * SEQ + s)) * QD + 128;
                bf16* qp = QB_ + rowoff;
                const u32x4 xa = *(const u32x4*)(qp + i0), xb = *(const u32x4*)(qp + 32 + i0);
                const f32x4* cp = (const f32x4*)(ROPE_C + (size_t)m * 32 + i0); const f32x4* sp = (const f32x4*)(ROPE_S + (size_t)m * 32 + i0);
                const f32x4 c0 = cp[0], c1v = cp[1], s0 = sp[0], s1 = sp[1];
                const float cs[8] = {c0[0], c0[1], c0[2], c0[3], c1v[0], c1v[1], c1v[2], c1v[3]}, sn[8] = {s0[0], s0[1], s0[2], s0[3], s1[0], s1[1], s1[2], s1[3]};
                const unsigned xaw[4] = {xa.x, xa.y, xa.z, xa.w}, xbw[4] = {xb.x, xb.y, xb.z, xb.w};
                unsigned o1[4], o2[4];
#pragma unroll
                for (int q = 0; q < 4; ++q) { const float a0 = bflo(xaw[q]), a1 = bfhi(xaw[q]), b0 = bflo(xbw[q]), b1 = bfhi(xbw[q]);
                    o1[q] = cvtpk(a0 * cs[2 * q] - b0 * sn[2 * q], a1 * cs[2 * q + 1] - b1 * sn[2 * q + 1]);
                    o2[q] = cvtpk(a0 * sn[2 * q] + b0 * cs[2 * q], a1 * sn[2 * q + 1] + b1 * cs[2 * q + 1]); }
                *(u32x4*)(qp + i0) = (u32x4){o1[0], o1[1], o1[2], o1[3]}; *(u32x4*)(qp + 32 + i0) = (u32x4){o2[0], o2[1], o2[2], o2[3]};
                const f32x4* kp = (const f32x4*)(KPE + (size_t)m * 64 + i0); const f32x4* kp2 = (const f32x4*)(KPE + (size_t)m * 64 + 32 + i0);
                const f32x4 k0 = kp[0], k1 = kp[1], k2 = kp2[0], k3 = kp2[1];
                bf16* kd = KB_ + rowoff;
                *(u32x4*)(kd + i0) = (u32x4){cvtpk(k0[0], k0[1]), cvtpk(k0[2], k0[3]), cvtpk(k1[0], k1[1]), cvtpk(k1[2], k1[3])};
                *(u32x4*)(kd + 32 + i0) = (u32x4){cvtpk(k2[0], k2[1]), cvtpk(k2[2], k2[3]), cvtpk(k3[0], k3[1]), cvtpk(k3[2], k3[3])};
            }
            {
                LAS bf16* scr = (LAS bf16*)(F.lds + F.wave * 17408);
                for (int it = F.gw; it < 64 * 32; it += F.NGW) {
                    const int bhh = it >> 5, sb = it & 31, b = bhh >> 4, hd = bhh & 15, s0 = sb * 64;
#pragma unroll 4
                    for (int i = 0; i < 16; ++i) { const int row = 4 * i + (F.lane >> 4), c8 = (F.lane & 15) * 8;
                        *(LAS u32x4*)(scr + row * 136 + c8) = *(const u32x4*)(VB_ + (size_t)(b * SEQ + s0 + row) * D + hd * 128 + c8); }
                    LDS_WAIT(); asm volatile("" ::: "memory");
                    bf16* dst = VT + ((size_t)bhh * 128) * SEQ + s0 + F.lane;
#pragma unroll 8
                    for (int dv = 0; dv < 128; ++dv) dst[(size_t)dv * SEQ] = scr[F.lane * 136 + dv];
                    LDS_WAIT(); asm volatile("" ::: "memory");
                }
            }
        }
        SEAM(17);
        if (IN(18)) { PHASE_FRESH();
            constexpr int KBUF = 64 * 400, VBUF = 128 * 136;
            LAS unsigned char* KL = F.lds; LAS unsigned char* VL = F.lds + 2 * KBUF;
            const int w = F.wave;
            for (int pi = blockIdx.x; pi < 256; pi += F.G) {
                const int bhh = pi >> 2, pp = pi & 3, b = bhh >> 4, hd = bhh & 15;
                const char* kg = (const char*)(KB_ + (size_t)bhh * SEQ * QD); const char* vg = (const char*)(VT + (size_t)bhh * 128 * SEQ);
                for (int half = 0; half < 2; ++half) {
                    PHASE_FRESH(); const int r = F.lane & 31, hh = F.lane >> 5;
                    const int qb = half == 0 ? 7 - pp : pp, q0 = qb * 256, ntile = 4 * (qb + 1), qrow = q0 + 32 * w + r;
                    bf16x8 qf[12];
                    { const bf16* qp = QB_ + ((size_t)bhh * SEQ + qrow) * QD + 8 * hh;
#pragma unroll
                      for (int ks = 0; ks < 12; ++ks) qf[ks] = *(const bf16x8*)(qp + 16 * ks); }
                    f32x16 oT[4];
#pragma unroll
                    for (int mt = 0; mt < 4; ++mt)
#pragma unroll
                        for (int i = 0; i < 16; ++i) oT[mt][i] = 0.f;
                    float mrun = -1e30f, lsum = 0.f;
                    u32x4 kst[3], vst[2];
#pragma unroll
                    for (int q = 0; q < 3; ++q) kst[q] = *(const u32x4*)(kg + (size_t)(F.tid + 512 * q) * 16);
#pragma unroll
                    for (int q = 0; q < 2; ++q) { const int p = F.tid + 512 * q; vst[q] = *(const u32x4*)(vg + (size_t)(p >> 3) * (SEQ * 2) + (p & 7) * 16); }
#pragma unroll
                    for (int q = 0; q < 3; ++q) { const int p = F.tid + 512 * q; *(LAS u32x4*)(KL + (p / 24) * 400 + (p % 24) * 16) = kst[q]; }
#pragma unroll
                    for (int q = 0; q < 2; ++q) { const int p = F.tid + 512 * q; LAS unsigned char* d = VL + (p >> 3) * 136 + (p & 7) * 16;
                        *(LAS u32x2*)d = (u32x2){vst[q].x, vst[q].y}; *(LAS u32x2*)(d + 8) = (u32x2){vst[q].z, vst[q].w}; }
                    __syncthreads();
                    for (int kt = 0; kt < ntile; ++kt) {
                        const bool more = (kt + 1 < ntile); const int k0 = kt * 64;
                        if (more) {
                            const int k1 = k0 + 64;
#pragma unroll
                            for (int q = 0; q < 3; ++q) kst[q] = *(const u32x4*)(kg + (size_t)k1 * (QD * 2) + (size_t)(F.tid + 512 * q) * 16);
#pragma unroll
                            for (int q = 0; q < 2; ++q) { const int p = F.tid + 512 * q; vst[q] = *(const u32x4*)(vg + (size_t)(p >> 3) * (SEQ * 2) + (size_t)k1 * 2 + (p & 7) * 16); }
                        }
                        if (k0 <= q0 + 32 * w + 31) {
                            const LAS unsigned char* kb = KL + (kt & 1) * KBUF; const LAS unsigned char* vb_ = VL + (kt & 1) * VBUF;
                            f32x16 sT[2];
#pragma unroll
                            for (int kk = 0; kk < 2; ++kk) {
#pragma unroll
                                for (int i = 0; i < 16; ++i) sT[kk][i] = 0.f;
#pragma unroll
                                for (int ks = 0; ks < 12; ++ks) sT[kk] = MFMA32(*(const LAS bf16x8*)(kb + (32 * kk + r) * 400 + (16 * ks + 8 * hh) * 2), qf[ks], sT[kk]);
                            }
                            if (k0 + 63 > q0 + 32 * w) {
#pragma unroll
                                for (int kk = 0; kk < 2; ++kk)
#pragma unroll
                                    for (int reg = 0; reg < 16; ++reg) { const int key = k0 + 32 * kk + crow(reg, hh); if (key > qrow) sT[kk][reg] = -1e30f; }
                            }
                            float mloc = sT[0][0];
#pragma unroll
                            for (int kk = 0; kk < 2; ++kk)
#pragma unroll
                                for (int reg = 0; reg < 16; ++reg) mloc = fmaxf(mloc, sT[kk][reg]);
                            mloc = fmaxf(mloc, __shfl_xor(mloc, 32));
                            const float mnew = fmaxf(mrun, mloc), alpha = __builtin_amdgcn_exp2f(mrun - mnew);
                            float ps = 0.f;
#pragma unroll
                            for (int kk = 0; kk < 2; ++kk)
#pragma unroll
                                for (int reg = 0; reg < 16; ++reg) { const float pe = __builtin_amdgcn_exp2f(sT[kk][reg] - mnew); sT[kk][reg] = pe; ps += pe; }
                            lsum = lsum * alpha + ps; mrun = mnew;
#pragma unroll
                            for (int mt = 0; mt < 4; ++mt)
#pragma unroll
                                for (int i = 0; i < 16; ++i) oT[mt][i] *= alpha;
                            bf16x8 pb[4];
#pragma unroll
                            for (int kk = 0; kk < 2; ++kk) { pb[2 * kk] = pack_acc(sT[kk], 0); pb[2 * kk + 1] = pack_acc(sT[kk], 1); }
#pragma unroll
                            for (int mt = 0; mt < 4; ++mt)
#pragma unroll
                                for (int ks = 0; ks < 4; ++ks) { const LAS unsigned char* vp = vb_ + (32 * mt + r) * 136 + (16 * ks + 4 * hh) * 2;
                                    const u32x2 vlo = *(const LAS u32x2*)vp, vhi = *(const LAS u32x2*)(vp + 16);
                                    const u32x4 va = {vlo.x, vlo.y, vhi.x, vhi.y};
                                    oT[mt] = MFMA32(__builtin_bit_cast(bf16x8, va), pb[ks], oT[mt]); }
                        }
                        if (more) {
                            LAS unsigned char* kn = KL + ((kt + 1) & 1) * KBUF; LAS unsigned char* vn_ = VL + ((kt + 1) & 1) * VBUF;
#pragma unroll
                            for (int q = 0; q < 3; ++q) { const int p = F.tid + 512 * q; *(LAS u32x4*)(kn + (p / 24) * 400 + (p % 24) * 16) = kst[q]; }
#pragma unroll
                            for (int q = 0; q < 2; ++q) { const int p = F.tid + 512 * q; LAS unsigned char* d = vn_ + (p >> 3) * 136 + (p & 7) * 16;
                                *(LAS u32x2*)d = (u32x2){vst[q].x, vst[q].y}; *(LAS u32x2*)(d + 8) = (u32x2){vst[q].z, vst[q].w}; }
                        }
                        __syncthreads();
                    }
                    const float ltot = lsum + __shfl_xor(lsum, 32), inv = 1.f / ltot;
                    bf16* orow = YAB + (size_t)(b * SEQ + qrow) * D + hd * 128 + 4 * hh;
#pragma unroll
                    for (int mt = 0; mt < 4; ++mt)
#pragma unroll
                        for (int g4 = 0; g4 < 4; ++g4) { u32x2 o; o.x = cvtpk(oT[mt][4 * g4] * inv, oT[mt][4 * g4 + 1] * inv); o.y = cvtpk(oT[mt][4 * g4 + 2] * inv, oT[mt][4 * g4 + 3] * inv);
                            *(u32x2*)(orow + 32 * mt + 8 * g4) = o; }
                }
            }
        }
        SEAM(18);
        if (IN(19)) { PHASE_FRESH();
            pg8::StaticOrder S; S.init(YAB, WMOUT, T, D, D, F.G, (int)blockIdx.x);
            pg8::EpiResid E{XB, MOD + (size_t)4 * 12288 + 2 * D, RB};
            pg8::gemm_phase<pg8::EpiResid, pg8::StaticOrder>(F.lds, D, S, E, F.tid, F.wave);
        }
        SEAM(19);
        if (IN(20)) { PHASE_FRESH();
            for (int m = F.gw; m < T; m += F.NGW) {
                const int b = m / SEQ; const float* modb = MOD + (size_t)(4 + b) * 12288;
                f32x4 v[8];
#pragma unroll
                for (int j = 0; j < 8; ++j) v[j] = ((const f32x4*)(RB + (size_t)m * D))[F.lane + 64 * j];
                LN_ROW(v, ln_g + 2 * D, ln_b + 2 * D);
                bf16* hrow = HIN + (size_t)m * D;
                WRITE_X_HIN(v, XA + (size_t)m * D, hrow, modb + 3 * D, modb + 4 * D);
            }
        }
        SEAM(20);

    moe_phases<1>(F, args, bar, lo, hi, TAB);
#undef IN
#undef INL
#undef SEAM
#undef WSB
#undef in_x
#undef in_c
#undef in_pos
#undef ada_w
#undef ada_b
#undef ln_g
#undef ln_b
#undef hyb_w_in
#undef gdn_conv_w
#undef gdn_a_log
#undef gdn_dt_bias
#undef gdn_norm_w
#undef sc_conv_w
#undef hyb_w_out
#undef mla_w_in
#undef mla_q_norm
#undef mla_kv_norm
#undef mla_w_uq
#undef mla_w_ukv
#undef mla_w_out
#undef moe_router_g
#undef moe_bias_g
#undef moe_router_e
#undef moe_bias_e
#undef moe_w_gate
#undef moe_w_up
#undef moe_w_down
#undef MOD
#undef ROPE_C
#undef ROPE_S
#undef PBA
#undef LOGITS
#undef TOK_E
#undef TOK_POS
#undef TOK_GATE
#undef EG
#undef WIN0
#undef WOUT0
#undef WMIN
#undef WUQ
#undef WUKV
#undef WMOUT
#undef WRT
#undef WGU
#undef WDN
#undef HIN
#undef XA
#undef XB
#undef RB
#undef PB
#undef GF
#undef GU
#undef GO
#undef YAB
#undef XS
#undef HID
#undef YS
#undef C1
#undef CQN
#undef CKVN
#undef KPE
#undef QB_
#undef KB_
#undef VB_
#undef VT
}

extern "C" void kernel_launch(void* const* d_in, const int* in_sizes, int n_in, void* d_out, int out_size, void* d_ws, size_t ws_size, hipStream_t stream) {
    static int grid = 0;
    if (grid == 0) {
        if (n_in != 27 || in_sizes[0] != T * D || out_size != T * D || ws_size < WS_END) { fprintf(stderr, "kernel_launch: unexpected problem (n_in %d, in0 %d, out %d, ws %zu)\n", n_in, n_in > 0 ? in_sizes[0] : -1, out_size, ws_size); grid = -1; return; }
        int dev = 0, cus = 0, per_cu = 0;
        if (hipGetDevice(&dev) != hipSuccess || hipDeviceGetAttribute(&cus, hipDeviceAttributeMultiprocessorCount, dev) != hipSuccess) { grid = -1; return; }
        if (hipFuncSetAttribute((const void*)mega, hipFuncAttributeMaxDynamicSharedMemorySize, LDS_BYTES) != hipSuccess) { fprintf(stderr, "kernel_launch: hipFuncSetAttribute failed\n"); grid = -1; return; }
        if (hipOccupancyMaxActiveBlocksPerMultiprocessor(&per_cu, (const void*)mega, 512, LDS_BYTES) != hipSuccess || per_cu < 1) fprintf(stderr, "kernel_launch: occupancy query reports %d\n", per_cu);
        (void)hipGetLastError();
        grid = cus;
    }
    if (grid < 0) return;
    (void)hipMemsetAsync((char*)d_ws + WS_CTL, 0, CTL_ZERO_BYTES, stream);
    Args a{};
    for (int i = 0; i < 27; ++i) a.in[i] = d_in[i];
    a.out = (float*)d_out; a.ws = (unsigned char*)d_ws;
#if MK_ONE_LAUNCH
    a.ph_lo = 0; a.ph_hi = NPH;
    hipLaunchKernelGGL(mega, dim3(grid), dim3(512), LDS_BYTES, stream, a);
#else
    for (int k = 0; k < NPH; ++k) { a.ph_lo = k; a.ph_hi = k + 1; hipLaunchKernelGGL(mega, dim3(grid), dim3(512), LDS_BYTES, stream, a); }
#endif
}
```

```cpp
#include <hip/hip_runtime.h>
#include <cstdio>
#include <cstdint>

#ifndef MK_ONE_LAUNCH
#define MK_ONE_LAUNCH 1
#endif

#define DI __device__ __forceinline__
#define GAS __attribute__((address_space(1)))
#define LAS __attribute__((address_space(3)))
typedef unsigned short bf16;
typedef float f32x4 __attribute__((ext_vector_type(4)));
typedef float f32x2 __attribute__((ext_vector_type(2)));
typedef float f32x16 __attribute__((ext_vector_type(16)));
typedef short bf16x8 __attribute__((ext_vector_type(8)));
typedef short s16x4 __attribute__((ext_vector_type(4)));
typedef unsigned u32x4 __attribute__((ext_vector_type(4)));
typedef unsigned u32x2 __attribute__((ext_vector_type(2)));
typedef __bf16 bf16x2_t __attribute__((ext_vector_type(2)));
typedef GAS unsigned gu32;
#define RLX_AGENT __ATOMIC_RELAXED, __HIP_MEMORY_SCOPE_AGENT
#define LDS_WAIT() asm volatile("s_waitcnt lgkmcnt(0)" ::: "memory")
#define VM_WAIT() asm volatile("s_waitcnt vmcnt(0)" ::: "memory")
#define MFMA32(a, b, c) __builtin_amdgcn_mfma_f32_32x32x16_bf16((a), (b), (c), 0, 0, 0)

DI unsigned cvtpk(float lo, float hi) { f32x2 v = {lo, hi}; bf16x2_t b = __builtin_convertvector(v, bf16x2_t); return __builtin_bit_cast(unsigned, b); }
DI bf16 f2bf(float f) { return (bf16)(cvtpk(f, 0.f) & 0xffffu); }
DI float bf2f(bf16 b) { return __uint_as_float(((unsigned)b) << 16); }
DI float bflo(unsigned w) { return __uint_as_float(w << 16); }
DI float bfhi(unsigned w) { return __uint_as_float(w & 0xffff0000u); }
DI int crow(int reg, int h) { return (reg & 3) + 8 * (reg >> 2) + 4 * h; }
DI int kperm(int j, int h) { return 8 * (j >> 2) + 4 * h + (j & 3); }
DI float wave_sum(float v) {
#pragma unroll
    for (int o = 1; o < 64; o <<= 1) v += __shfl_xor(v, o);
    return v;
}
DI bf16x8 pack_acc(const f32x16& x, int s) {
    u32x4 p; p.x = cvtpk(x[8 * s + 0], x[8 * s + 1]); p.y = cvtpk(x[8 * s + 2], x[8 * s + 3]); p.z = cvtpk(x[8 * s + 4], x[8 * s + 5]); p.w = cvtpk(x[8 * s + 6], x[8 * s + 7]);
    return __builtin_bit_cast(bf16x8, p);
}
DI float silu_f(float x) { return x / (1.f + __expf(-x)); }
template <class P> DI P* opaque_ptr(P* p) { asm volatile("" : "+v"(p)); return p; }

constexpr int D = 2048, BATCH = 4, SEQ = 2048, T = BATCH * SEQ;
constexpr int GH = 8, GD = 128, NCHK = 32, CHK = 64, NCH = BATCH * GH * NCHK;
constexpr int HYB_IN = 7184, NIN = 7424, NP = 7168;
constexpr int MH = 16, MLA_IN = 1088, NMLA = 1280, QD = 192;
constexpr int NE = 64, FF = 512, MAXBLK = 128;
constexpr float DN_ALPHA = 1.41421356237f;
constexpr float QSCALE = 0.10411754627697264f;
constexpr int NPH = 27;

constexpr size_t MiB = 1u << 20;
constexpr size_t WS_CTL = 0, CTL_ZERO_BYTES = 1 * MiB;
constexpr size_t WS_MOD = 1 * MiB;
constexpr size_t WS_ROPE = 2 * MiB;
constexpr size_t WS_PBA = 4 * MiB;
constexpr size_t WS_LOGITS = 5 * MiB;
constexpr size_t WS_ROUTE = 9 * MiB;
constexpr size_t WS_EG = 10 * MiB;
constexpr size_t WS_WIN0 = 16 * MiB;
constexpr size_t WS_WOUT0 = 46 * MiB;
constexpr size_t WS_WMIN = 54 * MiB;
constexpr size_t WS_WUQ = 59 * MiB;
constexpr size_t WS_WUKV = 62 * MiB;
constexpr size_t WS_WMOUT = 66 * MiB;
constexpr size_t WS_WRT = 74 * MiB;
constexpr size_t WS_WGU = 80 * MiB;
constexpr size_t WS_WDN = 592 * MiB;
constexpr size_t WS_HIN = 848 * MiB;
constexpr size_t WS_XA = 880 * MiB;
constexpr size_t WS_XB = 944 * MiB;
constexpr size_t WS_R = 1008 * MiB;
constexpr size_t WS_P = 1072 * MiB;
constexpr size_t WS_GF = 1184 * MiB;
constexpr size_t WS_GU = 1240 * MiB;
constexpr size_t WS_GO = 1272 * MiB;
constexpr size_t WS_YAB = 1304 * MiB;
constexpr size_t WS_XS = 1336 * MiB;
constexpr size_t WS_HID = 1464 * MiB;
constexpr size_t WS_YS = 1496 * MiB;
constexpr size_t WS_C1 = 1624 * MiB;
constexpr size_t WS_CQN = 1664 * MiB;
constexpr size_t WS_CKVN = 1672 * MiB;
constexpr size_t WS_KPE = 1680 * MiB;
constexpr size_t WS_Q = 1684 * MiB;
constexpr size_t WS_K = 1732 * MiB;
constexpr size_t WS_V = 1780 * MiB;
constexpr size_t WS_VT = 1812 * MiB;
constexpr size_t WS_END = 1844 * MiB;
constexpr int CW_BAR = 4096;
constexpr int CW_CNT = 8192;
constexpr int CW_BLK = 8448;

constexpr int RING_BYTES = 131072;
constexpr int LDSCTL_OFF = 143360, MISC_OFF = LDSCTL_OFF + 320;
constexpr int TAB_OFF = LDSCTL_OFF + 512;
constexpr int SC_OFF = LDSCTL_OFF + 1536;
constexpr int LDS_BYTES = 147456;

namespace pg8 {
constexpr int BM = 256, BK = 64, HALF = 128, HTB = HALF * BK * 2, STAGE_BYTES = 8 * HTB, NXCD = 8, WGM = 8;
__host__ __device__ __forceinline__ int lds_byte(int r, int c) { const int st = (r >> 4) * 2 + (c >> 5), rr = r & 15, cc = c & 31, ob = rr * 64 + cc * 2; return st * 1024 + (ob ^ (((ob >> 9) & 1) << 5)); }
__host__ __device__ __forceinline__ void stage_rc(int b, int& R, int& C) { const int st = b / 1024, sb = b % 1024, swz = sb ^ (((sb >> 9) & 1) << 5); R = (st >> 1) * 16 + swz / 64; C = (st & 1) * 32 + (swz % 64) / 2; }
__host__ __device__ __forceinline__ int perm32(int rho) { const int n = rho >> 4, i = rho & 15; return 8 * (i >> 2) + 4 * n + (i & 3); }

struct Unit { int pm, pn, ex; };

struct StaticOrder {
    int nM, nN, nwg, G, c; const char* A; const char* Bt; size_t tstep;
    __device__ void init(const bf16* A_, const bf16* Bt_, int M, int N, int K, int G_, int c_) { nM = M / BM; nN = N / BM; nwg = nM * nN; G = G_; c = c_; A = (const char*)A_; Bt = (const char*)Bt_; tstep = (size_t)BM * K * 2; }
    __device__ bool next(int i, Unit& u) const {
        const long L = (long)i * G + c; if (L >= nwg) return false;
        int wgid = (int)L; { const int q = nwg / NXCD, r = nwg % NXCD, xcd = wgid % NXCD, off = wgid / NXCD; wgid = (xcd < r ? xcd * (q + 1) : r * (q + 1) + (xcd - r) * q) + off; }
        const int nig = WGM * nN, gid = wgid / nig, fm = gid * WGM, gsz = (nM - fm) < WGM ? (nM - fm) : WGM;
        u.pm = fm + ((wgid % nig) % gsz); u.pn = (wgid % nig) / gsz; u.ex = 0; return true;
    }
    __device__ __forceinline__ const char* aptr(const Unit& u) const { return A + (size_t)u.pm * tstep; }
    __device__ __forceinline__ const char* bptr(const Unit& u) const { return Bt + (size_t)u.pn * tstep; }
};
struct MoeOrder {
    int nunits, NT, G, c; const LAS int* blk_e; const char* A; const char* W; size_t a_tstep, w_estride, w_tstep;
    __device__ bool next(int i, Unit& u) const {
        const long L = (long)i * G + c; if (L >= nunits) return false;
        u.pm = (int)L / NT; u.pn = (int)L % NT; u.ex = blk_e[u.pm]; return true;
    }
    __device__ __forceinline__ const char* aptr(const Unit& u) const { return A + (size_t)u.pm * a_tstep; }
    __device__ __forceinline__ const char* bptr(const Unit& u) const { return W + (size_t)u.ex * w_estride + (size_t)u.pn * w_tstep; }
};

template <class Epi, class Sched, bool ALIGN_EPI = true, bool SP2 = true>
__device__ __forceinline__ void gemm_phase(LAS unsigned char* lds, const int K_, const Sched& S, const Epi& E, const int tid, const int wid) {
    const int lane = tid & 63, wr = wid >> 2, wc = wid & 3, fr = lane & 15, fq = lane >> 4;
    int K = K_; asm volatile("" : "+s"(K));
    const int nt = K / BK;
    unsigned voffA[2], voffB[2];
#pragma unroll
    for (int i = 0; i < 2; ++i) { int R, C; stage_rc(tid * 16 + i * 8192, R, C); const int Rb = Epi::PERM ? ((R & ~31) + perm32(R & 31)) : R;
        voffA[i] = (unsigned)(R * K + C) * 2u; voffB[i] = (unsigned)(Rb * K + C) * 2u; }
    const size_t kstep = (size_t)(BK * 2);
    const size_t hstep = (size_t)HALF * K * 2;
    const unsigned ldsw = (unsigned)wid * 1024u;
    const int aoff = lds_byte(wr * 64 + fr, fq * 8), boff = lds_byte(wc * 32 + fr, fq * 8);
#define PG8_SA(b, h) (((b) * 2 + (h)) * HTB)
#define PG8_SB(b, h) ((4 + (b) * 2 + (h)) * HTB)
#define PG8_STAGE(bufoff, gbase, voff) do { _Pragma("unroll") for (int _i = 0; _i < 2; ++_i) \
        __builtin_amdgcn_global_load_lds((const unsigned*)((const char*)(gbase) + (voff)[_i]), (LAS unsigned*)(lds + (bufoff) + ldsw + _i * 8192), 16, 0, 0); } while (0)
#define PG8_LDA(dst, b, h) do { _Pragma("unroll") for (int m = 0; m < 4; ++m) _Pragma("unroll") for (int k = 0; k < 2; ++k) dst[m][k] = *(const LAS bf16x8*)(lds + PG8_SA(b, h) + aoff + m * 2048 + k * 1024); } while (0)
#define PG8_LDB(dst, b, h) do { _Pragma("unroll") for (int n = 0; n < 2; ++n) _Pragma("unroll") for (int k = 0; k < 2; ++k) dst[n][k] = *(const LAS bf16x8*)(lds + PG8_SB(b, h) + boff + n * 2048 + k * 1024); } while (0)
#define PG8_MMA(ai, bj, At, Bt) do { __builtin_amdgcn_s_setprio(1); _Pragma("unroll") for (int m = 0; m < 4; ++m) _Pragma("unroll") for (int n = 0; n < 2; ++n) _Pragma("unroll") for (int k = 0; k < 2; ++k) \
        acc[ai][bj][m][n] = __builtin_amdgcn_mfma_f32_16x16x32_bf16(Bt[n][k], At[m][k], acc[ai][bj][m][n], 0, 0, 0); __builtin_amdgcn_s_setprio(0); } while (0)
#define PG8_WAIT_V(n) asm volatile("s_waitcnt vmcnt(" #n ")" ::: "memory")
#define PG8_WAIT_L(n) asm volatile("s_waitcnt lgkmcnt(" #n ")" ::: "memory")
#define PG8_BAR __builtin_amdgcn_s_barrier()
#define PG8_SCHED __builtin_amdgcn_sched_barrier(0)
    Unit cur, nxt; int ui = 0;
    if (!S.next(0, cur)) return;
    f32x4 acc[2][2][4][2];
#pragma unroll
    for (int a = 0; a < 2; ++a)
#pragma unroll
        for (int b = 0; b < 2; ++b)
#pragma unroll
            for (int m = 0; m < 4; ++m)
#pragma unroll
                for (int n = 0; n < 2; ++n) acc[a][b][m][n] = (f32x4){0.f, 0.f, 0.f, 0.f};
    bf16x8 At[4][2], B0[2][2], B1[2][2];
    const char* cA = S.aptr(cur); const char* cB = S.bptr(cur);
    if constexpr (SP2) {
        PG8_STAGE(PG8_SB(0, 0), cB, voffB); PG8_STAGE(PG8_SB(0, 1), cB + hstep, voffB); PG8_STAGE(PG8_SA(0, 0), cA, voffA); PG8_STAGE(PG8_SA(0, 1), cA + hstep, voffA);
        if (wr == 1) PG8_BAR;
        PG8_WAIT_V(2); PG8_BAR;
        PG8_STAGE(PG8_SB(1, 0), cB + kstep, voffB); PG8_STAGE(PG8_SA(1, 0), cA + kstep, voffA); PG8_STAGE(PG8_SB(1, 1), cB + hstep + kstep, voffB);
        PG8_WAIT_V(6); PG8_BAR;
    } else {
        PG8_STAGE(PG8_SB(0, 0), cB, voffB); PG8_STAGE(PG8_SA(0, 0), cA, voffA); PG8_STAGE(PG8_SB(0, 1), cB + hstep, voffB); PG8_STAGE(PG8_SA(0, 1), cA + hstep, voffA);
        if (wr == 1) PG8_BAR;
        PG8_WAIT_V(4); PG8_BAR;
        PG8_STAGE(PG8_SB(1, 0), cB + kstep, voffB); PG8_STAGE(PG8_SA(1, 0), cA + kstep, voffA); PG8_STAGE(PG8_SB(1, 1), cB + hstep + kstep, voffB);
        PG8_WAIT_V(6); PG8_BAR;
    }
    for (;;) {
        const bool has_next = S.next(ui + 1, nxt);
        const char* nA = has_next ? S.aptr(nxt) : cA; const char* nB = has_next ? S.bptr(nxt) : cB;
        for (int t = 0; t < nt; t += 2) {
            const bool last = (t == nt - 2);
            const char* a1 = cA + (size_t)(t + 1) * kstep;
            const char* a2 = last ? nA : cA + (size_t)(t + 2) * kstep; const char* b2 = last ? nB : cB + (size_t)(t + 2) * kstep;
            const char* a3 = a2 + kstep; const char* b3 = b2 + kstep;
            if constexpr (SP2) {
            PG8_LDB(B0, 0, 0); PG8_LDB(B1, 0, 1); PG8_SCHED; PG8_LDA(At, 0, 0); PG8_STAGE(PG8_SA(1, 1), a1 + hstep, voffA);
            PG8_WAIT_V(8); PG8_WAIT_L(0); PG8_BAR; PG8_MMA(0, 0, At, B0); PG8_MMA(0, 1, At, B1); PG8_BAR; PG8_SCHED;
            PG8_LDA(At, 0, 1); PG8_STAGE(PG8_SB(0, 0), b2, voffB); PG8_STAGE(PG8_SB(0, 1), b2 + hstep, voffB); PG8_STAGE(PG8_SA(0, 0), a2, voffA);
            PG8_WAIT_V(8); PG8_WAIT_L(0); PG8_BAR; PG8_MMA(1, 0, At, B0); PG8_MMA(1, 1, At, B1); PG8_BAR; PG8_SCHED;
            PG8_LDB(B0, 1, 0); PG8_LDB(B1, 1, 1); PG8_SCHED; PG8_LDA(At, 1, 0); PG8_STAGE(PG8_SA(0, 1), a2 + hstep, voffA);
            PG8_WAIT_V(8); PG8_WAIT_L(0); PG8_BAR; PG8_MMA(0, 0, At, B0); PG8_MMA(0, 1, At, B1); PG8_BAR; PG8_SCHED;
            PG8_LDA(At, 1, 1); PG8_STAGE(PG8_SB(1, 0), b3, voffB); PG8_STAGE(PG8_SB(1, 1), b3 + hstep, voffB); PG8_STAGE(PG8_SA(1, 0), a3, voffA);
            PG8_WAIT_V(8); PG8_WAIT_L(0); PG8_BAR; PG8_MMA(1, 0, At, B0); PG8_MMA(1, 1, At, B1); PG8_BAR; PG8_SCHED;
            } else {
            PG8_LDB(B0, 0, 0); PG8_SCHED; PG8_LDA(At, 0, 0); PG8_STAGE(PG8_SA(1, 1), a1 + hstep, voffA);
            PG8_WAIT_L(8); PG8_BAR; PG8_WAIT_L(0); PG8_MMA(0, 0, At, B0); PG8_BAR; PG8_SCHED;
            PG8_LDB(B1, 0, 1); PG8_STAGE(PG8_SB(0, 0), b2, voffB);
            PG8_BAR; PG8_WAIT_L(0); PG8_MMA(0, 1, At, B1); PG8_BAR;
            PG8_LDA(At, 0, 1); PG8_STAGE(PG8_SA(0, 0), a2, voffA);
            PG8_BAR; PG8_WAIT_L(0); PG8_MMA(1, 0, At, B0); PG8_BAR; PG8_SCHED;
            PG8_STAGE(PG8_SB(0, 1), b2 + hstep, voffB);
            PG8_WAIT_V(6); PG8_BAR; PG8_MMA(1, 1, At, B1); PG8_BAR;
            PG8_LDB(B0, 1, 0); PG8_SCHED; PG8_LDA(At, 1, 0); PG8_STAGE(PG8_SA(0, 1), a2 + hstep, voffA);
            PG8_WAIT_L(8); PG8_BAR; PG8_WAIT_L(0); PG8_MMA(0, 0, At, B0); PG8_BAR; PG8_SCHED;
            PG8_LDB(B1, 1, 1); PG8_STAGE(PG8_SB(1, 0), b3, voffB);
            PG8_BAR; PG8_WAIT_L(0); PG8_MMA(0, 1, At, B1); PG8_BAR;
            PG8_LDA(At, 1, 1); PG8_STAGE(PG8_SA(1, 0), a3, voffA);
            PG8_BAR; PG8_WAIT_L(0); PG8_MMA(1, 0, At, B0); PG8_BAR; PG8_SCHED;
            PG8_STAGE(PG8_SB(1, 1), b3 + hstep, voffB);
            PG8_WAIT_V(6); PG8_BAR; PG8_MMA(1, 1, At, B1); PG8_BAR;
            }
        }
        if constexpr (ALIGN_EPI) { if (wr == 0) PG8_BAR; }
        E(acc, cur, wr, wc, fr, fq);
        if (!has_next) break;
#pragma unroll
        for (int a = 0; a < 2; ++a)
#pragma unroll
            for (int b = 0; b < 2; ++b)
#pragma unroll
                for (int m = 0; m < 4; ++m)
#pragma unroll
                    for (int n = 0; n < 2; ++n) acc[a][b][m][n] = (f32x4){0.f, 0.f, 0.f, 0.f};
        cur = nxt; cA = nA; cB = nB; ++ui;
        if constexpr (ALIGN_EPI) { if (wr == 1) PG8_BAR; }
    }
    PG8_WAIT_V(0);
    if constexpr (!ALIGN_EPI) { if (wr == 0) PG8_BAR; }
    PG8_BAR;
#undef PG8_SA
#undef PG8_SB
#undef PG8_STAGE
#undef PG8_LDA
#undef PG8_LDB
#undef PG8_MMA
#undef PG8_WAIT_V
#undef PG8_WAIT_L
#undef PG8_BAR
#undef PG8_SCHED
}

typedef const f32x4 (&AccRef)[2][2][4][2];
DI u32x4 pack8(const f32x4& v0, const f32x4& v1) { u32x4 w; w.x = cvtpk(v0[0], v0[1]); w.y = cvtpk(v0[2], v0[3]); w.z = cvtpk(v1[0], v1[1]); w.w = cvtpk(v1[2], v1[3]); return w; }

struct EpiBf16 {
    static constexpr bool PERM = true;
    bf16* O; int ldc;
    DI void operator()(AccRef acc, const Unit& u, int wr, int wc, int fr, int fq) const {
        const int row0 = u.pm * BM + wr * 64 + fr, col0 = u.pn * BM + wc * 32 + 8 * fq;
#pragma unroll
        for (int ai = 0; ai < 2; ++ai)
#pragma unroll
            for (int m = 0; m < 4; ++m) { bf16* rowp = O + (size_t)(row0 + ai * HALF + m * 16) * ldc + col0;
#pragma unroll
                for (int bj = 0; bj < 2; ++bj) *(u32x4*)(rowp + bj * HALF) = pack8(acc[ai][bj][m][0], acc[ai][bj][m][1]); }
    }
};
struct EpiF32 {
    static constexpr bool PERM = false;
    float* C; int ldc;
    DI void operator()(AccRef acc, const Unit& u, int wr, int wc, int fr, int fq) const {
        const int row0 = u.pm * BM + wr * 64 + fr, col0 = u.pn * BM + wc * 32 + 4 * fq;
#pragma unroll
        for (int ai = 0; ai < 2; ++ai)
#pragma unroll
            for (int m = 0; m < 4; ++m) { float* rowp = C + (size_t)(row0 + ai * HALF + m * 16) * ldc + col0;
#pragma unroll
                for (int bj = 0; bj < 2; ++bj)
#pragma unroll
                    for (int n = 0; n < 2; ++n) *(f32x4*)(rowp + bj * HALF + n * 16) = acc[ai][bj][m][n]; }
    }
};
struct EpiInProj {
    static constexpr bool PERM = true;
    bf16* P; float* PBA;
    DI void operator()(AccRef acc, const Unit& u, int wr, int wc, int fr, int fq) const {
        const int row0 = u.pm * BM + wr * 64 + fr;
        if (u.pn < 28) {
            const int col0 = u.pn * BM + wc * 32 + 8 * fq;
#pragma unroll
            for (int ai = 0; ai < 2; ++ai)
#pragma unroll
                for (int m = 0; m < 4; ++m) { bf16* rowp = P + (size_t)(row0 + ai * HALF + m * 16) * NP + col0;
#pragma unroll
                    for (int bj = 0; bj < 2; ++bj) *(u32x4*)(rowp + bj * HALF) = pack8(acc[ai][bj][m][0], acc[ai][bj][m][1]); }
        } else if (wc == 0 && fq < 2) {
#pragma unroll
            for (int ai = 0; ai < 2; ++ai)
#pragma unroll
                for (int m = 0; m < 4; ++m) { float* rp = PBA + (size_t)(row0 + ai * HALF + m * 16) * 16 + 8 * fq;
                    *(f32x4*)rp = acc[ai][0][m][0]; *(f32x4*)(rp + 4) = acc[ai][0][m][1]; }
        }
    }
};
struct EpiResid {
    static constexpr bool PERM = false;
    const float* x; const float* g; float* R;
    DI void operator()(AccRef acc, const Unit& u, int wr, int wc, int fr, int fq) const {
        const int row0 = u.pm * BM + wr * 64 + fr, col0 = u.pn * BM + wc * 32 + 4 * fq;
        const float* gb = g + (size_t)((u.pm * BM) / SEQ) * 12288 + col0;
        f32x4 gv[2][2];
#pragma unroll
        for (int bj = 0; bj < 2; ++bj)
#pragma unroll
            for (int n = 0; n < 2; ++n) gv[bj][n] = *(const f32x4*)(gb + bj * HALF + n * 16) + 1.0f;
#pragma unroll
        for (int ai = 0; ai < 2; ++ai)
#pragma unroll
            for (int m = 0; m < 4; ++m) { const size_t off = (size_t)(row0 + ai * HALF + m * 16) * D + col0;
#pragma unroll
                for (int bj = 0; bj < 2; ++bj)
#pragma unroll
                    for (int n = 0; n < 2; ++n) { const f32x4 xv = *(const f32x4*)(x + off + bj * HALF + n * 16);
                        *(f32x4*)(R + off + bj * HALF + n * 16) = xv * DN_ALPHA + gv[bj][n] * acc[ai][bj][m][n]; } }
    }
};
struct EpiLogits {
    static constexpr bool PERM = false;
    float* L;
    DI void operator()(AccRef acc, const Unit& u, int wr, int wc, int fr, int fq) const {
        const int row0 = u.pm * BM + wr * 64 + fr, col0 = wc * 32 + 4 * fq;
#pragma unroll
        for (int ai = 0; ai < 2; ++ai)
#pragma unroll
            for (int m = 0; m < 4; ++m) { float* rowp = L + (size_t)(row0 + ai * HALF + m * 16) * 128 + col0;
#pragma unroll
                for (int n = 0; n < 2; ++n) *(f32x4*)(rowp + n * 16) = acc[ai][0][m][n]; }
    }
};
struct EpiGateUp {
    static constexpr bool PERM = true;
    bf16* H;
    DI void operator()(AccRef acc, const Unit& u, int wr, int wc, int fr, int fq) const {
        const int row0 = u.pm * BM + wr * 64 + fr, col0 = u.pn * HALF + wc * 32 + 8 * fq;
#pragma unroll
        for (int ai = 0; ai < 2; ++ai)
#pragma unroll
            for (int m = 0; m < 4; ++m) { bf16* rowp = H + (size_t)(row0 + ai * HALF + m * 16) * FF + col0;
                f32x4 h0, h1;
#pragma unroll
                for (int j = 0; j < 4; ++j) { h0[j] = silu_f(acc[ai][0][m][0][j]) * acc[ai][1][m][0][j]; h1[j] = silu_f(acc[ai][0][m][1][j]) * acc[ai][1][m][1][j]; }
                *(u32x4*)rowp = pack8(h0, h1); }
    }
};
struct EpiQup {
    static constexpr bool PERM = true;
    bf16* Q;
    DI void operator()(AccRef acc, const Unit& u, int wr, int wc, int fr, int fq) const {
        const int row0 = u.pm * BM + wr * 64 + fr, b = (u.pm * BM) / SEQ, s0 = row0 - b * SEQ;
        const int cg0 = u.pn * BM + wc * 32 + 8 * fq, cg1 = cg0 + HALF;
        const int h0 = cg0 / QD, w0 = cg0 - h0 * QD, h1 = cg1 / QD, w1 = cg1 - h1 * QD;
        bf16* d0 = Q + ((size_t)((b * MH + h0) * SEQ + s0)) * QD + w0; bf16* d1 = Q + ((size_t)((b * MH + h1) * SEQ + s0)) * QD + w1;
#pragma unroll
        for (int ai = 0; ai < 2; ++ai)
#pragma unroll
            for (int m = 0; m < 4; ++m) { const int dr = (ai * HALF + m * 16) * QD;
                *(u32x4*)(d0 + dr) = pack8(acc[ai][0][m][0] * QSCALE, acc[ai][0][m][1] * QSCALE);
                *(u32x4*)(d1 + dr) = pack8(acc[ai][1][m][0] * QSCALE, acc[ai][1][m][1] * QSCALE);
                asm volatile("" ::: "memory"); }
    }
};
struct EpiKVup {
    static constexpr bool PERM = true;
    bf16* Kp; bf16* V;
    DI void operator()(AccRef acc, const Unit& u, int wr, int wc, int fr, int fq) const {
        const int row0 = u.pm * BM + wr * 64 + fr, c0 = wc * 32 + 8 * fq, head = u.pn, b = (u.pm * BM) / SEQ, s0 = row0 - b * SEQ;
        bf16* dk = Kp + ((size_t)((b * MH + head) * SEQ + s0)) * QD + c0; bf16* dv = V + (size_t)row0 * D + head * 128 + c0;
#pragma unroll
        for (int ai = 0; ai < 2; ++ai)
#pragma unroll
            for (int m = 0; m < 4; ++m) { const int dr = ai * HALF + m * 16;
                *(u32x4*)(dk + dr * QD) = pack8(acc[ai][0][m][0], acc[ai][0][m][1]);
                *(u32x4*)(dv + dr * D) = pack8(acc[ai][1][m][0], acc[ai][1][m][1]);
                asm volatile("" ::: "memory"); }
    }
};
}

#define XB_TMO      128
#define XB_XCNT(j)  (256  + 64 * (j))
#define XB_XSUB(j)  (1280 + 64 * (j))
#define XB_XGEN(j)  (2304 + 64 * (j))
#define XB_TOP      3328
#define XB_TOPGEN   3392
#define XCD_BAR_WORDS 3456
#define XB_SPIN_CAP (1u << 18)
__device__ __forceinline__ unsigned xb_ld(unsigned* p)              { return __hip_atomic_load(p, __ATOMIC_RELAXED, __HIP_MEMORY_SCOPE_AGENT); }
__device__ __forceinline__ unsigned xb_add(unsigned* p, unsigned v) { return __hip_atomic_fetch_add(p, v, __ATOMIC_RELAXED, __HIP_MEMORY_SCOPE_AGENT); }
__device__ __forceinline__ unsigned xb_xcc_id() { return (unsigned)__builtin_amdgcn_s_getreg((3 << 11) | 20) & 0xFu; }
#define XB_SPIN(cond, bar) do { unsigned _sp = 0; while (cond) { __builtin_amdgcn_s_sleep(1); \
    if ((++_sp & 255u) == 0u) { if (xb_ld(&(bar)[XB_TMO])) break; if (_sp > XB_SPIN_CAP) { atomicAdd(&(bar)[XB_TMO], 1u); break; } } } } while (0)
struct XcdBarrier { unsigned* bar; unsigned x; volatile LAS unsigned* st; };
__device__ __forceinline__ XcdBarrier xcd_barrier_post(unsigned* bar, volatile LAS unsigned* st, const bool leader  ) {
    XcdBarrier b; b.bar = bar; b.x = xb_xcc_id(); b.st = st;
    if (leader) (void)xb_add(&bar[XB_XCNT(b.x)], 1u);
    return b;
}
__device__ __forceinline__ void xcd_barrier_complete(unsigned* bar, unsigned x, unsigned& nloc, unsigned& nx) {
    const unsigned G = gridDim.x * gridDim.y * gridDim.z;
    unsigned sum, cnt, mine, sp = 0u;
    for (;;) {
        sum = 0u; cnt = 0u; mine = 0u;
#pragma unroll
        for (unsigned j = 0; j < 16; ++j) { const unsigned c = xb_ld(&bar[XB_XCNT(j)]); sum += c; cnt += (c > 0u) ? 1u : 0u; mine = (j == x) ? c : mine; }
        if (sum == G) break;
        __builtin_amdgcn_s_sleep(1);
        if ((++sp & 255u) == 0u) { if (xb_ld(&bar[XB_TMO])) break; if (sp > XB_SPIN_CAP) { atomicAdd(&bar[XB_TMO], 1u); break; } }
    }
    nloc = mine > 0u ? mine : 1u; nx = cnt > 0u ? cnt : 1u;
}
__device__ __forceinline__ void xcd_barrier(const XcdBarrier& b, const bool leader  ) {
    asm volatile("s_waitcnt vmcnt(0)" ::: "memory");
    __syncthreads();
    if (leader) {
        unsigned* bar = b.bar;
        __builtin_amdgcn_s_waitcnt(0);
        unsigned nloc = b.st[0], nx = b.st[1];
        if (nloc == 0u) { xcd_barrier_complete(bar, b.x, nloc, nx); b.st[0] = nloc; b.st[1] = nx; }
        const unsigned old = xb_add(&bar[XB_XSUB(b.x)], 1u);
        const unsigned gen = old / nloc;
        if (old + 1u == (gen + 1u) * nloc) {
            __builtin_amdgcn_fence(__ATOMIC_RELEASE, "agent");
            asm volatile("s_waitcnt vmcnt(0)" ::: "memory");
            const unsigned og = xb_add(&bar[XB_TOP], 1u);
            const unsigned tg = og / nx;
            if (og + 1u == (tg + 1u) * nx) xb_add(&bar[XB_TOPGEN], 1u);
            else XB_SPIN(xb_ld(&bar[XB_TOPGEN]) == tg, bar);
            __builtin_amdgcn_fence(__ATOMIC_ACQUIRE, "agent");
            xb_add(&bar[XB_XGEN(b.x)], 1u);
            asm volatile("s_waitcnt vmcnt(0)" ::: "memory");
        } else {
            XB_SPIN(xb_ld(&bar[XB_XGEN(b.x)]) == gen, bar);
            __builtin_amdgcn_fence(__ATOMIC_ACQUIRE, "agent");
            asm volatile("s_waitcnt vmcnt(0)" ::: "memory");
        }
    }
    __syncthreads();
}

struct Frame {
    LAS unsigned char* lds;
    int tid, lane, wave, vcu, G, gw, NGW;
    unsigned* ctl;
};
struct Args { const void* in[27]; float* out; unsigned char* ws; int ph_lo, ph_hi; };

__device__ const double ROPE_INVF[32] = {1, 0.74989420933245587, 0.56234132519034907, 0.42169650342858223, 0.31622776601683794, 0.23713737056616552, 0.17782794100389229, 0.1333521432163324,
    0.10000000000000001, 0.074989420933245579, 0.056234132519034911, 0.042169650342858224, 0.031622776601683791, 0.023713737056616554, 0.017782794100389229, 0.013335214321633241,
    0.01, 0.0074989420933245579, 0.005623413251903491, 0.0042169650342858229, 0.0031622776601683794, 0.0023713737056616554, 0.0017782794100389228, 0.0013335214321633241,
    0.001, 0.00074989420933245586, 0.0005623413251903491, 0.00042169650342858224, 0.00031622776601683794, 0.00023713737056616554, 0.00017782794100389227, 0.0001333521432163324};

struct TrRegs { f32x4 r[8]; };
DI void tr_load(TrRegs& t, const float* W, size_t ld, int k0, int n0, int nvalid, int lane) {
    const int ns = lane & 7, kq = lane >> 3;
    if (4 * ns < nvalid) { const float* src = W + (size_t)(k0 + 8 * kq) * ld + n0 + 4 * ns;
#pragma unroll
        for (int j = 0; j < 8; ++j) t.r[j] = *(const f32x4*)(src + (size_t)j * ld); }
}
DI void tr_store(const TrRegs& t, int k0, int nvalid, bf16* WT, int Kd, int drow0, int lane) {
    const int ns = lane & 7, kq = lane >> 3;
    if (4 * ns < nvalid) { bf16* dst = WT + (size_t)(drow0 + 4 * ns) * Kd + k0 + 8 * kq;
#pragma unroll
        for (int i = 0; i < 4; ++i) { u32x4 o; o.x = cvtpk(t.r[0][i], t.r[1][i]); o.y = cvtpk(t.r[2][i], t.r[3][i]); o.z = cvtpk(t.r[4][i], t.r[5][i]); o.w = cvtpk(t.r[6][i], t.r[7][i]);
            *(u32x4*)(dst + (size_t)i * Kd) = o; } }
}
DI void tr_job(const Frame& F, const float* W, size_t smat, int nmat, int ld, int K, int col0, int ncols, bf16* WT, size_t dmat, int Kd, int row_off, int mode) {
    const int nblk = (ncols + 31) / 32, kbs = K / 64, per = nblk * kbs; const long items = (long)nmat * per;
    for (long it0 = F.gw; it0 < items; it0 += 2 * (long)F.NGW) {
        TrRegs t[2]; int k0[2], nv[2], dr[2]; bf16* wt[2];
#pragma unroll
        for (int u = 0; u < 2; ++u) {
            const long it = it0 + (long)u * F.NGW;
            if (it < items) {
                const int mat = (int)(it / per), rem = (int)(it - (long)mat * per), kb = rem / nblk, nb = rem - kb * nblk;
                nv[u] = (ncols - nb * 32) < 32 ? (ncols - nb * 32) : 32; k0[u] = kb * 64;
                dr[u] = (mode == 0) ? (row_off + nb * 32) : ((nb >> 2) * 256 + row_off + (nb & 3) * 32);
                wt[u] = WT + (size_t)mat * dmat;
                tr_load(t[u], W + (size_t)mat * smat, (size_t)ld, k0[u], col0 + nb * 32, nv[u], F.lane);
            } else { nv[u] = 0; k0[u] = 0; dr[u] = 0; wt[u] = WT; }
        }
#pragma unroll
        for (int u = 0; u < 2; ++u) tr_store(t[u], k0[u], nv[u], wt[u], Kd, dr[u], F.lane);
    }
}
DI void zero_fill(const Frame& F, void* p, size_t bytes) {
    u32x4* q = (u32x4*)p; const size_t n = bytes / 16;
    for (size_t i = (size_t)F.gw * 64 + F.lane; i < n; i += (size_t)F.NGW * 64) q[i] = (u32x4){0u, 0u, 0u, 0u};
}

DI const void* arg_in(int k) { unsigned o = (unsigned)k * 8u; asm volatile("" : "+s"(o));
    return *(const void* const __attribute__((address_space(4)))*)((const __attribute__((address_space(4))) unsigned char*)__builtin_amdgcn_kernarg_segment_ptr() + o); }
#define WSB (args.ws)
#define in_x ((const float*)arg_in(0))
#define in_c ((const float*)arg_in(1))
#define in_pos ((const int*)arg_in(2))
#define ada_w ((const float*)arg_in(3))
#define ada_b ((const float*)arg_in(4))
#define ln_g ((const float*)arg_in(5))
#define ln_b ((const float*)arg_in(6))
#define hyb_w_in ((const float*)arg_in(7))
#define gdn_conv_w ((const float*)arg_in(8))
#define gdn_a_log ((const float*)arg_in(9))
#define gdn_dt_bias ((const float*)arg_in(10))
#define gdn_norm_w ((const float*)arg_in(11))
#define sc_conv_w ((const float*)arg_in(12))
#define hyb_w_out ((const float*)arg_in(13))
#define mla_w_in ((const float*)arg_in(14))
#define mla_q_norm ((const float*)arg_in(15))
#define mla_kv_norm ((const float*)arg_in(16))
#define mla_w_uq ((const float*)arg_in(17))
#define mla_w_ukv ((const float*)arg_in(18))
#define mla_w_out ((const float*)arg_in(19))
#define moe_router_g ((const float*)arg_in(20))
#define moe_bias_g ((const float*)arg_in(21))
#define moe_router_e ((const float*)arg_in(22))
#define moe_bias_e ((const float*)arg_in(23))
#define moe_w_gate ((const float*)arg_in(24))
#define moe_w_up ((const float*)arg_in(25))
#define moe_w_down ((const float*)arg_in(26))
#define MOD ((float*)(WSB + WS_MOD))
#define ROPE_C ((float*)(WSB + WS_ROPE))
#define ROPE_S ((float*)(ROPE_C + (size_t)T * 32))
#define PBA ((float*)(WSB + WS_PBA))
#define LOGITS ((float*)(WSB + WS_LOGITS))
#define TOK_E ((int*)(WSB + WS_ROUTE))
#define TOK_POS ((int*)(TOK_E + 2 * T))
#define TOK_GATE ((float*)(TOK_POS + 2 * T))
#define EG ((float*)(WSB + WS_EG))
#define WIN0 ((bf16*)(WSB + WS_WIN0))
#define WOUT0 ((bf16*)(WSB + WS_WOUT0))
#define WMIN ((bf16*)(WSB + WS_WMIN))
#define WUQ ((bf16*)(WSB + WS_WUQ))
#define WUKV ((bf16*)(WSB + WS_WUKV))
#define WMOUT ((bf16*)(WSB + WS_WMOUT))
#define WRT ((bf16*)(WSB + WS_WRT))
#define WGU ((bf16*)(WSB + WS_WGU))
#define WDN ((bf16*)(WSB + WS_WDN))
#define HIN ((bf16*)(WSB + WS_HIN))
#define XA ((float*)(WSB + WS_XA))
#define XB ((float*)(WSB + WS_XB))
#define RB ((float*)(WSB + WS_R))
#define PB ((bf16*)(WSB + WS_P))
#define GF ((unsigned char*)(WSB + WS_GF))
#define GU ((unsigned char*)(WSB + WS_GU))
#define GO ((float*)(WSB + WS_GO))
#define YAB ((bf16*)(WSB + WS_YAB))
#define XS ((bf16*)(WSB + WS_XS))
#define HID ((bf16*)(WSB + WS_HID))
#define YS ((bf16*)(WSB + WS_YS))
#define C1 ((float*)(WSB + WS_C1))
#define CQN ((bf16*)(WSB + WS_CQN))
#define CKVN ((bf16*)(WSB + WS_CKVN))
#define KPE ((float*)(WSB + WS_KPE))
#define QB_ ((bf16*)(WSB + WS_Q))
#define KB_ ((bf16*)(WSB + WS_K))
#define VB_ ((bf16*)(WSB + WS_V))
#define VT ((bf16*)(WSB + WS_VT))


#define LN_ROW(v, gptr, bptr) do { float _s = 0.f; _Pragma("unroll") for (int _j = 0; _j < 8; ++_j) _s += (v[_j][0] + v[_j][1]) + (v[_j][2] + v[_j][3]); \
        const float _mean = wave_sum(_s) * (1.f / D); float _q = 0.f; \
        _Pragma("unroll") for (int _j = 0; _j < 8; ++_j) { v[_j] = v[_j] - _mean; _q += (v[_j][0] * v[_j][0] + v[_j][1] * v[_j][1]) + (v[_j][2] * v[_j][2] + v[_j][3] * v[_j][3]); } \
        const float _rstd = rsqrtf(wave_sum(_q) * (1.f / D) + 1e-5f); \
        _Pragma("unroll") for (int _j = 0; _j < 8; ++_j) v[_j] = v[_j] * _rstd * ((const f32x4*)(gptr))[F.lane + 64 * _j] + ((const f32x4*)(bptr))[F.lane + 64 * _j]; } while (0)
#define WRITE_X_HIN(v, xrow, hrow, shp, scp) do { _Pragma("unroll") for (int _j = 0; _j < 8; ++_j) { ((f32x4*)(xrow))[F.lane + 64 * _j] = v[_j]; \
        if ((hrow) != nullptr) { const f32x4 _h = v[_j] * (((const f32x4*)(scp))[F.lane + 64 * _j] + 1.0f) + ((const f32x4*)(shp))[F.lane + 64 * _j]; \
            u32x2 _w; _w.x = cvtpk(_h[0], _h[1]); _w.y = cvtpk(_h[2], _h[3]); ((u32x2*)(hrow))[F.lane + 64 * _j] = _w; } } } while (0)


#ifndef PHMASK
#define PHMASK 0xFFFFFFFFull
#endif
#define PH_EN(k) (((PHMASK) >> (k)) & 1ull)
#define IN(k) (PH_EN(k) && lo <= (k) && (k) < hi)
#define INL(k0, k1) ((L == 0) ? IN(k0) : IN(k1))
#define PHASE_FRESH() do { int _l; asm volatile("v_mbcnt_lo_u32_b32 %0, -1, 0\n\tv_mbcnt_hi_u32_b32 %0, -1, %0" : "=v"(_l)); F.lane = _l; F.tid = F.wave * 64 + _l; } while (0)
#define SEAM(k) do { if (IN(k) && IN((k) + 1)) { PHASE_FRESH(); xcd_barrier(bar, F.tid == 0); } } while (0)

template <int L> DI void moe_phases(Frame& F, const Args& args, const XcdBarrier& bar, const int lo, const int hi, LAS int* TAB) {
        unsigned* cnt = F.ctl + CW_CNT + L * 64;
    if (INL(8, 21)) { PHASE_FRESH();
        pg8::StaticOrder S; S.init(HIN, WRT + (size_t)L * 256 * D, T, 256, D, F.G, (int)blockIdx.x);
        pg8::EpiLogits E{LOGITS};
        pg8::gemm_phase<pg8::EpiLogits, pg8::StaticOrder>(F.lds, D, S, E, F.tid, F.wave);
    }
    if (L == 0) SEAM(8); else SEAM(21);
    if (INL(9, 22)) { PHASE_FRESH();
        const float* bg = moe_bias_g + L * 8; const float* be = moe_bias_e + L * 64;
        for (int t = blockIdx.x * 512 + F.tid; t < T; t += F.G * 512) {
            const float* lg = LOGITS + (size_t)t * 128;
            float l8[8]; float mx = -3.0e38f; int grp = 0;
#pragma unroll
            for (int g = 0; g < 8; ++g) { l8[g] = lg[g] + bg[g]; if (l8[g] > mx) { mx = l8[g]; grp = g; } }
            float se = 0.f;
#pragma unroll
            for (int g = 0; g < 8; ++g) se += __expf(l8[g] - mx);
            const float pg = 1.f / se;
            float e8[8];
#pragma unroll
            for (int j = 0; j < 8; ++j) e8[j] = lg[8 + grp * 8 + j] + be[grp * 8 + j];
            int i1 = 0; float m1 = e8[0];
#pragma unroll
            for (int j = 1; j < 8; ++j) if (e8[j] > m1) { m1 = e8[j]; i1 = j; }
            int i2 = -1; float m2 = -3.0e38f;
#pragma unroll
            for (int j = 0; j < 8; ++j) if (j != i1 && e8[j] > m2) { m2 = e8[j]; i2 = j; }
            const float rr = __expf(m2 - m1), g1 = pg / (1.f + rr), g2 = pg * rr / (1.f + rr);
            const int ex1 = grp * 8 + i1, ex2 = grp * 8 + i2;
            const int p1 = (int)atomicAdd(&cnt[ex1], 1u), p2 = (int)atomicAdd(&cnt[ex2], 1u);
            TOK_E[2 * t] = ex1; TOK_E[2 * t + 1] = ex2; TOK_POS[2 * t] = p1; TOK_POS[2 * t + 1] = p2; TOK_GATE[2 * t] = g1; TOK_GATE[2 * t + 1] = g2;
        }
    }
    if (L == 0) SEAM(9); else SEAM(22);
    if (INL(10, 23)) { PHASE_FRESH();
        if (F.tid == 0) { int a = 0; for (int e = 0; e < NE; ++e) { TAB[128 + e] = a; const int nb = ((int)cnt[e] + 255) >> 8; for (int q = 0; q < nb; ++q) TAB[a + q] = e; a += nb; } TAB[192] = a; }
        __syncthreads();
        if (blockIdx.x == 0 && F.tid < 129) F.ctl[CW_BLK + L * 256 + F.tid] = (unsigned)((F.tid < 128) ? TAB[F.tid] : TAB[192]);
        for (int a = F.gw; a < 2 * T; a += F.NGW) {
            const int t = a >> 1, e = TOK_E[a], pos = TOK_POS[a], row = TAB[128 + e] * 256 + pos;
            const u32x4* src = (const u32x4*)(HIN + (size_t)t * D) + F.lane; u32x4* dst = (u32x4*)(XS + (size_t)row * D) + F.lane;
#pragma unroll
            for (int j = 0; j < 4; ++j) dst[64 * j] = src[64 * j];
        }
    }
    if (L == 0) SEAM(10); else SEAM(23);
    if (INL(11, 24)) { PHASE_FRESH();
        if (F.tid < 129) TAB[F.tid < 128 ? F.tid : 192] = (int)F.ctl[CW_BLK + L * 256 + F.tid];
        __syncthreads();
        pg8::MoeOrder S; S.nunits = TAB[192] * 4; S.NT = 4; S.G = F.G; S.c = F.vcu; S.blk_e = TAB; S.A = (const char*)XS; S.W = (const char*)(WGU + (size_t)L * 64 * 1024 * D);
        S.a_tstep = (size_t)256 * D * 2; S.w_estride = (size_t)1024 * D * 2; S.w_tstep = (size_t)256 * D * 2;
        pg8::EpiGateUp E{HID};
        pg8::gemm_phase<pg8::EpiGateUp, pg8::MoeOrder>(F.lds, D, S, E, F.tid, F.wave);
    }
    if (L == 0) SEAM(11); else SEAM(24);
    if (INL(12, 25)) { PHASE_FRESH();
        if (F.tid < 129) TAB[F.tid < 128 ? F.tid : 192] = (int)F.ctl[CW_BLK + L * 256 + F.tid];
        __syncthreads();
        pg8::MoeOrder S; S.nunits = TAB[192] * 8; S.NT = 8; S.G = F.G; S.c = F.vcu; S.blk_e = TAB; S.A = (const char*)HID; S.W = (const char*)(WDN + (size_t)L * 64 * D * FF);
        S.a_tstep = (size_t)256 * FF * 2; S.w_estride = (size_t)D * FF * 2; S.w_tstep = (size_t)256 * FF * 2;
        pg8::EpiBf16 E{YS, D};
        pg8::gemm_phase<pg8::EpiBf16, pg8::MoeOrder>(F.lds, FF, S, E, F.tid, F.wave);
    }
    if (L == 0) SEAM(12); else SEAM(25);
    if (INL(13, 26)) { PHASE_FRESH();
        if (F.tid == 0) { int a = 0; for (int e = 0; e < NE; ++e) { TAB[128 + e] = a; a += ((int)cnt[e] + 255) >> 8; } }
        __syncthreads();
        float* xout = (L == 0) ? XB : args.out;
        for (int m = F.gw; m < T; m += F.NGW) {
            const int b = m / SEQ; const float* modb = MOD + (size_t)(L * 4 + b) * 12288;
            const int r0 = TAB[128 + TOK_E[2 * m]] * 256 + TOK_POS[2 * m], r1 = TAB[128 + TOK_E[2 * m + 1]] * 256 + TOK_POS[2 * m + 1];
            const float g0 = TOK_GATE[2 * m], g1 = TOK_GATE[2 * m + 1];
            f32x4 v[8];
#pragma unroll
            for (int j = 0; j < 8; ++j) {
                const f32x4 xv = ((const f32x4*)(XA + (size_t)m * D))[F.lane + 64 * j];
                const u32x2 ya = ((const u32x2*)(YS + (size_t)r0 * D))[F.lane + 64 * j], yb = ((const u32x2*)(YS + (size_t)r1 * D))[F.lane + 64 * j];
                const f32x4 gg = ((const f32x4*)(modb + 5 * D))[F.lane + 64 * j] + 1.0f;
                f32x4 y; y[0] = g0 * bflo(ya.x) + g1 * bflo(yb.x); y[1] = g0 * bfhi(ya.x) + g1 * bfhi(yb.x); y[2] = g0 * bflo(ya.y) + g1 * bflo(yb.y); y[3] = g0 * bfhi(ya.y) + g1 * bfhi(yb.y);
                v[j] = xv * DN_ALPHA + gg * y;
            }
            LN_ROW(v, ln_g + (size_t)(L * 2 + 1) * D, ln_b + (size_t)(L * 2 + 1) * D);
            bf16* hrow = (L == 0) ? HIN + (size_t)m * D : nullptr;
            const float* mod1 = MOD + (size_t)(4 + b) * 12288;
            WRITE_X_HIN(v, xout + (size_t)m * D, hrow, mod1, mod1 + D);
        }
    }
    if (L == 0) SEAM(13);
}

__global__ void __launch_bounds__(512, 2) mega(Args args) {
    extern __shared__ __attribute__((aligned(16))) unsigned char lds_raw[];
    Frame F;
    F.lds = (LAS unsigned char*)lds_raw;
    F.wave = __builtin_amdgcn_readfirstlane((int)threadIdx.x >> 6); PHASE_FRESH();
    F.G = gridDim.x; { const int bx = blockIdx.x; F.vcu = (F.G % 8 == 0) ? (bx % 8) * (F.G / 8) + bx / 8 : bx; }
    F.gw = F.vcu * 8 + F.wave; F.NGW = F.G * 8;
    F.ctl = (unsigned*)(args.ws + WS_CTL);
    volatile LAS unsigned* MISC = (volatile LAS unsigned*)(F.lds + MISC_OFF);
    LAS int* TAB = (LAS int*)(F.lds + TAB_OFF);
    for (int u = F.tid; u < (LDS_BYTES - LDSCTL_OFF) / 4; u += 512) ((LAS unsigned*)(F.lds + LDSCTL_OFF))[u] = 0u;
    __syncthreads();
    XcdBarrier bar; bar.bar = F.ctl + CW_BAR; bar.x = 0; bar.st = nullptr;
    if (MK_ONE_LAUNCH) bar = xcd_barrier_post(F.ctl + CW_BAR, MISC + 8, F.tid == 0);
    const int lo = args.ph_lo, hi = args.ph_hi;

    if (IN(0)) { PHASE_FRESH();
        {
            LAS float* cact = (LAS float*)F.lds;
            LAS float* red = (LAS float*)(F.lds + 32768);
            for (int i = F.tid; i < 4 * D; i += 512) cact[i] = silu_f(in_c[i]);
            __syncthreads();
            for (int cg = blockIdx.x; cg < 256; cg += F.G) {
                const int jj0 = cg * 96, l = jj0 / 12288, j0 = jj0 - l * 12288;
                const int rsub = F.lane / 24, c4 = F.lane - rsub * 24;
                f32x4 a0 = {0.f, 0.f, 0.f, 0.f}, a1 = a0, a2 = a0, a3 = a0;
                if (F.lane < 48) {
                    const float* wp = ada_w + ((size_t)l * D) * 12288 + j0 + 4 * c4;
#pragma unroll 8
                    for (int it = 0; it < 128; ++it) { const int k = it * 16 + F.wave * 2 + rsub;
                        const f32x4 w4 = *(const f32x4*)(wp + (size_t)k * 12288);
                        a0 += w4 * cact[k]; a1 += w4 * cact[D + k]; a2 += w4 * cact[2 * D + k]; a3 += w4 * cact[3 * D + k]; }
                    LAS float* rp = red + (F.wave * 2 + rsub) * 384 + 4 * c4;
                    *(LAS f32x4*)(rp) = a0; *(LAS f32x4*)(rp + 96) = a1; *(LAS f32x4*)(rp + 192) = a2; *(LAS f32x4*)(rp + 288) = a3;
                }
                __syncthreads();
                if (F.tid < 384) { const int b = F.tid / 96, col = F.tid - b * 96; float s = ada_b[(size_t)l * 12288 + j0 + col];
#pragma unroll
                    for (int p = 0; p < 16; ++p) s += red[p * 384 + b * 96 + col];
                    MOD[((size_t)l * 4 + b) * 12288 + j0 + col] = s; }
                __syncthreads();
            }
        }
        {
            tr_job(F, hyb_w_in, 0, 1, HYB_IN, D, 0, 4096, WIN0, 0, D, 0, 0);
            tr_job(F, hyb_w_in, 0, 1, HYB_IN, D, 4112, 3072, WIN0, 0, D, 4096, 0);
            tr_job(F, hyb_w_in, 0, 1, HYB_IN, D, 4096, 16, WIN0, 0, D, 7168, 0);
            zero_fill(F, WIN0 + (size_t)7184 * D, (size_t)(NIN - 7184) * D * 2);
            tr_job(F, hyb_w_out, 0, 1, D, D, 0, D, WOUT0, 0, D, 0, 0);
            tr_job(F, mla_w_in, 0, 1, MLA_IN, D, 0, MLA_IN, WMIN, 0, D, 0, 0);
            zero_fill(F, WMIN + (size_t)MLA_IN * D, (size_t)(NMLA - MLA_IN) * D * 2);
            tr_job(F, mla_w_uq, 0, 1, 3072, 512, 0, 3072, WUQ, 0, 512, 0, 0);
            tr_job(F, mla_w_ukv, 0, 1, 4096, 512, 0, 4096, WUKV, 0, 512, 0, 0);
            tr_job(F, mla_w_out, 0, 1, D, D, 0, D, WMOUT, 0, D, 0, 0);
            tr_job(F, moe_router_g, (size_t)D * 8, 2, 8, D, 0, 8, WRT, (size_t)256 * D, D, 0, 0);
            tr_job(F, moe_router_e, (size_t)D * 64, 2, 64, D, 0, 64, WRT, (size_t)256 * D, D, 8, 0);
            zero_fill(F, WRT + (size_t)72 * D, (size_t)(256 - 72) * D * 2);
            zero_fill(F, WRT + (size_t)256 * D + (size_t)72 * D, (size_t)(256 - 72) * D * 2);
            tr_job(F, moe_w_gate, (size_t)D * FF, 128, FF, D, 0, FF, WGU, (size_t)1024 * D, D, 0, 1);
            tr_job(F, moe_w_up, (size_t)D * FF, 128, FF, D, 0, FF, WGU, (size_t)1024 * D, D, 128, 1);
            tr_job(F, moe_w_down, (size_t)FF * D, 128, D, FF, 0, D, WDN, (size_t)D * FF, FF, 0, 0);
        }
        for (int idx = blockIdx.x * 512 + F.tid; idx < T * 32; idx += F.G * 512) {
            const int t = idx >> 5, i = idx & 31;
            const double rev = (double)in_pos[t] * ROPE_INVF[i] * 0.15915494309189535;
            const float fr = (float)(rev - __builtin_rint(rev));
            ROPE_C[idx] = __builtin_amdgcn_cosf(fr); ROPE_S[idx] = __builtin_amdgcn_sinf(fr);
        }
    }
    SEAM(0);

    if (IN(1)) { PHASE_FRESH();
        for (int m = F.gw; m < T; m += F.NGW) {
            const int b = m / SEQ; const float* modb = MOD + (size_t)b * 12288;
            const f32x4* xr = (const f32x4*)(in_x + (size_t)m * D) + F.lane; u32x2* o = (u32x2*)(HIN + (size_t)m * D) + F.lane;
#pragma unroll
            for (int j = 0; j < 8; ++j) { const f32x4 v = xr[64 * j]; const f32x4 sh = ((const f32x4*)(modb))[F.lane + 64 * j], sc = ((const f32x4*)(modb + D))[F.lane + 64 * j];
                const f32x4 h = v * (sc + 1.0f) + sh; u32x2 w; w.x = cvtpk(h[0], h[1]); w.y = cvtpk(h[2], h[3]); o[64 * j] = w; }
        }
    }
    SEAM(1);

    if (IN(2)) { PHASE_FRESH();
        pg8::StaticOrder S; S.init(HIN, WIN0, T, NIN, D, F.G, (int)blockIdx.x);
        pg8::EpiInProj E{PB, PBA};
        pg8::gemm_phase<pg8::EpiInProj, pg8::StaticOrder>(F.lds, D, S, E, F.tid, F.wave);
    }
    SEAM(2);

    if (IN(3)) { PHASE_FRESH();
        constexpr int QS = 136;
        LAS float* MT = (LAS float*)(F.lds);
        LAS bf16* QKM = (LAS bf16*)(F.lds + 17408);
        LAS float* RAWK = (LAS float*)(F.lds);
        LAS float* VF = (LAS float*)(F.lds + 32768);
        LAS float* WL = (LAS float*)(F.lds + 65536);
        LAS bf16* QBl = (LAS bf16*)(F.lds + 98304);
        LAS bf16* KBl = (LAS bf16*)(F.lds + 115712);
        int zoff = 0; asm volatile("" : "+v"(zoff));
        LAS float* s_beta = (LAS float*)(F.lds + 133120 + zoff); LAS float* s_gc = s_beta + 64; LAS float* s_egc = s_beta + 128;
        for (int ch = blockIdx.x; ch < NCH; ch += F.G) {
            PHASE_FRESH();
            const int n = ch & 31, bh = ch >> 5, h = bh & 7, b = bh >> 3;
            const int tok0 = b * SEQ + n * CHK;
            if (F.tid < 384) {
                const int mat = F.tid >> 7, d = F.tid & 127, col = mat * 1024 + h * 128 + d;
                const float w0 = gdn_conv_w[col], w1 = gdn_conv_w[3072 + col], w2 = gdn_conv_w[2 * 3072 + col], w3 = gdn_conv_w[3 * 3072 + col];
                const bf16* pc = PB + (size_t)tok0 * NP + col;
                float xm3 = 0.f, xm2 = 0.f, xm1 = 0.f;
                if (n > 0) { xm3 = bf2f(pc[-3 * NP]); xm2 = bf2f(pc[-2 * NP]); xm1 = bf2f(pc[-NP]); }
                LAS float* dst = (mat == 0) ? WL : (mat == 1 ? RAWK : VF);
#pragma unroll 8
                for (int i = 0; i < 64; ++i) { const float xi = bf2f(pc[(size_t)i * NP]); const float y = w0 * xm3 + w1 * xm2 + w2 * xm1 + w3 * xi;
                    dst[i * 128 + d] = silu_f(y); xm3 = xm2; xm2 = xm1; xm1 = xi; }
            }
            if (F.wave == 7) {
                const int tok = tok0 + F.lane;
                const float br = PBA[(size_t)tok * 16 + h], ar = PBA[(size_t)tok * 16 + 8 + h];
                const float beta = 1.f / (1.f + __expf(-br));
                const float xsp = ar + gdn_dt_bias[h];
                const float sp = fmaxf(xsp, 0.f) + log1pf(__expf(-fabsf(xsp)));
                float g = -__expf(gdn_a_log[h]) * sp;
#pragma unroll
                for (int off = 1; off < 64; off <<= 1) { const float v = __shfl_up(g, off); if (F.lane >= off) g += v; }
                s_beta[F.lane] = beta; s_gc[F.lane] = g; s_egc[F.lane] = __expf(g);
            }
            __syncthreads();
#pragma unroll
            for (int rr = 0; rr < 8; ++rr) {
                const int i = F.wave * 8 + rr;
                const float qa = WL[i * 128 + F.lane], qb2 = WL[i * 128 + 64 + F.lane];
                const float ka = RAWK[i * 128 + F.lane], kb2 = RAWK[i * 128 + 64 + F.lane];
                const float rq = rsqrtf(wave_sum(qa * qa + qb2 * qb2) + 1e-6f) * 0.08838834764831845f;
                const float rk = rsqrtf(wave_sum(ka * ka + kb2 * kb2) + 1e-6f);
                QBl[i * QS + F.lane] = f2bf(qa * rq); QBl[i * QS + 64 + F.lane] = f2bf(qb2 * rq);
                KBl[i * QS + F.lane] = f2bf(ka * rk); KBl[i * QS + 64 + F.lane] = f2bf(kb2 * rk);
            }
            __syncthreads();
            {
                const int mat = F.wave >> 2, mi = (F.wave >> 1) & 1, ni = F.wave & 1, r = F.lane & 31, hh = F.lane >> 5;
                const LAS bf16* Am = (mat == 0) ? KBl : QBl;
                f32x16 acc;
#pragma unroll
                for (int i = 0; i < 16; ++i) acc[i] = 0.f;
#pragma unroll
                for (int ks = 0; ks < 8; ++ks) {
                    const bf16x8 a = *(const LAS bf16x8*)(Am + (32 * mi + r) * QS + 16 * ks + 8 * hh);
                    const bf16x8 bb = *(const LAS bf16x8*)(KBl + (32 * ni + r) * QS + 16 * ks + 8 * hh);
                    acc = MFMA32(a, bb, acc);
                }
                const int j = 32 * ni + r; const float gj = s_gc[j];
#pragma unroll
                for (int reg = 0; reg < 16; ++reg) {
                    const int i = 32 * mi + crow(reg, hh);
                    const float gi = s_gc[i];
                    const float dec = __expf(fminf(gi - gj, 0.f));
                    if (mat == 0) MT[j * 68 + i] = (i > j) ? s_beta[i] * acc[reg] * dec : 0.f;
                    else QKM[i * 64 + j] = f2bf((i >= j) ? acc[reg] * dec : 0.f);
                }
            }
            __syncthreads();
            if (F.tid < 256) {
                const int c = F.tid, dcol = c & 127;
                float X[64];
                if (c < 128) {
#pragma unroll
                    for (int i = 0; i < 64; ++i) X[i] = VF[i * 128 + dcol] * s_beta[i];
                } else {
#pragma unroll
                    for (int i = 0; i < 64; ++i) X[i] = bf2f(KBl[i * QS + dcol]) * s_beta[i] * s_egc[i];
                }
#pragma unroll
                for (int j = 0; j < 63; ++j) {
                    asm volatile("" ::: "memory");
                    const float xj = X[j];
#pragma unroll
                    for (int i4 = ((j + 1) & ~3); i4 < 64; i4 += 4) {
                        const f32x4 m4 = *(const LAS f32x4*)(MT + j * 68 + i4);
#pragma unroll
                        for (int q = 0; q < 4; ++q) if (i4 + q > j) X[i4 + q] -= m4[q] * xj;
                    }
                }
                LAS float* dst = (c < 128) ? VF : WL;
#pragma unroll
                for (int i = 0; i < 64; ++i) dst[i * 128 + dcol] = X[i];
            }
            __syncthreads();
            {
                const int r = F.lane & 31, hh = F.lane >> 5;
                const float gl = s_gc[63];
                unsigned char* gf = GF + (size_t)ch * 57344;
                for (int f = F.wave; f < 56; f += 8) {
                    float v[8];
                    if (f < 16) { const int mt = f >> 3, ks = f & 7; const LAS float* src = WL + (32 * mt + r) * 128 + 16 * ks + 4 * hh;
#pragma unroll
                        for (int j = 0; j < 8; ++j) v[j] = -src[8 * (j >> 2) + (j & 3)]; }
                    else if (f < 32) { const int f2 = f - 16, mt = f2 >> 3, ks = f2 & 7, i = 32 * mt + r; const float e = s_egc[i]; const LAS bf16* src = QBl + i * QS + 16 * ks + 4 * hh;
#pragma unroll
                        for (int j = 0; j < 8; ++j) v[j] = bf2f(src[8 * (j >> 2) + (j & 3)]) * e; }
                    else if (f < 40) { const int f2 = f - 32, mt = f2 >> 2, ks = f2 & 3; const LAS bf16* src = QKM + (32 * mt + r) * 64 + 16 * ks + 4 * hh;
#pragma unroll
                        for (int j = 0; j < 8; ++j) v[j] = bf2f(src[8 * (j >> 2) + (j & 3)]); }
                    else { const int f2 = f - 40, mt = f2 >> 2, ks = f2 & 3, dd = 32 * mt + r;
#pragma unroll
                        for (int j = 0; j < 8; ++j) { const int i = 16 * ks + 8 * (j >> 2) + 4 * hh + (j & 3); v[j] = bf2f(KBl[i * QS + dd]) * __expf(gl - s_gc[i]); } }
                    u32x4 o; o.x = cvtpk(v[0], v[1]); o.y = cvtpk(v[2], v[3]); o.z = cvtpk(v[4], v[5]); o.w = cvtpk(v[6], v[7]);
                    *(u32x4*)(gf + f * 1024 + F.lane * 16) = o;
                }
                { const int sl = F.wave >> 1, it = F.wave & 1, col = 32 * sl + r;
                  float* up = (float*)(GU + (size_t)ch * 32768 + (size_t)((sl * 2 + it) * 64 + F.lane) * 64);
#pragma unroll
                  for (int g4 = 0; g4 < 4; ++g4) { f32x4 t4;
#pragma unroll
                      for (int q = 0; q < 4; ++q) t4[q] = VF[(32 * it + crow(4 * g4 + q, hh)) * 128 + col];
                      *(f32x4*)(up + 4 * g4) = t4; } }
                if (F.tid == 0) EG[ch] = __expf(gl);
            }
            __syncthreads();
        }
    }
    SEAM(3);

    if (IN(4)) { PHASE_FRESH();
        for (int bh = blockIdx.x; bh < BATCH * GH; bh += F.G) {
            const int b = bh >> 3, hd = bh & 7, r = F.lane & 31, hh = F.lane >> 5, sl = F.wave;
            f32x16 S[4];
#pragma unroll
            for (int dt = 0; dt < 4; ++dt)
#pragma unroll
                for (int i = 0; i < 16; ++i) S[dt][i] = 0.f;
            f32x16 un[2];
            if (F.wave >= 4) {
                const int t4 = F.tid - 256; const unsigned char* g0 = opaque_ptr(GF + (size_t)(bh * 32) * 57344 + (size_t)t4 * 16);
#pragma unroll
                for (int q = 0; q < 14; ++q) *(LAS u32x4*)(F.lds + (t4 + 256 * q) * 16) = *(const u32x4*)(g0 + (size_t)q * 4096);
            } else {
#pragma unroll
                for (int it = 0; it < 2; ++it) { const f32x4* up = (const f32x4*)opaque_ptr(GU + (size_t)(bh * 32) * 32768 + (size_t)((sl * 2 + it) * 64 + F.lane) * 64);
#pragma unroll
                    for (int g4 = 0; g4 < 4; ++g4) { const f32x4 t4 = up[g4]; un[it][4 * g4] = t4[0]; un[it][4 * g4 + 1] = t4[1]; un[it][4 * g4 + 2] = t4[2]; un[it][4 * g4 + 3] = t4[3]; } }
            }
            __syncthreads();
            for (int n = 0; n < NCHK; ++n) {
                const int ch = bh * 32 + n; const bool more = (n + 1 < NCHK);
                if (F.wave >= 4) {
                    if (more) {
                        const unsigned char* gn = opaque_ptr(GF + (size_t)(ch + 1) * 57344 + (size_t)(F.tid - 256) * 16); LAS unsigned char* nb = F.lds + ((n + 1) & 1) * 57344; const int t4 = F.tid - 256;
#pragma unroll
                        for (int q = 0; q < 14; ++q) *(LAS u32x4*)(nb + (t4 + 256 * q) * 16) = *(const u32x4*)(gn + (size_t)q * 4096);
                    }
                } else {
                    const LAS unsigned char* buf = F.lds + (n & 1) * 57344 + F.lane * 16;
                    const float eg = EG[ch];
                    bf16x8 Sb[8];
#pragma unroll
                    for (int dt = 0; dt < 4; ++dt) { Sb[2 * dt] = pack_acc(S[dt], 0); Sb[2 * dt + 1] = pack_acc(S[dt], 1); }
                    f32x16 vn[2]; vn[0] = un[0]; vn[1] = un[1];
#pragma unroll
                    for (int it = 0; it < 2; ++it)
#pragma unroll
                        for (int ks = 0; ks < 8; ++ks) vn[it] = MFMA32(*(const LAS bf16x8*)(buf + (it * 8 + ks) * 1024), Sb[ks], vn[it]);
                    __builtin_amdgcn_sched_barrier(0);
                    f32x16 oa[2];
#pragma unroll
                    for (int it = 0; it < 2; ++it) {
#pragma unroll
                        for (int i = 0; i < 16; ++i) oa[it][i] = 0.f;
#pragma unroll
                        for (int ks = 0; ks < 8; ++ks) oa[it] = MFMA32(*(const LAS bf16x8*)(buf + (16 + it * 8 + ks) * 1024), Sb[ks], oa[it]);
                    }
                    __builtin_amdgcn_sched_barrier(0);
                    bf16x8 vb[4];
#pragma unroll
                    for (int it = 0; it < 2; ++it) { vb[2 * it] = pack_acc(vn[it], 0); vb[2 * it + 1] = pack_acc(vn[it], 1); }
                    __builtin_amdgcn_sched_barrier(0);
                    {
                        const int chn = more ? ch + 1 : ch;
#pragma unroll
                        for (int it = 0; it < 2; ++it) { const f32x4* up = (const f32x4*)opaque_ptr(GU + (size_t)chn * 32768 + (size_t)((sl * 2 + it) * 64 + F.lane) * 64);
#pragma unroll
                            for (int g4 = 0; g4 < 4; ++g4) { const f32x4 t4 = up[g4]; un[it][4 * g4] = t4[0]; un[it][4 * g4 + 1] = t4[1]; un[it][4 * g4 + 2] = t4[2]; un[it][4 * g4 + 3] = t4[3]; } }
                    }
                    __builtin_amdgcn_sched_barrier(0);
#pragma unroll
                    for (int it = 0; it < 2; ++it)
#pragma unroll
                        for (int ks = 0; ks < 4; ++ks) oa[it] = MFMA32(*(const LAS bf16x8*)(buf + (32 + it * 4 + ks) * 1024), vb[ks], oa[it]);
#pragma unroll
                    for (int it = 0; it < 2; ++it) {
#pragma unroll
                        for (int g4 = 0; g4 < 4; ++g4) { float* op = opaque_ptr(GO + (size_t)(b * SEQ + n * CHK + 32 * it + 8 * g4 + 4 * hh) * 1024 + hd * 128 + sl * 32 + r);
#pragma unroll
                            for (int q = 0; q < 4; ++q) op[q * 1024] = oa[it][4 * g4 + q]; } }
                    __builtin_amdgcn_sched_barrier(0);
#pragma unroll
                    for (int dt = 0; dt < 4; ++dt) {
#pragma unroll
                        for (int i = 0; i < 16; ++i) S[dt][i] *= eg;
#pragma unroll
                        for (int ks = 0; ks < 4; ++ks) S[dt] = MFMA32(*(const LAS bf16x8*)(buf + (40 + dt * 4 + ks) * 1024), vb[ks], S[dt]);
                    }
                }
                __syncthreads();
            }
        }
    }
    SEAM(4);

    if (IN(5)) { PHASE_FRESH();
        for (int m = F.gw; m < T; m += F.NGW) {
            const int s = m & (SEQ - 1), c0 = F.lane * 16;
            const bf16* prow = PB + (size_t)m * NP;
            {
                const f32x4* op = (const f32x4*)(GO + (size_t)m * 1024 + c0);
                f32x4 o[4]; float ss = 0.f;
#pragma unroll
                for (int q = 0; q < 4; ++q) { o[q] = op[q]; ss += o[q][0] * o[q][0] + o[q][1] * o[q][1] + o[q][2] * o[q][2] + o[q][3] * o[q][3]; }
                ss += __shfl_xor(ss, 1); ss += __shfl_xor(ss, 2); ss += __shfl_xor(ss, 4);
                const float rms = rsqrtf(ss * (1.f / 128.f) + 1e-6f);
                const u32x4* zp = (const u32x4*)(prow + 3072 + c0); const u32x4 z0 = zp[0], z1 = zp[1];
                const unsigned zw[8] = {z0.x, z0.y, z0.z, z0.w, z1.x, z1.y, z1.z, z1.w};
                const f32x4* nwp = (const f32x4*)(gdn_norm_w + (c0 & 127));
                unsigned ow[8];
#pragma unroll
                for (int q = 0; q < 4; ++q) { const f32x4 nw = nwp[q];
                    const float y0 = o[q][0] * rms * nw[0] * silu_f(bflo(zw[2 * q])), y1 = o[q][1] * rms * nw[1] * silu_f(bfhi(zw[2 * q]));
                    const float y2 = o[q][2] * rms * nw[2] * silu_f(bflo(zw[2 * q + 1])), y3 = o[q][3] * rms * nw[3] * silu_f(bfhi(zw[2 * q + 1]));
                    ow[2 * q] = cvtpk(y0, y1); ow[2 * q + 1] = cvtpk(y2, y3); }
                u32x4* yp = (u32x4*)(YAB + (size_t)m * D + c0);
                yp[0] = (u32x4){ow[0], ow[1], ow[2], ow[3]}; yp[1] = (u32x4){ow[4], ow[5], ow[6], ow[7]};
            }
            {
                float accv[16];
#pragma unroll
                for (int q = 0; q < 16; ++q) accv[q] = 0.f;
#pragma unroll
                for (int j = 0; j < 3; ++j) {
                    if (s - 2 + j >= 0) {
                        const bf16* pr = prow + (ptrdiff_t)(j - 2) * NP;
                        const u32x4* cp = (const u32x4*)(pr + 5120 + c0); const u32x4* hp = (const u32x4*)(pr + 6144 + c0);
                        const u32x4 ca = cp[0], cb = cp[1], ha = hp[0], hb = hp[1];
                        const unsigned cw[8] = {ca.x, ca.y, ca.z, ca.w, cb.x, cb.y, cb.z, cb.w}, hw[8] = {ha.x, ha.y, ha.z, ha.w, hb.x, hb.y, hb.z, hb.w};
                        const f32x4* wp = (const f32x4*)(sc_conv_w + j * 1024 + c0);
#pragma unroll
                        for (int q = 0; q < 4; ++q) { const f32x4 w4 = wp[q];
                            accv[4 * q] += w4[0] * bflo(cw[2 * q]) * bflo(hw[2 * q]); accv[4 * q + 1] += w4[1] * bfhi(cw[2 * q]) * bfhi(hw[2 * q]);
                            accv[4 * q + 2] += w4[2] * bflo(cw[2 * q + 1]) * bflo(hw[2 * q + 1]); accv[4 * q + 3] += w4[3] * bfhi(cw[2 * q + 1]) * bfhi(hw[2 * q + 1]); }
                    }
                }
                const u32x4* bp = (const u32x4*)(prow + 4096 + c0); const u32x4 ba = bp[0], bb = bp[1];
                const unsigned bw[8] = {ba.x, ba.y, ba.z, ba.w, bb.x, bb.y, bb.z, bb.w};
                unsigned ow[8];
#pragma unroll
                for (int q = 0; q < 8; ++q) ow[q] = cvtpk(bflo(bw[q]) * accv[2 * q], bfhi(bw[q]) * accv[2 * q + 1]);
                u32x4* yp = (u32x4*)(YAB + (size_t)m * D + 1024 + c0);
                yp[0] = (u32x4){ow[0], ow[1], ow[2], ow[3]}; yp[1] = (u32x4){ow[4], ow[5], ow[6], ow[7]};
            }
        }
    }
    SEAM(5);

    if (IN(6)) { PHASE_FRESH();
        pg8::StaticOrder S; S.init(YAB, WOUT0, T, D, D, F.G, (int)blockIdx.x);
        pg8::EpiResid E{in_x, MOD + 2 * D, RB};
        pg8::gemm_phase<pg8::EpiResid, pg8::StaticOrder>(F.lds, D, S, E, F.tid, F.wave);
    }
    SEAM(6);

    if (IN(7)) { PHASE_FRESH();
        for (int m = F.gw; m < T; m += F.NGW) {
            const int b = m / SEQ; const float* modb = MOD + (size_t)b * 12288;
            f32x4 v[8];
#pragma unroll
            for (int j = 0; j < 8; ++j) v[j] = ((const f32x4*)(RB + (size_t)m * D))[F.lane + 64 * j];
            LN_ROW(v, ln_g, ln_b);
            bf16* hrow = HIN + (size_t)m * D;
            WRITE_X_HIN(v, XA + (size_t)m * D, hrow, modb + 3 * D, modb + 4 * D);
        }
    }
    SEAM(7);

    moe_phases<0>(F, args, bar, lo, hi, TAB);

        if (IN(14)) { PHASE_FRESH();
            pg8::StaticOrder S; S.init(HIN, WMIN, T, NMLA, D, F.G, (int)blockIdx.x);
            pg8::EpiF32 E{C1, NMLA};
            pg8::gemm_phase<pg8::EpiF32, pg8::StaticOrder>(F.lds, D, S, E, F.tid, F.wave);
        }
        SEAM(14);
        if (IN(15)) { PHASE_FRESH();
            for (int m = F.gw; m < T; m += F.NGW) {
                const float* c1 = C1 + (size_t)m * NMLA;
#pragma unroll
                for (int part = 0; part < 2; ++part) {
                    const f32x4* p = (const f32x4*)(c1 + part * 512 + 8 * F.lane); const f32x4 a0 = p[0], a1 = p[1];
                    const float ss = wave_sum((a0[0] * a0[0] + a0[1] * a0[1]) + (a0[2] * a0[2] + a0[3] * a0[3]) + (a1[0] * a1[0] + a1[1] * a1[1]) + (a1[2] * a1[2] + a1[3] * a1[3]));
                    const float rn = rsqrtf(ss * (1.f / 512.f) + 1e-6f);
                    const f32x4* wp = (const f32x4*)((part == 0 ? mla_q_norm : mla_kv_norm) + 8 * F.lane); const f32x4 w0 = wp[0], w1 = wp[1];
                    u32x4 o; o.x = cvtpk(a0[0] * rn * w0[0], a0[1] * rn * w0[1]); o.y = cvtpk(a0[2] * rn * w0[2], a0[3] * rn * w0[3]);
                    o.z = cvtpk(a1[0] * rn * w1[0], a1[1] * rn * w1[1]); o.w = cvtpk(a1[2] * rn * w1[2], a1[3] * rn * w1[3]);
                    *(u32x4*)((part == 0 ? CQN : CKVN) + (size_t)m * 512 + 8 * F.lane) = o;
                }
                if (F.lane < 32) { const float x1 = c1[1024 + F.lane], x2 = c1[1056 + F.lane], cs = ROPE_C[(size_t)m * 32 + F.lane], sn = ROPE_S[(size_t)m * 32 + F.lane];
                    KPE[(size_t)m * 64 + F.lane] = x1 * cs - x2 * sn; KPE[(size_t)m * 64 + 32 + F.lane] = x1 * sn + x2 * cs; }
            }
        }
        SEAM(15);
        if (IN(16)) { PHASE_FRESH();
            { pg8::StaticOrder S; S.init(CQN, WUQ, T, 3072, 512, F.G, (int)blockIdx.x); pg8::EpiQup E{QB_};
              pg8::gemm_phase<pg8::EpiQup, pg8::StaticOrder>(F.lds, 512, S, E, F.tid, F.wave); }
            { pg8::StaticOrder S; S.init(CKVN, WUKV, T, 4096, 512, F.G, (int)blockIdx.x); pg8::EpiKVup E{KB_, VB_};
              pg8::gemm_phase<pg8::EpiKVup, pg8::StaticOrder>(F.lds, 512, S, E, F.tid, F.wave); }
        }
        SEAM(16);
        if (IN(17)) { PHASE_FRESH();
            for (int m = F.gw; m < T; m += F.NGW) {
                const int b = m / SEQ, s = m - b * SEQ, hd = F.lane >> 2, i0 = (F.lane & 3) * 8;
                const size_t rowoff = ((size_t)((b * MH + hd) * SEQ + s)) * QD + 128;
                bf16* qp = QB_ + rowoff;
                const u32x4 xa = *(const u32x4*)(qp + i0), xb = *(const u32x4*)(qp + 32 + i0);
                const f32x4* cp = (const f32x4*)(ROPE_C + (size_t)m * 32 + i0); const f32x4* sp = (const f32x4*)(ROPE_S + (size_t)m * 32 + i0);
                const f32x4 c0 = cp[0], c1v = cp[1], s0 = sp[0], s1 = sp[1];
                const float cs[8] = {c0[0], c0[1], c0[2], c0[3], c1v[0], c1v[1], c1v[2], c1v[3]}, sn[8] = {s0[0], s0[1], s0[2], s0[3], s1[0], s1[1], s1[2], s1[3]};
                const unsigned xaw[4] = {xa.x, xa.y, xa.z, xa.w}, xbw[4] = {xb.x, xb.y, xb.z, xb.w};
                unsigned o1[4], o2[4];
#pragma unroll
                for (int q = 0; q < 4; ++q) { const float a0 = bflo(xaw[q]), a1 = bfhi(xaw[q]), b0 = bflo(xbw[q]), b1 = bfhi(xbw[q]);
                    o1[q] = cvtpk(a0 * cs[2 * q] - b0 * sn[2 * q], a1 * cs[2 * q + 1] - b1 * sn[2 * q + 1]);
                    o2[q] = cvtpk(a0 * sn[2 * q] + b0 * cs[2 * q], a1 * sn[2 * q + 1] + b1 * cs[2 * q + 1]); }
                *(u32x4*)(qp + i0) = (u32x4){o1[0], o1[1], o1[2], o1[3]}; *(u32x4*)(qp + 32 + i0) = (u32x4){o2[0], o2[1], o2[2], o2[3]};
                const f32x4* kp = (const f32x4*)(KPE + (size_t)m * 64 + i0); const f32x4* kp2 = (const f32x4*)(KPE + (size_t)m * 64 + 32 + i0);
                const f32x4 k0 = kp[0], k1 = kp[1], k2 = kp2[0], k3 = kp2[1];
                bf16* kd = KB_ + rowoff;
                *(u32x4*)(kd + i0) = (u32x4){cvtpk(k0[0], k0[1]), cvtpk(k0[2], k0[3]), cvtpk(k1[0], k1[1]), cvtpk(k1[2], k1[3])};
                *(u32x4*)(kd + 32 + i0) = (u32x4){cvtpk(k2[0], k2[1]), cvtpk(k2[2], k2[3]), cvtpk(k3[0], k3[1]), cvtpk(k3[2], k3[3])};
            }
            {
                LAS bf16* scr = (LAS bf16*)(F.lds + F.wave * 17408);
                for (int it = F.gw; it < 64 * 32; it += F.NGW) {
                    const int bhh = it >> 5, sb = it & 31, b = bhh >> 4, hd = bhh & 15, s0 = sb * 64;
#pragma unroll 4
                    for (int i = 0; i < 16; ++i) { const int row = 4 * i + (F.lane >> 4), c8 = (F.lane & 15) * 8;
                        *(LAS u32x4*)(scr + row * 136 + c8) = *(const u32x4*)(VB_ + (size_t)(b * SEQ + s0 + row) * D + hd * 128 + c8); }
                    LDS_WAIT(); asm volatile("" ::: "memory");
                    bf16* dst = VT + ((size_t)bhh * 128) * SEQ + s0 + F.lane;
#pragma unroll 8
                    for (int dv = 0; dv < 128; ++dv) dst[(size_t)dv * SEQ] = scr[F.lane * 136 + dv];
                    LDS_WAIT(); asm volatile("" ::: "memory");
                }
            }
        }
        SEAM(17);
        if (IN(18)) { PHASE_FRESH();
            constexpr int KBUF = 64 * 400, VBUF = 128 * 136;
            LAS unsigned char* KL = F.lds; LAS unsigned char* VL = F.lds + 2 * KBUF;
            const int w = F.wave;
            for (int pi = blockIdx.x; pi < 256; pi += F.G) {
                const int bhh = pi >> 2, pp = pi & 3, b = bhh >> 4, hd = bhh & 15;
                const char* kg = (const char*)(KB_ + (size_t)bhh * SEQ * QD); const char* vg = (const char*)(VT + (size_t)bhh * 128 * SEQ);
                for (int half = 0; half < 2; ++half) {
                    PHASE_FRESH(); const int r = F.lane & 31, hh = F.lane >> 5;
                    const int qb = half == 0 ? 7 - pp : pp, q0 = qb * 256, ntile = 4 * (qb + 1), qrow = q0 + 32 * w + r;
                    bf16x8 qf[12];
                    { const bf16* qp = QB_ + ((size_t)bhh * SEQ + qrow) * QD + 8 * hh;
#pragma unroll
                      for (int ks = 0; ks < 12; ++ks) qf[ks] = *(const bf16x8*)(qp + 16 * ks); }
                    f32x16 oT[4];
#pragma unroll
                    for (int mt = 0; mt < 4; ++mt)
#pragma unroll
                        for (int i = 0; i < 16; ++i) oT[mt][i] = 0.f;
                    float mrun = -1e30f, lsum = 0.f;
                    u32x4 kst[3], vst[2];
#pragma unroll
                    for (int q = 0; q < 3; ++q) kst[q] = *(const u32x4*)(kg + (size_t)(F.tid + 512 * q) * 16);
#pragma unroll
                    for (int q = 0; q < 2; ++q) { const int p = F.tid + 512 * q; vst[q] = *(const u32x4*)(vg + (size_t)(p >> 3) * (SEQ * 2) + (p & 7) * 16); }
#pragma unroll
                    for (int q = 0; q < 3; ++q) { const int p = F.tid + 512 * q; *(LAS u32x4*)(KL + (p / 24) * 400 + (p % 24) * 16) = kst[q]; }
#pragma unroll
                    for (int q = 0; q < 2; ++q) { const int p = F.tid + 512 * q; LAS unsigned char* d = VL + (p >> 3) * 136 + (p & 7) * 16;
                        *(LAS u32x2*)d = (u32x2){vst[q].x, vst[q].y}; *(LAS u32x2*)(d + 8) = (u32x2){vst[q].z, vst[q].w}; }
                    __syncthreads();
                    for (int kt = 0; kt < ntile; ++kt) {
                        const bool more = (kt + 1 < ntile); const int k0 = kt * 64;
                        if (more) {
                            const int k1 = k0 + 64;
#pragma unroll
                            for (int q = 0; q < 3; ++q) kst[q] = *(const u32x4*)(kg + (size_t)k1 * (QD * 2) + (size_t)(F.tid + 512 * q) * 16);
#pragma unroll
                            for (int q = 0; q < 2; ++q) { const int p = F.tid + 512 * q; vst[q] = *(const u32x4*)(vg + (size_t)(p >> 3) * (SEQ * 2) + (size_t)k1 * 2 + (p & 7) * 16); }
                        }
                        if (k0 <= q0 + 32 * w + 31) {
                            const LAS unsigned char* kb = KL + (kt & 1) * KBUF; const LAS unsigned char* vb_ = VL + (kt & 1) * VBUF;
                            f32x16 sT[2];
#pragma unroll
                            for (int kk = 0; kk < 2; ++kk) {
#pragma unroll
                                for (int i = 0; i < 16; ++i) sT[kk][i] = 0.f;
#pragma unroll
                                for (int ks = 0; ks < 12; ++ks) sT[kk] = MFMA32(*(const LAS bf16x8*)(kb + (32 * kk + r) * 400 + (16 * ks + 8 * hh) * 2), qf[ks], sT[kk]);
                            }
                            if (k0 + 63 > q0 + 32 * w) {
#pragma unroll
                                for (int kk = 0; kk < 2; ++kk)
#pragma unroll
                                    for (int reg = 0; reg < 16; ++reg) { const int key = k0 + 32 * kk + crow(reg, hh); if (key > qrow) sT[kk][reg] = -1e30f; }
                            }
                            float mloc = sT[0][0];
#pragma unroll
                            for (int kk = 0; kk < 2; ++kk)
#pragma unroll
                                for (int reg = 0; reg < 16; ++reg) mloc = fmaxf(mloc, sT[kk][reg]);
                            mloc = fmaxf(mloc, __shfl_xor(mloc, 32));
                            const float mnew = fmaxf(mrun, mloc), alpha = __builtin_amdgcn_exp2f(mrun - mnew);
                            float ps = 0.f;
#pragma unroll
                            for (int kk = 0; kk < 2; ++kk)
#pragma unroll
                                for (int reg = 0; reg < 16; ++reg) { const float pe = __builtin_amdgcn_exp2f(sT[kk][reg] - mnew); sT[kk][reg] = pe; ps += pe; }
                            lsum = lsum * alpha + ps; mrun = mnew;
#pragma unroll
                            for (int mt = 0; mt < 4; ++mt)
#pragma unroll
                                for (int i = 0; i < 16; ++i) oT[mt][i] *= alpha;
                            bf16x8 pb[4];
#pragma unroll
                            for (int kk = 0; kk < 2; ++kk) { pb[2 * kk] = pack_acc(sT[kk], 0); pb[2 * kk + 1] = pack_acc(sT[kk], 1); }
#pragma unroll
                            for (int mt = 0; mt < 4; ++mt)
#pragma unroll
                                for (int ks = 0; ks < 4; ++ks) { const LAS unsigned char* vp = vb_ + (32 * mt + r) * 136 + (16 * ks + 4 * hh) * 2;
                                    const u32x2 vlo = *(const LAS u32x2*)vp, vhi = *(const LAS u32x2*)(vp + 16);
                                    const u32x4 va = {vlo.x, vlo.y, vhi.x, vhi.y};
                                    oT[mt] = MFMA32(__builtin_bit_cast(bf16x8, va), pb[ks], oT[mt]); }
                        }
                        if (more) {
                            LAS unsigned char* kn = KL + ((kt + 1) & 1) * KBUF; LAS unsigned char* vn_ = VL + ((kt + 1) & 1) * VBUF;
#pragma unroll
                            for (int q = 0; q < 3; ++q) { const int p = F.tid + 512 * q; *(LAS u32x4*)(kn + (p / 24) * 400 + (p % 24) * 16) = kst[q]; }
#pragma unroll
                            for (int q = 0; q < 2; ++q) { const int p = F.tid + 512 * q; LAS unsigned char* d = vn_ + (p >> 3) * 136 + (p & 7) * 16;
                                *(LAS u32x2*)d = (u32x2){vst[q].x, vst[q].y}; *(LAS u32x2*)(d + 8) = (u32x2){vst[q].z, vst[q].w}; }
                        }
                        __syncthreads();
                    }
                    const float ltot = lsum + __shfl_xor(lsum, 32), inv = 1.f / ltot;
                    bf16* orow = YAB + (size_t)(b * SEQ + qrow) * D + hd * 128 + 4 * hh;
#pragma unroll
                    for (int mt = 0; mt < 4; ++mt)
#pragma unroll
                        for (int g4 = 0; g4 < 4; ++g4) { u32x2 o; o.x = cvtpk(oT[mt][4 * g4] * inv, oT[mt][4 * g4 + 1] * inv); o.y = cvtpk(oT[mt][4 * g4 + 2] * inv, oT[mt][4 * g4 + 3] * inv);
                            *(u32x2*)(orow + 32 * mt + 8 * g4) = o; }
                }
            }
        }
        SEAM(18);
        if (IN(19)) { PHASE_FRESH();
            pg8::StaticOrder S; S.init(YAB, WMOUT, T, D, D, F.G, (int)blockIdx.x);
            pg8::EpiResid E{XB, MOD + (size_t)4 * 12288 + 2 * D, RB};
            pg8::gemm_phase<pg8::EpiResid, pg8::StaticOrder>(F.lds, D, S, E, F.tid, F.wave);
        }
        SEAM(19);
        if (IN(20)) { PHASE_FRESH();
            for (int m = F.gw; m < T; m += F.NGW) {
                const int b = m / SEQ; const float* modb = MOD + (size_t)(4 + b) * 12288;
                f32x4 v[8];
#pragma unroll
                for (int j = 0; j < 8; ++j) v[j] = ((const f32x4*)(RB + (size_t)m * D))[F.lane + 64 * j];
                LN_ROW(v, ln_g + 2 * D, ln_b + 2 * D);
                bf16* hrow = HIN + (size_t)m * D;
                WRITE_X_HIN(v, XA + (size_t)m * D, hrow, modb + 3 * D, modb + 4 * D);
            }
        }
        SEAM(20);

    moe_phases<1>(F, args, bar, lo, hi, TAB);
#undef IN
#undef INL
#undef SEAM
#undef WSB
#undef in_x
#undef in_c
#undef in_pos
#undef ada_w
#undef ada_b
#undef ln_g
#undef ln_b
#undef hyb_w_in
#undef gdn_conv_w
#undef gdn_a_log
#undef gdn_dt_bias
#undef gdn_norm_w
#undef sc_conv_w
#undef hyb_w_out
#undef mla_w_in
#undef mla_q_norm
#undef mla_kv_norm
#undef mla_w_uq
#undef mla_w_ukv
#undef mla_w_out
#undef moe_router_g
#undef moe_bias_g
#undef moe_router_e
#undef moe_bias_e
#undef moe_w_gate
#undef moe_w_up
#undef moe_w_down
#undef MOD
#undef ROPE_C
#undef ROPE_S
#undef PBA
#undef LOGITS
#undef TOK_E
#undef TOK_POS
#undef TOK_GATE
#undef EG
#undef WIN0
#undef WOUT0
#undef WMIN
#undef WUQ
#undef WUKV
#undef WMOUT
#undef WRT
#undef WGU
#undef WDN
#undef HIN
#undef XA
#undef XB
#undef RB
#undef PB
#undef GF
#undef GU
#undef GO
#undef YAB
#undef XS
#undef HID
#undef YS
#undef C1
#undef CQN
#undef CKVN
#undef KPE
#undef QB_
#undef KB_
#undef VB_
#undef VT
}

extern "C" void kernel_launch(void* const* d_in, const int* in_sizes, int n_in, void* d_out, int out_size, void* d_ws, size_t ws_size, hipStream_t stream) {
    static int grid = 0;
    if (grid == 0) {
        if (n_in != 27 || in_sizes[0] != T * D || out_size != T * D || ws_size < WS_END) { fprintf(stderr, "kernel_launch: unexpected problem (n_in %d, in0 %d, out %d, ws %zu)\n", n_in, n_in > 0 ? in_sizes[0] : -1, out_size, ws_size); grid = -1; return; }
        int dev = 0, cus = 0, per_cu = 0;
        if (hipGetDevice(&dev) != hipSuccess || hipDeviceGetAttribute(&cus, hipDeviceAttributeMultiprocessorCount, dev) != hipSuccess) { grid = -1; return; }
        if (hipFuncSetAttribute((const void*)mega, hipFuncAttributeMaxDynamicSharedMemorySize, LDS_BYTES) != hipSuccess) { fprintf(stderr, "kernel_launch: hipFuncSetAttribute failed\n"); grid = -1; return; }
        if (hipOccupancyMaxActiveBlocksPerMultiprocessor(&per_cu, (const void*)mega, 512, LDS_BYTES) != hipSuccess || per_cu < 1) fprintf(stderr, "kernel_launch: occupancy query reports %d\n", per_cu);
        (void)hipGetLastError();
        grid = cus;
    }
    if (grid < 0) return;
    (void)hipMemsetAsync((char*)d_ws + WS_CTL, 0, CTL_ZERO_BYTES, stream);
    Args a{};
    for (int i = 0; i < 27; ++i) a.in[i] = d_in[i];
    a.out = (float*)d_out; a.ws = (unsigned char*)d_ws;
#if MK_ONE_LAUNCH
    a.ph_lo = 0; a.ph_hi = NPH;
    hipLaunchKernelGGL(mega, dim3(grid), dim3(512), LDS_BYTES, stream, a);
#else
    for (int k = 0; k < NPH; ++k) { a.ph_lo = k; a.ph_hi = k + 1; hipLaunchKernelGGL(mega, dim3(grid), dim3(512), LDS_BYTES, stream, a); }
#endif
}
```

```cpp
#include <hip/hip_runtime.h>
#include <cstdio>
#include <cstdint>

#ifndef MK_ONE_LAUNCH
#define MK_ONE_LAUNCH 1
#endif

#define DI __device__ __forceinline__
#define GAS __attribute__((address_space(1)))
#define LAS __attribute__((address_space(3)))
typedef unsigned short bf16;
typedef float f32x4 __attribute__((ext_vector_type(4)));
typedef float f32x2 __attribute__((ext_vector_type(2)));
typedef float f32x16 __attribute__((ext_vector_type(16)));
typedef short bf16x8 __attribute__((ext_vector_type(8)));
typedef short s16x4 __attribute__((ext_vector_type(4)));
typedef unsigned u32x4 __attribute__((ext_vector_type(4)));
typedef unsigned u32x2 __attribute__((ext_vector_type(2)));
typedef __bf16 bf16x2_t __attribute__((ext_vector_type(2)));
typedef GAS unsigned gu32;
#define RLX_AGENT __ATOMIC_RELAXED, __HIP_MEMORY_SCOPE_AGENT
#define LDS_WAIT() asm volatile("s_waitcnt lgkmcnt(0)" ::: "memory")
#define VM_WAIT() asm volatile("s_waitcnt vmcnt(0)" ::: "memory")
#define MFMA32(a, b, c) __builtin_amdgcn_mfma_f32_32x32x16_bf16((a), (b), (c), 0, 0, 0)

DI unsigned cvtpk(float lo, float hi) { f32x2 v = {lo, hi}; bf16x2_t b = __builtin_convertvector(v, bf16x2_t); return __builtin_bit_cast(unsigned, b); }
DI bf16 f2bf(float f) { return (bf16)(cvtpk(f, 0.f) & 0xffffu); }
DI float bf2f(bf16 b) { return __uint_as_float(((unsigned)b) << 16); }
DI float bflo(unsigned w) { return __uint_as_float(w << 16); }
DI float bfhi(unsigned w) { return __uint_as_float(w & 0xffff0000u); }
DI int crow(int reg, int h) { return (reg & 3) + 8 * (reg >> 2) + 4 * h; }
DI int kperm(int j, int h) { return 8 * (j >> 2) + 4 * h + (j & 3); }
DI float wave_sum(float v) {
#pragma unroll
    for (int o = 1; o < 64; o <<= 1) v += __shfl_xor(v, o);
    return v;
}
DI bf16x8 pack_acc(const f32x16& x, int s) {
    u32x4 p; p.x = cvtpk(x[8 * s + 0], x[8 * s + 1]); p.y = cvtpk(x[8 * s + 2], x[8 * s + 3]); p.z = cvtpk(x[8 * s + 4], x[8 * s + 5]); p.w = cvtpk(x[8 * s + 6], x[8 * s + 7]);
    return __builtin_bit_cast(bf16x8, p);
}
DI float silu_f(float x) { return x / (1.f + __expf(-x)); }
DI size_t opaque_off(size_t o) { asm volatile("" : "+v"(o)); return o; }

constexpr int D = 2048, BATCH = 4, SEQ = 2048, T = BATCH * SEQ;
constexpr int GH = 8, GD = 128, NCHK = 32, CHK = 64, NCH = BATCH * GH * NCHK;
constexpr int HYB_IN = 7184, NIN = 7424, NP = 7168;
constexpr int MH = 16, MLA_IN = 1088, NMLA = 1280, QD = 192;
constexpr int NE = 64, FF = 512, MAXBLK = 128;
constexpr float DN_ALPHA = 1.41421356237f;
constexpr float QSCALE = 0.10411754627697264f;
constexpr int NPH = 27;

constexpr size_t MiB = 1u << 20;
constexpr size_t WS_CTL = 0, CTL_ZERO_BYTES = 1 * MiB;
constexpr size_t WS_MOD = 1 * MiB;
constexpr size_t WS_ROPE = 2 * MiB;
constexpr size_t WS_PBA = 4 * MiB;
constexpr size_t WS_LOGITS = 5 * MiB;
constexpr size_t WS_ROUTE = 9 * MiB;
constexpr size_t WS_EG = 10 * MiB;
constexpr size_t WS_WIN0 = 16 * MiB;
constexpr size_t WS_WOUT0 = 46 * MiB;
constexpr size_t WS_WMIN = 54 * MiB;
constexpr size_t WS_WUQ = 59 * MiB;
constexpr size_t WS_WUKV = 62 * MiB;
constexpr size_t WS_WMOUT = 66 * MiB;
constexpr size_t WS_WRT = 74 * MiB;
constexpr size_t WS_WGU = 80 * MiB;
constexpr size_t WS_WDN = 592 * MiB;
constexpr size_t WS_HIN = 848 * MiB;
constexpr size_t WS_XA = 880 * MiB;
constexpr size_t WS_XB = 944 * MiB;
constexpr size_t WS_R = 1008 * MiB;
constexpr size_t WS_P = 1072 * MiB;
constexpr size_t WS_GF = 1184 * MiB;
constexpr size_t WS_GU = 1240 * MiB;
constexpr size_t WS_GO = 1272 * MiB;
constexpr size_t WS_YAB = 1304 * MiB;
constexpr size_t WS_XS = 1336 * MiB;
constexpr size_t WS_HID = 1464 * MiB;
constexpr size_t WS_YS = 1496 * MiB;
constexpr size_t WS_C1 = 1624 * MiB;
constexpr size_t WS_CQN = 1664 * MiB;
constexpr size_t WS_CKVN = 1672 * MiB;
constexpr size_t WS_KPE = 1680 * MiB;
constexpr size_t WS_Q = 1684 * MiB;
constexpr size_t WS_K = 1732 * MiB;
constexpr size_t WS_V = 1780 * MiB;
constexpr size_t WS_VT = 1812 * MiB;
constexpr size_t WS_END = 1844 * MiB;
constexpr int CW_BAR = 4096;
constexpr int CW_CNT = 8192;
constexpr int CW_BLK = 8448;

constexpr int RING_BYTES = 131072;
constexpr int LDSCTL_OFF = 143360, MISC_OFF = LDSCTL_OFF + 320;
constexpr int TAB_OFF = LDSCTL_OFF + 512;
constexpr int SC_OFF = LDSCTL_OFF + 1536;
constexpr int LDS_BYTES = 147456;

namespace pg8 {
constexpr int BM = 256, BK = 64, HALF = 128, HTB = HALF * BK * 2, STAGE_BYTES = 8 * HTB, NXCD = 8, WGM = 8;
__host__ __device__ __forceinline__ int lds_byte(int r, int c) { const int st = (r >> 4) * 2 + (c >> 5), rr = r & 15, cc = c & 31, ob = rr * 64 + cc * 2; return st * 1024 + (ob ^ (((ob >> 9) & 1) << 5)); }
__host__ __device__ __forceinline__ void stage_rc(int b, int& R, int& C) { const int st = b / 1024, sb = b % 1024, swz = sb ^ (((sb >> 9) & 1) << 5); R = (st >> 1) * 16 + swz / 64; C = (st & 1) * 32 + (swz % 64) / 2; }
__host__ __device__ __forceinline__ int perm32(int rho) { const int n = rho >> 4, i = rho & 15; return 8 * (i >> 2) + 4 * n + (i & 3); }

struct Unit { int pm, pn, ex; };

struct StaticOrder {
    int nM, nN, nwg, G, c; const char* A; const char* Bt; size_t tstep;
    __device__ void init(const bf16* A_, const bf16* Bt_, int M, int N, int K, int G_, int c_) { nM = M / BM; nN = N / BM; nwg = nM * nN; G = G_; c = c_; A = (const char*)A_; Bt = (const char*)Bt_; tstep = (size_t)BM * K * 2; }
    __device__ bool next(int i, Unit& u) const {
        const long L = (long)i * G + c; if (L >= nwg) return false;
        int wgid = (int)L; { const int q = nwg / NXCD, r = nwg % NXCD, xcd = wgid % NXCD, off = wgid / NXCD; wgid = (xcd < r ? xcd * (q + 1) : r * (q + 1) + (xcd - r) * q) + off; }
        const int nig = WGM * nN, gid = wgid / nig, fm = gid * WGM, gsz = (nM - fm) < WGM ? (nM - fm) : WGM;
        u.pm = fm + ((wgid % nig) % gsz); u.pn = (wgid % nig) / gsz; u.ex = 0; return true;
    }
    __device__ __forceinline__ const char* aptr(const Unit& u) const { return A + (size_t)u.pm * tstep; }
    __device__ __forceinline__ const char* bptr(const Unit& u) const { return Bt + (size_t)u.pn * tstep; }
};
struct MoeOrder {
    int nunits, NT, G, c; const LAS int* blk_e; const char* A; const char* W; size_t a_tstep, w_estride, w_tstep;
    __device__ bool next(int i, Unit& u) const {
        const long L = (long)i * G + c; if (L >= nunits) return false;
        u.pm = (int)L / NT; u.pn = (int)L % NT; u.ex = blk_e[u.pm]; return true;
    }
    __device__ __forceinline__ const char* aptr(const Unit& u) const { return A + (size_t)u.pm * a_tstep; }
    __device__ __forceinline__ const char* bptr(const Unit& u) const { return W + (size_t)u.ex * w_estride + (size_t)u.pn * w_tstep; }
};

template <class Epi, class Sched, bool ALIGN_EPI = true, bool SP2 = true>
__device__ __forceinline__ void gemm_phase(LAS unsigned char* lds, const int K_, const Sched& S, const Epi& E, const int tid, const int wid) {
    const int lane = tid & 63, wr = wid >> 2, wc = wid & 3, fr = lane & 15, fq = lane >> 4;
    int K = K_; asm volatile("" : "+s"(K));
    const int nt = K / BK;
    unsigned voffA[2], voffB[2];
#pragma unroll
    for (int i = 0; i < 2; ++i) { int R, C; stage_rc(tid * 16 + i * 8192, R, C); const int Rb = Epi::PERM ? ((R & ~31) + perm32(R & 31)) : R;
        voffA[i] = (unsigned)(R * K + C) * 2u; voffB[i] = (unsigned)(Rb * K + C) * 2u; }
    const size_t kstep = (size_t)(BK * 2);
    const size_t hstep = (size_t)HALF * K * 2;
    const unsigned ldsw = (unsigned)wid * 1024u;
    const int aoff = lds_byte(wr * 64 + fr, fq * 8), boff = lds_byte(wc * 32 + fr, fq * 8);
#define PG8_SA(b, h) (((b) * 2 + (h)) * HTB)
#define PG8_SB(b, h) ((4 + (b) * 2 + (h)) * HTB)
#define PG8_STAGE(bufoff, gbase, voff) do { _Pragma("unroll") for (int _i = 0; _i < 2; ++_i) \
        __builtin_amdgcn_global_load_lds((const unsigned*)((const char*)(gbase) + (voff)[_i]), (LAS unsigned*)(lds + (bufoff) + ldsw + _i * 8192), 16, 0, 0); } while (0)
#define PG8_LDA(dst, b, h) do { _Pragma("unroll") for (int m = 0; m < 4; ++m) _Pragma("unroll") for (int k = 0; k < 2; ++k) dst[m][k] = *(const LAS bf16x8*)(lds + PG8_SA(b, h) + aoff + m * 2048 + k * 1024); } while (0)
#define PG8_LDB(dst, b, h) do { _Pragma("unroll") for (int n = 0; n < 2; ++n) _Pragma("unroll") for (int k = 0; k < 2; ++k) dst[n][k] = *(const LAS bf16x8*)(lds + PG8_SB(b, h) + boff + n * 2048 + k * 1024); } while (0)
#define PG8_MMA(ai, bj, At, Bt) do { __builtin_amdgcn_s_setprio(1); _Pragma("unroll") for (int m = 0; m < 4; ++m) _Pragma("unroll") for (int n = 0; n < 2; ++n) _Pragma("unroll") for (int k = 0; k < 2; ++k) \
        acc[ai][bj][m][n] = __builtin_amdgcn_mfma_f32_16x16x32_bf16(Bt[n][k], At[m][k], acc[ai][bj][m][n], 0, 0, 0); __builtin_amdgcn_s_setprio(0); } while (0)
#define PG8_WAIT_V(n) asm volatile("s_waitcnt vmcnt(" #n ")" ::: "memory")
#define PG8_WAIT_L(n) asm volatile("s_waitcnt lgkmcnt(" #n ")" ::: "memory")
#define PG8_BAR __builtin_amdgcn_s_barrier()
#define PG8_SCHED __builtin_amdgcn_sched_barrier(0)
    Unit cur, nxt; int ui = 0;
    if (!S.next(0, cur)) return;
    f32x4 acc[2][2][4][2];
#pragma unroll
    for (int a = 0; a < 2; ++a)
#pragma unroll
        for (int b = 0; b < 2; ++b)
#pragma unroll
            for (int m = 0; m < 4; ++m)
#pragma unroll
                for (int n = 0; n < 2; ++n) acc[a][b][m][n] = (f32x4){0.f, 0.f, 0.f, 0.f};
    bf16x8 At[4][2], B0[2][2], B1[2][2];
    const char* cA = S.aptr(cur); const char* cB = S.bptr(cur);
    if constexpr (SP2) {
        PG8_STAGE(PG8_SB(0, 0), cB, voffB); PG8_STAGE(PG8_SB(0, 1), cB + hstep, voffB); PG8_STAGE(PG8_SA(0, 0), cA, voffA); PG8_STAGE(PG8_SA(0, 1), cA + hstep, voffA);
        if (wr == 1) PG8_BAR;
        PG8_WAIT_V(2); PG8_BAR;
        PG8_STAGE(PG8_SB(1, 0), cB + kstep, voffB); PG8_STAGE(PG8_SA(1, 0), cA + kstep, voffA); PG8_STAGE(PG8_SB(1, 1), cB + hstep + kstep, voffB);
        PG8_WAIT_V(6); PG8_BAR;
    } else {
        PG8_STAGE(PG8_SB(0, 0), cB, voffB); PG8_STAGE(PG8_SA(0, 0), cA, voffA); PG8_STAGE(PG8_SB(0, 1), cB + hstep, voffB); PG8_STAGE(PG8_SA(0, 1), cA + hstep, voffA);
        if (wr == 1) PG8_BAR;
        PG8_WAIT_V(4); PG8_BAR;
        PG8_STAGE(PG8_SB(1, 0), cB + kstep, voffB); PG8_STAGE(PG8_SA(1, 0), cA + kstep, voffA); PG8_STAGE(PG8_SB(1, 1), cB + hstep + kstep, voffB);
        PG8_WAIT_V(6); PG8_BAR;
    }
    for (;;) {
        const bool has_next = S.next(ui + 1, nxt);
        const char* nA = has_next ? S.aptr(nxt) : cA; const char* nB = has_next ? S.bptr(nxt) : cB;
        for (int t = 0; t < nt; t += 2) {
            const bool last = (t == nt - 2);
            const char* a1 = cA + (size_t)(t + 1) * kstep;
            const char* a2 = last ? nA : cA + (size_t)(t + 2) * kstep; const char* b2 = last ? nB : cB + (size_t)(t + 2) * kstep;
            const char* a3 = a2 + kstep; const char* b3 = b2 + kstep;
            if constexpr (SP2) {
            PG8_LDB(B0, 0, 0); PG8_LDB(B1, 0, 1); PG8_SCHED; PG8_LDA(At, 0, 0); PG8_STAGE(PG8_SA(1, 1), a1 + hstep, voffA);
            PG8_WAIT_V(8); PG8_WAIT_L(0); PG8_BAR; PG8_MMA(0, 0, At, B0); PG8_MMA(0, 1, At, B1); PG8_BAR; PG8_SCHED;
            PG8_LDA(At, 0, 1); PG8_STAGE(PG8_SB(0, 0), b2, voffB); PG8_STAGE(PG8_SB(0, 1), b2 + hstep, voffB); PG8_STAGE(PG8_SA(0, 0), a2, voffA);
            PG8_WAIT_V(8); PG8_WAIT_L(0); PG8_BAR; PG8_MMA(1, 0, At, B0); PG8_MMA(1, 1, At, B1); PG8_BAR; PG8_SCHED;
            PG8_LDB(B0, 1, 0); PG8_LDB(B1, 1, 1); PG8_SCHED; PG8_LDA(At, 1, 0); PG8_STAGE(PG8_SA(0, 1), a2 + hstep, voffA);
            PG8_WAIT_V(8); PG8_WAIT_L(0); PG8_BAR; PG8_MMA(0, 0, At, B0); PG8_MMA(0, 1, At, B1); PG8_BAR; PG8_SCHED;
            PG8_LDA(At, 1, 1); PG8_STAGE(PG8_SB(1, 0), b3, voffB); PG8_STAGE(PG8_SB(1, 1), b3 + hstep, voffB); PG8_STAGE(PG8_SA(1, 0), a3, voffA);
            PG8_WAIT_V(8); PG8_WAIT_L(0); PG8_BAR; PG8_MMA(1, 0, At, B0); PG8_MMA(1, 1, At, B1); PG8_BAR; PG8_SCHED;
            } else {
            PG8_LDB(B0, 0, 0); PG8_SCHED; PG8_LDA(At, 0, 0); PG8_STAGE(PG8_SA(1, 1), a1 + hstep, voffA);
            PG8_WAIT_L(8); PG8_BAR; PG8_WAIT_L(0); PG8_MMA(0, 0, At, B0); PG8_BAR; PG8_SCHED;
            PG8_LDB(B1, 0, 1); PG8_STAGE(PG8_SB(0, 0), b2, voffB);
            PG8_BAR; PG8_WAIT_L(0); PG8_MMA(0, 1, At, B1); PG8_BAR;
            PG8_LDA(At, 0, 1); PG8_STAGE(PG8_SA(0, 0), a2, voffA);
            PG8_BAR; PG8_WAIT_L(0); PG8_MMA(1, 0, At, B0); PG8_BAR; PG8_SCHED;
            PG8_STAGE(PG8_SB(0, 1), b2 + hstep, voffB);
            PG8_WAIT_V(6); PG8_BAR; PG8_MMA(1, 1, At, B1); PG8_BAR;
            PG8_LDB(B0, 1, 0); PG8_SCHED; PG8_LDA(At, 1, 0); PG8_STAGE(PG8_SA(0, 1), a2 + hstep, voffA);
            PG8_WAIT_L(8); PG8_BAR; PG8_WAIT_L(0); PG8_MMA(0, 0, At, B0); PG8_BAR; PG8_SCHED;
            PG8_LDB(B1, 1, 1); PG8_STAGE(PG8_SB(1, 0), b3, voffB);
            PG8_BAR; PG8_WAIT_L(0); PG8_MMA(0, 1, At, B1); PG8_BAR;
            PG8_LDA(At, 1, 1); PG8_STAGE(PG8_SA(1, 0), a3, voffA);
            PG8_BAR; PG8_WAIT_L(0); PG8_MMA(1, 0, At, B0); PG8_BAR; PG8_SCHED;
            PG8_STAGE(PG8_SB(1, 1), b3 + hstep, voffB);
            PG8_WAIT_V(6); PG8_BAR; PG8_MMA(1, 1, At, B1); PG8_BAR;
            }
        }
        if constexpr (ALIGN_EPI) { if (wr == 0) PG8_BAR; }
        E(acc, cur, wr, wc, fr, fq);
        if (!has_next) break;
#pragma unroll
        for (int a = 0; a < 2; ++a)
#pragma unroll
            for (int b = 0; b < 2; ++b)
#pragma unroll
                for (int m = 0; m < 4; ++m)
#pragma unroll
                    for (int n = 0; n < 2; ++n) acc[a][b][m][n] = (f32x4){0.f, 0.f, 0.f, 0.f};
        cur = nxt; cA = nA; cB = nB; ++ui;
        if constexpr (ALIGN_EPI) { if (wr == 1) PG8_BAR; }
    }
    PG8_WAIT_V(0);
    if constexpr (!ALIGN_EPI) { if (wr == 0) PG8_BAR; }
    PG8_BAR;
#undef PG8_SA
#undef PG8_SB
#undef PG8_STAGE
#undef PG8_LDA
#undef PG8_LDB
#undef PG8_MMA
#undef PG8_WAIT_V
#undef PG8_WAIT_L
#undef PG8_BAR
#undef PG8_SCHED
}

typedef const f32x4 (&AccRef)[2][2][4][2];
DI u32x4 pack8(const f32x4& v0, const f32x4& v1) { u32x4 w; w.x = cvtpk(v0[0], v0[1]); w.y = cvtpk(v0[2], v0[3]); w.z = cvtpk(v1[0], v1[1]); w.w = cvtpk(v1[2], v1[3]); return w; }

struct EpiBf16 {
    static constexpr bool PERM = true;
    bf16* O; int ldc;
    DI void operator()(AccRef acc, const Unit& u, int wr, int wc, int fr, int fq) const {
        const int row0 = u.pm * BM + wr * 64 + fr, col0 = u.pn * BM + wc * 32 + 8 * fq;
#pragma unroll
        for (int ai = 0; ai < 2; ++ai)
#pragma unroll
            for (int m = 0; m < 4; ++m) { bf16* rowp = O + (size_t)(row0 + ai * HALF + m * 16) * ldc + col0;
#pragma unroll
                for (int bj = 0; bj < 2; ++bj) *(u32x4*)(rowp + bj * HALF) = pack8(acc[ai][bj][m][0], acc[ai][bj][m][1]); }
    }
};
struct EpiF32 {
    static constexpr bool PERM = false;
    float* C; int ldc;
    DI void operator()(AccRef acc, const Unit& u, int wr, int wc, int fr, int fq) const {
        const int row0 = u.pm * BM + wr * 64 + fr, col0 = u.pn * BM + wc * 32 + 4 * fq;
#pragma unroll
        for (int ai = 0; ai < 2; ++ai)
#pragma unroll
            for (int m = 0; m < 4; ++m) { float* rowp = C + (size_t)(row0 + ai * HALF + m * 16) * ldc + col0;
#pragma unroll
                for (int bj = 0; bj < 2; ++bj)
#pragma unroll
                    for (int n = 0; n < 2; ++n) *(f32x4*)(rowp + bj * HALF + n * 16) = acc[ai][bj][m][n]; }
    }
};
struct EpiInProj {
    static constexpr bool PERM = true;
    bf16* P; float* PBA;
    DI void operator()(AccRef acc, const Unit& u, int wr, int wc, int fr, int fq) const {
        const int row0 = u.pm * BM + wr * 64 + fr;
        if (u.pn < 28) {
            const int col0 = u.pn * BM + wc * 32 + 8 * fq;
#pragma unroll
            for (int ai = 0; ai < 2; ++ai)
#pragma unroll
                for (int m = 0; m < 4; ++m) { bf16* rowp = P + (size_t)(row0 + ai * HALF + m * 16) * NP + col0;
#pragma unroll
                    for (int bj = 0; bj < 2; ++bj) *(u32x4*)(rowp + bj * HALF) = pack8(acc[ai][bj][m][0], acc[ai][bj][m][1]); }
        } else if (wc == 0 && fq < 2) {
#pragma unroll
            for (int ai = 0; ai < 2; ++ai)
#pragma unroll
                for (int m = 0; m < 4; ++m) { float* rp = PBA + (size_t)(row0 + ai * HALF + m * 16) * 16 + 8 * fq;
                    *(f32x4*)rp = acc[ai][0][m][0]; *(f32x4*)(rp + 4) = acc[ai][0][m][1]; }
        }
    }
};
struct EpiResid {
    static constexpr bool PERM = false;
    const float* x; const float* g; float* R;
    DI void operator()(AccRef acc, const Unit& u, int wr, int wc, int fr, int fq) const {
        const int row0 = u.pm * BM + wr * 64 + fr, col0 = u.pn * BM + wc * 32 + 4 * fq;
        const float* gb = g + (size_t)((u.pm * BM) / SEQ) * 12288 + col0;
        f32x4 gv[2][2];
#pragma unroll
        for (int bj = 0; bj < 2; ++bj)
#pragma unroll
            for (int n = 0; n < 2; ++n) gv[bj][n] = *(const f32x4*)(gb + bj * HALF + n * 16) + 1.0f;
#pragma unroll
        for (int ai = 0; ai < 2; ++ai)
#pragma unroll
            for (int m = 0; m < 4; ++m) { const size_t off = (size_t)(row0 + ai * HALF + m * 16) * D + col0;
#pragma unroll
                for (int bj = 0; bj < 2; ++bj)
#pragma unroll
                    for (int n = 0; n < 2; ++n) { const f32x4 xv = *(const f32x4*)(x + off + bj * HALF + n * 16);
                        *(f32x4*)(R + off + bj * HALF + n * 16) = xv * DN_ALPHA + gv[bj][n] * acc[ai][bj][m][n]; } }
    }
};
struct EpiLogits {
    static constexpr bool PERM = false;
    float* L;
    DI void operator()(AccRef acc, const Unit& u, int wr, int wc, int fr, int fq) const {
        const int row0 = u.pm * BM + wr * 64 + fr, col0 = wc * 32 + 4 * fq;
#pragma unroll
        for (int ai = 0; ai < 2; ++ai)
#pragma unroll
            for (int m = 0; m < 4; ++m) { float* rowp = L + (size_t)(row0 + ai * HALF + m * 16) * 128 + col0;
#pragma unroll
                for (int n = 0; n < 2; ++n) *(f32x4*)(rowp + n * 16) = acc[ai][0][m][n]; }
    }
};
struct EpiGateUp {
    static constexpr bool PERM = true;
    bf16* H;
    DI void operator()(AccRef acc, const Unit& u, int wr, int wc, int fr, int fq) const {
        const int row0 = u.pm * BM + wr * 64 + fr, col0 = u.pn * HALF + wc * 32 + 8 * fq;
#pragma unroll
        for (int ai = 0; ai < 2; ++ai)
#pragma unroll
            for (int m = 0; m < 4; ++m) { bf16* rowp = H + (size_t)(row0 + ai * HALF + m * 16) * FF + col0;
                f32x4 h0, h1;
#pragma unroll
                for (int j = 0; j < 4; ++j) { h0[j] = silu_f(acc[ai][0][m][0][j]) * acc[ai][1][m][0][j]; h1[j] = silu_f(acc[ai][0][m][1][j]) * acc[ai][1][m][1][j]; }
                *(u32x4*)rowp = pack8(h0, h1); }
    }
};
struct EpiQup {
    static constexpr bool PERM = true;
    bf16* Q;
    DI void operator()(AccRef acc, const Unit& u, int wr, int wc, int fr, int fq) const {
        const int row0 = u.pm * BM + wr * 64 + fr, b = (u.pm * BM) / SEQ, s0 = row0 - b * SEQ;
        const int cg0 = u.pn * BM + wc * 32 + 8 * fq, cg1 = cg0 + HALF;
        const int h0 = cg0 / QD, w0 = cg0 - h0 * QD, h1 = cg1 / QD, w1 = cg1 - h1 * QD;
        bf16* d0 = Q + ((size_t)((b * MH + h0) * SEQ + s0)) * QD + w0; bf16* d1 = Q + ((size_t)((b * MH + h1) * SEQ + s0)) * QD + w1;
#pragma unroll
        for (int ai = 0; ai < 2; ++ai)
#pragma unroll
            for (int m = 0; m < 4; ++m) { const int dr = (ai * HALF + m * 16) * QD;
                *(u32x4*)(d0 + dr) = pack8(acc[ai][0][m][0] * QSCALE, acc[ai][0][m][1] * QSCALE);
                *(u32x4*)(d1 + dr) = pack8(acc[ai][1][m][0] * QSCALE, acc[ai][1][m][1] * QSCALE);
                asm volatile("" ::: "memory"); }
    }
};
struct EpiKVup {
    static constexpr bool PERM = true;
    bf16* Kp; bf16* V;
    DI void operator()(AccRef acc, const Unit& u, int wr, int wc, int fr, int fq) const {
        const int row0 = u.pm * BM + wr * 64 + fr, c0 = wc * 32 + 8 * fq, head = u.pn, b = (u.pm * BM) / SEQ, s0 = row0 - b * SEQ;
        bf16* dk = Kp + ((size_t)((b * MH + head) * SEQ + s0)) * QD + c0; bf16* dv = V + (size_t)row0 * D + head * 128 + c0;
#pragma unroll
        for (int ai = 0; ai < 2; ++ai)
#pragma unroll
            for (int m = 0; m < 4; ++m) { const int dr = ai * HALF + m * 16;
                *(u32x4*)(dk + dr * QD) = pack8(acc[ai][0][m][0], acc[ai][0][m][1]);
                *(u32x4*)(dv + dr * D) = pack8(acc[ai][1][m][0], acc[ai][1][m][1]);
                asm volatile("" ::: "memory"); }
    }
};
}

#define XB_TMO      128
#define XB_XCNT(j)  (256  + 64 * (j))
#define XB_XSUB(j)  (1280 + 64 * (j))
#define XB_XGEN(j)  (2304 + 64 * (j))
#define XB_TOP      3328
#define XB_TOPGEN   3392
#define XCD_BAR_WORDS 3456
#define XB_SPIN_CAP (1u << 18)
__device__ __forceinline__ unsigned xb_ld(unsigned* p)              { return __hip_atomic_load(p, __ATOMIC_RELAXED, __HIP_MEMORY_SCOPE_AGENT); }
__device__ __forceinline__ unsigned xb_add(unsigned* p, unsigned v) { return __hip_atomic_fetch_add(p, v, __ATOMIC_RELAXED, __HIP_MEMORY_SCOPE_AGENT); }
__device__ __forceinline__ unsigned xb_xcc_id() { return (unsigned)__builtin_amdgcn_s_getreg((3 << 11) | 20) & 0xFu; }
#define XB_SPIN(cond, bar) do { unsigned _sp = 0; while (cond) { __builtin_amdgcn_s_sleep(1); \
    if ((++_sp & 255u) == 0u) { if (xb_ld(&(bar)[XB_TMO])) break; if (_sp > XB_SPIN_CAP) { atomicAdd(&(bar)[XB_TMO], 1u); break; } } } } while (0)
struct XcdBarrier { unsigned* bar; unsigned x; volatile LAS unsigned* st; };
__device__ __forceinline__ XcdBarrier xcd_barrier_post(unsigned* bar, volatile LAS unsigned* st, const bool leader  ) {
    XcdBarrier b; b.bar = bar; b.x = xb_xcc_id(); b.st = st;
    if (leader) (void)xb_add(&bar[XB_XCNT(b.x)], 1u);
    return b;
}
__device__ __forceinline__ void xcd_barrier_complete(unsigned* bar, unsigned x, unsigned& nloc, unsigned& nx) {
    const unsigned G = gridDim.x * gridDim.y * gridDim.z;
    unsigned sum, cnt, mine, sp = 0u;
    for (;;) {
        sum = 0u; cnt = 0u; mine = 0u;
#pragma unroll
        for (unsigned j = 0; j < 16; ++j) { const unsigned c = xb_ld(&bar[XB_XCNT(j)]); sum += c; cnt += (c > 0u) ? 1u : 0u; mine = (j == x) ? c : mine; }
        if (sum == G) break;
        __builtin_amdgcn_s_sleep(1);
        if ((++sp & 255u) == 0u) { if (xb_ld(&bar[XB_TMO])) break; if (sp > XB_SPIN_CAP) { atomicAdd(&bar[XB_TMO], 1u); break; } }
    }
    nloc = mine > 0u ? mine : 1u; nx = cnt > 0u ? cnt : 1u;
}
__device__ __forceinline__ void xcd_barrier(const XcdBarrier& b, const bool leader  ) {
    asm volatile("s_waitcnt vmcnt(0)" ::: "memory");
    __syncthreads();
    if (leader) {
        unsigned* bar = b.bar;
        __builtin_amdgcn_s_waitcnt(0);
        unsigned nloc = b.st[0], nx = b.st[1];
        if (nloc == 0u) { xcd_barrier_complete(bar, b.x, nloc, nx); b.st[0] = nloc; b.st[1] = nx; }
        const unsigned old = xb_add(&bar[XB_XSUB(b.x)], 1u);
        const unsigned gen = old / nloc;
        if (old + 1u == (gen + 1u) * nloc) {
            __builtin_amdgcn_fence(__ATOMIC_RELEASE, "agent");
            asm volatile("s_waitcnt vmcnt(0)" ::: "memory");
            const unsigned og = xb_add(&bar[XB_TOP], 1u);
            const unsigned tg = og / nx;
            if (og + 1u == (tg + 1u) * nx) xb_add(&bar[XB_TOPGEN], 1u);
            else XB_SPIN(xb_ld(&bar[XB_TOPGEN]) == tg, bar);
            __builtin_amdgcn_fence(__ATOMIC_ACQUIRE, "agent");
            xb_add(&bar[XB_XGEN(b.x)], 1u);
            asm volatile("s_waitcnt vmcnt(0)" ::: "memory");
        } else {
            XB_SPIN(xb_ld(&bar[XB_XGEN(b.x)]) == gen, bar);
            __builtin_amdgcn_fence(__ATOMIC_ACQUIRE, "agent");
            asm volatile("s_waitcnt vmcnt(0)" ::: "memory");
        }
    }
    __syncthreads();
}

struct Frame {
    LAS unsigned char* lds;
    int tid, lane, wave, vcu, G, gw, NGW;
    unsigned* ctl;
};
struct Args { const void* in[27]; float* out; unsigned char* ws; int ph_lo, ph_hi; };

__device__ const double ROPE_INVF[32] = {1, 0.74989420933245587, 0.56234132519034907, 0.42169650342858223, 0.31622776601683794, 0.23713737056616552, 0.17782794100389229, 0.1333521432163324,
    0.10000000000000001, 0.074989420933245579, 0.056234132519034911, 0.042169650342858224, 0.031622776601683791, 0.023713737056616554, 0.017782794100389229, 0.013335214321633241,
    0.01, 0.0074989420933245579, 0.005623413251903491, 0.0042169650342858229, 0.0031622776601683794, 0.0023713737056616554, 0.0017782794100389228, 0.0013335214321633241,
    0.001, 0.00074989420933245586, 0.0005623413251903491, 0.00042169650342858224, 0.00031622776601683794, 0.00023713737056616554, 0.00017782794100389227, 0.0001333521432163324};

struct TrRegs { f32x4 r[8]; };
DI void tr_load(TrRegs& t, const float* W, size_t ld, int k0, int n0, int nvalid, int lane) {
    const int ns = lane & 7, kq = lane >> 3;
    if (4 * ns < nvalid) { const float* src = W + (size_t)(k0 + 8 * kq) * ld + n0 + 4 * ns;
#pragma unroll
        for (int j = 0; j < 8; ++j) t.r[j] = *(const f32x4*)(src + (size_t)j * ld); }
}
DI void tr_store(const TrRegs& t, int k0, int nvalid, bf16* WT, int Kd, int drow0, int lane) {
    const int ns = lane & 7, kq = lane >> 3;
    if (4 * ns < nvalid) { bf16* dst = WT + (size_t)(drow0 + 4 * ns) * Kd + k0 + 8 * kq;
#pragma unroll
        for (int i = 0; i < 4; ++i) { u32x4 o; o.x = cvtpk(t.r[0][i], t.r[1][i]); o.y = cvtpk(t.r[2][i], t.r[3][i]); o.z = cvtpk(t.r[4][i], t.r[5][i]); o.w = cvtpk(t.r[6][i], t.r[7][i]);
            *(u32x4*)(dst + (size_t)i * Kd) = o; } }
}
DI void tr_job(const Frame& F, const float* W, size_t smat, int nmat, int ld, int K, int col0, int ncols, bf16* WT, size_t dmat, int Kd, int row_off, int mode) {
    const int nblk = (ncols + 31) / 32, kbs = K / 64, per = nblk * kbs; const long items = (long)nmat * per;
    for (long it0 = F.gw; it0 < items; it0 += 2 * (long)F.NGW) {
        TrRegs t[2]; int k0[2], nv[2], dr[2]; bf16* wt[2];
#pragma unroll
        for (int u = 0; u < 2; ++u) {
            const long it = it0 + (long)u * F.NGW;
            if (it < items) {
                const int mat = (int)(it / per), rem = (int)(it - (long)mat * per), kb = rem / nblk, nb = rem - kb * nblk;
                nv[u] = (ncols - nb * 32) < 32 ? (ncols - nb * 32) : 32; k0[u] = kb * 64;
                dr[u] = (mode == 0) ? (row_off + nb * 32) : ((nb >> 2) * 256 + row_off + (nb & 3) * 32);
                wt[u] = WT + (size_t)mat * dmat;
                tr_load(t[u], W + (size_t)mat * smat, (size_t)ld, k0[u], col0 + nb * 32, nv[u], F.lane);
            } else { nv[u] = 0; k0[u] = 0; dr[u] = 0; wt[u] = WT; }
        }
#pragma unroll
        for (int u = 0; u < 2; ++u) tr_store(t[u], k0[u], nv[u], wt[u], Kd, dr[u], F.lane);
    }
}
DI void zero_fill(const Frame& F, void* p, size_t bytes) {
    u32x4* q = (u32x4*)p; const size_t n = bytes / 16;
    for (size_t i = (size_t)F.gw * 64 + F.lane; i < n; i += (size_t)F.NGW * 64) q[i] = (u32x4){0u, 0u, 0u, 0u};
}

DI const void* arg_in(int k) { unsigned o = (unsigned)k * 8u; asm volatile("" : "+s"(o));
    const GAS void* p = *(const GAS void* const __attribute__((address_space(4)))*)((const __attribute__((address_space(4))) unsigned char*)__builtin_amdgcn_kernarg_segment_ptr() + o);
    return (const void*)p; }
#define WSB (args.ws)
#define in_x ((const float*)arg_in(0))
#define in_c ((const float*)arg_in(1))
#define in_pos ((const int*)arg_in(2))
#define ada_w ((const float*)arg_in(3))
#define ada_b ((const float*)arg_in(4))
#define ln_g ((const float*)arg_in(5))
#define ln_b ((const float*)arg_in(6))
#define hyb_w_in ((const float*)arg_in(7))
#define gdn_conv_w ((const float*)arg_in(8))
#define gdn_a_log ((const float*)arg_in(9))
#define gdn_dt_bias ((const float*)arg_in(10))
#define gdn_norm_w ((const float*)arg_in(11))
#define sc_conv_w ((const float*)arg_in(12))
#define hyb_w_out ((const float*)arg_in(13))
#define mla_w_in ((const float*)arg_in(14))
#define mla_q_norm ((const float*)arg_in(15))
#define mla_kv_norm ((const float*)arg_in(16))
#define mla_w_uq ((const float*)arg_in(17))
#define mla_w_ukv ((const float*)arg_in(18))
#define mla_w_out ((const float*)arg_in(19))
#define moe_router_g ((const float*)arg_in(20))
#define moe_bias_g ((const float*)arg_in(21))
#define moe_router_e ((const float*)arg_in(22))
#define moe_bias_e ((const float*)arg_in(23))
#define moe_w_gate ((const float*)arg_in(24))
#define moe_w_up ((const float*)arg_in(25))
#define moe_w_down ((const float*)arg_in(26))
#define MOD ((float*)(WSB + WS_MOD))
#define ROPE_C ((float*)(WSB + WS_ROPE))
#define ROPE_S ((float*)(ROPE_C + (size_t)T * 32))
#define PBA ((float*)(WSB + WS_PBA))
#define LOGITS ((float*)(WSB + WS_LOGITS))
#define TOK_E ((int*)(WSB + WS_ROUTE))
#define TOK_POS ((int*)(TOK_E + 2 * T))
#define TOK_GATE ((float*)(TOK_POS + 2 * T))
#define EG ((float*)(WSB + WS_EG))
#define WIN0 ((bf16*)(WSB + WS_WIN0))
#define WOUT0 ((bf16*)(WSB + WS_WOUT0))
#define WMIN ((bf16*)(WSB + WS_WMIN))
#define WUQ ((bf16*)(WSB + WS_WUQ))
#define WUKV ((bf16*)(WSB + WS_WUKV))
#define WMOUT ((bf16*)(WSB + WS_WMOUT))
#define WRT ((bf16*)(WSB + WS_WRT))
#define WGU ((bf16*)(WSB + WS_WGU))
#define WDN ((bf16*)(WSB + WS_WDN))
#define HIN ((bf16*)(WSB + WS_HIN))
#define XA ((float*)(WSB + WS_XA))
#define XB ((float*)(WSB + WS_XB))
#define RB ((float*)(WSB + WS_R))
#define PB ((bf16*)(WSB + WS_P))
#define GF ((unsigned char*)(WSB + WS_GF))
#define GU ((unsigned char*)(WSB + WS_GU))
#define GO ((float*)(WSB + WS_GO))
#define YAB ((bf16*)(WSB + WS_YAB))
#define XS ((bf16*)(WSB + WS_XS))
#define HID ((bf16*)(WSB + WS_HID))
#define YS ((bf16*)(WSB + WS_YS))
#define C1 ((float*)(WSB + WS_C1))
#define CQN ((bf16*)(WSB + WS_CQN))
#define CKVN ((bf16*)(WSB + WS_CKVN))
#define KPE ((float*)(WSB + WS_KPE))
#define QB_ ((bf16*)(WSB + WS_Q))
#define KB_ ((bf16*)(WSB + WS_K))
#define VB_ ((bf16*)(WSB + WS_V))
#define VT ((bf16*)(WSB + WS_VT))


#define LN_ROW(v, gptr, bptr) do { float _s = 0.f; _Pragma("unroll") for (int _j = 0; _j < 8; ++_j) _s += (v[_j][0] + v[_j][1]) + (v[_j][2] + v[_j][3]); \
        const float _mean = wave_sum(_s) * (1.f / D); float _q = 0.f; \
        _Pragma("unroll") for (int _j = 0; _j < 8; ++_j) { v[_j] = v[_j] - _mean; _q += (v[_j][0] * v[_j][0] + v[_j][1] * v[_j][1]) + (v[_j][2] * v[_j][2] + v[_j][3] * v[_j][3]); } \
        const float _rstd = rsqrtf(wave_sum(_q) * (1.f / D) + 1e-5f); \
        _Pragma("unroll") for (int _j = 0; _j < 8; ++_j) v[_j] = v[_j] * _rstd * ((const f32x4*)(gptr))[F.lane + 64 * _j] + ((const f32x4*)(bptr))[F.lane + 64 * _j]; } while (0)
#define WRITE_X_HIN(v, xrow, hrow, shp, scp) do { _Pragma("unroll") for (int _j = 0; _j < 8; ++_j) { ((f32x4*)(xrow))[F.lane + 64 * _j] = v[_j]; \
        if ((hrow) != nullptr) { const f32x4 _h = v[_j] * (((const f32x4*)(scp))[F.lane + 64 * _j] + 1.0f) + ((const f32x4*)(shp))[F.lane + 64 * _j]; \
            u32x2 _w; _w.x = cvtpk(_h[0], _h[1]); _w.y = cvtpk(_h[2], _h[3]); ((u32x2*)(hrow))[F.lane + 64 * _j] = _w; } } } while (0)


#ifndef PHMASK
#define PHMASK 0xFFFFFFFFull
#endif
#define PH_EN(k) (((PHMASK) >> (k)) & 1ull)
#define IN(k) (PH_EN(k) && lo <= (k) && (k) < hi)
#define INL(k0, k1) ((L == 0) ? IN(k0) : IN(k1))
#define PHASE_FRESH() do { int _l; asm volatile("v_mbcnt_lo_u32_b32 %0, -1, 0\n\tv_mbcnt_hi_u32_b32 %0, -1, %0" : "=v"(_l)); F.lane = _l; F.tid = F.wave * 64 + _l; } while (0)
#define SEAM(k) do { if (IN(k) && IN((k) + 1)) { PHASE_FRESH(); xcd_barrier(bar, F.tid == 0); } } while (0)

template <int L> DI void moe_phases(Frame& F, const Args& args, const XcdBarrier& bar, const int lo, const int hi, LAS int* TAB) {
        unsigned* cnt = F.ctl + CW_CNT + L * 64;
    if (INL(8, 21)) { PHASE_FRESH();
        pg8::StaticOrder S; S.init(HIN, WRT + (size_t)L * 256 * D, T, 256, D, F.G, (int)blockIdx.x);
        pg8::EpiLogits E{LOGITS};
        pg8::gemm_phase<pg8::EpiLogits, pg8::StaticOrder>(F.lds, D, S, E, F.tid, F.wave);
    }
    if (L == 0) SEAM(8); else SEAM(21);
    if (INL(9, 22)) { PHASE_FRESH();
        const float* bg = moe_bias_g + L * 8; const float* be = moe_bias_e + L * 64;
        for (int t = blockIdx.x * 512 + F.tid; t < T; t += F.G * 512) {
            const float* lg = LOGITS + (size_t)t * 128;
            float l8[8]; float mx = -3.0e38f; int grp = 0;
#pragma unroll
            for (int g = 0; g < 8; ++g) { l8[g] = lg[g] + bg[g]; if (l8[g] > mx) { mx = l8[g]; grp = g; } }
            float se = 0.f;
#pragma unroll
            for (int g = 0; g < 8; ++g) se += __expf(l8[g] - mx);
            const float pg = 1.f / se;
            float e8[8];
#pragma unroll
            for (int j = 0; j < 8; ++j) e8[j] = lg[8 + grp * 8 + j] + be[grp * 8 + j];
            int i1 = 0; float m1 = e8[0];
#pragma unroll
            for (int j = 1; j < 8; ++j) if (e8[j] > m1) { m1 = e8[j]; i1 = j; }
            int i2 = -1; float m2 = -3.0e38f;
#pragma unroll
            for (int j = 0; j < 8; ++j) if (j != i1 && e8[j] > m2) { m2 = e8[j]; i2 = j; }
            const float rr = __expf(m2 - m1), g1 = pg / (1.f + rr), g2 = pg * rr / (1.f + rr);
            const int ex1 = grp * 8 + i1, ex2 = grp * 8 + i2;
            const int p1 = (int)atomicAdd(&cnt[ex1], 1u), p2 = (int)atomicAdd(&cnt[ex2], 1u);
            TOK_E[2 * t] = ex1; TOK_E[2 * t + 1] = ex2; TOK_POS[2 * t] = p1; TOK_POS[2 * t + 1] = p2; TOK_GATE[2 * t] = g1; TOK_GATE[2 * t + 1] = g2;
        }
    }
    if (L == 0) SEAM(9); else SEAM(22);
    if (INL(10, 23)) { PHASE_FRESH();
        if (F.tid == 0) { int a = 0; for (int e = 0; e < NE; ++e) { TAB[128 + e] = a; const int nb = ((int)cnt[e] + 255) >> 8; for (int q = 0; q < nb; ++q) TAB[a + q] = e; a += nb; } TAB[192] = a; }
        __syncthreads();
        if (blockIdx.x == 0 && F.tid < 129) F.ctl[CW_BLK + L * 256 + F.tid] = (unsigned)((F.tid < 128) ? TAB[F.tid] : TAB[192]);
        for (int a = F.gw; a < 2 * T; a += F.NGW) {
            const int t = a >> 1, e = TOK_E[a], pos = TOK_POS[a], row = TAB[128 + e] * 256 + pos;
            const u32x4* src = (const u32x4*)(HIN + (size_t)t * D) + F.lane; u32x4* dst = (u32x4*)(XS + (size_t)row * D) + F.lane;
#pragma unroll
            for (int j = 0; j < 4; ++j) dst[64 * j] = src[64 * j];
        }
    }
    if (L == 0) SEAM(10); else SEAM(23);
    if (INL(11, 24)) { PHASE_FRESH();
        if (F.tid < 129) TAB[F.tid < 128 ? F.tid : 192] = (int)F.ctl[CW_BLK + L * 256 + F.tid];
        __syncthreads();
        pg8::MoeOrder S; S.nunits = TAB[192] * 4; S.NT = 4; S.G = F.G; S.c = F.vcu; S.blk_e = TAB; S.A = (const char*)XS; S.W = (const char*)(WGU + (size_t)L * 64 * 1024 * D);
        S.a_tstep = (size_t)256 * D * 2; S.w_estride = (size_t)1024 * D * 2; S.w_tstep = (size_t)256 * D * 2;
        pg8::EpiGateUp E{HID};
        pg8::gemm_phase<pg8::EpiGateUp, pg8::MoeOrder>(F.lds, D, S, E, F.tid, F.wave);
    }
    if (L == 0) SEAM(11); else SEAM(24);
    if (INL(12, 25)) { PHASE_FRESH();
        if (F.tid < 129) TAB[F.tid < 128 ? F.tid : 192] = (int)F.ctl[CW_BLK + L * 256 + F.tid];
        __syncthreads();
        pg8::MoeOrder S; S.nunits = TAB[192] * 8; S.NT = 8; S.G = F.G; S.c = F.vcu; S.blk_e = TAB; S.A = (const char*)HID; S.W = (const char*)(WDN + (size_t)L * 64 * D * FF);
        S.a_tstep = (size_t)256 * FF * 2; S.w_estride = (size_t)D * FF * 2; S.w_tstep = (size_t)256 * FF * 2;
        pg8::EpiBf16 E{YS, D};
        pg8::gemm_phase<pg8::EpiBf16, pg8::MoeOrder>(F.lds, FF, S, E, F.tid, F.wave);
    }
    if (L == 0) SEAM(12); else SEAM(25);
    if (INL(13, 26)) { PHASE_FRESH();
        if (F.tid == 0) { int a = 0; for (int e = 0; e < NE; ++e) { TAB[128 + e] = a; a += ((int)cnt[e] + 255) >> 8; } }
        __syncthreads();
        float* xout = (L == 0) ? XB : args.out;
        for (int m = F.gw; m < T; m += F.NGW) {
            const int b = m / SEQ; const float* modb = MOD + (size_t)(L * 4 + b) * 12288;
            const int r0 = TAB[128 + TOK_E[2 * m]] * 256 + TOK_POS[2 * m], r1 = TAB[128 + TOK_E[2 * m + 1]] * 256 + TOK_POS[2 * m + 1];
            const float g0 = TOK_GATE[2 * m], g1 = TOK_GATE[2 * m + 1];
            f32x4 v[8];
#pragma unroll
            for (int j = 0; j < 8; ++j) {
                const f32x4 xv = ((const f32x4*)(XA + (size_t)m * D))[F.lane + 64 * j];
                const u32x2 ya = ((const u32x2*)(YS + (size_t)r0 * D))[F.lane + 64 * j], yb = ((const u32x2*)(YS + (size_t)r1 * D))[F.lane + 64 * j];
                const f32x4 gg = ((const f32x4*)(modb + 5 * D))[F.lane + 64 * j] + 1.0f;
                f32x4 y; y[0] = g0 * bflo(ya.x) + g1 * bflo(yb.x); y[1] = g0 * bfhi(ya.x) + g1 * bfhi(yb.x); y[2] = g0 * bflo(ya.y) + g1 * bflo(yb.y); y[3] = g0 * bfhi(ya.y) + g1 * bfhi(yb.y);
                v[j] = xv * DN_ALPHA + gg * y;
            }
            LN_ROW(v, ln_g + (size_t)(L * 2 + 1) * D, ln_b + (size_t)(L * 2 + 1) * D);
            bf16* hrow = (L == 0) ? HIN + (size_t)m * D : nullptr;
            const float* mod1 = MOD + (size_t)(4 + b) * 12288;
            WRITE_X_HIN(v, xout + (size_t)m * D, hrow, mod1, mod1 + D);
        }
    }
    if (L == 0) SEAM(13);
}

__global__ void __launch_bounds__(512, 2) mega(Args args) {
    extern __shared__ __attribute__((aligned(16))) unsigned char lds_raw[];
    Frame F;
    F.lds = (LAS unsigned char*)lds_raw;
    F.wave = __builtin_amdgcn_readfirstlane((int)threadIdx.x >> 6); PHASE_FRESH();
    F.G = gridDim.x; { const int bx = blockIdx.x; F.vcu = (F.G % 8 == 0) ? (bx % 8) * (F.G / 8) + bx / 8 : bx; }
    F.gw = F.vcu * 8 + F.wave; F.NGW = F.G * 8;
    F.ctl = (unsigned*)(args.ws + WS_CTL);
    volatile LAS unsigned* MISC = (volatile LAS unsigned*)(F.lds + MISC_OFF);
    LAS int* TAB = (LAS int*)(F.lds + TAB_OFF);
    for (int u = F.tid; u < (LDS_BYTES - LDSCTL_OFF) / 4; u += 512) ((LAS unsigned*)(F.lds + LDSCTL_OFF))[u] = 0u;
    __syncthreads();
    XcdBarrier bar; bar.bar = F.ctl + CW_BAR; bar.x = 0; bar.st = nullptr;
    if (MK_ONE_LAUNCH) bar = xcd_barrier_post(F.ctl + CW_BAR, MISC + 8, F.tid == 0);
    const int lo = args.ph_lo, hi = args.ph_hi;

    if (IN(0)) { PHASE_FRESH();
        {
            LAS float* cact = (LAS float*)F.lds;
            LAS float* red = (LAS float*)(F.lds + 32768);
            for (int i = F.tid; i < 4 * D; i += 512) cact[i] = silu_f(in_c[i]);
            __syncthreads();
            for (int cg = blockIdx.x; cg < 256; cg += F.G) {
                const int jj0 = cg * 96, l = jj0 / 12288, j0 = jj0 - l * 12288;
                const int rsub = F.lane / 24, c4 = F.lane - rsub * 24;
                f32x4 a0 = {0.f, 0.f, 0.f, 0.f}, a1 = a0, a2 = a0, a3 = a0;
                if (F.lane < 48) {
                    const float* wp = ada_w + ((size_t)l * D) * 12288 + j0 + 4 * c4;
#pragma unroll 8
                    for (int it = 0; it < 128; ++it) { const int k = it * 16 + F.wave * 2 + rsub;
                        const f32x4 w4 = *(const f32x4*)(wp + (size_t)k * 12288);
                        a0 += w4 * cact[k]; a1 += w4 * cact[D + k]; a2 += w4 * cact[2 * D + k]; a3 += w4 * cact[3 * D + k]; }
                    LAS float* rp = red + (F.wave * 2 + rsub) * 384 + 4 * c4;
                    *(LAS f32x4*)(rp) = a0; *(LAS f32x4*)(rp + 96) = a1; *(LAS f32x4*)(rp + 192) = a2; *(LAS f32x4*)(rp + 288) = a3;
                }
                __syncthreads();
                if (F.tid < 384) { const int b = F.tid / 96, col = F.tid - b * 96; float s = ada_b[(size_t)l * 12288 + j0 + col];
#pragma unroll
                    for (int p = 0; p < 16; ++p) s += red[p * 384 + b * 96 + col];
                    MOD[((size_t)l * 4 + b) * 12288 + j0 + col] = s; }
                __syncthreads();
            }
        }
        {
            tr_job(F, hyb_w_in, 0, 1, HYB_IN, D, 0, 4096, WIN0, 0, D, 0, 0);
            tr_job(F, hyb_w_in, 0, 1, HYB_IN, D, 4112, 3072, WIN0, 0, D, 4096, 0);
            tr_job(F, hyb_w_in, 0, 1, HYB_IN, D, 4096, 16, WIN0, 0, D, 7168, 0);
            zero_fill(F, WIN0 + (size_t)7184 * D, (size_t)(NIN - 7184) * D * 2);
            tr_job(F, hyb_w_out, 0, 1, D, D, 0, D, WOUT0, 0, D, 0, 0);
            tr_job(F, mla_w_in, 0, 1, MLA_IN, D, 0, MLA_IN, WMIN, 0, D, 0, 0);
            zero_fill(F, WMIN + (size_t)MLA_IN * D, (size_t)(NMLA - MLA_IN) * D * 2);
            tr_job(F, mla_w_uq, 0, 1, 3072, 512, 0, 3072, WUQ, 0, 512, 0, 0);
            tr_job(F, mla_w_ukv, 0, 1, 4096, 512, 0, 4096, WUKV, 0, 512, 0, 0);
            tr_job(F, mla_w_out, 0, 1, D, D, 0, D, WMOUT, 0, D, 0, 0);
            tr_job(F, moe_router_g, (size_t)D * 8, 2, 8, D, 0, 8, WRT, (size_t)256 * D, D, 0, 0);
            tr_job(F, moe_router_e, (size_t)D * 64, 2, 64, D, 0, 64, WRT, (size_t)256 * D, D, 8, 0);
            zero_fill(F, WRT + (size_t)72 * D, (size_t)(256 - 72) * D * 2);
            zero_fill(F, WRT + (size_t)256 * D + (size_t)72 * D, (size_t)(256 - 72) * D * 2);
            tr_job(F, moe_w_gate, (size_t)D * FF, 128, FF, D, 0, FF, WGU, (size_t)1024 * D, D, 0, 1);
            tr_job(F, moe_w_up, (size_t)D * FF, 128, FF, D, 0, FF, WGU, (size_t)1024 * D, D, 128, 1);
            tr_job(F, moe_w_down, (size_t)FF * D, 128, D, FF, 0, D, WDN, (size_t)D * FF, FF, 0, 0);
        }
        for (int idx = blockIdx.x * 512 + F.tid; idx < T * 32; idx += F.G * 512) {
            const int t = idx >> 5, i = idx & 31;
            const double rev = (double)in_pos[t] * ROPE_INVF[i] * 0.15915494309189535;
            const float fr = (float)(rev - __builtin_rint(rev));
            ROPE_C[idx] = __builtin_amdgcn_cosf(fr); ROPE_S[idx] = __builtin_amdgcn_sinf(fr);
        }
    }
    SEAM(0);

    if (IN(1)) { PHASE_FRESH();
        for (int m = F.gw; m < T; m += F.NGW) {
            const int b = m / SEQ; const float* modb = MOD + (size_t)b * 12288;
            const f32x4* xr = (const f32x4*)(in_x + (size_t)m * D) + F.lane; u32x2* o = (u32x2*)(HIN + (size_t)m * D) + F.lane;
#pragma unroll
            for (int j = 0; j < 8; ++j) { const f32x4 v = xr[64 * j]; const f32x4 sh = ((const f32x4*)(modb))[F.lane + 64 * j], sc = ((const f32x4*)(modb + D))[F.lane + 64 * j];
                const f32x4 h = v * (sc + 1.0f) + sh; u32x2 w; w.x = cvtpk(h[0], h[1]); w.y = cvtpk(h[2], h[3]); o[64 * j] = w; }
        }
    }
    SEAM(1);

    if (IN(2)) { PHASE_FRESH();
        pg8::StaticOrder S; S.init(HIN, WIN0, T, NIN, D, F.G, (int)blockIdx.x);
        pg8::EpiInProj E{PB, PBA};
        pg8::gemm_phase<pg8::EpiInProj, pg8::StaticOrder>(F.lds, D, S, E, F.tid, F.wave);
    }
    SEAM(2);

    if (IN(3)) { PHASE_FRESH();
        constexpr int QS = 136;
        LAS float* MT = (LAS float*)(F.lds);
        LAS bf16* QKM = (LAS bf16*)(F.lds + 17408);
        LAS float* RAWK = (LAS float*)(F.lds);
        LAS float* VF = (LAS float*)(F.lds + 32768);
        LAS float* WL = (LAS float*)(F.lds + 65536);
        LAS bf16* QBl = (LAS bf16*)(F.lds + 98304);
        LAS bf16* KBl = (LAS bf16*)(F.lds + 115712);
        int zoff = 0; asm volatile("" : "+v"(zoff));
        LAS float* s_beta = (LAS float*)(F.lds + 133120 + zoff); LAS float* s_gc = s_beta + 64; LAS float* s_egc = s_beta + 128;
        for (int ch = blockIdx.x; ch < NCH; ch += F.G) {
            PHASE_FRESH();
            const int n = ch & 31, bh = ch >> 5, h = bh & 7, b = bh >> 3;
            const int tok0 = b * SEQ + n * CHK;
            if (F.tid < 384) {
                const int mat = F.tid >> 7, d = F.tid & 127, col = mat * 1024 + h * 128 + d;
                const float w0 = gdn_conv_w[col], w1 = gdn_conv_w[3072 + col], w2 = gdn_conv_w[2 * 3072 + col], w3 = gdn_conv_w[3 * 3072 + col];
                const bf16* pc = PB + (size_t)tok0 * NP + col;
                float xm3 = 0.f, xm2 = 0.f, xm1 = 0.f;
                if (n > 0) { xm3 = bf2f(pc[-3 * NP]); xm2 = bf2f(pc[-2 * NP]); xm1 = bf2f(pc[-NP]); }
                LAS float* dst = (mat == 0) ? WL : (mat == 1 ? RAWK : VF);
#pragma unroll 8
                for (int i = 0; i < 64; ++i) { const float xi = bf2f(pc[(size_t)i * NP]); const float y = w0 * xm3 + w1 * xm2 + w2 * xm1 + w3 * xi;
                    dst[i * 128 + d] = silu_f(y); xm3 = xm2; xm2 = xm1; xm1 = xi; }
            }
            if (F.wave == 7) {
                const int tok = tok0 + F.lane;
                const float br = PBA[(size_t)tok * 16 + h], ar = PBA[(size_t)tok * 16 + 8 + h];
                const float beta = 1.f / (1.f + __expf(-br));
                const float xsp = ar + gdn_dt_bias[h];
                const float sp = fmaxf(xsp, 0.f) + log1pf(__expf(-fabsf(xsp)));
                float g = -__expf(gdn_a_log[h]) * sp;
#pragma unroll
                for (int off = 1; off < 64; off <<= 1) { const float v = __shfl_up(g, off); if (F.lane >= off) g += v; }
                s_beta[F.lane] = beta; s_gc[F.lane] = g; s_egc[F.lane] = __expf(g);
            }
            __syncthreads();
#pragma unroll
            for (int rr = 0; rr < 8; ++rr) {
                const int i = F.wave * 8 + rr;
                const float qa = WL[i * 128 + F.lane], qb2 = WL[i * 128 + 64 + F.lane];
                const float ka = RAWK[i * 128 + F.lane], kb2 = RAWK[i * 128 + 64 + F.lane];
                const float rq = rsqrtf(wave_sum(qa * qa + qb2 * qb2) + 1e-6f) * 0.08838834764831845f;
                const float rk = rsqrtf(wave_sum(ka * ka + kb2 * kb2) + 1e-6f);
                QBl[i * QS + F.lane] = f2bf(qa * rq); QBl[i * QS + 64 + F.lane] = f2bf(qb2 * rq);
                KBl[i * QS + F.lane] = f2bf(ka * rk); KBl[i * QS + 64 + F.lane] = f2bf(kb2 * rk);
            }
            __syncthreads();
            {
                const int mat = F.wave >> 2, mi = (F.wave >> 1) & 1, ni = F.wave & 1, r = F.lane & 31, hh = F.lane >> 5;
                const LAS bf16* Am = (mat == 0) ? KBl : QBl;
                f32x16 acc;
#pragma unroll
                for (int i = 0; i < 16; ++i) acc[i] = 0.f;
#pragma unroll
                for (int ks = 0; ks < 8; ++ks) {
                    const bf16x8 a = *(const LAS bf16x8*)(Am + (32 * mi + r) * QS + 16 * ks + 8 * hh);
                    const bf16x8 bb = *(const LAS bf16x8*)(KBl + (32 * ni + r) * QS + 16 * ks + 8 * hh);
                    acc = MFMA32(a, bb, acc);
                }
                const int j = 32 * ni + r; const float gj = s_gc[j];
#pragma unroll
                for (int reg = 0; reg < 16; ++reg) {
                    const int i = 32 * mi + crow(reg, hh);
                    const float gi = s_gc[i];
                    const float dec = __expf(fminf(gi - gj, 0.f));
                    if (mat == 0) MT[j * 68 + i] = (i > j) ? s_beta[i] * acc[reg] * dec : 0.f;
                    else QKM[i * 64 + j] = f2bf((i >= j) ? acc[reg] * dec : 0.f);
                }
            }
            __syncthreads();
            if (F.tid < 256) {
                const int c = F.tid, dcol = c & 127;
                float X[64];
                if (c < 128) {
#pragma unroll
                    for (int i = 0; i < 64; ++i) X[i] = VF[i * 128 + dcol] * s_beta[i];
                } else {
#pragma unroll
                    for (int i = 0; i < 64; ++i) X[i] = bf2f(KBl[i * QS + dcol]) * s_beta[i] * s_egc[i];
                }
#pragma unroll
                for (int j = 0; j < 63; ++j) {
                    asm volatile("" ::: "memory");
                    const float xj = X[j];
#pragma unroll
                    for (int i4 = ((j + 1) & ~3); i4 < 64; i4 += 4) {
                        const f32x4 m4 = *(const LAS f32x4*)(MT + j * 68 + i4);
#pragma unroll
                        for (int q = 0; q < 4; ++q) if (i4 + q > j) X[i4 + q] -= m4[q] * xj;
                    }
                }
                LAS float* dst = (c < 128) ? VF : WL;
#pragma unroll
                for (int i = 0; i < 64; ++i) dst[i * 128 + dcol] = X[i];
            }
            __syncthreads();
            {
                const int r = F.lane & 31, hh = F.lane >> 5;
                const float gl = s_gc[63];
                unsigned char* gf = GF + (size_t)ch * 57344;
                for (int f = F.wave; f < 56; f += 8) {
                    float v[8];
                    if (f < 16) { const int mt = f >> 3, ks = f & 7; const LAS float* src = WL + (32 * mt + r) * 128 + 16 * ks + 4 * hh;
#pragma unroll
                        for (int j = 0; j < 8; ++j) v[j] = -src[8 * (j >> 2) + (j & 3)]; }
                    else if (f < 32) { const int f2 = f - 16, mt = f2 >> 3, ks = f2 & 7, i = 32 * mt + r; const float e = s_egc[i]; const LAS bf16* src = QBl + i * QS + 16 * ks + 4 * hh;
#pragma unroll
                        for (int j = 0; j < 8; ++j) v[j] = bf2f(src[8 * (j >> 2) + (j & 3)]) * e; }
                    else if (f < 40) { const int f2 = f - 32, mt = f2 >> 2, ks = f2 & 3; const LAS bf16* src = QKM + (32 * mt + r) * 64 + 16 * ks + 4 * hh;
#pragma unroll
                        for (int j = 0; j < 8; ++j) v[j] = bf2f(src[8 * (j >> 2) + (j & 3)]); }
                    else { const int f2 = f - 40, mt = f2 >> 2, ks = f2 & 3, dd = 32 * mt + r;
#pragma unroll
                        for (int j = 0; j < 8; ++j) { const int i = 16 * ks + 8 * (j >> 2) + 4 * hh + (j & 3); v[j] = bf2f(KBl[i * QS + dd]) * __expf(gl - s_gc[i]); } }
                    u32x4 o; o.x = cvtpk(v[0], v[1]); o.y = cvtpk(v[2], v[3]); o.z = cvtpk(v[4], v[5]); o.w = cvtpk(v[6], v[7]);
                    *(u32x4*)(gf + f * 1024 + F.lane * 16) = o;
                }
                { const int sl = F.wave >> 1, it = F.wave & 1, col = 32 * sl + r;
                  float* up = (float*)(GU + (size_t)ch * 32768 + (size_t)((sl * 2 + it) * 64 + F.lane) * 64);
#pragma unroll
                  for (int g4 = 0; g4 < 4; ++g4) { f32x4 t4;
#pragma unroll
                      for (int q = 0; q < 4; ++q) t4[q] = VF[(32 * it + crow(4 * g4 + q, hh)) * 128 + col];
                      *(f32x4*)(up + 4 * g4) = t4; } }
                if (F.tid == 0) EG[ch] = __expf(gl);
            }
            __syncthreads();
        }
    }
    SEAM(3);

    if (IN(4)) { PHASE_FRESH();
        for (int bh = blockIdx.x; bh < BATCH * GH; bh += F.G) {
            const int b = bh >> 3, hd = bh & 7, r = F.lane & 31, hh = F.lane >> 5, sl = F.wave;
            f32x16 S[4];
#pragma unroll
            for (int dt = 0; dt < 4; ++dt)
#pragma unroll
                for (int i = 0; i < 16; ++i) S[dt][i] = 0.f;
            f32x16 un[2];
            if (F.wave >= 4) {
                const int t4 = F.tid - 256; const unsigned char* g0 = GF + opaque_off((size_t)(bh * 32) * 57344 + (size_t)t4 * 16);
#pragma unroll
                for (int q = 0; q < 14; ++q) *(LAS u32x4*)(F.lds + (t4 + 256 * q) * 16) = *(const u32x4*)(g0 + (size_t)q * 4096);
            } else {
#pragma unroll
                for (int it = 0; it < 2; ++it) { const f32x4* up = (const f32x4*)(GU + opaque_off((size_t)(bh * 32) * 32768 + (size_t)((sl * 2 + it) * 64 + F.lane) * 64));
#pragma unroll
                    for (int g4 = 0; g4 < 4; ++g4) { const f32x4 t4 = up[g4]; un[it][4 * g4] = t4[0]; un[it][4 * g4 + 1] = t4[1]; un[it][4 * g4 + 2] = t4[2]; un[it][4 * g4 + 3] = t4[3]; } }
            }
            __syncthreads();
            for (int n = 0; n < NCHK; ++n) {
                const int ch = bh * 32 + n; const bool more = (n + 1 < NCHK);
                if (F.wave >= 4) {
                    if (more) {
                        const unsigned char* gn = GF + opaque_off((size_t)(ch + 1) * 57344 + (size_t)(F.tid - 256) * 16); LAS unsigned char* nb = F.lds + ((n + 1) & 1) * 57344; const int t4 = F.tid - 256;
#pragma unroll
                        for (int q = 0; q < 14; ++q) *(LAS u32x4*)(nb + (t4 + 256 * q) * 16) = *(const u32x4*)(gn + (size_t)q * 4096);
                    }
                } else {
                    const LAS unsigned char* buf = F.lds + (n & 1) * 57344 + F.lane * 16;
                    const float eg = EG[ch];
                    bf16x8 Sb[8];
#pragma unroll
                    for (int dt = 0; dt < 4; ++dt) { Sb[2 * dt] = pack_acc(S[dt], 0); Sb[2 * dt + 1] = pack_acc(S[dt], 1); }
                    f32x16 vn[2]; vn[0] = un[0]; vn[1] = un[1];
#pragma unroll
                    for (int it = 0; it < 2; ++it)
#pragma unroll
                        for (int ks = 0; ks < 8; ++ks) vn[it] = MFMA32(*(const LAS bf16x8*)(buf + (it * 8 + ks) * 1024), Sb[ks], vn[it]);
                    __builtin_amdgcn_sched_barrier(0);
                    f32x16 oa[2];
#pragma unroll
                    for (int it = 0; it < 2; ++it) {
#pragma unroll
                        for (int i = 0; i < 16; ++i) oa[it][i] = 0.f;
#pragma unroll
                        for (int ks = 0; ks < 8; ++ks) oa[it] = MFMA32(*(const LAS bf16x8*)(buf + (16 + it * 8 + ks) * 1024), Sb[ks], oa[it]);
                    }
                    __builtin_amdgcn_sched_barrier(0);
                    bf16x8 vb[4];
#pragma unroll
                    for (int it = 0; it < 2; ++it) { vb[2 * it] = pack_acc(vn[it], 0); vb[2 * it + 1] = pack_acc(vn[it], 1); }
                    __builtin_amdgcn_sched_barrier(0);
                    {
                        const int chn = more ? ch + 1 : ch;
#pragma unroll
                        for (int it = 0; it < 2; ++it) { const f32x4* up = (const f32x4*)(GU + opaque_off((size_t)chn * 32768 + (size_t)((sl * 2 + it) * 64 + F.lane) * 64));
#pragma unroll
                            for (int g4 = 0; g4 < 4; ++g4) { const f32x4 t4 = up[g4]; un[it][4 * g4] = t4[0]; un[it][4 * g4 + 1] = t4[1]; un[it][4 * g4 + 2] = t4[2]; un[it][4 * g4 + 3] = t4[3]; } }
                    }
                    __builtin_amdgcn_sched_barrier(0);
#pragma unroll
                    for (int it = 0; it < 2; ++it)
#pragma unroll
                        for (int ks = 0; ks < 4; ++ks) oa[it] = MFMA32(*(const LAS bf16x8*)(buf + (32 + it * 4 + ks) * 1024), vb[ks], oa[it]);
#pragma unroll
                    for (int it = 0; it < 2; ++it) {
#pragma unroll
                        for (int g4 = 0; g4 < 4; ++g4) { float* op = GO + opaque_off((size_t)(b * SEQ + n * CHK + 32 * it + 8 * g4 + 4 * hh) * 1024 + hd * 128 + sl * 32 + r);
#pragma unroll
                            for (int q = 0; q < 4; ++q) op[q * 1024] = oa[it][4 * g4 + q]; } }
                    __builtin_amdgcn_sched_barrier(0);
#pragma unroll
                    for (int dt = 0; dt < 4; ++dt) {
#pragma unroll
                        for (int i = 0; i < 16; ++i) S[dt][i] *= eg;
#pragma unroll
                        for (int ks = 0; ks < 4; ++ks) S[dt] = MFMA32(*(const LAS bf16x8*)(buf + (40 + dt * 4 + ks) * 1024), vb[ks], S[dt]);
                    }
                }
                LDS_WAIT(); __builtin_amdgcn_s_barrier(); asm volatile("" ::: "memory");
            }
            __syncthreads();
        }
    }
    SEAM(4);

    if (IN(5)) { PHASE_FRESH();
        for (int m = F.gw; m < T; m += F.NGW) {
            const int s = m & (SEQ - 1), c0 = F.lane * 16;
            const bf16* prow = PB + (size_t)m * NP;
            {
                const f32x4* op = (const f32x4*)(GO + (size_t)m * 1024 + c0);
                f32x4 o[4]; float ss = 0.f;
#pragma unroll
                for (int q = 0; q < 4; ++q) { o[q] = op[q]; ss += o[q][0] * o[q][0] + o[q][1] * o[q][1] + o[q][2] * o[q][2] + o[q][3] * o[q][3]; }
                ss += __shfl_xor(ss, 1); ss += __shfl_xor(ss, 2); ss += __shfl_xor(ss, 4);
                const float rms = rsqrtf(ss * (1.f / 128.f) + 1e-6f);
                const u32x4* zp = (const u32x4*)(prow + 3072 + c0); const u32x4 z0 = zp[0], z1 = zp[1];
                const unsigned zw[8] = {z0.x, z0.y, z0.z, z0.w, z1.x, z1.y, z1.z, z1.w};
                const f32x4* nwp = (const f32x4*)(gdn_norm_w + (c0 & 127));
                unsigned ow[8];
#pragma unroll
                for (int q = 0; q < 4; ++q) { const f32x4 nw = nwp[q];
                    const float y0 = o[q][0] * rms * nw[0] * silu_f(bflo(zw[2 * q])), y1 = o[q][1] * rms * nw[1] * silu_f(bfhi(zw[2 * q]));
                    const float y2 = o[q][2] * rms * nw[2] * silu_f(bflo(zw[2 * q + 1])), y3 = o[q][3] * rms * nw[3] * silu_f(bfhi(zw[2 * q + 1]));
                    ow[2 * q] = cvtpk(y0, y1); ow[2 * q + 1] = cvtpk(y2, y3); }
                u32x4* yp = (u32x4*)(YAB + (size_t)m * D + c0);
                yp[0] = (u32x4){ow[0], ow[1], ow[2], ow[3]}; yp[1] = (u32x4){ow[4], ow[5], ow[6], ow[7]};
            }
            {
                float accv[16];
#pragma unroll
                for (int q = 0; q < 16; ++q) accv[q] = 0.f;
#pragma unroll
                for (int j = 0; j < 3; ++j) {
                    if (s - 2 + j >= 0) {
                        const bf16* pr = prow + (ptrdiff_t)(j - 2) * NP;
                        const u32x4* cp = (const u32x4*)(pr + 5120 + c0); const u32x4* hp = (const u32x4*)(pr + 6144 + c0);
                        const u32x4 ca = cp[0], cb = cp[1], ha = hp[0], hb = hp[1];
                        const unsigned cw[8] = {ca.x, ca.y, ca.z, ca.w, cb.x, cb.y, cb.z, cb.w}, hw[8] = {ha.x, ha.y, ha.z, ha.w, hb.x, hb.y, hb.z, hb.w};
                        const f32x4* wp = (const f32x4*)(sc_conv_w + j * 1024 + c0);
#pragma unroll
                        for (int q = 0; q < 4; ++q) { const f32x4 w4 = wp[q];
                            accv[4 * q] += w4[0] * bflo(cw[2 * q]) * bflo(hw[2 * q]); accv[4 * q + 1] += w4[1] * bfhi(cw[2 * q]) * bfhi(hw[2 * q]);
                            accv[4 * q + 2] += w4[2] * bflo(cw[2 * q + 1]) * bflo(hw[2 * q + 1]); accv[4 * q + 3] += w4[3] * bfhi(cw[2 * q + 1]) * bfhi(hw[2 * q + 1]); }
                    }
                }
                const u32x4* bp = (const u32x4*)(prow + 4096 + c0); const u32x4 ba = bp[0], bb = bp[1];
                const unsigned bw[8] = {ba.x, ba.y, ba.z, ba.w, bb.x, bb.y, bb.z, bb.w};
                unsigned ow[8];
#pragma unroll
                for (int q = 0; q < 8; ++q) ow[q] = cvtpk(bflo(bw[q]) * accv[2 * q], bfhi(bw[q]) * accv[2 * q + 1]);
                u32x4* yp = (u32x4*)(YAB + (size_t)m * D + 1024 + c0);
                yp[0] = (u32x4){ow[0], ow[1], ow[2], ow[3]}; yp[1] = (u32x4){ow[4], ow[5], ow[6], ow[7]};
            }
        }
    }
    SEAM(5);

    if (IN(6)) { PHASE_FRESH();
        pg8::StaticOrder S; S.init(YAB, WOUT0, T, D, D, F.G, (int)blockIdx.x);
        pg8::EpiResid E{in_x, MOD + 2 * D, RB};
        pg8::gemm_phase<pg8::EpiResid, pg8::StaticOrder>(F.lds, D, S, E, F.tid, F.wave);
    }
    SEAM(6);

    if (IN(7)) { PHASE_FRESH();
        for (int m = F.gw; m < T; m += F.NGW) {
            const int b = m / SEQ; const float* modb = MOD + (size_t)b * 12288;
            f32x4 v[8];
#pragma unroll
            for (int j = 0; j < 8; ++j) v[j] = ((const f32x4*)(RB + (size_t)m * D))[F.lane + 64 * j];
            LN_ROW(v, ln_g, ln_b);
            bf16* hrow = HIN + (size_t)m * D;
            WRITE_X_HIN(v, XA + (size_t)m * D, hrow, modb + 3 * D, modb + 4 * D);
        }
    }
    SEAM(7);

    moe_phases<0>(F, args, bar, lo, hi, TAB);

        if (IN(14)) { PHASE_FRESH();
            pg8::StaticOrder S; S.init(HIN, WMIN, T, NMLA, D, F.G, (int)blockIdx.x);
            pg8::EpiF32 E{C1, NMLA};
            pg8::gemm_phase<pg8::EpiF32, pg8::StaticOrder>(F.lds, D, S, E, F.tid, F.wave);
        }
        SEAM(14);
        if (IN(15)) { PHASE_FRESH();
            for (int m = F.gw; m < T; m += F.NGW) {
                const float* c1 = C1 + (size_t)m * NMLA;
#pragma unroll
                for (int part = 0; part < 2; ++part) {
                    const f32x4* p = (const f32x4*)(c1 + part * 512 + 8 * F.lane); const f32x4 a0 = p[0], a1 = p[1];
                    const float ss = wave_sum((a0[0] * a0[0] + a0[1] * a0[1]) + (a0[2] * a0[2] + a0[3] * a0[3]) + (a1[0] * a1[0] + a1[1] * a1[1]) + (a1[2] * a1[2] + a1[3] * a1[3]));
                    const float rn = rsqrtf(ss * (1.f / 512.f) + 1e-6f);
                    const f32x4* wp = (const f32x4*)((part == 0 ? mla_q_norm : mla_kv_norm) + 8 * F.lane); const f32x4 w0 = wp[0], w1 = wp[1];
                    u32x4 o; o.x = cvtpk(a0[0] * rn * w0[0], a0[1] * rn * w0[1]); o.y = cvtpk(a0[2] * rn * w0[2], a0[3] * rn * w0[3]);
                    o.z = cvtpk(a1[0] * rn * w1[0], a1[1] * rn * w1[1]); o.w = cvtpk(a1[2] * rn * w1[2], a1[3] * rn * w1[3]);
                    *(u32x4*)((part == 0 ? CQN : CKVN) + (size_t)m * 512 + 8 * F.lane) = o;
                }
                if (F.lane < 32) { const float x1 = c1[1024 + F.lane], x2 = c1[1056 + F.lane], cs = ROPE_C[(size_t)m * 32 + F.lane], sn = ROPE_S[(size_t)m * 32 + F.lane];
                    KPE[(size_t)m * 64 + F.lane] = x1 * cs - x2 * sn; KPE[(size_t)m * 64 + 32 + F.lane] = x1 * sn + x2 * cs; }
            }
        }
        SEAM(15);
        if (IN(16)) { PHASE_FRESH();
            { pg8::StaticOrder S; S.init(CQN, WUQ, T, 3072, 512, F.G, (int)blockIdx.x); pg8::EpiQup E{QB_};
              pg8::gemm_phase<pg8::EpiQup, pg8::StaticOrder>(F.lds, 512, S, E, F.tid, F.wave); }
            { pg8::StaticOrder S; S.init(CKVN, WUKV, T, 4096, 512, F.G, (int)blockIdx.x); pg8::EpiKVup E{KB_, VB_};
              pg8::gemm_phase<pg8::EpiKVup, pg8::StaticOrder>(F.lds, 512, S, E, F.tid, F.wave); }
        }
        SEAM(16);
        if (IN(17)) { PHASE_FRESH();
            for (int m = F.gw; m < T; m += F.NGW) {
                const int b = m / SEQ, s = m - b * SEQ, hd = F.lane >> 2, i0 = (F.lane & 3) * 8;
                const size_t rowoff = ((size_t)((b * MH + hd) * SEQ + s)) * QD + 128;
                bf16* qp = QB_ + rowoff;
                const u32x4 xa = *(const u32x4*)(qp + i0), xb = *(const u32x4*)(qp + 32 + i0);
                const f32x4* cp = (const f32x4*)(ROPE_C + (size_t)m * 32 + i0); const f32x4* sp = (const f32x4*)(ROPE_S + (size_t)m * 32 + i0);
                const f32x4 c0 = cp[0], c1v = cp[1], s0 = sp[0], s1 = sp[1];
                const float cs[8] = {c0[0], c0[1], c0[2], c0[3], c1v[0], c1v[1], c1v[2], c1v[3]}, sn[8] = {s0[0], s0[1], s0[2], s0[3], s1[0], s1[1], s1[2], s1[3]};
                const unsigned xaw[4] = {xa.x, xa.y, xa.z, xa.w}, xbw[4] = {xb.x, xb.y, xb.z, xb.w};
                unsigned o1[4], o2[4];
#pragma unroll
                for (int q = 0; q < 4; ++q) { const float a0 = bflo(xaw[q]), a1 = bfhi(xaw[q]), b0 = bflo(xbw[q]), b1 = bfhi(xbw[q]);
                    o1[q] = cvtpk(a0 * cs[2 * q] - b0 * sn[2 * q], a1 * cs[2 * q + 1] - b1 * sn[2 * q + 1]);
                    o2[q] = cvtpk(a0 * sn[2 * q] + b0 * cs[2 * q], a1 * sn[2 * q + 1] + b1 * cs[2 * q + 1]); }
                *(u32x4*)(qp + i0) = (u32x4){o1[0], o1[1], o1[2], o1[3]}; *(u32x4*)(qp + 32 + i0) = (u32x4){o2[0], o2[1], o2[2], o2[3]};
                const f32x4* kp = (const f32x4*)(KPE + (size_t)m * 64 + i0); const f32x4* kp2 = (const f32x4*)(KPE + (size_t)m * 64 + 32 + i0);
                const f32x4 k0 = kp[0], k1 = kp[1], k2 = kp2[0], k3 = kp2[1];
                bf16* kd = KB_ + rowoff;
                *(u32x4*)(kd + i0) = (u32x4){cvtpk(k0[0], k0[1]), cvtpk(k0[2], k0[3]), cvtpk(k1[0], k1[1]), cvtpk(k1[2], k1[3])};
                *(u32x4*)(kd + 32 + i0) = (u32x4){cvtpk(k2[0], k2[1]), cvtpk(k2[2], k2[3]), cvtpk(k3[0], k3[1]), cvtpk(k3[2], k3[3])};
            }
            {
                LAS bf16* scr = (LAS bf16*)(F.lds + F.wave * 17408);
                for (int it = F.gw; it < 64 * 32; it += F.NGW) {
                    const int bhh = it >> 5, sb = it & 31, b = bhh >> 4, hd = bhh & 15, s0 = sb * 64;
#pragma unroll 4
                    for (int i = 0; i < 16; ++i) { const int row = 4 * i + (F.lane >> 4), c8 = (F.lane & 15) * 8;
                        *(LAS u32x4*)(scr + row * 136 + c8) = *(const u32x4*)(VB_ + (size_t)(b * SEQ + s0 + row) * D + hd * 128 + c8); }
                    LDS_WAIT(); asm volatile("" ::: "memory");
                    bf16* dst = VT + ((size_t)bhh * 128) * SEQ + s0 + F.lane;
#pragma unroll 8
                    for (int dv = 0; dv < 128; ++dv) dst[(size_t)dv * SEQ] = scr[F.lane * 136 + dv];
                    LDS_WAIT(); asm volatile("" ::: "memory");
                }
            }
        }
        SEAM(17);
        if (IN(18)) { PHASE_FRESH();
            constexpr int KBUF = 64 * 400, VBUF = 128 * 136;
            LAS unsigned char* KL = F.lds; LAS unsigned char* VL = F.lds + 2 * KBUF;
            const int w = F.wave;
            for (int pi = blockIdx.x; pi < 256; pi += F.G) {
                const int bhh = pi >> 2, pp = pi & 3, b = bhh >> 4, hd = bhh & 15;
                const char* kg = (const char*)(KB_ + (size_t)bhh * SEQ * QD); const char* vg = (const char*)(VT + (size_t)bhh * 128 * SEQ);
                for (int half = 0; half < 2; ++half) {
                    PHASE_FRESH(); const int r = F.lane & 31, hh = F.lane >> 5;
                    const int qb = half == 0 ? 7 - pp : pp, q0 = qb * 256, ntile = 4 * (qb + 1), qrow = q0 + 32 * w + r;
                    bf16x8 qf[12];
                    { const bf16* qp = QB_ + ((size_t)bhh * SEQ + qrow) * QD + 8 * hh;
#pragma unroll
                      for (int ks = 0; ks < 12; ++ks) qf[ks] = *(const bf16x8*)(qp + 16 * ks); }
                    f32x16 oT[4];
#pragma unroll
                    for (int mt = 0; mt < 4; ++mt)
#pragma unroll
                        for (int i = 0; i < 16; ++i) oT[mt][i] = 0.f;
                    float mrun = -1e30f, lsum = 0.f;
                    u32x4 kst[3], vst[2];
#pragma unroll
                    for (int q = 0; q < 3; ++q) kst[q] = *(const u32x4*)(kg + (size_t)(F.tid + 512 * q) * 16);
#pragma unroll
                    for (int q = 0; q < 2; ++q) { const int p = F.tid + 512 * q; vst[q] = *(const u32x4*)(vg + (size_t)(p >> 3) * (SEQ * 2) + (p & 7) * 16); }
#pragma unroll
                    for (int q = 0; q < 3; ++q) { const int p = F.tid + 512 * q; *(LAS u32x4*)(KL + (p / 24) * 400 + (p % 24) * 16) = kst[q]; }
#pragma unroll
                    for (int q = 0; q < 2; ++q) { const int p = F.tid + 512 * q; LAS unsigned char* d = VL + (p >> 3) * 136 + (p & 7) * 16;
                        *(LAS u32x2*)d = (u32x2){vst[q].x, vst[q].y}; *(LAS u32x2*)(d + 8) = (u32x2){vst[q].z, vst[q].w}; }
                    __syncthreads();
                    for (int kt = 0; kt < ntile; ++kt) {
                        const bool more = (kt + 1 < ntile); const int k0 = kt * 64;
                        if (more) {
                            const int k1 = k0 + 64;
#pragma unroll
                            for (int q = 0; q < 3; ++q) kst[q] = *(const u32x4*)(kg + (size_t)k1 * (QD * 2) + (size_t)(F.tid + 512 * q) * 16);
#pragma unroll
                            for (int q = 0; q < 2; ++q) { const int p = F.tid + 512 * q; vst[q] = *(const u32x4*)(vg + (size_t)(p >> 3) * (SEQ * 2) + (size_t)k1 * 2 + (p & 7) * 16); }
                        }
                        if (k0 <= q0 + 32 * w + 31) {
                            const LAS unsigned char* kb = KL + (kt & 1) * KBUF; const LAS unsigned char* vb_ = VL + (kt & 1) * VBUF;
                            f32x16 sT[2];
#pragma unroll
                            for (int kk = 0; kk < 2; ++kk) {
#pragma unroll
                                for (int i = 0; i < 16; ++i) sT[kk][i] = 0.f;
#pragma unroll
                                for (int ks = 0; ks < 12; ++ks) sT[kk] = MFMA32(*(const LAS bf16x8*)(kb + (32 * kk + r) * 400 + (16 * ks + 8 * hh) * 2), qf[ks], sT[kk]);
                            }
                            if (k0 + 63 > q0 + 32 * w) {
#pragma unroll
                                for (int kk = 0; kk < 2; ++kk)
#pragma unroll
                                    for (int reg = 0; reg < 16; ++reg) { const int key = k0 + 32 * kk + crow(reg, hh); if (key > qrow) sT[kk][reg] = -1e30f; }
                            }
                            float mloc = sT[0][0];
#pragma unroll
                            for (int kk = 0; kk < 2; ++kk)
#pragma unroll
                                for (int reg = 0; reg < 16; ++reg) mloc = fmaxf(mloc, sT[kk][reg]);
                            mloc = fmaxf(mloc, __shfl_xor(mloc, 32));
                            const float mnew = fmaxf(mrun, mloc), alpha = __builtin_amdgcn_exp2f(mrun - mnew);
                            float ps = 0.f;
#pragma unroll
                            for (int kk = 0; kk < 2; ++kk)
#pragma unroll
                                for (int reg = 0; reg < 16; ++reg) { const float pe = __builtin_amdgcn_exp2f(sT[kk][reg] - mnew); sT[kk][reg] = pe; ps += pe; }
                            lsum = lsum * alpha + ps; mrun = mnew;
#pragma unroll
                            for (int mt = 0; mt < 4; ++mt)
#pragma unroll
                                for (int i = 0; i < 16; ++i) oT[mt][i] *= alpha;
                            bf16x8 pb[4];
#pragma unroll
                            for (int kk = 0; kk < 2; ++kk) { pb[2 * kk] = pack_acc(sT[kk], 0); pb[2 * kk + 1] = pack_acc(sT[kk], 1); }
#pragma unroll
                            for (int mt = 0; mt < 4; ++mt)
#pragma unroll
                                for (int ks = 0; ks < 4; ++ks) { const LAS unsigned char* vp = vb_ + (32 * mt + r) * 136 + (16 * ks + 4 * hh) * 2;
                                    const u32x2 vlo = *(const LAS u32x2*)vp, vhi = *(const LAS u32x2*)(vp + 16);
                                    const u32x4 va = {vlo.x, vlo.y, vhi.x, vhi.y};
                                    oT[mt] = MFMA32(__builtin_bit_cast(bf16x8, va), pb[ks], oT[mt]); }
                        }
                        if (more) {
                            LAS unsigned char* kn = KL + ((kt + 1) & 1) * KBUF; LAS unsigned char* vn_ = VL + ((kt + 1) & 1) * VBUF;
#pragma unroll
                            for (int q = 0; q < 3; ++q) { const int p = F.tid + 512 * q; *(LAS u32x4*)(kn + (p / 24) * 400 + (p % 24) * 16) = kst[q]; }
#pragma unroll
                            for (int q = 0; q < 2; ++q) { const int p = F.tid + 512 * q; LAS unsigned char* d = vn_ + (p >> 3) * 136 + (p & 7) * 16;
                                *(LAS u32x2*)d = (u32x2){vst[q].x, vst[q].y}; *(LAS u32x2*)(d + 8) = (u32x2){vst[q].z, vst[q].w}; }
                        }
                        __syncthreads();
                    }
                    const float ltot = lsum + __shfl_xor(lsum, 32), inv = 1.f / ltot;
                    bf16* orow = YAB + (size_t)(b * SEQ + qrow) * D + hd * 128 + 4 * hh;
#pragma unroll
                    for (int mt = 0; mt < 4; ++mt)
#pragma unroll
                        for (int g4 = 0; g4 < 4; ++g4) { u32x2 o; o.x = cvtpk(oT[mt][4 * g4] * inv, oT[mt][4 * g4 + 1] * inv); o.y = cvtpk(oT[mt][4 * g4 + 2] * inv, oT[mt][4 * g4 + 3] * inv);
                            *(u32x2*)(orow + 32 * mt + 8 * g4) = o; }
                }
            }
        }
        SEAM(18);
        if (IN(19)) { PHASE_FRESH();
            pg8::StaticOrder S; S.init(YAB, WMOUT, T, D, D, F.G, (int)blockIdx.x);
            pg8::EpiResid E{XB, MOD + (size_t)4 * 12288 + 2 * D, RB};
            pg8::gemm_phase<pg8::EpiResid, pg8::StaticOrder>(F.lds, D, S, E, F.tid, F.wave);
        }
        SEAM(19);
        if (IN(20)) { PHASE_FRESH();
            for (int m = F.gw; m < T; m += F.NGW) {
                const int b = m / SEQ; const float* modb = MOD + (size_t)(4 + b) * 12288;
                f32x4 v[8];
#pragma unroll
                for (int j = 0; j < 8; ++j) v[j] = ((const f32x4*)(RB + (size_t)m * D))[F.lane + 64 * j];
                LN_ROW(v, ln_g + 2 * D, ln_b + 2 * D);
                bf16* hrow = HIN + (size_t)m * D;
                WRITE_X_HIN(v, XA + (size_t)m * D, hrow, modb + 3 * D, modb + 4 * D);
            }
        }
        SEAM(20);

    moe_phases<1>(F, args, bar, lo, hi, TAB);
#undef IN
#undef INL
#undef SEAM
#undef WSB
#undef in_x
#undef in_c
#undef in_pos
#undef ada_w
#undef ada_b
#undef ln_g
#undef ln_b
#undef hyb_w_in
#undef gdn_conv_w
#undef gdn_a_log
#undef gdn_dt_bias
#undef gdn_norm_w
#undef sc_conv_w
#undef hyb_w_out
#undef mla_w_in
#undef mla_q_norm
#undef mla_kv_norm
#undef mla_w_uq
#undef mla_w_ukv
#undef mla_w_out
#undef moe_router_g
#undef moe_bias_g
#undef moe_router_e
#undef moe_bias_e
#undef moe_w_gate
#undef moe_w_up
#undef moe_w_down
#undef MOD
#undef ROPE_C
#undef ROPE_S
#undef PBA
#undef LOGITS
#undef TOK_E
#undef TOK_POS
#undef TOK_GATE
#undef EG
#undef WIN0
#undef WOUT0
#undef WMIN
#undef WUQ
#undef WUKV
#undef WMOUT
#undef WRT
#undef WGU
#undef WDN
#undef HIN
#undef XA
#undef XB
#undef RB
#undef PB
#undef GF
#undef GU
#undef GO
#undef YAB
#undef XS
#undef HID
#undef YS
#undef C1
#undef CQN
#undef CKVN
#undef KPE
#undef QB_
#undef KB_
#undef VB_
#undef VT
}

extern "C" void kernel_launch(void* const* d_in, const int* in_sizes, int n_in, void* d_out, int out_size, void* d_ws, size_t ws_size, hipStream_t stream) {
    static int grid = 0;
    if (grid == 0) {
        if (n_in != 27 || in_sizes[0] != T * D || out_size != T * D || ws_size < WS_END) { fprintf(stderr, "kernel_launch: unexpected problem (n_in %d, in0 %d, out %d, ws %zu)\n", n_in, n_in > 0 ? in_sizes[0] : -1, out_size, ws_size); grid = -1; return; }
        int dev = 0, cus = 0, per_cu = 0;
        if (hipGetDevice(&dev) != hipSuccess || hipDeviceGetAttribute(&cus, hipDeviceAttributeMultiprocessorCount, dev) != hipSuccess) { grid = -1; return; }
        if (hipFuncSetAttribute((const void*)mega, hipFuncAttributeMaxDynamicSharedMemorySize, LDS_BYTES) != hipSuccess) { fprintf(stderr, "kernel_launch: hipFuncSetAttribute failed\n"); grid = -1; return; }
        if (hipOccupancyMaxActiveBlocksPerMultiprocessor(&per_cu, (const void*)mega, 512, LDS_BYTES) != hipSuccess || per_cu < 1) fprintf(stderr, "kernel_launch: occupancy query reports %d\n", per_cu);
        (void)hipGetLastError();
        grid = cus;
    }
    if (grid < 0) return;
    (void)hipMemsetAsync((char*)d_ws + WS_CTL, 0, CTL_ZERO_BYTES, stream);
    Args a{};
    for (int i = 0; i < 27; ++i) a.in[i] = d_in[i];
    a.out = (float*)d_out; a.ws = (unsigned char*)d_ws;
#if MK_ONE_LAUNCH
    a.ph_lo = 0; a.ph_hi = NPH;
    hipLaunchKernelGGL(mega, dim3(grid), dim3(512), LDS_BYTES, stream, a);
#else
    for (int k = 0; k < NPH; ++k) { a.ph_lo = k; a.ph_hi = k + 1; hipLaunchKernelGGL(mega, dim3(grid), dim3(512), LDS_BYTES, stream, a); }
#endif
}
```

```cpp
#include <hip/hip_runtime.h>
#include <cstdio>
#include <cstdint>

#ifndef MK_ONE_LAUNCH
#define MK_ONE_LAUNCH 1
#endif

#define DI __device__ __forceinline__
#define GAS __attribute__((address_space(1)))
#define LAS __attribute__((address_space(3)))
typedef unsigned short bf16;
typedef float f32x4 __attribute__((ext_vector_type(4)));
typedef float f32x2 __attribute__((ext_vector_type(2)));
typedef float f32x16 __attribute__((ext_vector_type(16)));
typedef short bf16x8 __attribute__((ext_vector_type(8)));
typedef short s16x4 __attribute__((ext_vector_type(4)));
typedef unsigned u32x4 __attribute__((ext_vector_type(4)));
typedef unsigned u32x2 __attribute__((ext_vector_type(2)));
typedef __bf16 bf16x2_t __attribute__((ext_vector_type(2)));
typedef GAS unsigned gu32;
#define RLX_AGENT __ATOMIC_RELAXED, __HIP_MEMORY_SCOPE_AGENT
#define LDS_WAIT() asm volatile("s_waitcnt lgkmcnt(0)" ::: "memory")
#define VM_WAIT() asm volatile("s_waitcnt vmcnt(0)" ::: "memory")
#define MFMA32(a, b, c) __builtin_amdgcn_mfma_f32_32x32x16_bf16((a), (b), (c), 0, 0, 0)

DI unsigned cvtpk(float lo, float hi) { f32x2 v = {lo, hi}; bf16x2_t b = __builtin_convertvector(v, bf16x2_t); return __builtin_bit_cast(unsigned, b); }
DI bf16 f2bf(float f) { return (bf16)(cvtpk(f, 0.f) & 0xffffu); }
DI float bf2f(bf16 b) { return __uint_as_float(((unsigned)b) << 16); }
DI float bflo(unsigned w) { return __uint_as_float(w << 16); }
DI float bfhi(unsigned w) { return __uint_as_float(w & 0xffff0000u); }
DI int crow(int reg, int h) { return (reg & 3) + 8 * (reg >> 2) + 4 * h; }
DI int kperm(int j, int h) { return 8 * (j >> 2) + 4 * h + (j & 3); }
DI float wave_sum(float v) {
#pragma unroll
    for (int o = 1; o < 64; o <<= 1) v += __shfl_xor(v, o);
    return v;
}
DI bf16x8 pack_acc(const f32x16& x, int s) {
    u32x4 p; p.x = cvtpk(x[8 * s + 0], x[8 * s + 1]); p.y = cvtpk(x[8 * s + 2], x[8 * s + 3]); p.z = cvtpk(x[8 * s + 4], x[8 * s + 5]); p.w = cvtpk(x[8 * s + 6], x[8 * s + 7]);
    return __builtin_bit_cast(bf16x8, p);
}
DI float silu_f(float x) { return x / (1.f + __expf(-x)); }
DI size_t opaque_off(size_t o) { asm volatile("" : "+v"(o)); return o; }

constexpr int D = 2048, BATCH = 4, SEQ = 2048, T = BATCH * SEQ;
constexpr int GH = 8, GD = 128, NCHK = 32, CHK = 64, NCH = BATCH * GH * NCHK;
constexpr int HYB_IN = 7184, NIN = 7424, NP = 7168;
constexpr int MH = 16, MLA_IN = 1088, NMLA = 1280, QD = 192;
constexpr int NE = 64, FF = 512, MAXBLK = 128;
constexpr float DN_ALPHA = 1.41421356237f;
constexpr float QSCALE = 0.10411754627697264f;
constexpr int NPH = 27;

constexpr size_t MiB = 1u << 20;
constexpr size_t WS_CTL = 0, CTL_ZERO_BYTES = 1 * MiB;
constexpr size_t WS_MOD = 1 * MiB;
constexpr size_t WS_ROPE = 2 * MiB;
constexpr size_t WS_PBA = 4 * MiB;
constexpr size_t WS_LOGITS = 5 * MiB;
constexpr size_t WS_ROUTE = 9 * MiB;
constexpr size_t WS_EG = 10 * MiB;
constexpr size_t WS_WIN0 = 16 * MiB;
constexpr size_t WS_WOUT0 = 46 * MiB;
constexpr size_t WS_WMIN = 54 * MiB;
constexpr size_t WS_WUQ = 59 * MiB;
constexpr size_t WS_WUKV = 62 * MiB;
constexpr size_t WS_WMOUT = 66 * MiB;
constexpr size_t WS_WRT = 74 * MiB;
constexpr size_t WS_WGU = 80 * MiB;
constexpr size_t WS_WDN = 592 * MiB;
constexpr size_t WS_HIN = 848 * MiB;
constexpr size_t WS_XA = 880 * MiB;
constexpr size_t WS_XB = 944 * MiB;
constexpr size_t WS_R = 1008 * MiB;
constexpr size_t WS_P = 1072 * MiB;
constexpr size_t WS_GF = 1184 * MiB;
constexpr size_t WS_GU = 1240 * MiB;
constexpr size_t WS_GO = 1272 * MiB;
constexpr size_t WS_YAB = 1304 * MiB;
constexpr size_t WS_XS = 1336 * MiB;
constexpr size_t WS_HID = 1464 * MiB;
constexpr size_t WS_YS = 1496 * MiB;
constexpr size_t WS_C1 = 1624 * MiB;
constexpr size_t WS_CQN = 1664 * MiB;
constexpr size_t WS_CKVN = 1672 * MiB;
constexpr size_t WS_KPE = 1680 * MiB;
constexpr size_t WS_Q = 1684 * MiB;
constexpr size_t WS_K = 1732 * MiB;
constexpr size_t WS_V = 1780 * MiB;
constexpr size_t WS_VT = 1812 * MiB;
constexpr size_t WS_END = 1844 * MiB;
constexpr int CW_BAR = 4096;
constexpr int CW_CNT = 8192;
constexpr int CW_BLK = 8448;

constexpr int RING_BYTES = 131072;
constexpr int LDSCTL_OFF = 143360, MISC_OFF = LDSCTL_OFF + 320;
constexpr int TAB_OFF = LDSCTL_OFF + 512;
constexpr int SC_OFF = LDSCTL_OFF + 1536;
constexpr int LDS_BYTES = 147456;

namespace pg8 {
constexpr int BM = 256, BK = 64, HALF = 128, HTB = HALF * BK * 2, STAGE_BYTES = 8 * HTB, NXCD = 8, WGM = 8;
__host__ __device__ __forceinline__ int lds_byte(int r, int c) { const int st = (r >> 4) * 2 + (c >> 5), rr = r & 15, cc = c & 31, ob = rr * 64 + cc * 2; return st * 1024 + (ob ^ (((ob >> 9) & 1) << 5)); }
__host__ __device__ __forceinline__ void stage_rc(int b, int& R, int& C) { const int st = b / 1024, sb = b % 1024, swz = sb ^ (((sb >> 9) & 1) << 5); R = (st >> 1) * 16 + swz / 64; C = (st & 1) * 32 + (swz % 64) / 2; }
__host__ __device__ __forceinline__ int perm32(int rho) { const int n = rho >> 4, i = rho & 15; return 8 * (i >> 2) + 4 * n + (i & 3); }

struct Unit { int pm, pn, ex, rows; };

struct StaticOrder {
    int nM, nN, nwg, G, c; const char* A; const char* Bt; size_t tstep;
    __device__ void init(const bf16* A_, const bf16* Bt_, int M, int N, int K, int G_, int c_) { nM = M / BM; nN = N / BM; nwg = nM * nN; G = G_; c = c_; A = (const char*)A_; Bt = (const char*)Bt_; tstep = (size_t)BM * K * 2; }
    __device__ bool next(int i, Unit& u) const {
        const long L = (long)i * G + c; if (L >= nwg) return false;
        int wgid = (int)L; { const int q = nwg / NXCD, r = nwg % NXCD, xcd = wgid % NXCD, off = wgid / NXCD; wgid = (xcd < r ? xcd * (q + 1) : r * (q + 1) + (xcd - r) * q) + off; }
        const int nig = WGM * nN, gid = wgid / nig, fm = gid * WGM, gsz = (nM - fm) < WGM ? (nM - fm) : WGM;
        u.pm = fm + ((wgid % nig) % gsz); u.pn = (wgid % nig) / gsz; u.ex = 0; u.rows = 256; return true;
    }
    __device__ __forceinline__ const char* aptr(const Unit& u) const { return A + (size_t)u.pm * tstep; }
    __device__ __forceinline__ const char* bptr(const Unit& u) const { return Bt + (size_t)u.pn * tstep; }
};
struct MoeOrder {
    int nunits, NT, G, c; const LAS int* blk_e; const char* A; const char* W; size_t a_tstep, w_estride, w_tstep;
    __device__ bool next(int i, Unit& u) const {
        const long L = (long)i * G + c; if (L >= nunits) return false;
        u.pm = (int)L / NT; u.pn = (int)L % NT; u.ex = blk_e[u.pm]; u.rows = 256; return true;
    }
    __device__ __forceinline__ const char* aptr(const Unit& u) const { return A + (size_t)u.pm * a_tstep; }
    __device__ __forceinline__ const char* bptr(const Unit& u) const { return W + (size_t)u.ex * w_estride + (size_t)u.pn * w_tstep; }
};

template <class Epi, class Sched, bool ALIGN_EPI = true, bool SP2 = true>
__device__ __forceinline__ void gemm_phase(LAS unsigned char* lds, const int K_, const Sched& S, const Epi& E, const int tid, const int wid) {
    const int lane = tid & 63, wr = wid >> 2, wc = wid & 3, fr = lane & 15, fq = lane >> 4;
    int K = K_; asm volatile("" : "+s"(K));
    const int nt = K / BK;
    unsigned voffA[2], voffB[2];
#pragma unroll
    for (int i = 0; i < 2; ++i) { int R, C; stage_rc(tid * 16 + i * 8192, R, C); const int Rb = Epi::PERM ? ((R & ~31) + perm32(R & 31)) : R;
        voffA[i] = (unsigned)(R * K + C) * 2u; voffB[i] = (unsigned)(Rb * K + C) * 2u; }
    const size_t kstep = (size_t)(BK * 2);
    const size_t hstep = (size_t)HALF * K * 2;
    const unsigned ldsw = (unsigned)wid * 1024u;
    const int aoff = lds_byte(wr * 64 + fr, fq * 8), boff = lds_byte(wc * 32 + fr, fq * 8);
#define PG8_SA(b, h) (((b) * 2 + (h)) * HTB)
#define PG8_SB(b, h) ((4 + (b) * 2 + (h)) * HTB)
#define PG8_STAGE(bufoff, gbase, voff) do { _Pragma("unroll") for (int _i = 0; _i < 2; ++_i) \
        __builtin_amdgcn_global_load_lds((const unsigned*)((const char*)(gbase) + (voff)[_i]), (LAS unsigned*)(lds + (bufoff) + ldsw + _i * 8192), 16, 0, 0); } while (0)
#define PG8_LDA(dst, b, h) do { _Pragma("unroll") for (int m = 0; m < 4; ++m) _Pragma("unroll") for (int k = 0; k < 2; ++k) dst[m][k] = *(const LAS bf16x8*)(lds + PG8_SA(b, h) + aoff + m * 2048 + k * 1024); } while (0)
#define PG8_LDB(dst, b, h) do { _Pragma("unroll") for (int n = 0; n < 2; ++n) _Pragma("unroll") for (int k = 0; k < 2; ++k) dst[n][k] = *(const LAS bf16x8*)(lds + PG8_SB(b, h) + boff + n * 2048 + k * 1024); } while (0)
#define PG8_MMA(ai, bj, At, Bt) do { __builtin_amdgcn_s_setprio(1); _Pragma("unroll") for (int m = 0; m < 4; ++m) _Pragma("unroll") for (int n = 0; n < 2; ++n) _Pragma("unroll") for (int k = 0; k < 2; ++k) \
        acc[ai][bj][m][n] = __builtin_amdgcn_mfma_f32_16x16x32_bf16(Bt[n][k], At[m][k], acc[ai][bj][m][n], 0, 0, 0); __builtin_amdgcn_s_setprio(0); } while (0)
#define PG8_WAIT_V(n) asm volatile("s_waitcnt vmcnt(" #n ")" ::: "memory")
#define PG8_WAIT_L(n) asm volatile("s_waitcnt lgkmcnt(" #n ")" ::: "memory")
#define PG8_BAR __builtin_amdgcn_s_barrier()
#define PG8_SCHED __builtin_amdgcn_sched_barrier(0)
    Unit cur, nxt; int ui = 0;
    if (!S.next(0, cur)) return;
    f32x4 acc[2][2][4][2];
#pragma unroll
    for (int a = 0; a < 2; ++a)
#pragma unroll
        for (int b = 0; b < 2; ++b)
#pragma unroll
            for (int m = 0; m < 4; ++m)
#pragma unroll
                for (int n = 0; n < 2; ++n) acc[a][b][m][n] = (f32x4){0.f, 0.f, 0.f, 0.f};
    bf16x8 At[4][2], B0[2][2], B1[2][2];
    const char* cA = S.aptr(cur); const char* cB = S.bptr(cur);
    if constexpr (SP2) {
        PG8_STAGE(PG8_SB(0, 0), cB, voffB); PG8_STAGE(PG8_SB(0, 1), cB + hstep, voffB); PG8_STAGE(PG8_SA(0, 0), cA, voffA); PG8_STAGE(PG8_SA(0, 1), cA + hstep, voffA);
        if (wr == 1) PG8_BAR;
        PG8_WAIT_V(2); PG8_BAR;
        PG8_STAGE(PG8_SB(1, 0), cB + kstep, voffB); PG8_STAGE(PG8_SA(1, 0), cA + kstep, voffA); PG8_STAGE(PG8_SB(1, 1), cB + hstep + kstep, voffB);
        PG8_WAIT_V(6); PG8_BAR;
    } else {
        PG8_STAGE(PG8_SB(0, 0), cB, voffB); PG8_STAGE(PG8_SA(0, 0), cA, voffA); PG8_STAGE(PG8_SB(0, 1), cB + hstep, voffB); PG8_STAGE(PG8_SA(0, 1), cA + hstep, voffA);
        if (wr == 1) PG8_BAR;
        PG8_WAIT_V(4); PG8_BAR;
        PG8_STAGE(PG8_SB(1, 0), cB + kstep, voffB); PG8_STAGE(PG8_SA(1, 0), cA + kstep, voffA); PG8_STAGE(PG8_SB(1, 1), cB + hstep + kstep, voffB);
        PG8_WAIT_V(6); PG8_BAR;
    }
    for (;;) {
        const bool has_next = S.next(ui + 1, nxt);
        const char* nA = has_next ? S.aptr(nxt) : cA; const char* nB = has_next ? S.bptr(nxt) : cB;
        for (int t = 0; t < nt; t += 2) {
            const bool last = (t == nt - 2);
            const char* a1 = cA + (size_t)(t + 1) * kstep;
            const char* a2 = last ? nA : cA + (size_t)(t + 2) * kstep; const char* b2 = last ? nB : cB + (size_t)(t + 2) * kstep;
            const char* a3 = a2 + kstep; const char* b3 = b2 + kstep;
            if constexpr (SP2) {
            PG8_LDB(B0, 0, 0); PG8_LDB(B1, 0, 1); PG8_SCHED; PG8_LDA(At, 0, 0); PG8_STAGE(PG8_SA(1, 1), a1 + hstep, voffA);
            PG8_WAIT_V(8); PG8_WAIT_L(0); PG8_BAR; PG8_MMA(0, 0, At, B0); PG8_MMA(0, 1, At, B1); PG8_BAR; PG8_SCHED;
            PG8_LDA(At, 0, 1); PG8_STAGE(PG8_SB(0, 0), b2, voffB); PG8_STAGE(PG8_SB(0, 1), b2 + hstep, voffB); PG8_STAGE(PG8_SA(0, 0), a2, voffA);
            PG8_WAIT_V(8); PG8_WAIT_L(0); PG8_BAR; PG8_MMA(1, 0, At, B0); PG8_MMA(1, 1, At, B1); PG8_BAR; PG8_SCHED;
            PG8_LDB(B0, 1, 0); PG8_LDB(B1, 1, 1); PG8_SCHED; PG8_LDA(At, 1, 0); PG8_STAGE(PG8_SA(0, 1), a2 + hstep, voffA);
            PG8_WAIT_V(8); PG8_WAIT_L(0); PG8_BAR; PG8_MMA(0, 0, At, B0); PG8_MMA(0, 1, At, B1); PG8_BAR; PG8_SCHED;
            PG8_LDA(At, 1, 1); PG8_STAGE(PG8_SB(1, 0), b3, voffB); PG8_STAGE(PG8_SB(1, 1), b3 + hstep, voffB); PG8_STAGE(PG8_SA(1, 0), a3, voffA);
            PG8_WAIT_V(8); PG8_WAIT_L(0); PG8_BAR; PG8_MMA(1, 0, At, B0); PG8_MMA(1, 1, At, B1); PG8_BAR; PG8_SCHED;
            } else {
            PG8_LDB(B0, 0, 0); PG8_SCHED; PG8_LDA(At, 0, 0); PG8_STAGE(PG8_SA(1, 1), a1 + hstep, voffA);
            PG8_WAIT_L(8); PG8_BAR; PG8_WAIT_L(0); PG8_MMA(0, 0, At, B0); PG8_BAR; PG8_SCHED;
            PG8_LDB(B1, 0, 1); PG8_STAGE(PG8_SB(0, 0), b2, voffB);
            PG8_BAR; PG8_WAIT_L(0); PG8_MMA(0, 1, At, B1); PG8_BAR;
            PG8_LDA(At, 0, 1); PG8_STAGE(PG8_SA(0, 0), a2, voffA);
            PG8_BAR; PG8_WAIT_L(0); PG8_MMA(1, 0, At, B0); PG8_BAR; PG8_SCHED;
            PG8_STAGE(PG8_SB(0, 1), b2 + hstep, voffB);
            PG8_WAIT_V(6); PG8_BAR; PG8_MMA(1, 1, At, B1); PG8_BAR;
            PG8_LDB(B0, 1, 0); PG8_SCHED; PG8_LDA(At, 1, 0); PG8_STAGE(PG8_SA(0, 1), a2 + hstep, voffA);
            PG8_WAIT_L(8); PG8_BAR; PG8_WAIT_L(0); PG8_MMA(0, 0, At, B0); PG8_BAR; PG8_SCHED;
            PG8_LDB(B1, 1, 1); PG8_STAGE(PG8_SB(1, 0), b3, voffB);
            PG8_BAR; PG8_WAIT_L(0); PG8_MMA(0, 1, At, B1); PG8_BAR;
            PG8_LDA(At, 1, 1); PG8_STAGE(PG8_SA(1, 0), a3, voffA);
            PG8_BAR; PG8_WAIT_L(0); PG8_MMA(1, 0, At, B0); PG8_BAR; PG8_SCHED;
            PG8_STAGE(PG8_SB(1, 1), b3 + hstep, voffB);
            PG8_WAIT_V(6); PG8_BAR; PG8_MMA(1, 1, At, B1); PG8_BAR;
            }
        }
        if constexpr (ALIGN_EPI) { if (wr == 0) PG8_BAR; }
        E(acc, cur, wr, wc, fr, fq);
        if (!has_next) break;
#pragma unroll
        for (int a = 0; a < 2; ++a)
#pragma unroll
            for (int b = 0; b < 2; ++b)
#pragma unroll
                for (int m = 0; m < 4; ++m)
#pragma unroll
                    for (int n = 0; n < 2; ++n) acc[a][b][m][n] = (f32x4){0.f, 0.f, 0.f, 0.f};
        cur = nxt; cA = nA; cB = nB; ++ui;
        if constexpr (ALIGN_EPI) { if (wr == 1) PG8_BAR; }
    }
    PG8_WAIT_V(0);
    if constexpr (!ALIGN_EPI) { if (wr == 0) PG8_BAR; }
    PG8_BAR;
#undef PG8_SA
#undef PG8_SB
#undef PG8_STAGE
#undef PG8_LDA
#undef PG8_LDB
#undef PG8_MMA
#undef PG8_WAIT_V
#undef PG8_WAIT_L
#undef PG8_BAR
#undef PG8_SCHED
}


__host__ __device__ __forceinline__ int iperm32(int c) { return 16 * ((c >> 2) & 1) + 4 * (c >> 3) + (c & 3); }
struct MoeDirect {
    int nunits, NT, G, c; const LAS int* tab;
    const float* W0; const float* W1; size_t estride; int cols_per_tile, half1_off;
    __device__ bool next(int i, Unit& u) const {
        const long L = (long)i * G + c; if (L >= nunits) return false;
        u.pm = (int)L / NT; u.pn = (int)L % NT; u.ex = tab[u.pm];
        const int rem = tab[200 + u.ex] - (u.pm - tab[128 + u.ex]) * 256; u.rows = rem < 256 ? rem : 256; return true;
    }
    __device__ __forceinline__ const float* bptr(const Unit& u, int h) const { return (h ? W1 + half1_off : W0) + (size_t)u.ex * estride + (size_t)u.pn * cols_per_tile; }
};
template <class Epi, bool GATHER>
__device__ __forceinline__ void gemm_phase_moe(LAS unsigned char* lds, const int K_, const int ldw_, const MoeDirect& S, const Epi& E, const bf16* Abase, const int* LIST, const int tid, const int wid) {
    const int wr = wid >> 2, wc = wid & 3;
#define MO_LANE_CONSTS(tl) const int lane = (tl) & 63, fr = lane & 15, fq = lane >> 4; \
    const int aoff = lds_byte(wr * 64 + fr, fq * 8), boff = lds_byte(wc * 32 + fr, fq * 8); \
    const int kq = lane & 7, ng = 8 * wc + (lane >> 3); \
    const unsigned bvoff = (unsigned)((4 * kq) * ldw + 4 * ng) * 4u; \
    const int bslot0 = Epi::PERM ? (((4 * ng) & ~31) + iperm32((4 * ng) & 31)) : 4 * ng; \
    const unsigned bwbase = (unsigned)lds_byte(bslot0, 4 * kq)
    int K = K_; asm volatile("" : "+s"(K));
    int ldw = ldw_; asm volatile("" : "+s"(ldw));
    const int nt = K / BK;
    const unsigned ldsw = (unsigned)wid * 1024u;
    const size_t bkstep = (size_t)64 * ldw * 4, browb = (size_t)ldw * 4;
    f32x4 br[4];
#define MO_SA(b, h) (((b) * 2 + (h)) * HTB)
#define MO_SB(b, h) ((4 + (b) * 2 + (h)) * HTB)
#define MO_STAGE_A(bufoff, basep, o0, o1) do { \
        __builtin_amdgcn_global_load_lds((const unsigned*)((const char*)(basep) + (o0)), (LAS unsigned*)(lds + (bufoff) + ldsw), 16, 0, 0); \
        __builtin_amdgcn_global_load_lds((const unsigned*)((const char*)(basep) + (o1)), (LAS unsigned*)(lds + (bufoff) + ldsw + 8192), 16, 0, 0); } while (0)
#define MO_BISSUE(p, R) do { const char* _p = (const char*)(p) + (size_t)(32 * (R)) * browb; _Pragma("unroll") for (int _j = 0; _j < 4; ++_j) \
        asm volatile("global_load_dwordx4 %0, %1, %2" : "=v"(br[_j]) : "v"(bvoff), "s"(_p + (size_t)_j * browb) : "memory"); } while (0)
#define MO_VWAIT0() asm volatile("s_waitcnt vmcnt(0)" : "+v"(br[0]), "+v"(br[1]), "+v"(br[2]), "+v"(br[3]) :: "memory")
#define MO_BWRITE(b, R) do { _Pragma("unroll") for (int _i = 0; _i < 4; ++_i) { u32x2 _o; _o.x = cvtpk(br[0][_i], br[1][_i]); _o.y = cvtpk(br[2][_i], br[3][_i]); \
        *(LAS u32x2*)(lds + MO_SB(b, wr) + bwbase + 1024 * (R) + 64 * _i) = _o; } } while (0)
#define MO_LDA(dst, b, h) do { _Pragma("unroll") for (int m = 0; m < 4; ++m) _Pragma("unroll") for (int k = 0; k < 2; ++k) dst[m][k] = *(const LAS bf16x8*)(lds + MO_SA(b, h) + aoff + m * 2048 + k * 1024); } while (0)
#define MO_LDB(dst, b, h) do { _Pragma("unroll") for (int n = 0; n < 2; ++n) _Pragma("unroll") for (int k = 0; k < 2; ++k) dst[n][k] = *(const LAS bf16x8*)(lds + MO_SB(b, h) + boff + n * 2048 + k * 1024); } while (0)
#define MO_MMA(ai, bj, At, Bt) do { __builtin_amdgcn_s_setprio(1); _Pragma("unroll") for (int m = 0; m < 4; ++m) _Pragma("unroll") for (int n = 0; n < 2; ++n) _Pragma("unroll") for (int k = 0; k < 2; ++k) \
        acc[ai][bj][m][n] = __builtin_amdgcn_mfma_f32_16x16x32_bf16(Bt[n][k], At[m][k], acc[ai][bj][m][n], 0, 0, 0); __builtin_amdgcn_s_setprio(0); } while (0)
#define MO_WAIT_L(n) asm volatile("s_waitcnt lgkmcnt(" #n ")" ::: "memory")
#define MO_BAR __builtin_amdgcn_s_barrier()
#define MO_SCHED __builtin_amdgcn_sched_barrier(0)
#define MO_AOFF(u, dst) do { _Pragma("unroll") for (int _i = 0; _i < 2; ++_i) { int _R, _C; stage_rc(tid * 16 + _i * 8192, _R, _C); _Pragma("unroll") for (int _h = 0; _h < 2; ++_h) { const int _r = 128 * _h + _R; \
        if (GATHER) { const int _p = ((u).pm - S.tab[128 + (u).ex]) * 256 + _r; const int _t = (_r < (u).rows) ? LIST[(size_t)(u).ex * 8192 + _p] : 0; dst[_h][_i] = (unsigned)(_t * K + _C) * 2u; } \
        else dst[_h][_i] = (unsigned)(_r * K + _C) * 2u; } } } while (0)
    Unit cur, nxt; int ui = 0;
    if (!S.next(0, cur)) return;
    f32x4 acc[2][2][4][2];
#pragma unroll
    for (int a = 0; a < 2; ++a)
#pragma unroll
        for (int b = 0; b < 2; ++b)
#pragma unroll
            for (int m = 0; m < 4; ++m)
#pragma unroll
                for (int n = 0; n < 2; ++n) acc[a][b][m][n] = (f32x4){0.f, 0.f, 0.f, 0.f};
    bf16x8 At[4][2], B0[2][2], B1[2][2];
    unsigned cAo[2][2];
    LAS u32x4* const aslot = (LAS u32x4*)(lds + STAGE_BYTES) + tid;
    MO_AOFF(cur, cAo);
    const char* cAb = GATHER ? (const char*)Abase : (const char*)Abase + (size_t)cur.pm * 256 * K * 2;
    const char* cBh = (const char*)S.bptr(cur, wr);
    { MO_LANE_CONSTS(tid);
    MO_BISSUE(cBh, 0); MO_STAGE_A(MO_SA(0, 0), cAb, cAo[0][0], cAo[0][1]); MO_STAGE_A(MO_SA(0, 1), cAb, cAo[1][0], cAo[1][1]);
    if (wr == 1) MO_BAR;
    MO_VWAIT0(); MO_BWRITE(0, 0); MO_BISSUE(cBh, 1);
    MO_VWAIT0(); MO_BWRITE(0, 1);
    MO_WAIT_L(0); MO_BAR;
    MO_BISSUE(cBh + bkstep, 0); MO_STAGE_A(MO_SA(1, 0), cAb + 128, cAo[0][0], cAo[0][1]);
    MO_VWAIT0(); MO_BWRITE(1, 0); MO_BISSUE(cBh + bkstep, 1);
    MO_WAIT_L(0); MO_BAR; }
    for (;;) {
        const bool has_next = S.next(ui + 1, nxt);
        const char* nAb = cAb; const char* nBh = cBh;
        if (has_next) { nAb = GATHER ? (const char*)Abase : (const char*)Abase + (size_t)nxt.pm * 256 * K * 2; nBh = (const char*)S.bptr(nxt, wr);
            if (GATHER) { unsigned nAo[2][2]; MO_AOFF(nxt, nAo); *aslot = (u32x4){nAo[0][0], nAo[0][1], nAo[1][0], nAo[1][1]}; } }
        const bool halfu = cur.rows <= 128;
        for (int t = 0; t < nt; t += 2) {
            int tl = tid; asm volatile("" : "+v"(tl)); MO_LANE_CONSTS(tl);
            const bool last = (t == nt - 2);
            const char* a1 = cAb + (size_t)(t + 1) * 128;
            const char* a2 = last ? nAb : cAb + (size_t)(t + 2) * 128; const char* a3 = a2 + 128;
            const char* b2 = last ? nBh : cBh + (size_t)(t + 2) * bkstep; const char* b3 = b2 + bkstep;
            MO_LDB(B0, 0, 0); MO_LDB(B1, 0, 1); MO_SCHED; MO_LDA(At, 0, 0);
            MO_VWAIT0(); MO_BWRITE(1, 1); MO_STAGE_A(MO_SA(1, 1), a1, cAo[1][0], cAo[1][1]); MO_BISSUE(b2, 0);
            if (GATHER && last && has_next) { const u32x4 _n = *aslot; cAo[0][0] = _n.x; cAo[0][1] = _n.y; cAo[1][0] = _n.z; cAo[1][1] = _n.w; }
            MO_WAIT_L(0); MO_BAR; MO_MMA(0, 0, At, B0); MO_MMA(0, 1, At, B1); MO_BAR; MO_SCHED;
            MO_LDA(At, 0, 1);
            MO_VWAIT0(); MO_BWRITE(0, 0); MO_STAGE_A(MO_SA(0, 0), a2, cAo[0][0], cAo[0][1]); MO_BISSUE(b2, 1);
            MO_WAIT_L(0); MO_BAR; if (!halfu) { MO_MMA(1, 0, At, B0); MO_MMA(1, 1, At, B1); } MO_BAR; MO_SCHED;
            MO_LDB(B0, 1, 0); MO_LDB(B1, 1, 1); MO_SCHED; MO_LDA(At, 1, 0);
            MO_VWAIT0(); MO_BWRITE(0, 1); MO_STAGE_A(MO_SA(0, 1), a2, cAo[1][0], cAo[1][1]); MO_BISSUE(b3, 0);
            MO_WAIT_L(0); MO_BAR; MO_MMA(0, 0, At, B0); MO_MMA(0, 1, At, B1); MO_BAR; MO_SCHED;
            MO_LDA(At, 1, 1);
            MO_VWAIT0(); MO_BWRITE(1, 0); MO_STAGE_A(MO_SA(1, 0), a3, cAo[0][0], cAo[0][1]); MO_BISSUE(b3, 1);
            MO_WAIT_L(0); MO_BAR; if (!halfu) { MO_MMA(1, 0, At, B0); MO_MMA(1, 1, At, B1); } MO_BAR; MO_SCHED;
        }
        if (wr == 0) MO_BAR;
        { const int lane = tid & 63; E(acc, cur, wr, wc, lane & 15, lane >> 4); }
        if (!has_next) break;
#pragma unroll
        for (int a = 0; a < 2; ++a)
#pragma unroll
            for (int b = 0; b < 2; ++b)
#pragma unroll
                for (int m = 0; m < 4; ++m)
#pragma unroll
                    for (int n = 0; n < 2; ++n) acc[a][b][m][n] = (f32x4){0.f, 0.f, 0.f, 0.f};
        cur = nxt; cAb = nAb; cBh = nBh; ++ui;
        if (wr == 1) MO_BAR;
    }
    MO_VWAIT0();
    MO_BAR;
#undef MO_SA
#undef MO_SB
#undef MO_STAGE_A
#undef MO_BISSUE
#undef MO_VWAIT0
#undef MO_BWRITE
#undef MO_LDA
#undef MO_LDB
#undef MO_MMA
#undef MO_WAIT_L
#undef MO_BAR
#undef MO_SCHED
#undef MO_AOFF
#undef MO_LANE_CONSTS
}

typedef const f32x4 (&AccRef)[2][2][4][2];
DI u32x4 pack8(const f32x4& v0, const f32x4& v1) { u32x4 w; w.x = cvtpk(v0[0], v0[1]); w.y = cvtpk(v0[2], v0[3]); w.z = cvtpk(v1[0], v1[1]); w.w = cvtpk(v1[2], v1[3]); return w; }

struct EpiBf16 {
    static constexpr bool PERM = true;
    bf16* O; int ldc;
    DI void operator()(AccRef acc, const Unit& u, int wr, int wc, int fr, int fq) const {
        const int row0 = u.pm * BM + wr * 64 + fr, col0 = u.pn * BM + wc * 32 + 8 * fq;
#pragma unroll
        for (int ai = 0; ai < 2; ++ai)
#pragma unroll
            for (int m = 0; m < 4; ++m) { bf16* rowp = O + (size_t)(row0 + ai * HALF + m * 16) * ldc + col0;
#pragma unroll
                for (int bj = 0; bj < 2; ++bj) *(u32x4*)(rowp + bj * HALF) = pack8(acc[ai][bj][m][0], acc[ai][bj][m][1]); }
    }
};
struct EpiF32 {
    static constexpr bool PERM = false;
    float* C; int ldc;
    DI void operator()(AccRef acc, const Unit& u, int wr, int wc, int fr, int fq) const {
        const int row0 = u.pm * BM + wr * 64 + fr, col0 = u.pn * BM + wc * 32 + 4 * fq;
#pragma unroll
        for (int ai = 0; ai < 2; ++ai)
#pragma unroll
            for (int m = 0; m < 4; ++m) { float* rowp = C + (size_t)(row0 + ai * HALF + m * 16) * ldc + col0;
#pragma unroll
                for (int bj = 0; bj < 2; ++bj)
#pragma unroll
                    for (int n = 0; n < 2; ++n) *(f32x4*)(rowp + bj * HALF + n * 16) = acc[ai][bj][m][n]; }
    }
};
struct EpiInProj {
    static constexpr bool PERM = true;
    bf16* P; float* PBA;
    DI void operator()(AccRef acc, const Unit& u, int wr, int wc, int fr, int fq) const {
        const int row0 = u.pm * BM + wr * 64 + fr;
        if (u.pn < 28) {
            const int col0 = u.pn * BM + wc * 32 + 8 * fq;
#pragma unroll
            for (int ai = 0; ai < 2; ++ai)
#pragma unroll
                for (int m = 0; m < 4; ++m) { bf16* rowp = P + (size_t)(row0 + ai * HALF + m * 16) * NP + col0;
#pragma unroll
                    for (int bj = 0; bj < 2; ++bj) *(u32x4*)(rowp + bj * HALF) = pack8(acc[ai][bj][m][0], acc[ai][bj][m][1]); }
        } else if (wc == 0 && fq < 2) {
#pragma unroll
            for (int ai = 0; ai < 2; ++ai)
#pragma unroll
                for (int m = 0; m < 4; ++m) { float* rp = PBA + (size_t)(row0 + ai * HALF + m * 16) * 16 + 8 * fq;
                    *(f32x4*)rp = acc[ai][0][m][0]; *(f32x4*)(rp + 4) = acc[ai][0][m][1]; }
        }
    }
};
struct EpiResid {
    static constexpr bool PERM = false;
    const float* x; const float* g; float* R;
    DI void operator()(AccRef acc, const Unit& u, int wr, int wc, int fr, int fq) const {
        const int row0 = u.pm * BM + wr * 64 + fr, col0 = u.pn * BM + wc * 32 + 4 * fq;
        const float* gb = g + (size_t)((u.pm * BM) / SEQ) * 12288 + col0;
        f32x4 gv[2][2];
#pragma unroll
        for (int bj = 0; bj < 2; ++bj)
#pragma unroll
            for (int n = 0; n < 2; ++n) gv[bj][n] = *(const f32x4*)(gb + bj * HALF + n * 16) + 1.0f;
#pragma unroll
        for (int ai = 0; ai < 2; ++ai)
#pragma unroll
            for (int m = 0; m < 4; ++m) { const size_t off = (size_t)(row0 + ai * HALF + m * 16) * D + col0;
#pragma unroll
                for (int bj = 0; bj < 2; ++bj)
#pragma unroll
                    for (int n = 0; n < 2; ++n) { const f32x4 xv = *(const f32x4*)(x + off + bj * HALF + n * 16);
                        *(f32x4*)(R + off + bj * HALF + n * 16) = xv * DN_ALPHA + gv[bj][n] * acc[ai][bj][m][n]; } }
    }
};
struct EpiLogits {
    static constexpr bool PERM = false;
    float* L;
    DI void operator()(AccRef acc, const Unit& u, int wr, int wc, int fr, int fq) const {
        const int row0 = u.pm * BM + wr * 64 + fr, col0 = wc * 32 + 4 * fq;
#pragma unroll
        for (int ai = 0; ai < 2; ++ai)
#pragma unroll
            for (int m = 0; m < 4; ++m) { float* rowp = L + (size_t)(row0 + ai * HALF + m * 16) * 128 + col0;
#pragma unroll
                for (int n = 0; n < 2; ++n) *(f32x4*)(rowp + n * 16) = acc[ai][0][m][n]; }
    }
};
struct EpiGateUp {
    static constexpr bool PERM = true;
    bf16* H;
    DI void operator()(AccRef acc, const Unit& u, int wr, int wc, int fr, int fq) const {
        const int row0 = u.pm * BM + wr * 64 + fr, col0 = u.pn * HALF + wc * 32 + 8 * fq;
#pragma unroll
        for (int ai = 0; ai < 2; ++ai)
#pragma unroll
            for (int m = 0; m < 4; ++m) { bf16* rowp = H + (size_t)(row0 + ai * HALF + m * 16) * FF + col0;
                f32x4 h0, h1;
#pragma unroll
                for (int j = 0; j < 4; ++j) { h0[j] = silu_f(acc[ai][0][m][0][j]) * acc[ai][1][m][0][j]; h1[j] = silu_f(acc[ai][0][m][1][j]) * acc[ai][1][m][1][j]; }
                *(u32x4*)rowp = pack8(h0, h1); }
    }
};
struct EpiQup {
    static constexpr bool PERM = true;
    bf16* Q;
    DI void operator()(AccRef acc, const Unit& u, int wr, int wc, int fr, int fq) const {
        const int row0 = u.pm * BM + wr * 64 + fr, b = (u.pm * BM) / SEQ, s0 = row0 - b * SEQ;
        const int cg0 = u.pn * BM + wc * 32 + 8 * fq, cg1 = cg0 + HALF;
        const int h0 = cg0 / QD, w0 = cg0 - h0 * QD, h1 = cg1 / QD, w1 = cg1 - h1 * QD;
        bf16* d0 = Q + ((size_t)((b * MH + h0) * SEQ + s0)) * QD + w0; bf16* d1 = Q + ((size_t)((b * MH + h1) * SEQ + s0)) * QD + w1;
#pragma unroll
        for (int ai = 0; ai < 2; ++ai)
#pragma unroll
            for (int m = 0; m < 4; ++m) { const int dr = (ai * HALF + m * 16) * QD;
                *(u32x4*)(d0 + dr) = pack8(acc[ai][0][m][0] * QSCALE, acc[ai][0][m][1] * QSCALE);
                *(u32x4*)(d1 + dr) = pack8(acc[ai][1][m][0] * QSCALE, acc[ai][1][m][1] * QSCALE);
                asm volatile("" ::: "memory"); }
    }
};
struct EpiKVup {
    static constexpr bool PERM = true;
    bf16* Kp; bf16* V;
    DI void operator()(AccRef acc, const Unit& u, int wr, int wc, int fr, int fq) const {
        const int row0 = u.pm * BM + wr * 64 + fr, c0 = wc * 32 + 8 * fq, head = u.pn, b = (u.pm * BM) / SEQ, s0 = row0 - b * SEQ;
        bf16* dk = Kp + ((size_t)((b * MH + head) * SEQ + s0)) * QD + c0; bf16* dv = V + (size_t)row0 * D + head * 128 + c0;
#pragma unroll
        for (int ai = 0; ai < 2; ++ai)
#pragma unroll
            for (int m = 0; m < 4; ++m) { const int dr = ai * HALF + m * 16;
                *(u32x4*)(dk + dr * QD) = pack8(acc[ai][0][m][0], acc[ai][0][m][1]);
                *(u32x4*)(dv + dr * D) = pack8(acc[ai][1][m][0], acc[ai][1][m][1]);
                asm volatile("" ::: "memory"); }
    }
};
}

#define XB_TMO      128
#define XB_XCNT(j)  (256  + 64 * (j))
#define XB_XSUB(j)  (1280 + 64 * (j))
#define XB_XGEN(j)  (2304 + 64 * (j))
#define XB_TOP      3328
#define XB_TOPGEN   3392
#define XCD_BAR_WORDS 3456
#define XB_SPIN_CAP (1u << 18)
__device__ __forceinline__ unsigned xb_ld(unsigned* p)              { return __hip_atomic_load(p, __ATOMIC_RELAXED, __HIP_MEMORY_SCOPE_AGENT); }
__device__ __forceinline__ unsigned xb_add(unsigned* p, unsigned v) { return __hip_atomic_fetch_add(p, v, __ATOMIC_RELAXED, __HIP_MEMORY_SCOPE_AGENT); }
__device__ __forceinline__ unsigned xb_xcc_id() { return (unsigned)__builtin_amdgcn_s_getreg((3 << 11) | 20) & 0xFu; }
#define XB_SPIN(cond, bar) do { unsigned _sp = 0; while (cond) { __builtin_amdgcn_s_sleep(1); \
    if ((++_sp & 255u) == 0u) { if (xb_ld(&(bar)[XB_TMO])) break; if (_sp > XB_SPIN_CAP) { atomicAdd(&(bar)[XB_TMO], 1u); break; } } } } while (0)
struct XcdBarrier { unsigned* bar; unsigned x; volatile LAS unsigned* st; };
__device__ __forceinline__ XcdBarrier xcd_barrier_post(unsigned* bar, volatile LAS unsigned* st, const bool leader  ) {
    XcdBarrier b; b.bar = bar; b.x = xb_xcc_id(); b.st = st;
    if (leader) (void)xb_add(&bar[XB_XCNT(b.x)], 1u);
    return b;
}
__device__ __forceinline__ void xcd_barrier_complete(unsigned* bar, unsigned x, unsigned& nloc, unsigned& nx) {
    const unsigned G = gridDim.x * gridDim.y * gridDim.z;
    unsigned sum, cnt, mine, sp = 0u;
    for (;;) {
        sum = 0u; cnt = 0u; mine = 0u;
#pragma unroll
        for (unsigned j = 0; j < 16; ++j) { const unsigned c = xb_ld(&bar[XB_XCNT(j)]); sum += c; cnt += (c > 0u) ? 1u : 0u; mine = (j == x) ? c : mine; }
        if (sum == G) break;
        __builtin_amdgcn_s_sleep(1);
        if ((++sp & 255u) == 0u) { if (xb_ld(&bar[XB_TMO])) break; if (sp > XB_SPIN_CAP) { atomicAdd(&bar[XB_TMO], 1u); break; } }
    }
    nloc = mine > 0u ? mine : 1u; nx = cnt > 0u ? cnt : 1u;
}
__device__ __forceinline__ void xcd_barrier(const XcdBarrier& b, const bool leader  ) {
    asm volatile("s_waitcnt vmcnt(0)" ::: "memory");
    __syncthreads();
    if (leader) {
        unsigned* bar = b.bar;
        __builtin_amdgcn_s_waitcnt(0);
        unsigned nloc = b.st[0], nx = b.st[1];
        if (nloc == 0u) { xcd_barrier_complete(bar, b.x, nloc, nx); b.st[0] = nloc; b.st[1] = nx; }
        const unsigned old = xb_add(&bar[XB_XSUB(b.x)], 1u);
        const unsigned gen = old / nloc;
        if (old + 1u == (gen + 1u) * nloc) {
            __builtin_amdgcn_fence(__ATOMIC_RELEASE, "agent");
            asm volatile("s_waitcnt vmcnt(0)" ::: "memory");
            const unsigned og = xb_add(&bar[XB_TOP], 1u);
            const unsigned tg = og / nx;
            if (og + 1u == (tg + 1u) * nx) xb_add(&bar[XB_TOPGEN], 1u);
            else XB_SPIN(xb_ld(&bar[XB_TOPGEN]) == tg, bar);
            __builtin_amdgcn_fence(__ATOMIC_ACQUIRE, "agent");
            xb_add(&bar[XB_XGEN(b.x)], 1u);
            asm volatile("s_waitcnt vmcnt(0)" ::: "memory");
        } else {
            XB_SPIN(xb_ld(&bar[XB_XGEN(b.x)]) == gen, bar);
            __builtin_amdgcn_fence(__ATOMIC_ACQUIRE, "agent");
            asm volatile("s_waitcnt vmcnt(0)" ::: "memory");
        }
    }
    __syncthreads();
}

struct Frame {
    LAS unsigned char* lds;
    int tid, lane, wave, vcu, G, gw, NGW;
    unsigned* ctl;
};
struct Args { const void* in[27]; float* out; unsigned char* ws; int ph_lo, ph_hi; };

__device__ const double ROPE_INVF[32] = {1, 0.74989420933245587, 0.56234132519034907, 0.42169650342858223, 0.31622776601683794, 0.23713737056616552, 0.17782794100389229, 0.1333521432163324,
    0.10000000000000001, 0.074989420933245579, 0.056234132519034911, 0.042169650342858224, 0.031622776601683791, 0.023713737056616554, 0.017782794100389229, 0.013335214321633241,
    0.01, 0.0074989420933245579, 0.005623413251903491, 0.0042169650342858229, 0.0031622776601683794, 0.0023713737056616554, 0.0017782794100389228, 0.0013335214321633241,
    0.001, 0.00074989420933245586, 0.0005623413251903491, 0.00042169650342858224, 0.00031622776601683794, 0.00023713737056616554, 0.00017782794100389227, 0.0001333521432163324};

struct TrRegs { f32x4 r[8]; };
DI void tr_load(TrRegs& t, const float* W, size_t ld, int k0, int n0, int nvalid, int lane) {
    const int ns = lane & 7, kq = lane >> 3;
    if (4 * ns < nvalid) { const float* src = W + (size_t)(k0 + 8 * kq) * ld + n0 + 4 * ns;
#pragma unroll
        for (int j = 0; j < 8; ++j) t.r[j] = *(const f32x4*)(src + (size_t)j * ld); }
}
DI void tr_store(const TrRegs& t, int k0, int nvalid, bf16* WT, int Kd, int drow0, int lane) {
    const int ns = lane & 7, kq = lane >> 3;
    if (4 * ns < nvalid) { bf16* dst = WT + (size_t)(drow0 + 4 * ns) * Kd + k0 + 8 * kq;
#pragma unroll
        for (int i = 0; i < 4; ++i) { u32x4 o; o.x = cvtpk(t.r[0][i], t.r[1][i]); o.y = cvtpk(t.r[2][i], t.r[3][i]); o.z = cvtpk(t.r[4][i], t.r[5][i]); o.w = cvtpk(t.r[6][i], t.r[7][i]);
            *(u32x4*)(dst + (size_t)i * Kd) = o; } }
}
DI void tr_job(const Frame& F, const float* W, size_t smat, int nmat, int ld, int K, int col0, int ncols, bf16* WT, size_t dmat, int Kd, int row_off, int mode) {
    const int nblk = (ncols + 31) / 32, kbs = K / 64, per = nblk * kbs; const long items = (long)nmat * per;
    for (long it0 = F.gw; it0 < items; it0 += 2 * (long)F.NGW) {
        TrRegs t[2]; int k0[2], nv[2], dr[2]; bf16* wt[2];
#pragma unroll
        for (int u = 0; u < 2; ++u) {
            const long it = it0 + (long)u * F.NGW;
            if (it < items) {
                const int mat = (int)(it / per), rem = (int)(it - (long)mat * per), kb = rem / nblk, nb = rem - kb * nblk;
                nv[u] = (ncols - nb * 32) < 32 ? (ncols - nb * 32) : 32; k0[u] = kb * 64;
                dr[u] = (mode == 0) ? (row_off + nb * 32) : ((nb >> 2) * 256 + row_off + (nb & 3) * 32);
                wt[u] = WT + (size_t)mat * dmat;
                tr_load(t[u], W + (size_t)mat * smat, (size_t)ld, k0[u], col0 + nb * 32, nv[u], F.lane);
            } else { nv[u] = 0; k0[u] = 0; dr[u] = 0; wt[u] = WT; }
        }
#pragma unroll
        for (int u = 0; u < 2; ++u) tr_store(t[u], k0[u], nv[u], wt[u], Kd, dr[u], F.lane);
    }
}
DI void zero_fill(const Frame& F, void* p, size_t bytes) {
    u32x4* q = (u32x4*)p; const size_t n = bytes / 16;
    for (size_t i = (size_t)F.gw * 64 + F.lane; i < n; i += (size_t)F.NGW * 64) q[i] = (u32x4){0u, 0u, 0u, 0u};
}

DI const void* arg_in(int k) { unsigned o = (unsigned)k * 8u; asm volatile("" : "+s"(o));
    const GAS void* p = *(const GAS void* const __attribute__((address_space(4)))*)((const __attribute__((address_space(4))) unsigned char*)__builtin_amdgcn_kernarg_segment_ptr() + o);
    return (const void*)p; }
#define WSB (args.ws)
#define in_x ((const float*)arg_in(0))
#define in_c ((const float*)arg_in(1))
#define in_pos ((const int*)arg_in(2))
#define ada_w ((const float*)arg_in(3))
#define ada_b ((const float*)arg_in(4))
#define ln_g ((const float*)arg_in(5))
#define ln_b ((const float*)arg_in(6))
#define hyb_w_in ((const float*)arg_in(7))
#define gdn_conv_w ((const float*)arg_in(8))
#define gdn_a_log ((const float*)arg_in(9))
#define gdn_dt_bias ((const float*)arg_in(10))
#define gdn_norm_w ((const float*)arg_in(11))
#define sc_conv_w ((const float*)arg_in(12))
#define hyb_w_out ((const float*)arg_in(13))
#define mla_w_in ((const float*)arg_in(14))
#define mla_q_norm ((const float*)arg_in(15))
#define mla_kv_norm ((const float*)arg_in(16))
#define mla_w_uq ((const float*)arg_in(17))
#define mla_w_ukv ((const float*)arg_in(18))
#define mla_w_out ((const float*)arg_in(19))
#define moe_router_g ((const float*)arg_in(20))
#define moe_bias_g ((const float*)arg_in(21))
#define moe_router_e ((const float*)arg_in(22))
#define moe_bias_e ((const float*)arg_in(23))
#define moe_w_gate ((const float*)arg_in(24))
#define moe_w_up ((const float*)arg_in(25))
#define moe_w_down ((const float*)arg_in(26))
#define MOD ((float*)(WSB + WS_MOD))
#define ROPE_C ((float*)(WSB + WS_ROPE))
#define ROPE_S ((float*)(ROPE_C + (size_t)T * 32))
#define PBA ((float*)(WSB + WS_PBA))
#define LOGITS ((float*)(WSB + WS_LOGITS))
#define TOK_E ((int*)(WSB + WS_ROUTE))
#define TOK_POS ((int*)(TOK_E + 2 * T))
#define TOK_GATE ((float*)(TOK_POS + 2 * T))
#define EG ((float*)(WSB + WS_EG))
#define WIN0 ((bf16*)(WSB + WS_WIN0))
#define WOUT0 ((bf16*)(WSB + WS_WOUT0))
#define WMIN ((bf16*)(WSB + WS_WMIN))
#define WUQ ((bf16*)(WSB + WS_WUQ))
#define WUKV ((bf16*)(WSB + WS_WUKV))
#define WMOUT ((bf16*)(WSB + WS_WMOUT))
#define WRT ((bf16*)(WSB + WS_WRT))
#define WGU ((bf16*)(WSB + WS_WGU))
#define WDN ((bf16*)(WSB + WS_WDN))
#define HIN ((bf16*)(WSB + WS_HIN))
#define XA ((float*)(WSB + WS_XA))
#define XB ((float*)(WSB + WS_XB))
#define RB ((float*)(WSB + WS_R))
#define PB ((bf16*)(WSB + WS_P))
#define GF ((unsigned char*)(WSB + WS_GF))
#define GU ((unsigned char*)(WSB + WS_GU))
#define GO ((float*)(WSB + WS_GO))
#define YAB ((bf16*)(WSB + WS_YAB))
#define LISTP ((int*)(WSB + WS_XS))
#define HID ((bf16*)(WSB + WS_HID))
#define YS ((bf16*)(WSB + WS_YS))
#define C1 ((float*)(WSB + WS_C1))
#define CQN ((bf16*)(WSB + WS_CQN))
#define CKVN ((bf16*)(WSB + WS_CKVN))
#define KPE ((float*)(WSB + WS_KPE))
#define QB_ ((bf16*)(WSB + WS_Q))
#define KB_ ((bf16*)(WSB + WS_K))
#define VB_ ((bf16*)(WSB + WS_V))
#define VT ((bf16*)(WSB + WS_VT))


#define LN_ROW(v, gptr, bptr) do { float _s = 0.f; _Pragma("unroll") for (int _j = 0; _j < 8; ++_j) _s += (v[_j][0] + v[_j][1]) + (v[_j][2] + v[_j][3]); \
        const float _mean = wave_sum(_s) * (1.f / D); float _q = 0.f; \
        _Pragma("unroll") for (int _j = 0; _j < 8; ++_j) { v[_j] = v[_j] - _mean; _q += (v[_j][0] * v[_j][0] + v[_j][1] * v[_j][1]) + (v[_j][2] * v[_j][2] + v[_j][3] * v[_j][3]); } \
        const float _rstd = rsqrtf(wave_sum(_q) * (1.f / D) + 1e-5f); \
        _Pragma("unroll") for (int _j = 0; _j < 8; ++_j) v[_j] = v[_j] * _rstd * ((const f32x4*)(gptr))[F.lane + 64 * _j] + ((const f32x4*)(bptr))[F.lane + 64 * _j]; } while (0)
#define WRITE_X_HIN(v, xrow, hrow, shp, scp) do { _Pragma("unroll") for (int _j = 0; _j < 8; ++_j) { ((f32x4*)(xrow))[F.lane + 64 * _j] = v[_j]; \
        if ((hrow) != nullptr) { const f32x4 _h = v[_j] * (((const f32x4*)(scp))[F.lane + 64 * _j] + 1.0f) + ((const f32x4*)(shp))[F.lane + 64 * _j]; \
            u32x2 _w; _w.x = cvtpk(_h[0], _h[1]); _w.y = cvtpk(_h[2], _h[3]); ((u32x2*)(hrow))[F.lane + 64 * _j] = _w; } } } while (0)


#ifndef PHMASK
#define PHMASK 0xFFFFFFFFull
#endif
#define PH_EN(k) (((PHMASK) >> (k)) & 1ull)
#define IN(k) (PH_EN(k) && lo <= (k) && (k) < hi)
#define INL(k0, k1) ((L == 0) ? IN(k0) : IN(k1))
#define PHASE_FRESH() do { int _l; asm volatile("v_mbcnt_lo_u32_b32 %0, -1, 0\n\tv_mbcnt_hi_u32_b32 %0, -1, %0" : "=v"(_l)); F.lane = _l; F.tid = F.wave * 64 + _l; } while (0)
#define SEAM(k) do { if (IN(k) && IN((k) + 1)) { PHASE_FRESH(); xcd_barrier(bar, F.tid == 0); } } while (0)

template <int L> DI void moe_phases(Frame& F, const Args& args, const XcdBarrier& bar, const int lo, const int hi, LAS int* TAB) {
        unsigned* cnt = F.ctl + CW_CNT + L * 64;
    if (INL(8, 21)) { PHASE_FRESH();
        pg8::StaticOrder S; S.init(HIN, WRT + (size_t)L * 256 * D, T, 256, D, F.G, (int)blockIdx.x);
        pg8::EpiLogits E{LOGITS};
        pg8::gemm_phase<pg8::EpiLogits, pg8::StaticOrder>(F.lds, D, S, E, F.tid, F.wave);
    }
    if (L == 0) SEAM(8); else SEAM(21);
    if (INL(9, 22)) { PHASE_FRESH();
        const float* bg = moe_bias_g + L * 8; const float* be = moe_bias_e + L * 64;
        for (int t = blockIdx.x * 512 + F.tid; t < T; t += F.G * 512) {
            const float* lg = LOGITS + (size_t)t * 128;
            float l8[8]; float mx = -3.0e38f; int grp = 0;
#pragma unroll
            for (int g = 0; g < 8; ++g) { l8[g] = lg[g] + bg[g]; if (l8[g] > mx) { mx = l8[g]; grp = g; } }
            float se = 0.f;
#pragma unroll
            for (int g = 0; g < 8; ++g) se += __expf(l8[g] - mx);
            const float pg = 1.f / se;
            float e8[8];
#pragma unroll
            for (int j = 0; j < 8; ++j) e8[j] = lg[8 + grp * 8 + j] + be[grp * 8 + j];
            int i1 = 0; float m1 = e8[0];
#pragma unroll
            for (int j = 1; j < 8; ++j) if (e8[j] > m1) { m1 = e8[j]; i1 = j; }
            int i2 = -1; float m2 = -3.0e38f;
#pragma unroll
            for (int j = 0; j < 8; ++j) if (j != i1 && e8[j] > m2) { m2 = e8[j]; i2 = j; }
            const float rr = __expf(m2 - m1), g1 = pg / (1.f + rr), g2 = pg * rr / (1.f + rr);
            const int ex1 = grp * 8 + i1, ex2 = grp * 8 + i2;
            const int p1 = (int)atomicAdd(&cnt[ex1], 1u), p2 = (int)atomicAdd(&cnt[ex2], 1u);
            TOK_E[2 * t] = ex1; TOK_E[2 * t + 1] = ex2; TOK_POS[2 * t] = p1; TOK_POS[2 * t + 1] = p2; TOK_GATE[2 * t] = g1; TOK_GATE[2 * t + 1] = g2;
            LISTP[(size_t)ex1 * 8192 + p1] = t; LISTP[(size_t)ex2 * 8192 + p2] = t;
        }
    }
    if ((L == 0) ? (IN(9) && IN(11)) : (IN(22) && IN(24))) { PHASE_FRESH(); xcd_barrier(bar, F.tid == 0); }
#define MOE_TABLE() do { if (F.tid == 0) { int _a = 0; for (int _e = 0; _e < NE; ++_e) { const int _c = (int)cnt[_e]; TAB[128 + _e] = _a; TAB[200 + _e] = _c; const int _nb = (_c + 255) >> 8; \
        for (int _q = 0; _q < _nb; ++_q) TAB[_a + _q] = _e; _a += _nb; } TAB[192] = _a; } __syncthreads(); } while (0)
    if (INL(11, 24)) { PHASE_FRESH();
        MOE_TABLE();
        pg8::MoeDirect S; S.nunits = TAB[192] * 4; S.NT = 4; S.G = F.G; S.c = F.vcu; S.tab = TAB;
        S.W0 = moe_w_gate + (size_t)L * 64 * D * FF; S.W1 = moe_w_up + (size_t)L * 64 * D * FF; S.estride = (size_t)D * FF; S.cols_per_tile = 128; S.half1_off = 0;
        pg8::EpiGateUp E{HID};
        pg8::gemm_phase_moe<pg8::EpiGateUp, true>(F.lds, D, FF, S, E, HIN, LISTP, F.tid, F.wave);
    }
    if (L == 0) SEAM(11); else SEAM(24);
    if (INL(12, 25)) { PHASE_FRESH();
        MOE_TABLE();
        pg8::MoeDirect S; S.nunits = TAB[192] * 8; S.NT = 8; S.G = F.G; S.c = F.vcu; S.tab = TAB;
        S.W0 = moe_w_down + (size_t)L * 64 * D * FF; S.W1 = S.W0; S.estride = (size_t)D * FF; S.cols_per_tile = 256; S.half1_off = 128;
        pg8::EpiBf16 E{YS, D};
        pg8::gemm_phase_moe<pg8::EpiBf16, false>(F.lds, FF, D, S, E, HID, nullptr, F.tid, F.wave);
    }
    if (L == 0) SEAM(12); else SEAM(25);
    if (INL(13, 26)) { PHASE_FRESH();
        if (F.tid == 0) { int a = 0; for (int e = 0; e < NE; ++e) { TAB[128 + e] = a; a += ((int)cnt[e] + 255) >> 8; } }
        __syncthreads();
        float* xout = (L == 0) ? XB : args.out;
        for (int m = F.gw; m < T; m += F.NGW) {
            const int b = m / SEQ; const float* modb = MOD + (size_t)(L * 4 + b) * 12288;
            const int r0 = TAB[128 + TOK_E[2 * m]] * 256 + TOK_POS[2 * m], r1 = TAB[128 + TOK_E[2 * m + 1]] * 256 + TOK_POS[2 * m + 1];
            const float g0 = TOK_GATE[2 * m], g1 = TOK_GATE[2 * m + 1];
            f32x4 v[8];
#pragma unroll
            for (int j = 0; j < 8; ++j) {
                const f32x4 xv = ((const f32x4*)(XA + (size_t)m * D))[F.lane + 64 * j];
                const u32x2 ya = ((const u32x2*)(YS + (size_t)r0 * D))[F.lane + 64 * j], yb = ((const u32x2*)(YS + (size_t)r1 * D))[F.lane + 64 * j];
                const f32x4 gg = ((const f32x4*)(modb + 5 * D))[F.lane + 64 * j] + 1.0f;
                f32x4 y; y[0] = g0 * bflo(ya.x) + g1 * bflo(yb.x); y[1] = g0 * bfhi(ya.x) + g1 * bfhi(yb.x); y[2] = g0 * bflo(ya.y) + g1 * bflo(yb.y); y[3] = g0 * bfhi(ya.y) + g1 * bfhi(yb.y);
                v[j] = xv * DN_ALPHA + gg * y;
            }
            LN_ROW(v, ln_g + (size_t)(L * 2 + 1) * D, ln_b + (size_t)(L * 2 + 1) * D);
            bf16* hrow = (L == 0) ? HIN + (size_t)m * D : nullptr;
            const float* mod1 = MOD + (size_t)(4 + b) * 12288;
            WRITE_X_HIN(v, xout + (size_t)m * D, hrow, mod1, mod1 + D);
        }
    }
    if (L == 0) SEAM(13);
}

__global__ void __launch_bounds__(512, 2) mega(Args args) {
    extern __shared__ __attribute__((aligned(16))) unsigned char lds_raw[];
    Frame F;
    F.lds = (LAS unsigned char*)lds_raw;
    F.wave = __builtin_amdgcn_readfirstlane((int)threadIdx.x >> 6); PHASE_FRESH();
    F.G = gridDim.x; { const int bx = blockIdx.x; F.vcu = (F.G % 8 == 0) ? (bx % 8) * (F.G / 8) + bx / 8 : bx; }
    F.gw = F.vcu * 8 + F.wave; F.NGW = F.G * 8;
    F.ctl = (unsigned*)(args.ws + WS_CTL);
    volatile LAS unsigned* MISC = (volatile LAS unsigned*)(F.lds + MISC_OFF);
    LAS int* TAB = (LAS int*)(F.lds + TAB_OFF);
    for (int u = F.tid; u < (LDS_BYTES - LDSCTL_OFF) / 4; u += 512) ((LAS unsigned*)(F.lds + LDSCTL_OFF))[u] = 0u;
    __syncthreads();
    XcdBarrier bar; bar.bar = F.ctl + CW_BAR; bar.x = 0; bar.st = nullptr;
    if (MK_ONE_LAUNCH) bar = xcd_barrier_post(F.ctl + CW_BAR, MISC + 8, F.tid == 0);
    const int lo = args.ph_lo, hi = args.ph_hi;

    if (IN(0)) { PHASE_FRESH();
        {
            LAS float* cact = (LAS float*)F.lds;
            LAS float* red = (LAS float*)(F.lds + 32768);
            for (int i = F.tid; i < 4 * D; i += 512) cact[i] = silu_f(in_c[i]);
            __syncthreads();
            for (int cg = blockIdx.x; cg < 256; cg += F.G) {
                const int jj0 = cg * 96, l = jj0 / 12288, j0 = jj0 - l * 12288;
                const int rsub = F.lane / 24, c4 = F.lane - rsub * 24;
                f32x4 a0 = {0.f, 0.f, 0.f, 0.f}, a1 = a0, a2 = a0, a3 = a0;
                if (F.lane < 48) {
                    const float* wp = ada_w + ((size_t)l * D) * 12288 + j0 + 4 * c4;
#pragma unroll 8
                    for (int it = 0; it < 128; ++it) { const int k = it * 16 + F.wave * 2 + rsub;
                        const f32x4 w4 = *(const f32x4*)(wp + (size_t)k * 12288);
                        a0 += w4 * cact[k]; a1 += w4 * cact[D + k]; a2 += w4 * cact[2 * D + k]; a3 += w4 * cact[3 * D + k]; }
                    LAS float* rp = red + (F.wave * 2 + rsub) * 384 + 4 * c4;
                    *(LAS f32x4*)(rp) = a0; *(LAS f32x4*)(rp + 96) = a1; *(LAS f32x4*)(rp + 192) = a2; *(LAS f32x4*)(rp + 288) = a3;
                }
                __syncthreads();
                if (F.tid < 384) { const int b = F.tid / 96, col = F.tid - b * 96; float s = ada_b[(size_t)l * 12288 + j0 + col];
#pragma unroll
                    for (int p = 0; p < 16; ++p) s += red[p * 384 + b * 96 + col];
                    MOD[((size_t)l * 4 + b) * 12288 + j0 + col] = s; }
                __syncthreads();
            }
        }
        {
            tr_job(F, hyb_w_in, 0, 1, HYB_IN, D, 0, 4096, WIN0, 0, D, 0, 0);
            tr_job(F, hyb_w_in, 0, 1, HYB_IN, D, 4112, 3072, WIN0, 0, D, 4096, 0);
            tr_job(F, hyb_w_in, 0, 1, HYB_IN, D, 4096, 16, WIN0, 0, D, 7168, 0);
            zero_fill(F, WIN0 + (size_t)7184 * D, (size_t)(NIN - 7184) * D * 2);
            tr_job(F, hyb_w_out, 0, 1, D, D, 0, D, WOUT0, 0, D, 0, 0);
            tr_job(F, mla_w_in, 0, 1, MLA_IN, D, 0, MLA_IN, WMIN, 0, D, 0, 0);
            zero_fill(F, WMIN + (size_t)MLA_IN * D, (size_t)(NMLA - MLA_IN) * D * 2);
            tr_job(F, mla_w_uq, 0, 1, 3072, 512, 0, 3072, WUQ, 0, 512, 0, 0);
            tr_job(F, mla_w_ukv, 0, 1, 4096, 512, 0, 4096, WUKV, 0, 512, 0, 0);
            tr_job(F, mla_w_out, 0, 1, D, D, 0, D, WMOUT, 0, D, 0, 0);
            tr_job(F, moe_router_g, (size_t)D * 8, 2, 8, D, 0, 8, WRT, (size_t)256 * D, D, 0, 0);
            tr_job(F, moe_router_e, (size_t)D * 64, 2, 64, D, 0, 64, WRT, (size_t)256 * D, D, 8, 0);
            zero_fill(F, WRT + (size_t)72 * D, (size_t)(256 - 72) * D * 2);
            zero_fill(F, WRT + (size_t)256 * D + (size_t)72 * D, (size_t)(256 - 72) * D * 2);
        }
        for (int idx = blockIdx.x * 512 + F.tid; idx < T * 32; idx += F.G * 512) {
            const int t = idx >> 5, i = idx & 31;
            const double rev = (double)in_pos[t] * ROPE_INVF[i] * 0.15915494309189535;
            const float fr = (float)(rev - __builtin_rint(rev));
            ROPE_C[idx] = __builtin_amdgcn_cosf(fr); ROPE_S[idx] = __builtin_amdgcn_sinf(fr);
        }
    }
    SEAM(0);

    if (IN(1)) { PHASE_FRESH();
        for (int m = F.gw; m < T; m += F.NGW) {
            const int b = m / SEQ; const float* modb = MOD + (size_t)b * 12288;
            const f32x4* xr = (const f32x4*)(in_x + (size_t)m * D) + F.lane; u32x2* o = (u32x2*)(HIN + (size_t)m * D) + F.lane;
#pragma unroll
            for (int j = 0; j < 8; ++j) { const f32x4 v = xr[64 * j]; const f32x4 sh = ((const f32x4*)(modb))[F.lane + 64 * j], sc = ((const f32x4*)(modb + D))[F.lane + 64 * j];
                const f32x4 h = v * (sc + 1.0f) + sh; u32x2 w; w.x = cvtpk(h[0], h[1]); w.y = cvtpk(h[2], h[3]); o[64 * j] = w; }
        }
    }
    SEAM(1);

    if (IN(2)) { PHASE_FRESH();
        pg8::StaticOrder S; S.init(HIN, WIN0, T, NIN, D, F.G, (int)blockIdx.x);
        pg8::EpiInProj E{PB, PBA};
        pg8::gemm_phase<pg8::EpiInProj, pg8::StaticOrder>(F.lds, D, S, E, F.tid, F.wave);
    }
    SEAM(2);

    if (IN(3)) { PHASE_FRESH();
        constexpr int QS = 136;
        LAS float* MT = (LAS float*)(F.lds);
        LAS bf16* QKM = (LAS bf16*)(F.lds + 17408);
        LAS float* RAWK = (LAS float*)(F.lds);
        LAS float* VF = (LAS float*)(F.lds + 32768);
        LAS float* WL = (LAS float*)(F.lds + 65536);
        LAS bf16* QBl = (LAS bf16*)(F.lds + 98304);
        LAS bf16* KBl = (LAS bf16*)(F.lds + 115712);
        int zoff = 0; asm volatile("" : "+v"(zoff));
        LAS float* s_beta = (LAS float*)(F.lds + 133120 + zoff); LAS float* s_gc = s_beta + 64; LAS float* s_egc = s_beta + 128;
        for (int ch = blockIdx.x; ch < NCH; ch += F.G) {
            PHASE_FRESH();
            const int n = ch & 31, bh = ch >> 5, h = bh & 7, b = bh >> 3;
            const int tok0 = b * SEQ + n * CHK;
            if (F.tid < 384) {
                const int mat = F.tid >> 7, d = F.tid & 127, col = mat * 1024 + h * 128 + d;
                const float w0 = gdn_conv_w[col], w1 = gdn_conv_w[3072 + col], w2 = gdn_conv_w[2 * 3072 + col], w3 = gdn_conv_w[3 * 3072 + col];
                const bf16* pc = PB + (size_t)tok0 * NP + col;
                float xm3 = 0.f, xm2 = 0.f, xm1 = 0.f;
                if (n > 0) { xm3 = bf2f(pc[-3 * NP]); xm2 = bf2f(pc[-2 * NP]); xm1 = bf2f(pc[-NP]); }
                LAS float* dst = (mat == 0) ? WL : (mat == 1 ? RAWK : VF);
#pragma unroll 8
                for (int i = 0; i < 64; ++i) { const float xi = bf2f(pc[(size_t)i * NP]); const float y = w0 * xm3 + w1 * xm2 + w2 * xm1 + w3 * xi;
                    dst[i * 128 + d] = silu_f(y); xm3 = xm2; xm2 = xm1; xm1 = xi; }
            }
            if (F.wave == 7) {
                const int tok = tok0 + F.lane;
                const float br = PBA[(size_t)tok * 16 + h], ar = PBA[(size_t)tok * 16 + 8 + h];
                const float beta = 1.f / (1.f + __expf(-br));
                const float xsp = ar + gdn_dt_bias[h];
                const float sp = fmaxf(xsp, 0.f) + log1pf(__expf(-fabsf(xsp)));
                float g = -__expf(gdn_a_log[h]) * sp;
#pragma unroll
                for (int off = 1; off < 64; off <<= 1) { const float v = __shfl_up(g, off); if (F.lane >= off) g += v; }
                s_beta[F.lane] = beta; s_gc[F.lane] = g; s_egc[F.lane] = __expf(g);
            }
            __syncthreads();
#pragma unroll
            for (int rr = 0; rr < 8; ++rr) {
                const int i = F.wave * 8 + rr;
                const float qa = WL[i * 128 + F.lane], qb2 = WL[i * 128 + 64 + F.lane];
                const float ka = RAWK[i * 128 + F.lane], kb2 = RAWK[i * 128 + 64 + F.lane];
                const float rq = rsqrtf(wave_sum(qa * qa + qb2 * qb2) + 1e-6f) * 0.08838834764831845f;
                const float rk = rsqrtf(wave_sum(ka * ka + kb2 * kb2) + 1e-6f);
                QBl[i * QS + F.lane] = f2bf(qa * rq); QBl[i * QS + 64 + F.lane] = f2bf(qb2 * rq);
                KBl[i * QS + F.lane] = f2bf(ka * rk); KBl[i * QS + 64 + F.lane] = f2bf(kb2 * rk);
            }
            __syncthreads();
            {
                const int mat = F.wave >> 2, mi = (F.wave >> 1) & 1, ni = F.wave & 1, r = F.lane & 31, hh = F.lane >> 5;
                const LAS bf16* Am = (mat == 0) ? KBl : QBl;
                f32x16 acc;
#pragma unroll
                for (int i = 0; i < 16; ++i) acc[i] = 0.f;
#pragma unroll
                for (int ks = 0; ks < 8; ++ks) {
                    const bf16x8 a = *(const LAS bf16x8*)(Am + (32 * mi + r) * QS + 16 * ks + 8 * hh);
                    const bf16x8 bb = *(const LAS bf16x8*)(KBl + (32 * ni + r) * QS + 16 * ks + 8 * hh);
                    acc = MFMA32(a, bb, acc);
                }
                const int j = 32 * ni + r; const float gj = s_gc[j];
#pragma unroll
                for (int reg = 0; reg < 16; ++reg) {
                    const int i = 32 * mi + crow(reg, hh);
                    const float gi = s_gc[i];
                    const float dec = __expf(fminf(gi - gj, 0.f));
                    if (mat == 0) MT[j * 68 + i] = (i > j) ? s_beta[i] * acc[reg] * dec : 0.f;
                    else QKM[i * 64 + j] = f2bf((i >= j) ? acc[reg] * dec : 0.f);
                }
            }
            __syncthreads();
            if (F.tid < 256) {
                const int c = F.tid, dcol = c & 127;
                float X[64];
                if (c < 128) {
#pragma unroll
                    for (int i = 0; i < 64; ++i) X[i] = VF[i * 128 + dcol] * s_beta[i];
                } else {
#pragma unroll
                    for (int i = 0; i < 64; ++i) X[i] = bf2f(KBl[i * QS + dcol]) * s_beta[i] * s_egc[i];
                }
#pragma unroll
                for (int j = 0; j < 63; ++j) {
                    asm volatile("" ::: "memory");
                    const float xj = X[j];
#pragma unroll
                    for (int i4 = ((j + 1) & ~3); i4 < 64; i4 += 4) {
                        const f32x4 m4 = *(const LAS f32x4*)(MT + j * 68 + i4);
#pragma unroll
                        for (int q = 0; q < 4; ++q) if (i4 + q > j) X[i4 + q] -= m4[q] * xj;
                    }
                }
                LAS float* dst = (c < 128) ? VF : WL;
#pragma unroll
                for (int i = 0; i < 64; ++i) dst[i * 128 + dcol] = X[i];
            }
            __syncthreads();
            {
                const int r = F.lane & 31, hh = F.lane >> 5;
                const float gl = s_gc[63];
                unsigned char* gf = GF + (size_t)ch * 57344;
                for (int f = F.wave; f < 56; f += 8) {
                    float v[8];
                    if (f < 16) { const int mt = f >> 3, ks = f & 7; const LAS float* src = WL + (32 * mt + r) * 128 + 16 * ks + 4 * hh;
#pragma unroll
                        for (int j = 0; j < 8; ++j) v[j] = -src[8 * (j >> 2) + (j & 3)]; }
                    else if (f < 32) { const int f2 = f - 16, mt = f2 >> 3, ks = f2 & 7, i = 32 * mt + r; const float e = s_egc[i]; const LAS bf16* src = QBl + i * QS + 16 * ks + 4 * hh;
#pragma unroll
                        for (int j = 0; j < 8; ++j) v[j] = bf2f(src[8 * (j >> 2) + (j & 3)]) * e; }
                    else if (f < 40) { const int f2 = f - 32, mt = f2 >> 2, ks = f2 & 3; const LAS bf16* src = QKM + (32 * mt + r) * 64 + 16 * ks + 4 * hh;
#pragma unroll
                        for (int j = 0; j < 8; ++j) v[j] = bf2f(src[8 * (j >> 2) + (j & 3)]); }
                    else { const int f2 = f - 40, mt = f2 >> 2, ks = f2 & 3, dd = 32 * mt + r;
#pragma unroll
                        for (int j = 0; j < 8; ++j) { const int i = 16 * ks + 8 * (j >> 2) + 4 * hh + (j & 3); v[j] = bf2f(KBl[i * QS + dd]) * __expf(gl - s_gc[i]); } }
                    u32x4 o; o.x = cvtpk(v[0], v[1]); o.y = cvtpk(v[2], v[3]); o.z = cvtpk(v[4], v[5]); o.w = cvtpk(v[6], v[7]);
                    *(u32x4*)(gf + f * 1024 + F.lane * 16) = o;
                }
                { const int sl = F.wave >> 1, it = F.wave & 1, col = 32 * sl + r;
                  float* up = (float*)(GU + (size_t)ch * 32768 + (size_t)((sl * 2 + it) * 64 + F.lane) * 64);
#pragma unroll
                  for (int g4 = 0; g4 < 4; ++g4) { f32x4 t4;
#pragma unroll
                      for (int q = 0; q < 4; ++q) t4[q] = VF[(32 * it + crow(4 * g4 + q, hh)) * 128 + col];
                      *(f32x4*)(up + 4 * g4) = t4; } }
                if (F.tid == 0) EG[ch] = __expf(gl);
            }
            __syncthreads();
        }
    }
    SEAM(3);

    if (IN(4)) { PHASE_FRESH();
        for (int bh = blockIdx.x; bh < BATCH * GH; bh += F.G) {
            const int b = bh >> 3, hd = bh & 7, r = F.lane & 31, hh = F.lane >> 5, sl = F.wave;
            f32x16 S[4];
#pragma unroll
            for (int dt = 0; dt < 4; ++dt)
#pragma unroll
                for (int i = 0; i < 16; ++i) S[dt][i] = 0.f;
            f32x16 un[2];
            if (F.wave >= 4) {
                const int t4 = F.tid - 256; const unsigned char* g0 = GF + opaque_off((size_t)(bh * 32) * 57344 + (size_t)t4 * 16);
#pragma unroll
                for (int q = 0; q < 14; ++q) *(LAS u32x4*)(F.lds + (t4 + 256 * q) * 16) = *(const u32x4*)(g0 + (size_t)q * 4096);
            } else {
#pragma unroll
                for (int it = 0; it < 2; ++it) { const f32x4* up = (const f32x4*)(GU + opaque_off((size_t)(bh * 32) * 32768 + (size_t)((sl * 2 + it) * 64 + F.lane) * 64));
#pragma unroll
                    for (int g4 = 0; g4 < 4; ++g4) { const f32x4 t4 = up[g4]; un[it][4 * g4] = t4[0]; un[it][4 * g4 + 1] = t4[1]; un[it][4 * g4 + 2] = t4[2]; un[it][4 * g4 + 3] = t4[3]; } }
            }
            __syncthreads();
            for (int n = 0; n < NCHK; ++n) {
                const int ch = bh * 32 + n; const bool more = (n + 1 < NCHK);
                if (F.wave >= 4) {
                    if (more) {
                        const unsigned char* gn = GF + opaque_off((size_t)(ch + 1) * 57344 + (size_t)(F.tid - 256) * 16); LAS unsigned char* nb = F.lds + ((n + 1) & 1) * 57344; const int t4 = F.tid - 256;
#pragma unroll
                        for (int q = 0; q < 14; ++q) *(LAS u32x4*)(nb + (t4 + 256 * q) * 16) = *(const u32x4*)(gn + (size_t)q * 4096);
                    }
                } else {
                    const LAS unsigned char* buf = F.lds + (n & 1) * 57344 + F.lane * 16;
                    const float eg = EG[ch];
                    bf16x8 Sb[8];
#pragma unroll
                    for (int dt = 0; dt < 4; ++dt) { Sb[2 * dt] = pack_acc(S[dt], 0); Sb[2 * dt + 1] = pack_acc(S[dt], 1); }
                    f32x16 vn[2]; vn[0] = un[0]; vn[1] = un[1];
#pragma unroll
                    for (int it = 0; it < 2; ++it)
#pragma unroll
                        for (int ks = 0; ks < 8; ++ks) vn[it] = MFMA32(*(const LAS bf16x8*)(buf + (it * 8 + ks) * 1024), Sb[ks], vn[it]);
                    __builtin_amdgcn_sched_barrier(0);
                    f32x16 oa[2];
#pragma unroll
                    for (int it = 0; it < 2; ++it) {
#pragma unroll
                        for (int i = 0; i < 16; ++i) oa[it][i] = 0.f;
#pragma unroll
                        for (int ks = 0; ks < 8; ++ks) oa[it] = MFMA32(*(const LAS bf16x8*)(buf + (16 + it * 8 + ks) * 1024), Sb[ks], oa[it]);
                    }
                    __builtin_amdgcn_sched_barrier(0);
                    bf16x8 vb[4];
#pragma unroll
                    for (int it = 0; it < 2; ++it) { vb[2 * it] = pack_acc(vn[it], 0); vb[2 * it + 1] = pack_acc(vn[it], 1); }
                    __builtin_amdgcn_sched_barrier(0);
                    {
                        const int chn = more ? ch + 1 : ch;
#pragma unroll
                        for (int it = 0; it < 2; ++it) { const f32x4* up = (const f32x4*)(GU + opaque_off((size_t)chn * 32768 + (size_t)((sl * 2 + it) * 64 + F.lane) * 64));
#pragma unroll
                            for (int g4 = 0; g4 < 4; ++g4) { const f32x4 t4 = up[g4]; un[it][4 * g4] = t4[0]; un[it][4 * g4 + 1] = t4[1]; un[it][4 * g4 + 2] = t4[2]; un[it][4 * g4 + 3] = t4[3]; } }
                    }
                    __builtin_amdgcn_sched_barrier(0);
#pragma unroll
                    for (int it = 0; it < 2; ++it)
#pragma unroll
                        for (int ks = 0; ks < 4; ++ks) oa[it] = MFMA32(*(const LAS bf16x8*)(buf + (32 + it * 4 + ks) * 1024), vb[ks], oa[it]);
#pragma unroll
                    for (int it = 0; it < 2; ++it) {
#pragma unroll
                        for (int g4 = 0; g4 < 4; ++g4) { float* op = GO + opaque_off((size_t)(b * SEQ + n * CHK + 32 * it + 8 * g4 + 4 * hh) * 1024 + hd * 128 + sl * 32 + r);
#pragma unroll
                            for (int q = 0; q < 4; ++q) op[q * 1024] = oa[it][4 * g4 + q]; } }
                    __builtin_amdgcn_sched_barrier(0);
#pragma unroll
                    for (int dt = 0; dt < 4; ++dt) {
#pragma unroll
                        for (int i = 0; i < 16; ++i) S[dt][i] *= eg;
#pragma unroll
                        for (int ks = 0; ks < 4; ++ks) S[dt] = MFMA32(*(const LAS bf16x8*)(buf + (40 + dt * 4 + ks) * 1024), vb[ks], S[dt]);
                    }
                }
                LDS_WAIT(); __builtin_amdgcn_s_barrier(); asm volatile("" ::: "memory");
            }
            __syncthreads();
        }
    }
    SEAM(4);

    if (IN(5)) { PHASE_FRESH();
        for (int m = F.gw; m < T; m += F.NGW) {
            const int s = m & (SEQ - 1), c0 = F.lane * 16;
            const bf16* prow = PB + (size_t)m * NP;
            {
                const f32x4* op = (const f32x4*)(GO + (size_t)m * 1024 + c0);
                f32x4 o[4]; float ss = 0.f;
#pragma unroll
                for (int q = 0; q < 4; ++q) { o[q] = op[q]; ss += o[q][0] * o[q][0] + o[q][1] * o[q][1] + o[q][2] * o[q][2] + o[q][3] * o[q][3]; }
                ss += __shfl_xor(ss, 1); ss += __shfl_xor(ss, 2); ss += __shfl_xor(ss, 4);
                const float rms = rsqrtf(ss * (1.f / 128.f) + 1e-6f);
                const u32x4* zp = (const u32x4*)(prow + 3072 + c0); const u32x4 z0 = zp[0], z1 = zp[1];
                const unsigned zw[8] = {z0.x, z0.y, z0.z, z0.w, z1.x, z1.y, z1.z, z1.w};
                const f32x4* nwp = (const f32x4*)(gdn_norm_w + (c0 & 127));
                unsigned ow[8];
#pragma unroll
                for (int q = 0; q < 4; ++q) { const f32x4 nw = nwp[q];
                    const float y0 = o[q][0] * rms * nw[0] * silu_f(bflo(zw[2 * q])), y1 = o[q][1] * rms * nw[1] * silu_f(bfhi(zw[2 * q]));
                    const float y2 = o[q][2] * rms * nw[2] * silu_f(bflo(zw[2 * q + 1])), y3 = o[q][3] * rms * nw[3] * silu_f(bfhi(zw[2 * q + 1]));
                    ow[2 * q] = cvtpk(y0, y1); ow[2 * q + 1] = cvtpk(y2, y3); }
                u32x4* yp = (u32x4*)(YAB + (size_t)m * D + c0);
                yp[0] = (u32x4){ow[0], ow[1], ow[2], ow[3]}; yp[1] = (u32x4){ow[4], ow[5], ow[6], ow[7]};
            }
            {
                float accv[16];
#pragma unroll
                for (int q = 0; q < 16; ++q) accv[q] = 0.f;
#pragma unroll
                for (int j = 0; j < 3; ++j) {
                    if (s - 2 + j >= 0) {
                        const bf16* pr = prow + (ptrdiff_t)(j - 2) * NP;
                        const u32x4* cp = (const u32x4*)(pr + 5120 + c0); const u32x4* hp = (const u32x4*)(pr + 6144 + c0);
                        const u32x4 ca = cp[0], cb = cp[1], ha = hp[0], hb = hp[1];
                        const unsigned cw[8] = {ca.x, ca.y, ca.z, ca.w, cb.x, cb.y, cb.z, cb.w}, hw[8] = {ha.x, ha.y, ha.z, ha.w, hb.x, hb.y, hb.z, hb.w};
                        const f32x4* wp = (const f32x4*)(sc_conv_w + j * 1024 + c0);
#pragma unroll
                        for (int q = 0; q < 4; ++q) { const f32x4 w4 = wp[q];
                            accv[4 * q] += w4[0] * bflo(cw[2 * q]) * bflo(hw[2 * q]); accv[4 * q + 1] += w4[1] * bfhi(cw[2 * q]) * bfhi(hw[2 * q]);
                            accv[4 * q + 2] += w4[2] * bflo(cw[2 * q + 1]) * bflo(hw[2 * q + 1]); accv[4 * q + 3] += w4[3] * bfhi(cw[2 * q + 1]) * bfhi(hw[2 * q + 1]); }
                    }
                }
                const u32x4* bp = (const u32x4*)(prow + 4096 + c0); const u32x4 ba = bp[0], bb = bp[1];
                const unsigned bw[8] = {ba.x, ba.y, ba.z, ba.w, bb.x, bb.y, bb.z, bb.w};
                unsigned ow[8];
#pragma unroll
                for (int q = 0; q < 8; ++q) ow[q] = cvtpk(bflo(bw[q]) * accv[2 * q], bfhi(bw[q]) * accv[2 * q + 1]);
                u32x4* yp = (u32x4*)(YAB + (size_t)m * D + 1024 + c0);
                yp[0] = (u32x4){ow[0], ow[1], ow[2], ow[3]}; yp[1] = (u32x4){ow[4], ow[5], ow[6], ow[7]};
            }
        }
    }
    SEAM(5);

    if (IN(6)) { PHASE_FRESH();
        pg8::StaticOrder S; S.init(YAB, WOUT0, T, D, D, F.G, (int)blockIdx.x);
        pg8::EpiResid E{in_x, MOD + 2 * D, RB};
        pg8::gemm_phase<pg8::EpiResid, pg8::StaticOrder>(F.lds, D, S, E, F.tid, F.wave);
    }
    SEAM(6);

    if (IN(7)) { PHASE_FRESH();
        for (int m = F.gw; m < T; m += F.NGW) {
            const int b = m / SEQ; const float* modb = MOD + (size_t)b * 12288;
            f32x4 v[8];
#pragma unroll
            for (int j = 0; j < 8; ++j) v[j] = ((const f32x4*)(RB + (size_t)m * D))[F.lane + 64 * j];
            LN_ROW(v, ln_g, ln_b);
            bf16* hrow = HIN + (size_t)m * D;
            WRITE_X_HIN(v, XA + (size_t)m * D, hrow, modb + 3 * D, modb + 4 * D);
        }
    }
    SEAM(7);

    moe_phases<0>(F, args, bar, lo, hi, TAB);

        if (IN(14)) { PHASE_FRESH();
            pg8::StaticOrder S; S.init(HIN, WMIN, T, NMLA, D, F.G, (int)blockIdx.x);
            pg8::EpiF32 E{C1, NMLA};
            pg8::gemm_phase<pg8::EpiF32, pg8::StaticOrder>(F.lds, D, S, E, F.tid, F.wave);
        }
        SEAM(14);
        if (IN(15)) { PHASE_FRESH();
            for (int m = F.gw; m < T; m += F.NGW) {
                const float* c1 = C1 + (size_t)m * NMLA;
#pragma unroll
                for (int part = 0; part < 2; ++part) {
                    const f32x4* p = (const f32x4*)(c1 + part * 512 + 8 * F.lane); const f32x4 a0 = p[0], a1 = p[1];
                    const float ss = wave_sum((a0[0] * a0[0] + a0[1] * a0[1]) + (a0[2] * a0[2] + a0[3] * a0[3]) + (a1[0] * a1[0] + a1[1] * a1[1]) + (a1[2] * a1[2] + a1[3] * a1[3]));
                    const float rn = rsqrtf(ss * (1.f / 512.f) + 1e-6f);
                    const f32x4* wp = (const f32x4*)((part == 0 ? mla_q_norm : mla_kv_norm) + 8 * F.lane); const f32x4 w0 = wp[0], w1 = wp[1];
                    u32x4 o; o.x = cvtpk(a0[0] * rn * w0[0], a0[1] * rn * w0[1]); o.y = cvtpk(a0[2] * rn * w0[2], a0[3] * rn * w0[3]);
                    o.z = cvtpk(a1[0] * rn * w1[0], a1[1] * rn * w1[1]); o.w = cvtpk(a1[2] * rn * w1[2], a1[3] * rn * w1[3]);
                    *(u32x4*)((part == 0 ? CQN : CKVN) + (size_t)m * 512 + 8 * F.lane) = o;
                }
                if (F.lane < 32) { const float x1 = c1[1024 + F.lane], x2 = c1[1056 + F.lane], cs = ROPE_C[(size_t)m * 32 + F.lane], sn = ROPE_S[(size_t)m * 32 + F.lane];
                    KPE[(size_t)m * 64 + F.lane] = x1 * cs - x2 * sn; KPE[(size_t)m * 64 + 32 + F.lane] = x1 * sn + x2 * cs; }
            }
        }
        SEAM(15);
        if (IN(16)) { PHASE_FRESH();
            { pg8::StaticOrder S; S.init(CQN, WUQ, T, 3072, 512, F.G, (int)blockIdx.x); pg8::EpiQup E{QB_};
              pg8::gemm_phase<pg8::EpiQup, pg8::StaticOrder>(F.lds, 512, S, E, F.tid, F.wave); }
            { pg8::StaticOrder S; S.init(CKVN, WUKV, T, 4096, 512, F.G, (int)blockIdx.x); pg8::EpiKVup E{KB_, VB_};
              pg8::gemm_phase<pg8::EpiKVup, pg8::StaticOrder>(F.lds, 512, S, E, F.tid, F.wave); }
        }
        SEAM(16);
        if (IN(17)) { PHASE_FRESH();
            for (int m = F.gw; m < T; m += F.NGW) {
                const int b = m / SEQ, s = m - b * SEQ, hd = F.lane >> 2, i0 = (F.lane & 3) * 8;
                const size_t rowoff = ((size_t)((b * MH + hd) * SEQ + s)) * QD + 128;
                bf16* qp = QB_ + rowoff;
                const u32x4 xa = *(const u32x4*)(qp + i0), xb = *(const u32x4*)(qp + 32 + i0);
                const f32x4* cp = (const f32x4*)(ROPE_C + (size_t)m * 32 + i0); const f32x4* sp = (const f32x4*)(ROPE_S + (size_t)m * 32 + i0);
                const f32x4 c0 = cp[0], c1v = cp[1], s0 = sp[0], s1 = sp[1];
                const float cs[8] = {c0[0], c0[1], c0[2], c0[3], c1v[0], c1v[1], c1v[2], c1v[3]}, sn[8] = {s0[0], s0[1], s0[2], s0[3], s1[0], s1[1], s1[2], s1[3]};
                const unsigned xaw[4] = {xa.x, xa.y, xa.z, xa.w}, xbw[4] = {xb.x, xb.y, xb.z, xb.w};
                unsigned o1[4], o2[4];
#pragma unroll
                for (int q = 0; q < 4; ++q) { const float a0 = bflo(xaw[q]), a1 = bfhi(xaw[q]), b0 = bflo(xbw[q]), b1 = bfhi(xbw[q]);
                    o1[q] = cvtpk(a0 * cs[2 * q] - b0 * sn[2 * q], a1 * cs[2 * q + 1] - b1 * sn[2 * q + 1]);
                    o2[q] = cvtpk(a0 * sn[2 * q] + b0 * cs[2 * q], a1 * sn[2 * q + 1] + b1 * cs[2 * q + 1]); }
                *(u32x4*)(qp + i0) = (u32x4){o1[0], o1[1], o1[2], o1[3]}; *(u32x4*)(qp + 32 + i0) = (u32x4){o2[0], o2[1], o2[2], o2[3]};
                const f32x4* kp = (const f32x4*)(KPE + (size_t)m * 64 + i0); const f32x4* kp2 = (const f32x4*)(KPE + (size_t)m * 64 + 32 + i0);
                const f32x4 k0 = kp[0], k1 = kp[1], k2 = kp2[0], k3 = kp2[1];
                bf16* kd = KB_ + rowoff;
                *(u32x4*)(kd + i0) = (u32x4){cvtpk(k0[0], k0[1]), cvtpk(k0[2], k0[3]), cvtpk(k1[0], k1[1]), cvtpk(k1[2], k1[3])};
                *(u32x4*)(kd + 32 + i0) = (u32x4){cvtpk(k2[0], k2[1]), cvtpk(k2[2], k2[3]), cvtpk(k3[0], k3[1]), cvtpk(k3[2], k3[3])};
            }
            {
                LAS bf16* scr = (LAS bf16*)(F.lds + F.wave * 17408);
                for (int it = F.gw; it < 64 * 32; it += F.NGW) {
                    const int bhh = it >> 5, sb = it & 31, b = bhh >> 4, hd = bhh & 15, s0 = sb * 64;
#pragma unroll 4
                    for (int i = 0; i < 16; ++i) { const int row = 4 * i + (F.lane >> 4), c8 = (F.lane & 15) * 8;
                        *(LAS u32x4*)(scr + row * 136 + c8) = *(const u32x4*)(VB_ + (size_t)(b * SEQ + s0 + row) * D + hd * 128 + c8); }
                    LDS_WAIT(); asm volatile("" ::: "memory");
                    bf16* dst = VT + ((size_t)bhh * 128) * SEQ + s0 + F.lane;
#pragma unroll 8
                    for (int dv = 0; dv < 128; ++dv) dst[(size_t)dv * SEQ] = scr[F.lane * 136 + dv];
                    LDS_WAIT(); asm volatile("" ::: "memory");
                }
            }
        }
        SEAM(17);
        if (IN(18)) { PHASE_FRESH();
            constexpr int KBUF = 64 * 400, VBUF = 128 * 136;
            LAS unsigned char* KL = F.lds; LAS unsigned char* VL = F.lds + 2 * KBUF;
            const int w = F.wave;
            for (int pi = blockIdx.x; pi < 256; pi += F.G) {
                const int bhh = pi >> 2, pp = pi & 3, b = bhh >> 4, hd = bhh & 15;
                const char* kg = (const char*)(KB_ + (size_t)bhh * SEQ * QD); const char* vg = (const char*)(VT + (size_t)bhh * 128 * SEQ);
                for (int half = 0; half < 2; ++half) {
                    PHASE_FRESH(); const int r = F.lane & 31, hh = F.lane >> 5;
                    const int qb = half == 0 ? 7 - pp : pp, q0 = qb * 256, ntile = 4 * (qb + 1), qrow = q0 + 32 * w + r;
                    bf16x8 qf[12];
                    { const bf16* qp = QB_ + ((size_t)bhh * SEQ + qrow) * QD + 8 * hh;
#pragma unroll
                      for (int ks = 0; ks < 12; ++ks) qf[ks] = *(const bf16x8*)(qp + 16 * ks); }
                    f32x16 oT[4];
#pragma unroll
                    for (int mt = 0; mt < 4; ++mt)
#pragma unroll
                        for (int i = 0; i < 16; ++i) oT[mt][i] = 0.f;
                    float mrun = -1e30f, lsum = 0.f;
                    u32x4 kst[3], vst[2];
#pragma unroll
                    for (int q = 0; q < 3; ++q) kst[q] = *(const u32x4*)(kg + (size_t)(F.tid + 512 * q) * 16);
#pragma unroll
                    for (int q = 0; q < 2; ++q) { const int p = F.tid + 512 * q; vst[q] = *(const u32x4*)(vg + (size_t)(p >> 3) * (SEQ * 2) + (p & 7) * 16); }
#pragma unroll
                    for (int q = 0; q < 3; ++q) { const int p = F.tid + 512 * q; *(LAS u32x4*)(KL + (p / 24) * 400 + (p % 24) * 16) = kst[q]; }
#pragma unroll
                    for (int q = 0; q < 2; ++q) { const int p = F.tid + 512 * q; LAS unsigned char* d = VL + (p >> 3) * 136 + (p & 7) * 16;
                        *(LAS u32x2*)d = (u32x2){vst[q].x, vst[q].y}; *(LAS u32x2*)(d + 8) = (u32x2){vst[q].z, vst[q].w}; }
                    __syncthreads();
                    for (int kt = 0; kt < ntile; ++kt) {
                        const bool more = (kt + 1 < ntile); const int k0 = kt * 64;
                        if (more) {
                            const int k1 = k0 + 64;
#pragma unroll
                            for (int q = 0; q < 3; ++q) kst[q] = *(const u32x4*)(kg + (size_t)k1 * (QD * 2) + (size_t)(F.tid + 512 * q) * 16);
#pragma unroll
                            for (int q = 0; q < 2; ++q) { const int p = F.tid + 512 * q; vst[q] = *(const u32x4*)(vg + (size_t)(p >> 3) * (SEQ * 2) + (size_t)k1 * 2 + (p & 7) * 16); }
                        }
                        if (k0 <= q0 + 32 * w + 31) {
                            const LAS unsigned char* kb = KL + (kt & 1) * KBUF; const LAS unsigned char* vb_ = VL + (kt & 1) * VBUF;
                            f32x16 sT[2];
#pragma unroll
                            for (int kk = 0; kk < 2; ++kk) {
#pragma unroll
                                for (int i = 0; i < 16; ++i) sT[kk][i] = 0.f;
#pragma unroll
                                for (int ks = 0; ks < 12; ++ks) sT[kk] = MFMA32(*(const LAS bf16x8*)(kb + (32 * kk + r) * 400 + (16 * ks + 8 * hh) * 2), qf[ks], sT[kk]);
                            }
                            if (k0 + 63 > q0 + 32 * w) {
#pragma unroll
                                for (int kk = 0; kk < 2; ++kk)
#pragma unroll
                                    for (int reg = 0; reg < 16; ++reg) { const int key = k0 + 32 * kk + crow(reg, hh); if (key > qrow) sT[kk][reg] = -1e30f; }
                            }
                            float mloc = sT[0][0];
#pragma unroll
                            for (int kk = 0; kk < 2; ++kk)
#pragma unroll
                                for (int reg = 0; reg < 16; ++reg) mloc = fmaxf(mloc, sT[kk][reg]);
                            mloc = fmaxf(mloc, __shfl_xor(mloc, 32));
                            const float mnew = fmaxf(mrun, mloc), alpha = __builtin_amdgcn_exp2f(mrun - mnew);
                            float ps = 0.f;
#pragma unroll
                            for (int kk = 0; kk < 2; ++kk)
#pragma unroll
                                for (int reg = 0; reg < 16; ++reg) { const float pe = __builtin_amdgcn_exp2f(sT[kk][reg] - mnew); sT[kk][reg] = pe; ps += pe; }
                            lsum = lsum * alpha + ps; mrun = mnew;
#pragma unroll
                            for (int mt = 0; mt < 4; ++mt)
#pragma unroll
                                for (int i = 0; i < 16; ++i) oT[mt][i] *= alpha;
                            bf16x8 pb[4];
#pragma unroll
                            for (int kk = 0; kk < 2; ++kk) { pb[2 * kk] = pack_acc(sT[kk], 0); pb[2 * kk + 1] = pack_acc(sT[kk], 1); }
#pragma unroll
                            for (int mt = 0; mt < 4; ++mt)
#pragma unroll
                                for (int ks = 0; ks < 4; ++ks) { const LAS unsigned char* vp = vb_ + (32 * mt + r) * 136 + (16 * ks + 4 * hh) * 2;
                                    const u32x2 vlo = *(const LAS u32x2*)vp, vhi = *(const LAS u32x2*)(vp + 16);
                                    const u32x4 va = {vlo.x, vlo.y, vhi.x, vhi.y};
                                    oT[mt] = MFMA32(__builtin_bit_cast(bf16x8, va), pb[ks], oT[mt]); }
                        }
                        if (more) {
                            LAS unsigned char* kn = KL + ((kt + 1) & 1) * KBUF; LAS unsigned char* vn_ = VL + ((kt + 1) & 1) * VBUF;
#pragma unroll
                            for (int q = 0; q < 3; ++q) { const int p = F.tid + 512 * q; *(LAS u32x4*)(kn + (p / 24) * 400 + (p % 24) * 16) = kst[q]; }
#pragma unroll
                            for (int q = 0; q < 2; ++q) { const int p = F.tid + 512 * q; LAS unsigned char* d = vn_ + (p >> 3) * 136 + (p & 7) * 16;
                                *(LAS u32x2*)d = (u32x2){vst[q].x, vst[q].y}; *(LAS u32x2*)(d + 8) = (u32x2){vst[q].z, vst[q].w}; }
                        }
                        __syncthreads();
                    }
                    const float ltot = lsum + __shfl_xor(lsum, 32), inv = 1.f / ltot;
                    bf16* orow = YAB + (size_t)(b * SEQ + qrow) * D + hd * 128 + 4 * hh;
#pragma unroll
                    for (int mt = 0; mt < 4; ++mt)
#pragma unroll
                        for (int g4 = 0; g4 < 4; ++g4) { u32x2 o; o.x = cvtpk(oT[mt][4 * g4] * inv, oT[mt][4 * g4 + 1] * inv); o.y = cvtpk(oT[mt][4 * g4 + 2] * inv, oT[mt][4 * g4 + 3] * inv);
                            *(u32x2*)(orow + 32 * mt + 8 * g4) = o; }
                }
            }
        }
        SEAM(18);
        if (IN(19)) { PHASE_FRESH();
            pg8::StaticOrder S; S.init(YAB, WMOUT, T, D, D, F.G, (int)blockIdx.x);
            pg8::EpiResid E{XB, MOD + (size_t)4 * 12288 + 2 * D, RB};
            pg8::gemm_phase<pg8::EpiResid, pg8::StaticOrder>(F.lds, D, S, E, F.tid, F.wave);
        }
        SEAM(19);
        if (IN(20)) { PHASE_FRESH();
            for (int m = F.gw; m < T; m += F.NGW) {
                const int b = m / SEQ; const float* modb = MOD + (size_t)(4 + b) * 12288;
                f32x4 v[8];
#pragma unroll
                for (int j = 0; j < 8; ++j) v[j] = ((const f32x4*)(RB + (size_t)m * D))[F.lane + 64 * j];
                LN_ROW(v, ln_g + 2 * D, ln_b + 2 * D);
                bf16* hrow = HIN + (size_t)m * D;
                WRITE_X_HIN(v, XA + (size_t)m * D, hrow, modb + 3 * D, modb + 4 * D);
            }
        }
        SEAM(20);

    moe_phases<1>(F, args, bar, lo, hi, TAB);
#undef IN
#undef INL
#undef SEAM
#undef WSB
#undef in_x
#undef in_c
#undef in_pos
#undef ada_w
#undef ada_b
#undef ln_g
#undef ln_b
#undef hyb_w_in
#undef gdn_conv_w
#undef gdn_a_log
#undef gdn_dt_bias
#undef gdn_norm_w
#undef sc_conv_w
#undef hyb_w_out
#undef mla_w_in
#undef mla_q_norm
#undef mla_kv_norm
#undef mla_w_uq
#undef mla_w_ukv
#undef mla_w_out
#undef moe_router_g
#undef moe_bias_g
#undef moe_router_e
#undef moe_bias_e
#undef moe_w_gate
#undef moe_w_up
#undef moe_w_down
#undef MOD
#undef ROPE_C
#undef ROPE_S
#undef PBA
#undef LOGITS
#undef TOK_E
#undef TOK_POS
#undef TOK_GATE
#undef EG
#undef WIN0
#undef WOUT0
#undef WMIN
#undef WUQ
#undef WUKV
#undef WMOUT
#undef WRT
#undef WGU
#undef WDN
#undef HIN
#undef XA
#undef XB
#undef RB
#undef PB
#undef GF
#undef GU
#undef GO
#undef YAB
#undef LISTP
#undef HID
#undef YS
#undef C1
#undef CQN
#undef CKVN
#undef KPE
#undef QB_
#undef KB_
#undef VB_
#undef VT
}

extern "C" void kernel_launch(void* const* d_in, const int* in_sizes, int n_in, void* d_out, int out_size, void* d_ws, size_t ws_size, hipStream_t stream) {
    static int grid = 0;
    if (grid == 0) {
        if (n_in != 27 || in_sizes[0] != T * D || out_size != T * D || ws_size < WS_END) { fprintf(stderr, "kernel_launch: unexpected problem (n_in %d, in0 %d, out %d, ws %zu)\n", n_in, n_in > 0 ? in_sizes[0] : -1, out_size, ws_size); grid = -1; return; }
        int dev = 0, cus = 0, per_cu = 0;
        if (hipGetDevice(&dev) != hipSuccess || hipDeviceGetAttribute(&cus, hipDeviceAttributeMultiprocessorCount, dev) != hipSuccess) { grid = -1; return; }
        if (hipFuncSetAttribute((const void*)mega, hipFuncAttributeMaxDynamicSharedMemorySize, LDS_BYTES) != hipSuccess) { fprintf(stderr, "kernel_launch: hipFuncSetAttribute failed\n"); grid = -1; return; }
        if (hipOccupancyMaxActiveBlocksPerMultiprocessor(&per_cu, (const void*)mega, 512, LDS_BYTES) != hipSuccess || per_cu < 1) fprintf(stderr, "kernel_launch: occupancy query reports %d\n", per_cu);
        (void)hipGetLastError();
        grid = cus;
    }
    if (grid < 0) return;
    (void)hipMemsetAsync((char*)d_ws + WS_CTL, 0, CTL_ZERO_BYTES, stream);
    Args a{};
    for (int i = 0; i < 27; ++i) a.in[i] = d_in[i];
    a.out = (float*)d_out; a.ws = (unsigned char*)d_ws;
#if MK_ONE_LAUNCH
    a.ph_lo = 0; a.ph_hi = NPH;
    hipLaunchKernelGGL(mega, dim3(grid), dim3(512), LDS_BYTES, stream, a);
#else
    for (int k = 0; k < NPH; ++k) { a.ph_lo = k; a.ph_hi = k + 1; hipLaunchKernelGGL(mega, dim3(grid), dim3(512), LDS_BYTES, stream, a); }
#endif
}
```

```cpp
#include <hip/hip_runtime.h>
#include <cstdio>
#include <cstdint>

#ifndef MK_ONE_LAUNCH
#define MK_ONE_LAUNCH 1
#endif

#define DI __device__ __forceinline__
#define GAS __attribute__((address_space(1)))
#define LAS __attribute__((address_space(3)))
typedef unsigned short bf16;
typedef float f32x4 __attribute__((ext_vector_type(4)));
typedef float f32x2 __attribute__((ext_vector_type(2)));
typedef float f32x16 __attribute__((ext_vector_type(16)));
typedef short bf16x8 __attribute__((ext_vector_type(8)));
typedef short s16x4 __attribute__((ext_vector_type(4)));
typedef unsigned u32x4 __attribute__((ext_vector_type(4)));
typedef unsigned u32x2 __attribute__((ext_vector_type(2)));
typedef __bf16 bf16x2_t __attribute__((ext_vector_type(2)));
typedef GAS unsigned gu32;
#define RLX_AGENT __ATOMIC_RELAXED, __HIP_MEMORY_SCOPE_AGENT
#define LDS_WAIT() asm volatile("s_waitcnt lgkmcnt(0)" ::: "memory")
#define VM_WAIT() asm volatile("s_waitcnt vmcnt(0)" ::: "memory")
#define MFMA32(a, b, c) __builtin_amdgcn_mfma_f32_32x32x16_bf16((a), (b), (c), 0, 0, 0)

DI unsigned cvtpk(float lo, float hi) { f32x2 v = {lo, hi}; bf16x2_t b = __builtin_convertvector(v, bf16x2_t); return __builtin_bit_cast(unsigned, b); }
DI bf16 f2bf(float f) { return (bf16)(cvtpk(f, 0.f) & 0xffffu); }
DI float bf2f(bf16 b) { return __uint_as_float(((unsigned)b) << 16); }
DI float bflo(unsigned w) { return __uint_as_float(w << 16); }
DI float bfhi(unsigned w) { return __uint_as_float(w & 0xffff0000u); }
DI int crow(int reg, int h) { return (reg & 3) + 8 * (reg >> 2) + 4 * h; }
DI int kperm(int j, int h) { return 8 * (j >> 2) + 4 * h + (j & 3); }
DI float wave_sum(float v) {
#pragma unroll
    for (int o = 1; o < 64; o <<= 1) v += __shfl_xor(v, o);
    return v;
}
DI bf16x8 pack_acc(const f32x16& x, int s) {
    u32x4 p; p.x = cvtpk(x[8 * s + 0], x[8 * s + 1]); p.y = cvtpk(x[8 * s + 2], x[8 * s + 3]); p.z = cvtpk(x[8 * s + 4], x[8 * s + 5]); p.w = cvtpk(x[8 * s + 6], x[8 * s + 7]);
    return __builtin_bit_cast(bf16x8, p);
}
DI float silu_f(float x) { return x / (1.f + __expf(-x)); }
DI size_t opaque_off(size_t o) { asm volatile("" : "+v"(o)); return o; }

constexpr int D = 2048, BATCH = 4, SEQ = 2048, T = BATCH * SEQ;
constexpr int GH = 8, GD = 128, NCHK = 32, CHK = 64, NCH = BATCH * GH * NCHK;
constexpr int HYB_IN = 7184, NIN = 7424, NP = 7168;
constexpr int MH = 16, MLA_IN = 1088, NMLA = 1280, QD = 192;
constexpr int NE = 64, FF = 512, MAXBLK = 128;
constexpr float DN_ALPHA = 1.41421356237f;
constexpr float QSCALE = 0.10411754627697264f;
constexpr int NPH = 27;

constexpr size_t MiB = 1u << 20;
constexpr size_t WS_CTL = 0, CTL_ZERO_BYTES = 1 * MiB;
constexpr size_t WS_MOD = 1 * MiB;
constexpr size_t WS_ROPE = 2 * MiB;
constexpr size_t WS_PBA = 4 * MiB;
constexpr size_t WS_LOGITS = 5 * MiB;
constexpr size_t WS_ROUTE = 9 * MiB;
constexpr size_t WS_EG = 10 * MiB;
constexpr size_t WS_WIN0 = 16 * MiB;
constexpr size_t WS_WOUT0 = 46 * MiB;
constexpr size_t WS_WMIN = 54 * MiB;
constexpr size_t WS_WUQ = 59 * MiB;
constexpr size_t WS_WUKV = 62 * MiB;
constexpr size_t WS_WMOUT = 66 * MiB;
constexpr size_t WS_WRT = 74 * MiB;
constexpr size_t WS_WGU = 80 * MiB;
constexpr size_t WS_WDN = 592 * MiB;
constexpr size_t WS_HIN = 848 * MiB;
constexpr size_t WS_XA = 880 * MiB;
constexpr size_t WS_XB = 944 * MiB;
constexpr size_t WS_R = 1008 * MiB;
constexpr size_t WS_P = 1072 * MiB;
constexpr size_t WS_GF = 1184 * MiB;
constexpr size_t WS_GU = 1240 * MiB;
constexpr size_t WS_GO = 1272 * MiB;
constexpr size_t WS_YAB = 1304 * MiB;
constexpr size_t WS_XS = 1336 * MiB;
constexpr size_t WS_HID = 1464 * MiB;
constexpr size_t WS_YS = 1496 * MiB;
constexpr size_t WS_C1 = 1624 * MiB;
constexpr size_t WS_CQN = 1664 * MiB;
constexpr size_t WS_CKVN = 1672 * MiB;
constexpr size_t WS_KPE = 1680 * MiB;
constexpr size_t WS_Q = 1684 * MiB;
constexpr size_t WS_K = 1732 * MiB;
constexpr size_t WS_V = 1780 * MiB;
constexpr size_t WS_VT = 1812 * MiB;
constexpr size_t WS_END = 1844 * MiB;
constexpr int CW_BAR = 4096;
constexpr int CW_CNT = 8192;
constexpr int CW_BLK = 8448;

constexpr int RING_BYTES = 131072;
constexpr int LDSCTL_OFF = 143360, MISC_OFF = LDSCTL_OFF + 320;
constexpr int TAB_OFF = LDSCTL_OFF + 512;
constexpr int SC_OFF = LDSCTL_OFF + 1536;
constexpr int LDS_BYTES = 147456;

namespace pg8 {
constexpr int BM = 256, BK = 64, HALF = 128, HTB = HALF * BK * 2, STAGE_BYTES = 8 * HTB, NXCD = 8, WGM = 8;
__host__ __device__ __forceinline__ int lds_byte(int r, int c) { const int st = (r >> 4) * 2 + (c >> 5), rr = r & 15, cc = c & 31, ob = rr * 64 + cc * 2; return st * 1024 + (ob ^ (((ob >> 9) & 1) << 5)); }
__host__ __device__ __forceinline__ void stage_rc(int b, int& R, int& C) { const int st = b / 1024, sb = b % 1024, swz = sb ^ (((sb >> 9) & 1) << 5); R = (st >> 1) * 16 + swz / 64; C = (st & 1) * 32 + (swz % 64) / 2; }
__host__ __device__ __forceinline__ int perm32(int rho) { const int n = rho >> 4, i = rho & 15; return 8 * (i >> 2) + 4 * n + (i & 3); }

struct Unit { int pm, pn, ex, rows; };

struct StaticOrder {
    int nM, nN, nwg, G, c; const char* A; const char* Bt; size_t tstep;
    __device__ void init(const bf16* A_, const bf16* Bt_, int M, int N, int K, int G_, int c_) { nM = M / BM; nN = N / BM; nwg = nM * nN; G = G_; c = c_; A = (const char*)A_; Bt = (const char*)Bt_; tstep = (size_t)BM * K * 2; }
    __device__ bool next(int i, Unit& u) const {
        const long L = (long)i * G + c; if (L >= nwg) return false;
        int wgid = (int)L; { const int q = nwg / NXCD, r = nwg % NXCD, xcd = wgid % NXCD, off = wgid / NXCD; wgid = (xcd < r ? xcd * (q + 1) : r * (q + 1) + (xcd - r) * q) + off; }
        const int nig = WGM * nN, gid = wgid / nig, fm = gid * WGM, gsz = (nM - fm) < WGM ? (nM - fm) : WGM;
        u.pm = fm + ((wgid % nig) % gsz); u.pn = (wgid % nig) / gsz; u.ex = 0; u.rows = 256; return true;
    }
    __device__ __forceinline__ const char* aptr(const Unit& u) const { return A + (size_t)u.pm * tstep; }
    __device__ __forceinline__ const char* bptr(const Unit& u) const { return Bt + (size_t)u.pn * tstep; }
};
struct MoeOrder {
    int nunits, NT, G, c; const LAS int* blk_e; const char* A; const char* W; size_t a_tstep, w_estride, w_tstep;
    __device__ bool next(int i, Unit& u) const {
        const long L = (long)i * G + c; if (L >= nunits) return false;
        u.pm = (int)L / NT; u.pn = (int)L % NT; u.ex = blk_e[u.pm]; u.rows = 256; return true;
    }
    __device__ __forceinline__ const char* aptr(const Unit& u) const { return A + (size_t)u.pm * a_tstep; }
    __device__ __forceinline__ const char* bptr(const Unit& u) const { return W + (size_t)u.ex * w_estride + (size_t)u.pn * w_tstep; }
};

template <class Epi, class Sched, bool ALIGN_EPI = true, bool SP2 = true>
__device__ __forceinline__ void gemm_phase(LAS unsigned char* lds, const int K_, const Sched& S, const Epi& E, const int tid, const int wid) {
    const int lane = tid & 63, wr = wid >> 2, wc = wid & 3, fr = lane & 15, fq = lane >> 4;
    int K = K_; asm volatile("" : "+s"(K));
    const int nt = K / BK;
    unsigned voffA[2], voffB[2];
#pragma unroll
    for (int i = 0; i < 2; ++i) { int R, C; stage_rc(tid * 16 + i * 8192, R, C); const int Rb = Epi::PERM ? ((R & ~31) + perm32(R & 31)) : R;
        voffA[i] = (unsigned)(R * K + C) * 2u; voffB[i] = (unsigned)(Rb * K + C) * 2u; }
    const size_t kstep = (size_t)(BK * 2);
    const size_t hstep = (size_t)HALF * K * 2;
    const unsigned ldsw = (unsigned)wid * 1024u;
    const int aoff = lds_byte(wr * 64 + fr, fq * 8), boff = lds_byte(wc * 32 + fr, fq * 8);
#define PG8_SA(b, h) (((b) * 2 + (h)) * HTB)
#define PG8_SB(b, h) ((4 + (b) * 2 + (h)) * HTB)
#define PG8_STAGE(bufoff, gbase, voff) do { _Pragma("unroll") for (int _i = 0; _i < 2; ++_i) \
        __builtin_amdgcn_global_load_lds((const unsigned*)((const char*)(gbase) + (voff)[_i]), (LAS unsigned*)(lds + (bufoff) + ldsw + _i * 8192), 16, 0, 0); } while (0)
#define PG8_LDA(dst, b, h) do { _Pragma("unroll") for (int m = 0; m < 4; ++m) _Pragma("unroll") for (int k = 0; k < 2; ++k) dst[m][k] = *(const LAS bf16x8*)(lds + PG8_SA(b, h) + aoff + m * 2048 + k * 1024); } while (0)
#define PG8_LDB(dst, b, h) do { _Pragma("unroll") for (int n = 0; n < 2; ++n) _Pragma("unroll") for (int k = 0; k < 2; ++k) dst[n][k] = *(const LAS bf16x8*)(lds + PG8_SB(b, h) + boff + n * 2048 + k * 1024); } while (0)
#define PG8_MMA(ai, bj, At, Bt) do { __builtin_amdgcn_s_setprio(1); _Pragma("unroll") for (int m = 0; m < 4; ++m) _Pragma("unroll") for (int n = 0; n < 2; ++n) _Pragma("unroll") for (int k = 0; k < 2; ++k) \
        acc[ai][bj][m][n] = __builtin_amdgcn_mfma_f32_16x16x32_bf16(Bt[n][k], At[m][k], acc[ai][bj][m][n], 0, 0, 0); __builtin_amdgcn_s_setprio(0); } while (0)
#define PG8_WAIT_V(n) asm volatile("s_waitcnt vmcnt(" #n ")" ::: "memory")
#define PG8_WAIT_L(n) asm volatile("s_waitcnt lgkmcnt(" #n ")" ::: "memory")
#define PG8_BAR __builtin_amdgcn_s_barrier()
#define PG8_SCHED __builtin_amdgcn_sched_barrier(0)
    Unit cur, nxt; int ui = 0;
    if (!S.next(0, cur)) return;
    f32x4 acc[2][2][4][2];
#pragma unroll
    for (int a = 0; a < 2; ++a)
#pragma unroll
        for (int b = 0; b < 2; ++b)
#pragma unroll
            for (int m = 0; m < 4; ++m)
#pragma unroll
                for (int n = 0; n < 2; ++n) acc[a][b][m][n] = (f32x4){0.f, 0.f, 0.f, 0.f};
    bf16x8 At[4][2], B0[2][2], B1[2][2];
    const char* cA = S.aptr(cur); const char* cB = S.bptr(cur);
    if constexpr (SP2) {
        PG8_STAGE(PG8_SB(0, 0), cB, voffB); PG8_STAGE(PG8_SB(0, 1), cB + hstep, voffB); PG8_STAGE(PG8_SA(0, 0), cA, voffA); PG8_STAGE(PG8_SA(0, 1), cA + hstep, voffA);
        if (wr == 1) PG8_BAR;
        PG8_WAIT_V(2); PG8_BAR;
        PG8_STAGE(PG8_SB(1, 0), cB + kstep, voffB); PG8_STAGE(PG8_SA(1, 0), cA + kstep, voffA); PG8_STAGE(PG8_SB(1, 1), cB + hstep + kstep, voffB);
        PG8_WAIT_V(6); PG8_BAR;
    } else {
        PG8_STAGE(PG8_SB(0, 0), cB, voffB); PG8_STAGE(PG8_SA(0, 0), cA, voffA); PG8_STAGE(PG8_SB(0, 1), cB + hstep, voffB); PG8_STAGE(PG8_SA(0, 1), cA + hstep, voffA);
        if (wr == 1) PG8_BAR;
        PG8_WAIT_V(4); PG8_BAR;
        PG8_STAGE(PG8_SB(1, 0), cB + kstep, voffB); PG8_STAGE(PG8_SA(1, 0), cA + kstep, voffA); PG8_STAGE(PG8_SB(1, 1), cB + hstep + kstep, voffB);
        PG8_WAIT_V(6); PG8_BAR;
    }
    for (;;) {
        const bool has_next = S.next(ui + 1, nxt);
        const char* nA = has_next ? S.aptr(nxt) : cA; const char* nB = has_next ? S.bptr(nxt) : cB;
        for (int t = 0; t < nt; t += 2) {
            const bool last = (t == nt - 2);
            const char* a1 = cA + (size_t)(t + 1) * kstep;
            const char* a2 = last ? nA : cA + (size_t)(t + 2) * kstep; const char* b2 = last ? nB : cB + (size_t)(t + 2) * kstep;
            const char* a3 = a2 + kstep; const char* b3 = b2 + kstep;
            if constexpr (SP2) {
            PG8_LDB(B0, 0, 0); PG8_LDB(B1, 0, 1); PG8_SCHED; PG8_LDA(At, 0, 0); PG8_STAGE(PG8_SA(1, 1), a1 + hstep, voffA);
            PG8_WAIT_V(8); PG8_WAIT_L(0); PG8_BAR; PG8_MMA(0, 0, At, B0); PG8_MMA(0, 1, At, B1); PG8_BAR; PG8_SCHED;
            PG8_LDA(At, 0, 1); PG8_STAGE(PG8_SB(0, 0), b2, voffB); PG8_STAGE(PG8_SB(0, 1), b2 + hstep, voffB); PG8_STAGE(PG8_SA(0, 0), a2, voffA);
            PG8_WAIT_V(8); PG8_WAIT_L(0); PG8_BAR; PG8_MMA(1, 0, At, B0); PG8_MMA(1, 1, At, B1); PG8_BAR; PG8_SCHED;
            PG8_LDB(B0, 1, 0); PG8_LDB(B1, 1, 1); PG8_SCHED; PG8_LDA(At, 1, 0); PG8_STAGE(PG8_SA(0, 1), a2 + hstep, voffA);
            PG8_WAIT_V(8); PG8_WAIT_L(0); PG8_BAR; PG8_MMA(0, 0, At, B0); PG8_MMA(0, 1, At, B1); PG8_BAR; PG8_SCHED;
            PG8_LDA(At, 1, 1); PG8_STAGE(PG8_SB(1, 0), b3, voffB); PG8_STAGE(PG8_SB(1, 1), b3 + hstep, voffB); PG8_STAGE(PG8_SA(1, 0), a3, voffA);
            PG8_WAIT_V(8); PG8_WAIT_L(0); PG8_BAR; PG8_MMA(1, 0, At, B0); PG8_MMA(1, 1, At, B1); PG8_BAR; PG8_SCHED;
            } else {
            PG8_LDB(B0, 0, 0); PG8_SCHED; PG8_LDA(At, 0, 0); PG8_STAGE(PG8_SA(1, 1), a1 + hstep, voffA);
            PG8_WAIT_L(8); PG8_BAR; PG8_WAIT_L(0); PG8_MMA(0, 0, At, B0); PG8_BAR; PG8_SCHED;
            PG8_LDB(B1, 0, 1); PG8_STAGE(PG8_SB(0, 0), b2, voffB);
            PG8_BAR; PG8_WAIT_L(0); PG8_MMA(0, 1, At, B1); PG8_BAR;
            PG8_LDA(At, 0, 1); PG8_STAGE(PG8_SA(0, 0), a2, voffA);
            PG8_BAR; PG8_WAIT_L(0); PG8_MMA(1, 0, At, B0); PG8_BAR; PG8_SCHED;
            PG8_STAGE(PG8_SB(0, 1), b2 + hstep, voffB);
            PG8_WAIT_V(6); PG8_BAR; PG8_MMA(1, 1, At, B1); PG8_BAR;
            PG8_LDB(B0, 1, 0); PG8_SCHED; PG8_LDA(At, 1, 0); PG8_STAGE(PG8_SA(0, 1), a2 + hstep, voffA);
            PG8_WAIT_L(8); PG8_BAR; PG8_WAIT_L(0); PG8_MMA(0, 0, At, B0); PG8_BAR; PG8_SCHED;
            PG8_LDB(B1, 1, 1); PG8_STAGE(PG8_SB(1, 0), b3, voffB);
            PG8_BAR; PG8_WAIT_L(0); PG8_MMA(0, 1, At, B1); PG8_BAR;
            PG8_LDA(At, 1, 1); PG8_STAGE(PG8_SA(1, 0), a3, voffA);
            PG8_BAR; PG8_WAIT_L(0); PG8_MMA(1, 0, At, B0); PG8_BAR; PG8_SCHED;
            PG8_STAGE(PG8_SB(1, 1), b3 + hstep, voffB);
            PG8_WAIT_V(6); PG8_BAR; PG8_MMA(1, 1, At, B1); PG8_BAR;
            }
        }
        if constexpr (ALIGN_EPI) { if (wr == 0) PG8_BAR; }
        E(acc, cur, wr, wc, fr, fq);
        if (!has_next) break;
#pragma unroll
        for (int a = 0; a < 2; ++a)
#pragma unroll
            for (int b = 0; b < 2; ++b)
#pragma unroll
                for (int m = 0; m < 4; ++m)
#pragma unroll
                    for (int n = 0; n < 2; ++n) acc[a][b][m][n] = (f32x4){0.f, 0.f, 0.f, 0.f};
        cur = nxt; cA = nA; cB = nB; ++ui;
        if constexpr (ALIGN_EPI) { if (wr == 1) PG8_BAR; }
    }
    PG8_WAIT_V(0);
    if constexpr (!ALIGN_EPI) { if (wr == 0) PG8_BAR; }
    PG8_BAR;
#undef PG8_SA
#undef PG8_SB
#undef PG8_STAGE
#undef PG8_LDA
#undef PG8_LDB
#undef PG8_MMA
#undef PG8_WAIT_V
#undef PG8_WAIT_L
#undef PG8_BAR
#undef PG8_SCHED
}


__host__ __device__ __forceinline__ int iperm32(int c) { return 16 * ((c >> 2) & 1) + 4 * (c >> 3) + (c & 3); }
struct MoeDirect {
    int nunits, NT, G, c; const LAS int* tab;
    const float* W0; const float* W1; size_t estride; int cols_per_tile, half1_off;
    __device__ bool next(int i, Unit& u) const {
        const long L = (long)i * G + c; if (L >= nunits) return false;
        u.pm = (int)L / NT; u.pn = (int)L % NT; u.ex = tab[u.pm];
        const int rem = tab[200 + u.ex] - (u.pm - tab[128 + u.ex]) * 256; u.rows = rem < 256 ? rem : 256; return true;
    }
    __device__ __forceinline__ const float* bptr(const Unit& u, int h) const { return (h ? W1 + half1_off : W0) + (size_t)u.ex * estride + (size_t)u.pn * cols_per_tile; }
};
template <class Epi, bool GATHER>
__device__ __forceinline__ void gemm_phase_moe(LAS unsigned char* lds, const int K_, const int ldw_, const MoeDirect& S, const Epi& E, const bf16* Abase, const int* LIST, const int tid, const int wid) {
    const int wr = wid >> 2, wc = wid & 3;
#define MO_LANE_CONSTS(tl) const int lane = (tl) & 63, fr = lane & 15, fq = lane >> 4; \
    const int aoff = lds_byte(wr * 64 + fr, fq * 8), boff = lds_byte(wc * 32 + fr, fq * 8); \
    const int kq = lane & 7, ng = 8 * wc + (lane >> 3); \
    const unsigned bvoff = (unsigned)((4 * kq) * ldw + 4 * ng) * 4u; \
    const int bslot0 = Epi::PERM ? (((4 * ng) & ~31) + iperm32((4 * ng) & 31)) : 4 * ng; \
    const unsigned bwbase = (unsigned)lds_byte(bslot0, 4 * kq)
    int K = K_; asm volatile("" : "+s"(K));
    int ldw = ldw_; asm volatile("" : "+s"(ldw));
    const int nt = K / BK;
    const unsigned ldsw = (unsigned)wid * 1024u;
    const size_t bkstep = (size_t)64 * ldw * 4, browb = (size_t)ldw * 4;
    f32x4 br[4];
#define MO_SA(b, h) (((b) * 2 + (h)) * HTB)
#define MO_SB(b, h) ((4 + (b) * 2 + (h)) * HTB)
#define MO_STAGE_A(bufoff, basep, o0, o1) do { \
        __builtin_amdgcn_global_load_lds((const unsigned*)((const char*)(basep) + (o0)), (LAS unsigned*)(lds + (bufoff) + ldsw), 16, 0, 0); \
        __builtin_amdgcn_global_load_lds((const unsigned*)((const char*)(basep) + (o1)), (LAS unsigned*)(lds + (bufoff) + ldsw + 8192), 16, 0, 0); } while (0)
#define MO_BISSUE(p, R) do { const char* _p = (const char*)(p) + (size_t)(32 * (R)) * browb; _Pragma("unroll") for (int _j = 0; _j < 4; ++_j) \
        asm volatile("global_load_dwordx4 %0, %1, %2" : "=v"(br[_j]) : "v"(bvoff), "s"(_p + (size_t)_j * browb) : "memory"); } while (0)
#define MO_VWAIT0() asm volatile("s_waitcnt vmcnt(0)" : "+v"(br[0]), "+v"(br[1]), "+v"(br[2]), "+v"(br[3]) :: "memory")
#define MO_BWRITE(b, R) do { _Pragma("unroll") for (int _i = 0; _i < 4; ++_i) { u32x2 _o; _o.x = cvtpk(br[0][_i], br[1][_i]); _o.y = cvtpk(br[2][_i], br[3][_i]); \
        *(LAS u32x2*)(lds + MO_SB(b, wr) + bwbase + 1024 * (R) + 64 * _i) = _o; } } while (0)
#define MO_LDA(dst, b, h) do { _Pragma("unroll") for (int m = 0; m < 4; ++m) _Pragma("unroll") for (int k = 0; k < 2; ++k) dst[m][k] = *(const LAS bf16x8*)(lds + MO_SA(b, h) + aoff + m * 2048 + k * 1024); } while (0)
#define MO_LDB(dst, b, h) do { _Pragma("unroll") for (int n = 0; n < 2; ++n) _Pragma("unroll") for (int k = 0; k < 2; ++k) dst[n][k] = *(const LAS bf16x8*)(lds + MO_SB(b, h) + boff + n * 2048 + k * 1024); } while (0)
#define MO_MMA(ai, bj, At, Bt) do { __builtin_amdgcn_s_setprio(1); _Pragma("unroll") for (int m = 0; m < 4; ++m) _Pragma("unroll") for (int n = 0; n < 2; ++n) _Pragma("unroll") for (int k = 0; k < 2; ++k) \
        acc[ai][bj][m][n] = __builtin_amdgcn_mfma_f32_16x16x32_bf16(Bt[n][k], At[m][k], acc[ai][bj][m][n], 0, 0, 0); __builtin_amdgcn_s_setprio(0); } while (0)
#define MO_WAIT_L(n) asm volatile("s_waitcnt lgkmcnt(" #n ")" ::: "memory")
#define MO_BAR __builtin_amdgcn_s_barrier()
#define MO_SCHED __builtin_amdgcn_sched_barrier(0)
#define MO_AOFF(u, dst) do { _Pragma("unroll") for (int _i = 0; _i < 2; ++_i) { int _R, _C; stage_rc(tid * 16 + _i * 8192, _R, _C); _Pragma("unroll") for (int _h = 0; _h < 2; ++_h) { const int _r = 128 * _h + _R; \
        if (GATHER) { const int _p = ((u).pm - S.tab[128 + (u).ex]) * 256 + _r; const int _t = (_r < (u).rows) ? LIST[(size_t)(u).ex * 8192 + _p] : 0; dst[_h][_i] = (unsigned)(_t * K + _C) * 2u; } \
        else dst[_h][_i] = (unsigned)(_r * K + _C) * 2u; } } } while (0)
    Unit cur, nxt; int ui = 0;
    if (!S.next(0, cur)) return;
    f32x4 acc[2][2][4][2];
#pragma unroll
    for (int a = 0; a < 2; ++a)
#pragma unroll
        for (int b = 0; b < 2; ++b)
#pragma unroll
            for (int m = 0; m < 4; ++m)
#pragma unroll
                for (int n = 0; n < 2; ++n) acc[a][b][m][n] = (f32x4){0.f, 0.f, 0.f, 0.f};
    bf16x8 At[4][2], B0[2][2], B1[2][2];
    unsigned cAo[2][2];
    LAS u32x4* const aslot = (LAS u32x4*)(lds + STAGE_BYTES) + tid;
    MO_AOFF(cur, cAo);
    const char* cAb = GATHER ? (const char*)Abase : (const char*)Abase + (size_t)cur.pm * 256 * K * 2;
    const char* cBh = (const char*)S.bptr(cur, wr);
    { MO_LANE_CONSTS(tid);
    MO_BISSUE(cBh, 0); MO_STAGE_A(MO_SA(0, 0), cAb, cAo[0][0], cAo[0][1]); MO_STAGE_A(MO_SA(0, 1), cAb, cAo[1][0], cAo[1][1]);
    if (wr == 1) MO_BAR;
    MO_VWAIT0(); MO_BWRITE(0, 0); MO_BISSUE(cBh, 1);
    MO_VWAIT0(); MO_BWRITE(0, 1);
    MO_WAIT_L(0); MO_BAR;
    MO_BISSUE(cBh + bkstep, 0); MO_STAGE_A(MO_SA(1, 0), cAb + 128, cAo[0][0], cAo[0][1]);
    MO_VWAIT0(); MO_BWRITE(1, 0); MO_BISSUE(cBh + bkstep, 1);
    MO_WAIT_L(0); MO_BAR; }
    for (;;) {
        const bool has_next = S.next(ui + 1, nxt);
        const char* nAb = cAb; const char* nBh = cBh;
        if (has_next) { nAb = GATHER ? (const char*)Abase : (const char*)Abase + (size_t)nxt.pm * 256 * K * 2; nBh = (const char*)S.bptr(nxt, wr);
            if (GATHER) { unsigned nAo[2][2]; MO_AOFF(nxt, nAo); *aslot = (u32x4){nAo[0][0], nAo[0][1], nAo[1][0], nAo[1][1]}; } }
        const bool halfu = cur.rows <= 128;
        for (int t = 0; t < nt; t += 2) {
            int tl = tid; asm volatile("" : "+v"(tl)); MO_LANE_CONSTS(tl);
            const bool last = (t == nt - 2);
            const char* a1 = cAb + (size_t)(t + 1) * 128;
            const char* a2 = last ? nAb : cAb + (size_t)(t + 2) * 128; const char* a3 = a2 + 128;
            const char* b2 = last ? nBh : cBh + (size_t)(t + 2) * bkstep; const char* b3 = b2 + bkstep;
            MO_LDB(B0, 0, 0); MO_LDB(B1, 0, 1); MO_SCHED; MO_LDA(At, 0, 0);
            MO_VWAIT0(); MO_BWRITE(1, 1); MO_STAGE_A(MO_SA(1, 1), a1, cAo[1][0], cAo[1][1]); MO_BISSUE(b2, 0);
            if (GATHER && last && has_next) { const u32x4 _n = *aslot; cAo[0][0] = _n.x; cAo[0][1] = _n.y; cAo[1][0] = _n.z; cAo[1][1] = _n.w; }
            MO_WAIT_L(0); MO_BAR; MO_MMA(0, 0, At, B0); MO_MMA(0, 1, At, B1); MO_BAR; MO_SCHED;
            MO_LDA(At, 0, 1);
            MO_VWAIT0(); MO_BWRITE(0, 0); MO_STAGE_A(MO_SA(0, 0), a2, cAo[0][0], cAo[0][1]); MO_BISSUE(b2, 1);
            MO_WAIT_L(0); MO_BAR; if (!halfu) { MO_MMA(1, 0, At, B0); MO_MMA(1, 1, At, B1); } MO_BAR; MO_SCHED;
            MO_LDB(B0, 1, 0); MO_LDB(B1, 1, 1); MO_SCHED; MO_LDA(At, 1, 0);
            MO_VWAIT0(); MO_BWRITE(0, 1); MO_STAGE_A(MO_SA(0, 1), a2, cAo[1][0], cAo[1][1]); MO_BISSUE(b3, 0);
            MO_WAIT_L(0); MO_BAR; MO_MMA(0, 0, At, B0); MO_MMA(0, 1, At, B1); MO_BAR; MO_SCHED;
            MO_LDA(At, 1, 1);
            MO_VWAIT0(); MO_BWRITE(1, 0); MO_STAGE_A(MO_SA(1, 0), a3, cAo[0][0], cAo[0][1]); MO_BISSUE(b3, 1);
            MO_WAIT_L(0); MO_BAR; if (!halfu) { MO_MMA(1, 0, At, B0); MO_MMA(1, 1, At, B1); } MO_BAR; MO_SCHED;
        }
        if (wr == 0) MO_BAR;
        { const int lane = tid & 63; E(acc, cur, wr, wc, lane & 15, lane >> 4); }
        if (!has_next) break;
#pragma unroll
        for (int a = 0; a < 2; ++a)
#pragma unroll
            for (int b = 0; b < 2; ++b)
#pragma unroll
                for (int m = 0; m < 4; ++m)
#pragma unroll
                    for (int n = 0; n < 2; ++n) acc[a][b][m][n] = (f32x4){0.f, 0.f, 0.f, 0.f};
        cur = nxt; cAb = nAb; cBh = nBh; ++ui;
        if (wr == 1) MO_BAR;
    }
    MO_VWAIT0();
    MO_BAR;
#undef MO_SA
#undef MO_SB
#undef MO_STAGE_A
#undef MO_BISSUE
#undef MO_VWAIT0
#undef MO_BWRITE
#undef MO_LDA
#undef MO_LDB
#undef MO_MMA
#undef MO_WAIT_L
#undef MO_BAR
#undef MO_SCHED
#undef MO_AOFF
#undef MO_LANE_CONSTS
}

template <class Epi, bool GATHER>
__device__ __forceinline__ void gemm_phase_moe32(LAS unsigned char* lds, const int K_, const int ldw_, const MoeDirect& S, const Epi& E, const bf16* Abase, const int* LIST, const int tid, const int wid) {
    const int wr = wid >> 2, wc = wid & 3;
#define MO_LANE_CONSTS(tl) const int lane = (tl) & 63, fr = lane & 15, fq = lane >> 4; \
    const int aoff = lds_byte(wr * 64 + fr, fq * 8), boff = lds_byte(wc * 32 + fr, fq * 8); \
    const int kq = lane & 7, ng = 8 * wc + (lane >> 3); \
    const unsigned bvoff = (unsigned)((4 * kq) * ldw + 4 * ng) * 4u; \
    const int bslot0 = Epi::PERM ? (((4 * ng) & ~31) + iperm32((4 * ng) & 31)) : 4 * ng; \
    const unsigned bwbase = (unsigned)lds_byte(bslot0, 4 * kq)
    int K = K_; asm volatile("" : "+s"(K));
    int ldw = ldw_; asm volatile("" : "+s"(ldw));
    const int nt = K / BK;
    const unsigned ldsw = (unsigned)wid * 1024u;
    const size_t bkstep = (size_t)64 * ldw * 4, browb = (size_t)ldw * 4;
    f32x4 br[8];
#define MO_SA(b, h) (((b) * 2 + (h)) * HTB)
#define MO_SB(b, h) ((4 + (b) * 2 + (h)) * HTB)
#define MO_STAGE_A(bufoff, basep, o0, o1) do { \
        __builtin_amdgcn_global_load_lds((const unsigned*)((const char*)(basep) + (o0)), (LAS unsigned*)(lds + (bufoff) + ldsw), 16, 0, 0); \
        __builtin_amdgcn_global_load_lds((const unsigned*)((const char*)(basep) + (o1)), (LAS unsigned*)(lds + (bufoff) + ldsw + 8192), 16, 0, 0); } while (0)
#define MO_BISSUE(p) do { const char* _p = (const char*)(p); _Pragma("unroll") for (int _j = 0; _j < 8; ++_j) \
        asm volatile("global_load_dwordx4 %0, %1, %2" : "=v"(br[_j]) : "v"(bvoff), "s"(_p + (size_t)(32 * (_j >> 2) + (_j & 3)) * browb) : "memory"); } while (0)
#define MO_BWAIT(n) asm volatile("s_waitcnt vmcnt(" #n ")" : "+v"(br[0]), "+v"(br[1]), "+v"(br[2]), "+v"(br[3]), "+v"(br[4]), "+v"(br[5]), "+v"(br[6]), "+v"(br[7]) :: "memory")
#define MO_WAIT_V(n) asm volatile("s_waitcnt vmcnt(" #n ")" ::: "memory")
#define MO_BWRITE(b) do { _Pragma("unroll") for (int _R = 0; _R < 2; ++_R) _Pragma("unroll") for (int _i = 0; _i < 4; ++_i) { u32x2 _o; \
        _o.x = cvtpk(br[4 * _R][_i], br[4 * _R + 1][_i]); _o.y = cvtpk(br[4 * _R + 2][_i], br[4 * _R + 3][_i]); \
        *(LAS u32x2*)(lds + MO_SB(b, wr) + bwbase + 1024 * _R + 64 * _i) = _o; } } while (0)
#define MO_LDA(dst, b, h) do { _Pragma("unroll") for (int m = 0; m < 4; ++m) _Pragma("unroll") for (int k = 0; k < 2; ++k) dst[m][k] = *(const LAS bf16x8*)(lds + MO_SA(b, h) + aoff + m * 2048 + k * 1024); } while (0)
#define MO_LDB(dst, b, h) do { _Pragma("unroll") for (int n = 0; n < 2; ++n) _Pragma("unroll") for (int k = 0; k < 2; ++k) dst[n][k] = *(const LAS bf16x8*)(lds + MO_SB(b, h) + boff + n * 2048 + k * 1024); } while (0)
#define MO_MMA(ai, bj, At, Bt) do { __builtin_amdgcn_s_setprio(1); _Pragma("unroll") for (int m = 0; m < 4; ++m) _Pragma("unroll") for (int n = 0; n < 2; ++n) _Pragma("unroll") for (int k = 0; k < 2; ++k) \
        acc[ai][bj][m][n] = __builtin_amdgcn_mfma_f32_16x16x32_bf16(Bt[n][k], At[m][k], acc[ai][bj][m][n], 0, 0, 0); __builtin_amdgcn_s_setprio(0); } while (0)
#define MO_WAIT_L(n) asm volatile("s_waitcnt lgkmcnt(" #n ")" ::: "memory")
#define MO_BAR __builtin_amdgcn_s_barrier()
#define MO_SCHED __builtin_amdgcn_sched_barrier(0)
#define MO_AOFF(u, dst) do { _Pragma("unroll") for (int _i = 0; _i < 2; ++_i) { int _R, _C; stage_rc(tid * 16 + _i * 8192, _R, _C); _Pragma("unroll") for (int _h = 0; _h < 2; ++_h) { const int _r = 128 * _h + _R; \
        if (GATHER) { const int _p = ((u).pm - S.tab[128 + (u).ex]) * 256 + _r; const int _t = (_r < (u).rows) ? LIST[(size_t)(u).ex * 8192 + _p] : 0; dst[_h][_i] = (unsigned)(_t * K + _C) * 2u; } \
        else dst[_h][_i] = (unsigned)(_r * K + _C) * 2u; } } } while (0)
    Unit cur, nxt; int ui = 0;
    if (!S.next(0, cur)) return;
    f32x4 acc[2][2][4][2];
#pragma unroll
    for (int a = 0; a < 2; ++a)
#pragma unroll
        for (int b = 0; b < 2; ++b)
#pragma unroll
            for (int m = 0; m < 4; ++m)
#pragma unroll
                for (int n = 0; n < 2; ++n) acc[a][b][m][n] = (f32x4){0.f, 0.f, 0.f, 0.f};
    bf16x8 At[4][2], B0[2][2], B1[2][2];
    unsigned cAo[2][2];
    LAS u32x4* const aslot = (LAS u32x4*)(lds + STAGE_BYTES) + tid;
    MO_AOFF(cur, cAo);
    const char* cAb = GATHER ? (const char*)Abase : (const char*)Abase + (size_t)cur.pm * 256 * K * 2;
    const char* cBh = (const char*)S.bptr(cur, wr);
    { MO_LANE_CONSTS(tid);
    MO_BISSUE(cBh); MO_STAGE_A(MO_SA(0, 0), cAb, cAo[0][0], cAo[0][1]); MO_STAGE_A(MO_SA(0, 1), cAb, cAo[1][0], cAo[1][1]);
    if (wr == 1) MO_BAR;
    MO_BWAIT(4); MO_BWRITE(0);
    MO_WAIT_V(0); MO_WAIT_L(0); MO_BAR;
    MO_STAGE_A(MO_SA(1, 0), cAb + 128, cAo[0][0], cAo[0][1]); MO_BISSUE(cBh + bkstep);
    MO_BAR; }
    for (;;) {
        const bool has_next = S.next(ui + 1, nxt);
        const char* nAb = cAb; const char* nBh = cBh;
        if (has_next) { nAb = GATHER ? (const char*)Abase : (const char*)Abase + (size_t)nxt.pm * 256 * K * 2; nBh = (const char*)S.bptr(nxt, wr);
            if (GATHER) { unsigned nAo[2][2]; MO_AOFF(nxt, nAo); *aslot = (u32x4){nAo[0][0], nAo[0][1], nAo[1][0], nAo[1][1]}; } }
        const bool halfu = cur.rows <= 128;
        for (int t = 0; t < nt; t += 2) {
            int tl = tid; asm volatile("" : "+v"(tl)); MO_LANE_CONSTS(tl);
            const bool last = (t == nt - 2);
            const char* a1 = cAb + (size_t)(t + 1) * 128;
            const char* a2 = last ? nAb : cAb + (size_t)(t + 2) * 128; const char* a3 = a2 + 128;
            const char* b2 = last ? nBh : cBh + (size_t)(t + 2) * bkstep; const char* b3 = b2 + bkstep;
            MO_LDB(B0, 0, 0); MO_LDB(B1, 0, 1); MO_SCHED; MO_LDA(At, 0, 0); MO_STAGE_A(MO_SA(1, 1), a1, cAo[1][0], cAo[1][1]);
            MO_WAIT_V(12); MO_WAIT_L(0); MO_BAR; MO_MMA(0, 0, At, B0); MO_MMA(0, 1, At, B1); MO_BAR; MO_SCHED;
            if (GATHER && last && has_next) { const u32x4 _n = *aslot; cAo[0][0] = _n.x; cAo[0][1] = _n.y; cAo[1][0] = _n.z; cAo[1][1] = _n.w; }
            MO_LDA(At, 0, 1); MO_BWAIT(2); MO_BWRITE(1); MO_STAGE_A(MO_SA(0, 0), a2, cAo[0][0], cAo[0][1]); MO_BISSUE(b2);
            MO_WAIT_L(0); MO_BAR; if (!halfu) { MO_MMA(1, 0, At, B0); MO_MMA(1, 1, At, B1); } MO_BAR; MO_SCHED;
            MO_LDB(B0, 1, 0); MO_LDB(B1, 1, 1); MO_SCHED; MO_LDA(At, 1, 0); MO_STAGE_A(MO_SA(0, 1), a2, cAo[1][0], cAo[1][1]);
            MO_WAIT_V(12); MO_WAIT_L(0); MO_BAR; MO_MMA(0, 0, At, B0); MO_MMA(0, 1, At, B1); MO_BAR; MO_SCHED;
            MO_LDA(At, 1, 1); MO_BWAIT(2); MO_BWRITE(0); MO_STAGE_A(MO_SA(1, 0), a3, cAo[0][0], cAo[0][1]); MO_BISSUE(b3);
            MO_WAIT_L(0); MO_BAR; if (!halfu) { MO_MMA(1, 0, At, B0); MO_MMA(1, 1, At, B1); } MO_BAR; MO_SCHED;
        }
        if (wr == 0) MO_BAR;
        { const int lane = tid & 63; E(acc, cur, wr, wc, lane & 15, lane >> 4); }
        if (!has_next) break;
#pragma unroll
        for (int a = 0; a < 2; ++a)
#pragma unroll
            for (int b = 0; b < 2; ++b)
#pragma unroll
                for (int m = 0; m < 4; ++m)
#pragma unroll
                    for (int n = 0; n < 2; ++n) acc[a][b][m][n] = (f32x4){0.f, 0.f, 0.f, 0.f};
        cur = nxt; cAb = nAb; cBh = nBh; ++ui;
        if (wr == 1) MO_BAR;
    }
    MO_BWAIT(0);
    MO_BAR;
#undef MO_SA
#undef MO_SB
#undef MO_STAGE_A
#undef MO_BISSUE
#undef MO_BWAIT
#undef MO_WAIT_V
#undef MO_BWRITE
#undef MO_LDA
#undef MO_LDB
#undef MO_MMA
#undef MO_WAIT_L
#undef MO_BAR
#undef MO_SCHED
#undef MO_AOFF
#undef MO_LANE_CONSTS
}


typedef const f32x4 (&AccRef)[2][2][4][2];
DI u32x4 pack8(const f32x4& v0, const f32x4& v1) { u32x4 w; w.x = cvtpk(v0[0], v0[1]); w.y = cvtpk(v0[2], v0[3]); w.z = cvtpk(v1[0], v1[1]); w.w = cvtpk(v1[2], v1[3]); return w; }

struct EpiBf16 {
    static constexpr bool PERM = true;
    bf16* O; int ldc;
    DI void operator()(AccRef acc, const Unit& u, int wr, int wc, int fr, int fq) const {
        const int row0 = u.pm * BM + wr * 64 + fr, col0 = u.pn * BM + wc * 32 + 8 * fq;
#pragma unroll
        for (int ai = 0; ai < 2; ++ai)
#pragma unroll
            for (int m = 0; m < 4; ++m) { bf16* rowp = O + (size_t)(row0 + ai * HALF + m * 16) * ldc + col0;
#pragma unroll
                for (int bj = 0; bj < 2; ++bj) *(u32x4*)(rowp + bj * HALF) = pack8(acc[ai][bj][m][0], acc[ai][bj][m][1]); }
    }
};
struct EpiF32 {
    static constexpr bool PERM = false;
    float* C; int ldc;
    DI void operator()(AccRef acc, const Unit& u, int wr, int wc, int fr, int fq) const {
        const int row0 = u.pm * BM + wr * 64 + fr, col0 = u.pn * BM + wc * 32 + 4 * fq;
#pragma unroll
        for (int ai = 0; ai < 2; ++ai)
#pragma unroll
            for (int m = 0; m < 4; ++m) { float* rowp = C + (size_t)(row0 + ai * HALF + m * 16) * ldc + col0;
#pragma unroll
                for (int bj = 0; bj < 2; ++bj)
#pragma unroll
                    for (int n = 0; n < 2; ++n) *(f32x4*)(rowp + bj * HALF + n * 16) = acc[ai][bj][m][n]; }
    }
};
struct EpiInProj {
    static constexpr bool PERM = true;
    bf16* P; float* PBA;
    DI void operator()(AccRef acc, const Unit& u, int wr, int wc, int fr, int fq) const {
        const int row0 = u.pm * BM + wr * 64 + fr;
        if (u.pn < 28) {
            const int col0 = u.pn * BM + wc * 32 + 8 * fq;
#pragma unroll
            for (int ai = 0; ai < 2; ++ai)
#pragma unroll
                for (int m = 0; m < 4; ++m) { bf16* rowp = P + (size_t)(row0 + ai * HALF + m * 16) * NP + col0;
#pragma unroll
                    for (int bj = 0; bj < 2; ++bj) *(u32x4*)(rowp + bj * HALF) = pack8(acc[ai][bj][m][0], acc[ai][bj][m][1]); }
        } else if (wc == 0 && fq < 2) {
#pragma unroll
            for (int ai = 0; ai < 2; ++ai)
#pragma unroll
                for (int m = 0; m < 4; ++m) { float* rp = PBA + (size_t)(row0 + ai * HALF + m * 16) * 16 + 8 * fq;
                    *(f32x4*)rp = acc[ai][0][m][0]; *(f32x4*)(rp + 4) = acc[ai][0][m][1]; }
        }
    }
};
struct EpiResid {
    static constexpr bool PERM = false;
    const float* x; const float* g; float* R;
    DI void operator()(AccRef acc, const Unit& u, int wr, int wc, int fr, int fq) const {
        const int row0 = u.pm * BM + wr * 64 + fr, col0 = u.pn * BM + wc * 32 + 4 * fq;
        const float* gb = g + (size_t)((u.pm * BM) / SEQ) * 12288 + col0;
        f32x4 gv[2][2];
#pragma unroll
        for (int bj = 0; bj < 2; ++bj)
#pragma unroll
            for (int n = 0; n < 2; ++n) gv[bj][n] = *(const f32x4*)(gb + bj * HALF + n * 16) + 1.0f;
#pragma unroll
        for (int ai = 0; ai < 2; ++ai)
#pragma unroll
            for (int m = 0; m < 4; ++m) { const size_t off = (size_t)(row0 + ai * HALF + m * 16) * D + col0;
#pragma unroll
                for (int bj = 0; bj < 2; ++bj)
#pragma unroll
                    for (int n = 0; n < 2; ++n) { const f32x4 xv = *(const f32x4*)(x + off + bj * HALF + n * 16);
                        *(f32x4*)(R + off + bj * HALF + n * 16) = xv * DN_ALPHA + gv[bj][n] * acc[ai][bj][m][n]; } }
    }
};
struct EpiLogits {
    static constexpr bool PERM = false;
    float* L;
    DI void operator()(AccRef acc, const Unit& u, int wr, int wc, int fr, int fq) const {
        const int row0 = u.pm * BM + wr * 64 + fr, col0 = wc * 32 + 4 * fq;
#pragma unroll
        for (int ai = 0; ai < 2; ++ai)
#pragma unroll
            for (int m = 0; m < 4; ++m) { float* rowp = L + (size_t)(row0 + ai * HALF + m * 16) * 128 + col0;
#pragma unroll
                for (int n = 0; n < 2; ++n) *(f32x4*)(rowp + n * 16) = acc[ai][0][m][n]; }
    }
};
struct EpiGateUp {
    static constexpr bool PERM = true;
    bf16* H;
    DI void operator()(AccRef acc, const Unit& u, int wr, int wc, int fr, int fq) const {
        const int row0 = u.pm * BM + wr * 64 + fr, col0 = u.pn * HALF + wc * 32 + 8 * fq;
#pragma unroll
        for (int ai = 0; ai < 2; ++ai)
#pragma unroll
            for (int m = 0; m < 4; ++m) { bf16* rowp = H + (size_t)(row0 + ai * HALF + m * 16) * FF + col0;
                f32x4 h0, h1;
#pragma unroll
                for (int j = 0; j < 4; ++j) { h0[j] = silu_f(acc[ai][0][m][0][j]) * acc[ai][1][m][0][j]; h1[j] = silu_f(acc[ai][0][m][1][j]) * acc[ai][1][m][1][j]; }
                *(u32x4*)rowp = pack8(h0, h1); }
    }
};
struct EpiQup {
    static constexpr bool PERM = true;
    bf16* Q;
    DI void operator()(AccRef acc, const Unit& u, int wr, int wc, int fr, int fq) const {
        const int row0 = u.pm * BM + wr * 64 + fr, b = (u.pm * BM) / SEQ, s0 = row0 - b * SEQ;
        const int cg0 = u.pn * BM + wc * 32 + 8 * fq, cg1 = cg0 + HALF;
        const int h0 = cg0 / QD, w0 = cg0 - h0 * QD, h1 = cg1 / QD, w1 = cg1 - h1 * QD;
        bf16* d0 = Q + ((size_t)((b * MH + h0) * SEQ + s0)) * QD + w0; bf16* d1 = Q + ((size_t)((b * MH + h1) * SEQ + s0)) * QD + w1;
#pragma unroll
        for (int ai = 0; ai < 2; ++ai)
#pragma unroll
            for (int m = 0; m < 4; ++m) { const int dr = (ai * HALF + m * 16) * QD;
                *(u32x4*)(d0 + dr) = pack8(acc[ai][0][m][0] * QSCALE, acc[ai][0][m][1] * QSCALE);
                *(u32x4*)(d1 + dr) = pack8(acc[ai][1][m][0] * QSCALE, acc[ai][1][m][1] * QSCALE);
                asm volatile("" ::: "memory"); }
    }
};
struct EpiKVup {
    static constexpr bool PERM = true;
    bf16* Kp; bf16* V;
    DI void operator()(AccRef acc, const Unit& u, int wr, int wc, int fr, int fq) const {
        const int row0 = u.pm * BM + wr * 64 + fr, c0 = wc * 32 + 8 * fq, head = u.pn, b = (u.pm * BM) / SEQ, s0 = row0 - b * SEQ;
        bf16* dk = Kp + ((size_t)((b * MH + head) * SEQ + s0)) * QD + c0; bf16* dv = V + (size_t)row0 * D + head * 128 + c0;
#pragma unroll
        for (int ai = 0; ai < 2; ++ai)
#pragma unroll
            for (int m = 0; m < 4; ++m) { const int dr = ai * HALF + m * 16;
                *(u32x4*)(dk + dr * QD) = pack8(acc[ai][0][m][0], acc[ai][0][m][1]);
                *(u32x4*)(dv + dr * D) = pack8(acc[ai][1][m][0], acc[ai][1][m][1]);
                asm volatile("" ::: "memory"); }
    }
};
}

#define XB_TMO      128
#define XB_XCNT(j)  (256  + 64 * (j))
#define XB_XSUB(j)  (1280 + 64 * (j))
#define XB_XGEN(j)  (2304 + 64 * (j))
#define XB_TOP      3328
#define XB_TOPGEN   3392
#define XCD_BAR_WORDS 3456
#define XB_SPIN_CAP (1u << 18)
__device__ __forceinline__ unsigned xb_ld(unsigned* p)              { return __hip_atomic_load(p, __ATOMIC_RELAXED, __HIP_MEMORY_SCOPE_AGENT); }
__device__ __forceinline__ unsigned xb_add(unsigned* p, unsigned v) { return __hip_atomic_fetch_add(p, v, __ATOMIC_RELAXED, __HIP_MEMORY_SCOPE_AGENT); }
__device__ __forceinline__ unsigned xb_xcc_id() { return (unsigned)__builtin_amdgcn_s_getreg((3 << 11) | 20) & 0xFu; }
#define XB_SPIN(cond, bar) do { unsigned _sp = 0; while (cond) { __builtin_amdgcn_s_sleep(1); \
    if ((++_sp & 255u) == 0u) { if (xb_ld(&(bar)[XB_TMO])) break; if (_sp > XB_SPIN_CAP) { atomicAdd(&(bar)[XB_TMO], 1u); break; } } } } while (0)
struct XcdBarrier { unsigned* bar; unsigned x; volatile LAS unsigned* st; };
__device__ __forceinline__ XcdBarrier xcd_barrier_post(unsigned* bar, volatile LAS unsigned* st, const bool leader  ) {
    XcdBarrier b; b.bar = bar; b.x = xb_xcc_id(); b.st = st;
    if (leader) (void)xb_add(&bar[XB_XCNT(b.x)], 1u);
    return b;
}
__device__ __forceinline__ void xcd_barrier_complete(unsigned* bar, unsigned x, unsigned& nloc, unsigned& nx) {
    const unsigned G = gridDim.x * gridDim.y * gridDim.z;
    unsigned sum, cnt, mine, sp = 0u;
    for (;;) {
        sum = 0u; cnt = 0u; mine = 0u;
#pragma unroll
        for (unsigned j = 0; j < 16; ++j) { const unsigned c = xb_ld(&bar[XB_XCNT(j)]); sum += c; cnt += (c > 0u) ? 1u : 0u; mine = (j == x) ? c : mine; }
        if (sum == G) break;
        __builtin_amdgcn_s_sleep(1);
        if ((++sp & 255u) == 0u) { if (xb_ld(&bar[XB_TMO])) break; if (sp > XB_SPIN_CAP) { atomicAdd(&bar[XB_TMO], 1u); break; } }
    }
    nloc = mine > 0u ? mine : 1u; nx = cnt > 0u ? cnt : 1u;
}
__device__ __forceinline__ void xcd_barrier(const XcdBarrier& b, const bool leader  ) {
    asm volatile("s_waitcnt vmcnt(0)" ::: "memory");
    __syncthreads();
    if (leader) {
        unsigned* bar = b.bar;
        __builtin_amdgcn_s_waitcnt(0);
        unsigned nloc = b.st[0], nx = b.st[1];
        if (nloc == 0u) { xcd_barrier_complete(bar, b.x, nloc, nx); b.st[0] = nloc; b.st[1] = nx; }
        const unsigned old = xb_add(&bar[XB_XSUB(b.x)], 1u);
        const unsigned gen = old / nloc;
        if (old + 1u == (gen + 1u) * nloc) {
            __builtin_amdgcn_fence(__ATOMIC_RELEASE, "agent");
            asm volatile("s_waitcnt vmcnt(0)" ::: "memory");
            const unsigned og = xb_add(&bar[XB_TOP], 1u);
            const unsigned tg = og / nx;
            if (og + 1u == (tg + 1u) * nx) xb_add(&bar[XB_TOPGEN], 1u);
            else XB_SPIN(xb_ld(&bar[XB_TOPGEN]) == tg, bar);
            __builtin_amdgcn_fence(__ATOMIC_ACQUIRE, "agent");
            xb_add(&bar[XB_XGEN(b.x)], 1u);
            asm volatile("s_waitcnt vmcnt(0)" ::: "memory");
        } else {
            XB_SPIN(xb_ld(&bar[XB_XGEN(b.x)]) == gen, bar);
            __builtin_amdgcn_fence(__ATOMIC_ACQUIRE, "agent");
            asm volatile("s_waitcnt vmcnt(0)" ::: "memory");
        }
    }
    __syncthreads();
}

struct Frame {
    LAS unsigned char* lds;
    int tid, lane, wave, vcu, G, gw, NGW;
    unsigned* ctl;
};
struct Args { const void* in[27]; float* out; unsigned char* ws; int ph_lo, ph_hi; };

__device__ const double ROPE_INVF[32] = {1, 0.74989420933245587, 0.56234132519034907, 0.42169650342858223, 0.31622776601683794, 0.23713737056616552, 0.17782794100389229, 0.1333521432163324,
    0.10000000000000001, 0.074989420933245579, 0.056234132519034911, 0.042169650342858224, 0.031622776601683791, 0.023713737056616554, 0.017782794100389229, 0.013335214321633241,
    0.01, 0.0074989420933245579, 0.005623413251903491, 0.0042169650342858229, 0.0031622776601683794, 0.0023713737056616554, 0.0017782794100389228, 0.0013335214321633241,
    0.001, 0.00074989420933245586, 0.0005623413251903491, 0.00042169650342858224, 0.00031622776601683794, 0.00023713737056616554, 0.00017782794100389227, 0.0001333521432163324};

struct TrRegs { f32x4 r[8]; };
DI void tr_load(TrRegs& t, const float* W, size_t ld, int k0, int n0, int nvalid, int lane) {
    const int ns = lane & 7, kq = lane >> 3;
    if (4 * ns < nvalid) { const float* src = W + (size_t)(k0 + 8 * kq) * ld + n0 + 4 * ns;
#pragma unroll
        for (int j = 0; j < 8; ++j) t.r[j] = *(const f32x4*)(src + (size_t)j * ld); }
}
DI void tr_store(const TrRegs& t, int k0, int nvalid, bf16* WT, int Kd, int drow0, int lane) {
    const int ns = lane & 7, kq = lane >> 3;
    if (4 * ns < nvalid) { bf16* dst = WT + (size_t)(drow0 + 4 * ns) * Kd + k0 + 8 * kq;
#pragma unroll
        for (int i = 0; i < 4; ++i) { u32x4 o; o.x = cvtpk(t.r[0][i], t.r[1][i]); o.y = cvtpk(t.r[2][i], t.r[3][i]); o.z = cvtpk(t.r[4][i], t.r[5][i]); o.w = cvtpk(t.r[6][i], t.r[7][i]);
            *(u32x4*)(dst + (size_t)i * Kd) = o; } }
}
DI void tr_job(const Frame& F, const float* W, size_t smat, int nmat, int ld, int K, int col0, int ncols, bf16* WT, size_t dmat, int Kd, int row_off, int mode) {
    const int nblk = (ncols + 31) / 32, kbs = K / 64, per = nblk * kbs; const long items = (long)nmat * per;
    for (long it0 = F.gw; it0 < items; it0 += 2 * (long)F.NGW) {
        TrRegs t[2]; int k0[2], nv[2], dr[2]; bf16* wt[2];
#pragma unroll
        for (int u = 0; u < 2; ++u) {
            const long it = it0 + (long)u * F.NGW;
            if (it < items) {
                const int mat = (int)(it / per), rem = (int)(it - (long)mat * per), kb = rem / nblk, nb = rem - kb * nblk;
                nv[u] = (ncols - nb * 32) < 32 ? (ncols - nb * 32) : 32; k0[u] = kb * 64;
                dr[u] = (mode == 0) ? (row_off + nb * 32) : ((nb >> 2) * 256 + row_off + (nb & 3) * 32);
                wt[u] = WT + (size_t)mat * dmat;
                tr_load(t[u], W + (size_t)mat * smat, (size_t)ld, k0[u], col0 + nb * 32, nv[u], F.lane);
            } else { nv[u] = 0; k0[u] = 0; dr[u] = 0; wt[u] = WT; }
        }
#pragma unroll
        for (int u = 0; u < 2; ++u) tr_store(t[u], k0[u], nv[u], wt[u], Kd, dr[u], F.lane);
    }
}
DI void zero_fill(const Frame& F, void* p, size_t bytes) {
    u32x4* q = (u32x4*)p; const size_t n = bytes / 16;
    for (size_t i = (size_t)F.gw * 64 + F.lane; i < n; i += (size_t)F.NGW * 64) q[i] = (u32x4){0u, 0u, 0u, 0u};
}

DI const void* arg_in(int k) { unsigned o = (unsigned)k * 8u; asm volatile("" : "+s"(o));
    const GAS void* p = *(const GAS void* const __attribute__((address_space(4)))*)((const __attribute__((address_space(4))) unsigned char*)__builtin_amdgcn_kernarg_segment_ptr() + o);
    return (const void*)p; }
#define WSB (args.ws)
#define in_x ((const float*)arg_in(0))
#define in_c ((const float*)arg_in(1))
#define in_pos ((const int*)arg_in(2))
#define ada_w ((const float*)arg_in(3))
#define ada_b ((const float*)arg_in(4))
#define ln_g ((const float*)arg_in(5))
#define ln_b ((const float*)arg_in(6))
#define hyb_w_in ((const float*)arg_in(7))
#define gdn_conv_w ((const float*)arg_in(8))
#define gdn_a_log ((const float*)arg_in(9))
#define gdn_dt_bias ((const float*)arg_in(10))
#define gdn_norm_w ((const float*)arg_in(11))
#define sc_conv_w ((const float*)arg_in(12))
#define hyb_w_out ((const float*)arg_in(13))
#define mla_w_in ((const float*)arg_in(14))
#define mla_q_norm ((const float*)arg_in(15))
#define mla_kv_norm ((const float*)arg_in(16))
#define mla_w_uq ((const float*)arg_in(17))
#define mla_w_ukv ((const float*)arg_in(18))
#define mla_w_out ((const float*)arg_in(19))
#define moe_router_g ((const float*)arg_in(20))
#define moe_bias_g ((const float*)arg_in(21))
#define moe_router_e ((const float*)arg_in(22))
#define moe_bias_e ((const float*)arg_in(23))
#define moe_w_gate ((const float*)arg_in(24))
#define moe_w_up ((const float*)arg_in(25))
#define moe_w_down ((const float*)arg_in(26))
#define MOD ((float*)(WSB + WS_MOD))
#define ROPE_C ((float*)(WSB + WS_ROPE))
#define ROPE_S ((float*)(ROPE_C + (size_t)T * 32))
#define PBA ((float*)(WSB + WS_PBA))
#define LOGITS ((float*)(WSB + WS_LOGITS))
#define TOK_E ((int*)(WSB + WS_ROUTE))
#define TOK_POS ((int*)(TOK_E + 2 * T))
#define TOK_GATE ((float*)(TOK_POS + 2 * T))
#define EG ((float*)(WSB + WS_EG))
#define WIN0 ((bf16*)(WSB + WS_WIN0))
#define WOUT0 ((bf16*)(WSB + WS_WOUT0))
#define WMIN ((bf16*)(WSB + WS_WMIN))
#define WUQ ((bf16*)(WSB + WS_WUQ))
#define WUKV ((bf16*)(WSB + WS_WUKV))
#define WMOUT ((bf16*)(WSB + WS_WMOUT))
#define WRT ((bf16*)(WSB + WS_WRT))
#define WGU ((bf16*)(WSB + WS_WGU))
#define WDN ((bf16*)(WSB + WS_WDN))
#define HIN ((bf16*)(WSB + WS_HIN))
#define XA ((float*)(WSB + WS_XA))
#define XB ((float*)(WSB + WS_XB))
#define RB ((float*)(WSB + WS_R))
#define PB ((bf16*)(WSB + WS_P))
#define GF ((unsigned char*)(WSB + WS_GF))
#define GU ((unsigned char*)(WSB + WS_GU))
#define GO ((float*)(WSB + WS_GO))
#define YAB ((bf16*)(WSB + WS_YAB))
#define LISTP ((int*)(WSB + WS_XS))
#define HID ((bf16*)(WSB + WS_HID))
#define YS ((bf16*)(WSB + WS_YS))
#define C1 ((float*)(WSB + WS_C1))
#define CQN ((bf16*)(WSB + WS_CQN))
#define CKVN ((bf16*)(WSB + WS_CKVN))
#define KPE ((float*)(WSB + WS_KPE))
#define QB_ ((bf16*)(WSB + WS_Q))
#define KB_ ((bf16*)(WSB + WS_K))
#define VB_ ((bf16*)(WSB + WS_V))
#define VT ((bf16*)(WSB + WS_VT))


#define LN_ROW(v, gptr, bptr) do { float _s = 0.f; _Pragma("unroll") for (int _j = 0; _j < 8; ++_j) _s += (v[_j][0] + v[_j][1]) + (v[_j][2] + v[_j][3]); \
        const float _mean = wave_sum(_s) * (1.f / D); float _q = 0.f; \
        _Pragma("unroll") for (int _j = 0; _j < 8; ++_j) { v[_j] = v[_j] - _mean; _q += (v[_j][0] * v[_j][0] + v[_j][1] * v[_j][1]) + (v[_j][2] * v[_j][2] + v[_j][3] * v[_j][3]); } \
        const float _rstd = rsqrtf(wave_sum(_q) * (1.f / D) + 1e-5f); \
        _Pragma("unroll") for (int _j = 0; _j < 8; ++_j) v[_j] = v[_j] * _rstd * ((const f32x4*)(gptr))[F.lane + 64 * _j] + ((const f32x4*)(bptr))[F.lane + 64 * _j]; } while (0)
#define WRITE_X_HIN(v, xrow, hrow, shp, scp) do { _Pragma("unroll") for (int _j = 0; _j < 8; ++_j) { ((f32x4*)(xrow))[F.lane + 64 * _j] = v[_j]; \
        if ((hrow) != nullptr) { const f32x4 _h = v[_j] * (((const f32x4*)(scp))[F.lane + 64 * _j] + 1.0f) + ((const f32x4*)(shp))[F.lane + 64 * _j]; \
            u32x2 _w; _w.x = cvtpk(_h[0], _h[1]); _w.y = cvtpk(_h[2], _h[3]); ((u32x2*)(hrow))[F.lane + 64 * _j] = _w; } } } while (0)


#ifndef PHMASK
#define PHMASK 0xFFFFFFFFull
#endif
#define PH_EN(k) (((PHMASK) >> (k)) & 1ull)
#define IN(k) (PH_EN(k) && lo <= (k) && (k) < hi)
#define INL(k0, k1) ((L == 0) ? IN(k0) : IN(k1))
#define PHASE_FRESH() do { int _l; asm volatile("v_mbcnt_lo_u32_b32 %0, -1, 0\n\tv_mbcnt_hi_u32_b32 %0, -1, %0" : "=v"(_l)); F.lane = _l; F.tid = F.wave * 64 + _l; } while (0)
#define SEAM(k) do { if (IN(k) && IN((k) + 1)) { PHASE_FRESH(); xcd_barrier(bar, F.tid == 0); } } while (0)

template <int L> DI void moe_phases(Frame& F, const Args& args, const XcdBarrier& bar, const int lo, const int hi, LAS int* TAB) {
        unsigned* cnt = F.ctl + CW_CNT + L * 64;
    if (INL(8, 21)) { PHASE_FRESH();
        pg8::StaticOrder S; S.init(HIN, WRT + (size_t)L * 256 * D, T, 256, D, F.G, (int)blockIdx.x);
        pg8::EpiLogits E{LOGITS};
        pg8::gemm_phase<pg8::EpiLogits, pg8::StaticOrder>(F.lds, D, S, E, F.tid, F.wave);
    }
    if (L == 0) SEAM(8); else SEAM(21);
    if (INL(9, 22)) { PHASE_FRESH();
        const float* bg = moe_bias_g + L * 8; const float* be = moe_bias_e + L * 64;
        for (int t = blockIdx.x * 512 + F.tid; t < T; t += F.G * 512) {
            const float* lg = LOGITS + (size_t)t * 128;
            float l8[8]; float mx = -3.0e38f; int grp = 0;
#pragma unroll
            for (int g = 0; g < 8; ++g) { l8[g] = lg[g] + bg[g]; if (l8[g] > mx) { mx = l8[g]; grp = g; } }
            float se = 0.f;
#pragma unroll
            for (int g = 0; g < 8; ++g) se += __expf(l8[g] - mx);
            const float pg = 1.f / se;
            float e8[8];
#pragma unroll
            for (int j = 0; j < 8; ++j) e8[j] = lg[8 + grp * 8 + j] + be[grp * 8 + j];
            int i1 = 0; float m1 = e8[0];
#pragma unroll
            for (int j = 1; j < 8; ++j) if (e8[j] > m1) { m1 = e8[j]; i1 = j; }
            int i2 = -1; float m2 = -3.0e38f;
#pragma unroll
            for (int j = 0; j < 8; ++j) if (j != i1 && e8[j] > m2) { m2 = e8[j]; i2 = j; }
            const float rr = __expf(m2 - m1), g1 = pg / (1.f + rr), g2 = pg * rr / (1.f + rr);
            const int ex1 = grp * 8 + i1, ex2 = grp * 8 + i2;
            const int p1 = (int)atomicAdd(&cnt[ex1], 1u), p2 = (int)atomicAdd(&cnt[ex2], 1u);
            TOK_E[2 * t] = ex1; TOK_E[2 * t + 1] = ex2; TOK_POS[2 * t] = p1; TOK_POS[2 * t + 1] = p2; TOK_GATE[2 * t] = g1; TOK_GATE[2 * t + 1] = g2;
            LISTP[(size_t)ex1 * 8192 + p1] = t; LISTP[(size_t)ex2 * 8192 + p2] = t;
        }
    }
    if ((L == 0) ? (IN(9) && IN(11)) : (IN(22) && IN(24))) { PHASE_FRESH(); xcd_barrier(bar, F.tid == 0); }
#define MOE_TABLE() do { if (F.tid == 0) { int _a = 0; for (int _e = 0; _e < NE; ++_e) { const int _c = (int)cnt[_e]; TAB[128 + _e] = _a; TAB[200 + _e] = _c; const int _nb = (_c + 255) >> 8; \
        for (int _q = 0; _q < _nb; ++_q) TAB[_a + _q] = _e; _a += _nb; } TAB[192] = _a; } __syncthreads(); } while (0)
    if (INL(11, 24)) { PHASE_FRESH();
        MOE_TABLE();
        pg8::MoeDirect S; S.nunits = TAB[192] * 4; S.NT = 4; S.G = F.G; S.c = F.vcu; S.tab = TAB;
        S.W0 = moe_w_gate + (size_t)L * 64 * D * FF; S.W1 = moe_w_up + (size_t)L * 64 * D * FF; S.estride = (size_t)D * FF; S.cols_per_tile = 128; S.half1_off = 0;
        pg8::EpiGateUp E{HID};
        pg8::gemm_phase_moe<pg8::EpiGateUp, true>(F.lds, D, FF, S, E, HIN, LISTP, F.tid, F.wave);
    }
    if (L == 0) SEAM(11); else SEAM(24);
    if (INL(12, 25)) { PHASE_FRESH();
        MOE_TABLE();
        pg8::MoeDirect S; S.nunits = TAB[192] * 8; S.NT = 8; S.G = F.G; S.c = F.vcu; S.tab = TAB;
        S.W0 = moe_w_down + (size_t)L * 64 * D * FF; S.W1 = S.W0; S.estride = (size_t)D * FF; S.cols_per_tile = 256; S.half1_off = 128;
        pg8::EpiBf16 E{YS, D};
        pg8::gemm_phase_moe32<pg8::EpiBf16, false>(F.lds, FF, D, S, E, HID, nullptr, F.tid, F.wave);
    }
    if (L == 0) SEAM(12); else SEAM(25);
    if (INL(13, 26)) { PHASE_FRESH();
        if (F.tid == 0) { int a = 0; for (int e = 0; e < NE; ++e) { TAB[128 + e] = a; a += ((int)cnt[e] + 255) >> 8; } }
        __syncthreads();
        float* xout = (L == 0) ? XB : args.out;
        for (int m = F.gw; m < T; m += F.NGW) {
            const int b = m / SEQ; const float* modb = MOD + (size_t)(L * 4 + b) * 12288;
            const int r0 = TAB[128 + TOK_E[2 * m]] * 256 + TOK_POS[2 * m], r1 = TAB[128 + TOK_E[2 * m + 1]] * 256 + TOK_POS[2 * m + 1];
            const float g0 = TOK_GATE[2 * m], g1 = TOK_GATE[2 * m + 1];
            f32x4 v[8];
#pragma unroll
            for (int j = 0; j < 8; ++j) {
                const f32x4 xv = ((const f32x4*)(XA + (size_t)m * D))[F.lane + 64 * j];
                const u32x2 ya = ((const u32x2*)(YS + (size_t)r0 * D))[F.lane + 64 * j], yb = ((const u32x2*)(YS + (size_t)r1 * D))[F.lane + 64 * j];
                const f32x4 gg = ((const f32x4*)(modb + 5 * D))[F.lane + 64 * j] + 1.0f;
                f32x4 y; y[0] = g0 * bflo(ya.x) + g1 * bflo(yb.x); y[1] = g0 * bfhi(ya.x) + g1 * bfhi(yb.x); y[2] = g0 * bflo(ya.y) + g1 * bflo(yb.y); y[3] = g0 * bfhi(ya.y) + g1 * bfhi(yb.y);
                v[j] = xv * DN_ALPHA + gg * y;
            }
            LN_ROW(v, ln_g + (size_t)(L * 2 + 1) * D, ln_b + (size_t)(L * 2 + 1) * D);
            bf16* hrow = (L == 0) ? HIN + (size_t)m * D : nullptr;
            const float* mod1 = MOD + (size_t)(4 + b) * 12288;
            WRITE_X_HIN(v, xout + (size_t)m * D, hrow, mod1, mod1 + D);
        }
    }
    if (L == 0) SEAM(13);
}

__global__ void __launch_bounds__(512, 2) mega(Args args) {
    extern __shared__ __attribute__((aligned(16))) unsigned char lds_raw[];
    Frame F;
    F.lds = (LAS unsigned char*)lds_raw;
    F.wave = __builtin_amdgcn_readfirstlane((int)threadIdx.x >> 6); PHASE_FRESH();
    F.G = gridDim.x; { const int bx = blockIdx.x; F.vcu = (F.G % 8 == 0) ? (bx % 8) * (F.G / 8) + bx / 8 : bx; }
    F.gw = F.vcu * 8 + F.wave; F.NGW = F.G * 8;
    F.ctl = (unsigned*)(args.ws + WS_CTL);
    volatile LAS unsigned* MISC = (volatile LAS unsigned*)(F.lds + MISC_OFF);
    LAS int* TAB = (LAS int*)(F.lds + TAB_OFF);
    for (int u = F.tid; u < (LDS_BYTES - LDSCTL_OFF) / 4; u += 512) ((LAS unsigned*)(F.lds + LDSCTL_OFF))[u] = 0u;
    __syncthreads();
    XcdBarrier bar; bar.bar = F.ctl + CW_BAR; bar.x = 0; bar.st = nullptr;
    if (MK_ONE_LAUNCH) bar = xcd_barrier_post(F.ctl + CW_BAR, MISC + 8, F.tid == 0);
    const int lo = args.ph_lo, hi = args.ph_hi;

    if (IN(0)) { PHASE_FRESH();
        {
            LAS float* cact = (LAS float*)F.lds;
            LAS float* red = (LAS float*)(F.lds + 32768);
            for (int i = F.tid; i < 4 * D; i += 512) cact[i] = silu_f(in_c[i]);
            __syncthreads();
            for (int cg = blockIdx.x; cg < 256; cg += F.G) {
                const int jj0 = cg * 96, l = jj0 / 12288, j0 = jj0 - l * 12288;
                const int rsub = F.lane / 24, c4 = F.lane - rsub * 24;
                f32x4 a0 = {0.f, 0.f, 0.f, 0.f}, a1 = a0, a2 = a0, a3 = a0;
                if (F.lane < 48) {
                    const float* wp = ada_w + ((size_t)l * D) * 12288 + j0 + 4 * c4;
#pragma unroll 8
                    for (int it = 0; it < 128; ++it) { const int k = it * 16 + F.wave * 2 + rsub;
                        const f32x4 w4 = *(const f32x4*)(wp + (size_t)k * 12288);
                        a0 += w4 * cact[k]; a1 += w4 * cact[D + k]; a2 += w4 * cact[2 * D + k]; a3 += w4 * cact[3 * D + k]; }
                    LAS float* rp = red + (F.wave * 2 + rsub) * 384 + 4 * c4;
                    *(LAS f32x4*)(rp) = a0; *(LAS f32x4*)(rp + 96) = a1; *(LAS f32x4*)(rp + 192) = a2; *(LAS f32x4*)(rp + 288) = a3;
                }
                __syncthreads();
                if (F.tid < 384) { const int b = F.tid / 96, col = F.tid - b * 96; float s = ada_b[(size_t)l * 12288 + j0 + col];
#pragma unroll
                    for (int p = 0; p < 16; ++p) s += red[p * 384 + b * 96 + col];
                    MOD[((size_t)l * 4 + b) * 12288 + j0 + col] = s; }
                __syncthreads();
            }
        }
        {
            tr_job(F, hyb_w_in, 0, 1, HYB_IN, D, 0, 4096, WIN0, 0, D, 0, 0);
            tr_job(F, hyb_w_in, 0, 1, HYB_IN, D, 4112, 3072, WIN0, 0, D, 4096, 0);
            tr_job(F, hyb_w_in, 0, 1, HYB_IN, D, 4096, 16, WIN0, 0, D, 7168, 0);
            zero_fill(F, WIN0 + (size_t)7184 * D, (size_t)(NIN - 7184) * D * 2);
            tr_job(F, hyb_w_out, 0, 1, D, D, 0, D, WOUT0, 0, D, 0, 0);
            tr_job(F, mla_w_in, 0, 1, MLA_IN, D, 0, MLA_IN, WMIN, 0, D, 0, 0);
            zero_fill(F, WMIN + (size_t)MLA_IN * D, (size_t)(NMLA - MLA_IN) * D * 2);
            tr_job(F, mla_w_uq, 0, 1, 3072, 512, 0, 3072, WUQ, 0, 512, 0, 0);
            tr_job(F, mla_w_ukv, 0, 1, 4096, 512, 0, 4096, WUKV, 0, 512, 0, 0);
            tr_job(F, mla_w_out, 0, 1, D, D, 0, D, WMOUT, 0, D, 0, 0);
            tr_job(F, moe_router_g, (size_t)D * 8, 2, 8, D, 0, 8, WRT, (size_t)256 * D, D, 0, 0);
            tr_job(F, moe_router_e, (size_t)D * 64, 2, 64, D, 0, 64, WRT, (size_t)256 * D, D, 8, 0);
            zero_fill(F, WRT + (size_t)72 * D, (size_t)(256 - 72) * D * 2);
            zero_fill(F, WRT + (size_t)256 * D + (size_t)72 * D, (size_t)(256 - 72) * D * 2);
        }
        for (int idx = blockIdx.x * 512 + F.tid; idx < T * 32; idx += F.G * 512) {
            const int t = idx >> 5, i = idx & 31;
            const double rev = (double)in_pos[t] * ROPE_INVF[i] * 0.15915494309189535;
            const float fr = (float)(rev - __builtin_rint(rev));
            ROPE_C[idx] = __builtin_amdgcn_cosf(fr); ROPE_S[idx] = __builtin_amdgcn_sinf(fr);
        }
    }
    SEAM(0);

    if (IN(1)) { PHASE_FRESH();
        for (int m = F.gw; m < T; m += F.NGW) {
            const int b = m / SEQ; const float* modb = MOD + (size_t)b * 12288;
            const f32x4* xr = (const f32x4*)(in_x + (size_t)m * D) + F.lane; u32x2* o = (u32x2*)(HIN + (size_t)m * D) + F.lane;
#pragma unroll
            for (int j = 0; j < 8; ++j) { const f32x4 v = xr[64 * j]; const f32x4 sh = ((const f32x4*)(modb))[F.lane + 64 * j], sc = ((const f32x4*)(modb + D))[F.lane + 64 * j];
                const f32x4 h = v * (sc + 1.0f) + sh; u32x2 w; w.x = cvtpk(h[0], h[1]); w.y = cvtpk(h[2], h[3]); o[64 * j] = w; }
        }
    }
    SEAM(1);

    if (IN(2)) { PHASE_FRESH();
        pg8::StaticOrder S; S.init(HIN, WIN0, T, NIN, D, F.G, (int)blockIdx.x);
        pg8::EpiInProj E{PB, PBA};
        pg8::gemm_phase<pg8::EpiInProj, pg8::StaticOrder>(F.lds, D, S, E, F.tid, F.wave);
    }
    SEAM(2);

    if (IN(3)) { PHASE_FRESH();
        constexpr int QS = 136;
        LAS float* MT = (LAS float*)(F.lds);
        LAS bf16* QKM = (LAS bf16*)(F.lds + 17408);
        LAS float* RAWK = (LAS float*)(F.lds);
        LAS float* VF = (LAS float*)(F.lds + 32768);
        LAS float* WL = (LAS float*)(F.lds + 65536);
        LAS bf16* QBl = (LAS bf16*)(F.lds + 98304);
        LAS bf16* KBl = (LAS bf16*)(F.lds + 115712);
        int zoff = 0; asm volatile("" : "+v"(zoff));
        LAS float* s_beta = (LAS float*)(F.lds + 133120 + zoff); LAS float* s_gc = s_beta + 64; LAS float* s_egc = s_beta + 128;
        for (int ch = blockIdx.x; ch < NCH; ch += F.G) {
            PHASE_FRESH();
            const int n = ch & 31, bh = ch >> 5, h = bh & 7, b = bh >> 3;
            const int tok0 = b * SEQ + n * CHK;
            if (F.tid < 384) {
                const int mat = F.tid >> 7, d = F.tid & 127, col = mat * 1024 + h * 128 + d;
                const float w0 = gdn_conv_w[col], w1 = gdn_conv_w[3072 + col], w2 = gdn_conv_w[2 * 3072 + col], w3 = gdn_conv_w[3 * 3072 + col];
                const bf16* pc = PB + (size_t)tok0 * NP + col;
                float xm3 = 0.f, xm2 = 0.f, xm1 = 0.f;
                if (n > 0) { xm3 = bf2f(pc[-3 * NP]); xm2 = bf2f(pc[-2 * NP]); xm1 = bf2f(pc[-NP]); }
                LAS float* dst = (mat == 0) ? WL : (mat == 1 ? RAWK : VF);
#pragma unroll 8
                for (int i = 0; i < 64; ++i) { const float xi = bf2f(pc[(size_t)i * NP]); const float y = w0 * xm3 + w1 * xm2 + w2 * xm1 + w3 * xi;
                    dst[i * 128 + d] = silu_f(y); xm3 = xm2; xm2 = xm1; xm1 = xi; }
            }
            if (F.wave == 7) {
                const int tok = tok0 + F.lane;
                const float br = PBA[(size_t)tok * 16 + h], ar = PBA[(size_t)tok * 16 + 8 + h];
                const float beta = 1.f / (1.f + __expf(-br));
                const float xsp = ar + gdn_dt_bias[h];
                const float sp = fmaxf(xsp, 0.f) + log1pf(__expf(-fabsf(xsp)));
                float g = -__expf(gdn_a_log[h]) * sp;
#pragma unroll
                for (int off = 1; off < 64; off <<= 1) { const float v = __shfl_up(g, off); if (F.lane >= off) g += v; }
                s_beta[F.lane] = beta; s_gc[F.lane] = g; s_egc[F.lane] = __expf(g);
            }
            __syncthreads();
#pragma unroll
            for (int rr = 0; rr < 8; ++rr) {
                const int i = F.wave * 8 + rr;
                const float qa = WL[i * 128 + F.lane], qb2 = WL[i * 128 + 64 + F.lane];
                const float ka = RAWK[i * 128 + F.lane], kb2 = RAWK[i * 128 + 64 + F.lane];
                const float rq = rsqrtf(wave_sum(qa * qa + qb2 * qb2) + 1e-6f) * 0.08838834764831845f;
                const float rk = rsqrtf(wave_sum(ka * ka + kb2 * kb2) + 1e-6f);
                QBl[i * QS + F.lane] = f2bf(qa * rq); QBl[i * QS + 64 + F.lane] = f2bf(qb2 * rq);
                KBl[i * QS + F.lane] = f2bf(ka * rk); KBl[i * QS + 64 + F.lane] = f2bf(kb2 * rk);
            }
            __syncthreads();
            {
                const int mat = F.wave >> 2, mi = (F.wave >> 1) & 1, ni = F.wave & 1, r = F.lane & 31, hh = F.lane >> 5;
                const LAS bf16* Am = (mat == 0) ? KBl : QBl;
                f32x16 acc;
#pragma unroll
                for (int i = 0; i < 16; ++i) acc[i] = 0.f;
#pragma unroll
                for (int ks = 0; ks < 8; ++ks) {
                    const bf16x8 a = *(const LAS bf16x8*)(Am + (32 * mi + r) * QS + 16 * ks + 8 * hh);
                    const bf16x8 bb = *(const LAS bf16x8*)(KBl + (32 * ni + r) * QS + 16 * ks + 8 * hh);
                    acc = MFMA32(a, bb, acc);
                }
                const int j = 32 * ni + r; const float gj = s_gc[j];
#pragma unroll
                for (int reg = 0; reg < 16; ++reg) {
                    const int i = 32 * mi + crow(reg, hh);
                    const float gi = s_gc[i];
                    const float dec = __expf(fminf(gi - gj, 0.f));
                    if (mat == 0) MT[j * 68 + i] = (i > j) ? s_beta[i] * acc[reg] * dec : 0.f;
                    else QKM[i * 64 + j] = f2bf((i >= j) ? acc[reg] * dec : 0.f);
                }
            }
            __syncthreads();
            if (F.tid < 256) {
                const int c = F.tid, dcol = c & 127;
                float X[64];
                if (c < 128) {
#pragma unroll
                    for (int i = 0; i < 64; ++i) X[i] = VF[i * 128 + dcol] * s_beta[i];
                } else {
#pragma unroll
                    for (int i = 0; i < 64; ++i) X[i] = bf2f(KBl[i * QS + dcol]) * s_beta[i] * s_egc[i];
                }
#pragma unroll
                for (int j = 0; j < 63; ++j) {
                    asm volatile("" ::: "memory");
                    const float xj = X[j];
#pragma unroll
                    for (int i4 = ((j + 1) & ~3); i4 < 64; i4 += 4) {
                        const f32x4 m4 = *(const LAS f32x4*)(MT + j * 68 + i4);
#pragma unroll
                        for (int q = 0; q < 4; ++q) if (i4 + q > j) X[i4 + q] -= m4[q] * xj;
                    }
                }
                LAS float* dst = (c < 128) ? VF : WL;
#pragma unroll
                for (int i = 0; i < 64; ++i) dst[i * 128 + dcol] = X[i];
            }
            __syncthreads();
            {
                const int r = F.lane & 31, hh = F.lane >> 5;
                const float gl = s_gc[63];
                unsigned char* gf = GF + (size_t)ch * 57344;
                for (int f = F.wave; f < 56; f += 8) {
                    float v[8];
                    if (f < 16) { const int mt = f >> 3, ks = f & 7; const LAS float* src = WL + (32 * mt + r) * 128 + 16 * ks + 4 * hh;
#pragma unroll
                        for (int j = 0; j < 8; ++j) v[j] = -src[8 * (j >> 2) + (j & 3)]; }
                    else if (f < 32) { const int f2 = f - 16, mt = f2 >> 3, ks = f2 & 7, i = 32 * mt + r; const float e = s_egc[i]; const LAS bf16* src = QBl + i * QS + 16 * ks + 4 * hh;
#pragma unroll
                        for (int j = 0; j < 8; ++j) v[j] = bf2f(src[8 * (j >> 2) + (j & 3)]) * e; }
                    else if (f < 40) { const int f2 = f - 32, mt = f2 >> 2, ks = f2 & 3; const LAS bf16* src = QKM + (32 * mt + r) * 64 + 16 * ks + 4 * hh;
#pragma unroll
                        for (int j = 0; j < 8; ++j) v[j] = bf2f(src[8 * (j >> 2) + (j & 3)]); }
                    else { const int f2 = f - 40, mt = f2 >> 2, ks = f2 & 3, dd = 32 * mt + r;
#pragma unroll
                        for (int j = 0; j < 8; ++j) { const int i = 16 * ks + 8 * (j >> 2) + 4 * hh + (j & 3); v[j] = bf2f(KBl[i * QS + dd]) * __expf(gl - s_gc[i]); } }
                    u32x4 o; o.x = cvtpk(v[0], v[1]); o.y = cvtpk(v[2], v[3]); o.z = cvtpk(v[4], v[5]); o.w = cvtpk(v[6], v[7]);
                    *(u32x4*)(gf + f * 1024 + F.lane * 16) = o;
                }
                { const int sl = F.wave >> 1, it = F.wave & 1, col = 32 * sl + r;
                  float* up = (float*)(GU + (size_t)ch * 32768 + (size_t)((sl * 2 + it) * 64 + F.lane) * 64);
#pragma unroll
                  for (int g4 = 0; g4 < 4; ++g4) { f32x4 t4;
#pragma unroll
                      for (int q = 0; q < 4; ++q) t4[q] = VF[(32 * it + crow(4 * g4 + q, hh)) * 128 + col];
                      *(f32x4*)(up + 4 * g4) = t4; } }
                if (F.tid == 0) EG[ch] = __expf(gl);
            }
            __syncthreads();
        }
    }
    SEAM(3);

    if (IN(4)) { PHASE_FRESH();
        for (int bh = blockIdx.x; bh < BATCH * GH; bh += F.G) {
            const int b = bh >> 3, hd = bh & 7, r = F.lane & 31, hh = F.lane >> 5, sl = F.wave;
            f32x16 S[4];
#pragma unroll
            for (int dt = 0; dt < 4; ++dt)
#pragma unroll
                for (int i = 0; i < 16; ++i) S[dt][i] = 0.f;
            f32x16 un[2];
            if (F.wave >= 4) {
                const int t4 = F.tid - 256; const unsigned char* g0 = GF + opaque_off((size_t)(bh * 32) * 57344 + (size_t)t4 * 16);
#pragma unroll
                for (int q = 0; q < 14; ++q) *(LAS u32x4*)(F.lds + (t4 + 256 * q) * 16) = *(const u32x4*)(g0 + (size_t)q * 4096);
            } else {
#pragma unroll
                for (int it = 0; it < 2; ++it) { const f32x4* up = (const f32x4*)(GU + opaque_off((size_t)(bh * 32) * 32768 + (size_t)((sl * 2 + it) * 64 + F.lane) * 64));
#pragma unroll
                    for (int g4 = 0; g4 < 4; ++g4) { const f32x4 t4 = up[g4]; un[it][4 * g4] = t4[0]; un[it][4 * g4 + 1] = t4[1]; un[it][4 * g4 + 2] = t4[2]; un[it][4 * g4 + 3] = t4[3]; } }
            }
            __syncthreads();
            for (int n = 0; n < NCHK; ++n) {
                const int ch = bh * 32 + n; const bool more = (n + 1 < NCHK);
                if (F.wave >= 4) {
                    if (more) {
                        const unsigned char* gn = GF + opaque_off((size_t)(ch + 1) * 57344 + (size_t)(F.tid - 256) * 16); LAS unsigned char* nb = F.lds + ((n + 1) & 1) * 57344; const int t4 = F.tid - 256;
#pragma unroll
                        for (int q = 0; q < 14; ++q) *(LAS u32x4*)(nb + (t4 + 256 * q) * 16) = *(const u32x4*)(gn + (size_t)q * 4096);
                    }
                } else {
                    const LAS unsigned char* buf = F.lds + (n & 1) * 57344 + F.lane * 16;
                    const float eg = EG[ch];
                    bf16x8 Sb[8];
#pragma unroll
                    for (int dt = 0; dt < 4; ++dt) { Sb[2 * dt] = pack_acc(S[dt], 0); Sb[2 * dt + 1] = pack_acc(S[dt], 1); }
                    f32x16 vn[2]; vn[0] = un[0]; vn[1] = un[1];
#pragma unroll
                    for (int it = 0; it < 2; ++it)
#pragma unroll
                        for (int ks = 0; ks < 8; ++ks) vn[it] = MFMA32(*(const LAS bf16x8*)(buf + (it * 8 + ks) * 1024), Sb[ks], vn[it]);
                    __builtin_amdgcn_sched_barrier(0);
                    f32x16 oa[2];
#pragma unroll
                    for (int it = 0; it < 2; ++it) {
#pragma unroll
                        for (int i = 0; i < 16; ++i) oa[it][i] = 0.f;
#pragma unroll
                        for (int ks = 0; ks < 8; ++ks) oa[it] = MFMA32(*(const LAS bf16x8*)(buf + (16 + it * 8 + ks) * 1024), Sb[ks], oa[it]);
                    }
                    __builtin_amdgcn_sched_barrier(0);
                    bf16x8 vb[4];
#pragma unroll
                    for (int it = 0; it < 2; ++it) { vb[2 * it] = pack_acc(vn[it], 0); vb[2 * it + 1] = pack_acc(vn[it], 1); }
                    __builtin_amdgcn_sched_barrier(0);
                    {
                        const int chn = more ? ch + 1 : ch;
#pragma unroll
                        for (int it = 0; it < 2; ++it) { const f32x4* up = (const f32x4*)(GU + opaque_off((size_t)chn * 32768 + (size_t)((sl * 2 + it) * 64 + F.lane) * 64));
#pragma unroll
                            for (int g4 = 0; g4 < 4; ++g4) { const f32x4 t4 = up[g4]; un[it][4 * g4] = t4[0]; un[it][4 * g4 + 1] = t4[1]; un[it][4 * g4 + 2] = t4[2]; un[it][4 * g4 + 3] = t4[3]; } }
                    }
                    __builtin_amdgcn_sched_barrier(0);
#pragma unroll
                    for (int it = 0; it < 2; ++it)
#pragma unroll
                        for (int ks = 0; ks < 4; ++ks) oa[it] = MFMA32(*(const LAS bf16x8*)(buf + (32 + it * 4 + ks) * 1024), vb[ks], oa[it]);
#pragma unroll
                    for (int it = 0; it < 2; ++it) {
#pragma unroll
                        for (int g4 = 0; g4 < 4; ++g4) { float* op = GO + opaque_off((size_t)(b * SEQ + n * CHK + 32 * it + 8 * g4 + 4 * hh) * 1024 + hd * 128 + sl * 32 + r);
#pragma unroll
                            for (int q = 0; q < 4; ++q) op[q * 1024] = oa[it][4 * g4 + q]; } }
                    __builtin_amdgcn_sched_barrier(0);
#pragma unroll
                    for (int dt = 0; dt < 4; ++dt) {
#pragma unroll
                        for (int i = 0; i < 16; ++i) S[dt][i] *= eg;
#pragma unroll
                        for (int ks = 0; ks < 4; ++ks) S[dt] = MFMA32(*(const LAS bf16x8*)(buf + (40 + dt * 4 + ks) * 1024), vb[ks], S[dt]);
                    }
                }
                LDS_WAIT(); __builtin_amdgcn_s_barrier(); asm volatile("" ::: "memory");
            }
            __syncthreads();
        }
    }
    SEAM(4);

    if (IN(5)) { PHASE_FRESH();
        for (int m = F.gw; m < T; m += F.NGW) {
            const int s = m & (SEQ - 1), c0 = F.lane * 16;
            const bf16* prow = PB + (size_t)m * NP;
            {
                const f32x4* op = (const f32x4*)(GO + (size_t)m * 1024 + c0);
                f32x4 o[4]; float ss = 0.f;
#pragma unroll
                for (int q = 0; q < 4; ++q) { o[q] = op[q]; ss += o[q][0] * o[q][0] + o[q][1] * o[q][1] + o[q][2] * o[q][2] + o[q][3] * o[q][3]; }
                ss += __shfl_xor(ss, 1); ss += __shfl_xor(ss, 2); ss += __shfl_xor(ss, 4);
                const float rms = rsqrtf(ss * (1.f / 128.f) + 1e-6f);
                const u32x4* zp = (const u32x4*)(prow + 3072 + c0); const u32x4 z0 = zp[0], z1 = zp[1];
                const unsigned zw[8] = {z0.x, z0.y, z0.z, z0.w, z1.x, z1.y, z1.z, z1.w};
                const f32x4* nwp = (const f32x4*)(gdn_norm_w + (c0 & 127));
                unsigned ow[8];
#pragma unroll
                for (int q = 0; q < 4; ++q) { const f32x4 nw = nwp[q];
                    const float y0 = o[q][0] * rms * nw[0] * silu_f(bflo(zw[2 * q])), y1 = o[q][1] * rms * nw[1] * silu_f(bfhi(zw[2 * q]));
                    const float y2 = o[q][2] * rms * nw[2] * silu_f(bflo(zw[2 * q + 1])), y3 = o[q][3] * rms * nw[3] * silu_f(bfhi(zw[2 * q + 1]));
                    ow[2 * q] = cvtpk(y0, y1); ow[2 * q + 1] = cvtpk(y2, y3); }
                u32x4* yp = (u32x4*)(YAB + (size_t)m * D + c0);
                yp[0] = (u32x4){ow[0], ow[1], ow[2], ow[3]}; yp[1] = (u32x4){ow[4], ow[5], ow[6], ow[7]};
            }
            {
                float accv[16];
#pragma unroll
                for (int q = 0; q < 16; ++q) accv[q] = 0.f;
#pragma unroll
                for (int j = 0; j < 3; ++j) {
                    if (s - 2 + j >= 0) {
                        const bf16* pr = prow + (ptrdiff_t)(j - 2) * NP;
                        const u32x4* cp = (const u32x4*)(pr + 5120 + c0); const u32x4* hp = (const u32x4*)(pr + 6144 + c0);
                        const u32x4 ca = cp[0], cb = cp[1], ha = hp[0], hb = hp[1];
                        const unsigned cw[8] = {ca.x, ca.y, ca.z, ca.w, cb.x, cb.y, cb.z, cb.w}, hw[8] = {ha.x, ha.y, ha.z, ha.w, hb.x, hb.y, hb.z, hb.w};
                        const f32x4* wp = (const f32x4*)(sc_conv_w + j * 1024 + c0);
#pragma unroll
                        for (int q = 0; q < 4; ++q) { const f32x4 w4 = wp[q];
                            accv[4 * q] += w4[0] * bflo(cw[2 * q]) * bflo(hw[2 * q]); accv[4 * q + 1] += w4[1] * bfhi(cw[2 * q]) * bfhi(hw[2 * q]);
                            accv[4 * q + 2] += w4[2] * bflo(cw[2 * q + 1]) * bflo(hw[2 * q + 1]); accv[4 * q + 3] += w4[3] * bfhi(cw[2 * q + 1]) * bfhi(hw[2 * q + 1]); }
                    }
                }
                const u32x4* bp = (const u32x4*)(prow + 4096 + c0); const u32x4 ba = bp[0], bb = bp[1];
                const unsigned bw[8] = {ba.x, ba.y, ba.z, ba.w, bb.x, bb.y, bb.z, bb.w};
                unsigned ow[8];
#pragma unroll
                for (int q = 0; q < 8; ++q) ow[q] = cvtpk(bflo(bw[q]) * accv[2 * q], bfhi(bw[q]) * accv[2 * q + 1]);
                u32x4* yp = (u32x4*)(YAB + (size_t)m * D + 1024 + c0);
                yp[0] = (u32x4){ow[0], ow[1], ow[2], ow[3]}; yp[1] = (u32x4){ow[4], ow[5], ow[6], ow[7]};
            }
        }
    }
    SEAM(5);

    if (IN(6)) { PHASE_FRESH();
        pg8::StaticOrder S; S.init(YAB, WOUT0, T, D, D, F.G, (int)blockIdx.x);
        pg8::EpiResid E{in_x, MOD + 2 * D, RB};
        pg8::gemm_phase<pg8::EpiResid, pg8::StaticOrder>(F.lds, D, S, E, F.tid, F.wave);
    }
    SEAM(6);

    if (IN(7)) { PHASE_FRESH();
        for (int m = F.gw; m < T; m += F.NGW) {
            const int b = m / SEQ; const float* modb = MOD + (size_t)b * 12288;
            f32x4 v[8];
#pragma unroll
            for (int j = 0; j < 8; ++j) v[j] = ((const f32x4*)(RB + (size_t)m * D))[F.lane + 64 * j];
            LN_ROW(v, ln_g, ln_b);
            bf16* hrow = HIN + (size_t)m * D;
            WRITE_X_HIN(v, XA + (size_t)m * D, hrow, modb + 3 * D, modb + 4 * D);
        }
    }
    SEAM(7);

    moe_phases<0>(F, args, bar, lo, hi, TAB);

        if (IN(14)) { PHASE_FRESH();
            pg8::StaticOrder S; S.init(HIN, WMIN, T, NMLA, D, F.G, (int)blockIdx.x);
            pg8::EpiF32 E{C1, NMLA};
            pg8::gemm_phase<pg8::EpiF32, pg8::StaticOrder>(F.lds, D, S, E, F.tid, F.wave);
        }
        SEAM(14);
        if (IN(15)) { PHASE_FRESH();
            for (int m = F.gw; m < T; m += F.NGW) {
                const float* c1 = C1 + (size_t)m * NMLA;
#pragma unroll
                for (int part = 0; part < 2; ++part) {
                    const f32x4* p = (const f32x4*)(c1 + part * 512 + 8 * F.lane); const f32x4 a0 = p[0], a1 = p[1];
                    const float ss = wave_sum((a0[0] * a0[0] + a0[1] * a0[1]) + (a0[2] * a0[2] + a0[3] * a0[3]) + (a1[0] * a1[0] + a1[1] * a1[1]) + (a1[2] * a1[2] + a1[3] * a1[3]));
                    const float rn = rsqrtf(ss * (1.f / 512.f) + 1e-6f);
                    const f32x4* wp = (const f32x4*)((part == 0 ? mla_q_norm : mla_kv_norm) + 8 * F.lane); const f32x4 w0 = wp[0], w1 = wp[1];
                    u32x4 o; o.x = cvtpk(a0[0] * rn * w0[0], a0[1] * rn * w0[1]); o.y = cvtpk(a0[2] * rn * w0[2], a0[3] * rn * w0[3]);
                    o.z = cvtpk(a1[0] * rn * w1[0], a1[1] * rn * w1[1]); o.w = cvtpk(a1[2] * rn * w1[2], a1[3] * rn * w1[3]);
                    *(u32x4*)((part == 0 ? CQN : CKVN) + (size_t)m * 512 + 8 * F.lane) = o;
                }
                if (F.lane < 32) { const float x1 = c1[1024 + F.lane], x2 = c1[1056 + F.lane], cs = ROPE_C[(size_t)m * 32 + F.lane], sn = ROPE_S[(size_t)m * 32 + F.lane];
                    KPE[(size_t)m * 64 + F.lane] = x1 * cs - x2 * sn; KPE[(size_t)m * 64 + 32 + F.lane] = x1 * sn + x2 * cs; }
            }
        }
        SEAM(15);
        if (IN(16)) { PHASE_FRESH();
            { pg8::StaticOrder S; S.init(CQN, WUQ, T, 3072, 512, F.G, (int)blockIdx.x); pg8::EpiQup E{QB_};
              pg8::gemm_phase<pg8::EpiQup, pg8::StaticOrder>(F.lds, 512, S, E, F.tid, F.wave); }
            { pg8::StaticOrder S; S.init(CKVN, WUKV, T, 4096, 512, F.G, (int)blockIdx.x); pg8::EpiKVup E{KB_, VB_};
              pg8::gemm_phase<pg8::EpiKVup, pg8::StaticOrder>(F.lds, 512, S, E, F.tid, F.wave); }
        }
        SEAM(16);
        if (IN(17)) { PHASE_FRESH();
            for (int m = F.gw; m < T; m += F.NGW) {
                const int b = m / SEQ, s = m - b * SEQ, hd = F.lane >> 2, i0 = (F.lane & 3) * 8;
                const size_t rowoff = ((size_t)((b * MH + hd) * SEQ + s)) * QD + 128;
                bf16* qp = QB_ + rowoff;
                const u32x4 xa = *(const u32x4*)(qp + i0), xb = *(const u32x4*)(qp + 32 + i0);
                const f32x4* cp = (const f32x4*)(ROPE_C + (size_t)m * 32 + i0); const f32x4* sp = (const f32x4*)(ROPE_S + (size_t)m * 32 + i0);
                const f32x4 c0 = cp[0], c1v = cp[1], s0 = sp[0], s1 = sp[1];
                const float cs[8] = {c0[0], c0[1], c0[2], c0[3], c1v[0], c1v[1], c1v[2], c1v[3]}, sn[8] = {s0[0], s0[1], s0[2], s0[3], s1[0], s1[1], s1[2], s1[3]};
                const unsigned xaw[4] = {xa.x, xa.y, xa.z, xa.w}, xbw[4] = {xb.x, xb.y, xb.z, xb.w};
                unsigned o1[4], o2[4];
#pragma unroll
                for (int q = 0; q < 4; ++q) { const float a0 = bflo(xaw[q]), a1 = bfhi(xaw[q]), b0 = bflo(xbw[q]), b1 = bfhi(xbw[q]);
                    o1[q] = cvtpk(a0 * cs[2 * q] - b0 * sn[2 * q], a1 * cs[2 * q + 1] - b1 * sn[2 * q + 1]);
                    o2[q] = cvtpk(a0 * sn[2 * q] + b0 * cs[2 * q], a1 * sn[2 * q + 1] + b1 * cs[2 * q + 1]); }
                *(u32x4*)(qp + i0) = (u32x4){o1[0], o1[1], o1[2], o1[3]}; *(u32x4*)(qp + 32 + i0) = (u32x4){o2[0], o2[1], o2[2], o2[3]};
                const f32x4* kp = (const f32x4*)(KPE + (size_t)m * 64 + i0); const f32x4* kp2 = (const f32x4*)(KPE + (size_t)m * 64 + 32 + i0);
                const f32x4 k0 = kp[0], k1 = kp[1], k2 = kp2[0], k3 = kp2[1];
                bf16* kd = KB_ + rowoff;
                *(u32x4*)(kd + i0) = (u32x4){cvtpk(k0[0], k0[1]), cvtpk(k0[2], k0[3]), cvtpk(k1[0], k1[1]), cvtpk(k1[2], k1[3])};
                *(u32x4*)(kd + 32 + i0) = (u32x4){cvtpk(k2[0], k2[1]), cvtpk(k2[2], k2[3]), cvtpk(k3[0], k3[1]), cvtpk(k3[2], k3[3])};
            }
            {
                LAS bf16* scr = (LAS bf16*)(F.lds + F.wave * 17408);
                for (int it = F.gw; it < 64 * 32; it += F.NGW) {
                    const int bhh = it >> 5, sb = it & 31, b = bhh >> 4, hd = bhh & 15, s0 = sb * 64;
#pragma unroll 4
                    for (int i = 0; i < 16; ++i) { const int row = 4 * i + (F.lane >> 4), c8 = (F.lane & 15) * 8;
                        *(LAS u32x4*)(scr + row * 136 + c8) = *(const u32x4*)(VB_ + (size_t)(b * SEQ + s0 + row) * D + hd * 128 + c8); }
                    LDS_WAIT(); asm volatile("" ::: "memory");
                    bf16* dst = VT + ((size_t)bhh * 128) * SEQ + s0 + F.lane;
#pragma unroll 8
                    for (int dv = 0; dv < 128; ++dv) dst[(size_t)dv * SEQ] = scr[F.lane * 136 + dv];
                    LDS_WAIT(); asm volatile("" ::: "memory");
                }
            }
        }
        SEAM(17);
        if (IN(18)) { PHASE_FRESH();
            constexpr int KBUF = 64 * 400, VBUF = 128 * 136;
            LAS unsigned char* KL = F.lds; LAS unsigned char* VL = F.lds + 2 * KBUF;
            const int w = F.wave;
            for (int pi = blockIdx.x; pi < 256; pi += F.G) {
                const int bhh = pi >> 2, pp = pi & 3, b = bhh >> 4, hd = bhh & 15;
                const char* kg = (const char*)(KB_ + (size_t)bhh * SEQ * QD); const char* vg = (const char*)(VT + (size_t)bhh * 128 * SEQ);
                for (int half = 0; half < 2; ++half) {
                    PHASE_FRESH(); const int r = F.lane & 31, hh = F.lane >> 5;
                    const int qb = half == 0 ? 7 - pp : pp, q0 = qb * 256, ntile = 4 * (qb + 1), qrow = q0 + 32 * w + r;
                    bf16x8 qf[12];
                    { const bf16* qp = QB_ + ((size_t)bhh * SEQ + qrow) * QD + 8 * hh;
#pragma unroll
                      for (int ks = 0; ks < 12; ++ks) qf[ks] = *(const bf16x8*)(qp + 16 * ks); }
                    f32x16 oT[4];
#pragma unroll
                    for (int mt = 0; mt < 4; ++mt)
#pragma unroll
                        for (int i = 0; i < 16; ++i) oT[mt][i] = 0.f;
                    float mrun = -1e30f, lsum = 0.f;
                    u32x4 kst[3], vst[2];
#pragma unroll
                    for (int q = 0; q < 3; ++q) kst[q] = *(const u32x4*)(kg + (size_t)(F.tid + 512 * q) * 16);
#pragma unroll
                    for (int q = 0; q < 2; ++q) { const int p = F.tid + 512 * q; vst[q] = *(const u32x4*)(vg + (size_t)(p >> 3) * (SEQ * 2) + (p & 7) * 16); }
#pragma unroll
                    for (int q = 0; q < 3; ++q) { const int p = F.tid + 512 * q; *(LAS u32x4*)(KL + (p / 24) * 400 + (p % 24) * 16) = kst[q]; }
#pragma unroll
                    for (int q = 0; q < 2; ++q) { const int p = F.tid + 512 * q; LAS unsigned char* d = VL + (p >> 3) * 136 + (p & 7) * 16;
                        *(LAS u32x2*)d = (u32x2){vst[q].x, vst[q].y}; *(LAS u32x2*)(d + 8) = (u32x2){vst[q].z, vst[q].w}; }
                    __syncthreads();
                    for (int kt = 0; kt < ntile; ++kt) {
                        const bool more = (kt + 1 < ntile); const int k0 = kt * 64;
                        if (more) {
                            const int k1 = k0 + 64;
#pragma unroll
                            for (int q = 0; q < 3; ++q) kst[q] = *(const u32x4*)(kg + (size_t)k1 * (QD * 2) + (size_t)(F.tid + 512 * q) * 16);
#pragma unroll
                            for (int q = 0; q < 2; ++q) { const int p = F.tid + 512 * q; vst[q] = *(const u32x4*)(vg + (size_t)(p >> 3) * (SEQ * 2) + (size_t)k1 * 2 + (p & 7) * 16); }
                        }
                        if (k0 <= q0 + 32 * w + 31) {
                            const LAS unsigned char* kb = KL + (kt & 1) * KBUF; const LAS unsigned char* vb_ = VL + (kt & 1) * VBUF;
                            f32x16 sT[2];
#pragma unroll
                            for (int kk = 0; kk < 2; ++kk) {
#pragma unroll
                                for (int i = 0; i < 16; ++i) sT[kk][i] = 0.f;
#pragma unroll
                                for (int ks = 0; ks < 12; ++ks) sT[kk] = MFMA32(*(const LAS bf16x8*)(kb + (32 * kk + r) * 400 + (16 * ks + 8 * hh) * 2), qf[ks], sT[kk]);
                            }
                            if (k0 + 63 > q0 + 32 * w) {
#pragma unroll
                                for (int kk = 0; kk < 2; ++kk)
#pragma unroll
                                    for (int reg = 0; reg < 16; ++reg) { const int key = k0 + 32 * kk + crow(reg, hh); if (key > qrow) sT[kk][reg] = -1e30f; }
                            }
                            float mloc = sT[0][0];
#pragma unroll
                            for (int kk = 0; kk < 2; ++kk)
#pragma unroll
                                for (int reg = 0; reg < 16; ++reg) mloc = fmaxf(mloc, sT[kk][reg]);
                            mloc = fmaxf(mloc, __shfl_xor(mloc, 32));
                            const float mnew = fmaxf(mrun, mloc), alpha = __builtin_amdgcn_exp2f(mrun - mnew);
                            float ps = 0.f;
#pragma unroll
                            for (int kk = 0; kk < 2; ++kk)
#pragma unroll
                                for (int reg = 0; reg < 16; ++reg) { const float pe = __builtin_amdgcn_exp2f(sT[kk][reg] - mnew); sT[kk][reg] = pe; ps += pe; }
                            lsum = lsum * alpha + ps; mrun = mnew;
#pragma unroll
                            for (int mt = 0; mt < 4; ++mt)
#pragma unroll
                                for (int i = 0; i < 16; ++i) oT[mt][i] *= alpha;
                            bf16x8 pb[4];
#pragma unroll
                            for (int kk = 0; kk < 2; ++kk) { pb[2 * kk] = pack_acc(sT[kk], 0); pb[2 * kk + 1] = pack_acc(sT[kk], 1); }
#pragma unroll
                            for (int mt = 0; mt < 4; ++mt)
#pragma unroll
                                for (int ks = 0; ks < 4; ++ks) { const LAS unsigned char* vp = vb_ + (32 * mt + r) * 136 + (16 * ks + 4 * hh) * 2;
                                    const u32x2 vlo = *(const LAS u32x2*)vp, vhi = *(const LAS u32x2*)(vp + 16);
                                    const u32x4 va = {vlo.x, vlo.y, vhi.x, vhi.y};
                                    oT[mt] = MFMA32(__builtin_bit_cast(bf16x8, va), pb[ks], oT[mt]); }
                        }
                        if (more) {
                            LAS unsigned char* kn = KL + ((kt + 1) & 1) * KBUF; LAS unsigned char* vn_ = VL + ((kt + 1) & 1) * VBUF;
#pragma unroll
                            for (int q = 0; q < 3; ++q) { const int p = F.tid + 512 * q; *(LAS u32x4*)(kn + (p / 24) * 400 + (p % 24) * 16) = kst[q]; }
#pragma unroll
                            for (int q = 0; q < 2; ++q) { const int p = F.tid + 512 * q; LAS unsigned char* d = vn_ + (p >> 3) * 136 + (p & 7) * 16;
                                *(LAS u32x2*)d = (u32x2){vst[q].x, vst[q].y}; *(LAS u32x2*)(d + 8) = (u32x2){vst[q].z, vst[q].w}; }
                        }
                        __syncthreads();
                    }
                    const float ltot = lsum + __shfl_xor(lsum, 32), inv = 1.f / ltot;
                    bf16* orow = YAB + (size_t)(b * SEQ + qrow) * D + hd * 128 + 4 * hh;
#pragma unroll
                    for (int mt = 0; mt < 4; ++mt)
#pragma unroll
                        for (int g4 = 0; g4 < 4; ++g4) { u32x2 o; o.x = cvtpk(oT[mt][4 * g4] * inv, oT[mt][4 * g4 + 1] * inv); o.y = cvtpk(oT[mt][4 * g4 + 2] * inv, oT[mt][4 * g4 + 3] * inv);
                            *(u32x2*)(orow + 32 * mt + 8 * g4) = o; }
                }
            }
        }
        SEAM(18);
        if (IN(19)) { PHASE_FRESH();
            pg8::StaticOrder S; S.init(YAB, WMOUT, T, D, D, F.G, (int)blockIdx.x);
            pg8::EpiResid E{XB, MOD + (size_t)4 * 12288 + 2 * D, RB};
            pg8::gemm_phase<pg8::EpiResid, pg8::StaticOrder>(F.lds, D, S, E, F.tid, F.wave);
        }
        SEAM(19);
        if (IN(20)) { PHASE_FRESH();
            for (int m = F.gw; m < T; m += F.NGW) {
                const int b = m / SEQ; const float* modb = MOD + (size_t)(4 + b) * 12288;
                f32x4 v[8];
#pragma unroll
                for (int j = 0; j < 8; ++j) v[j] = ((const f32x4*)(RB + (size_t)m * D))[F.lane + 64 * j];
                LN_ROW(v, ln_g + 2 * D, ln_b + 2 * D);
                bf16* hrow = HIN + (size_t)m * D;
                WRITE_X_HIN(v, XA + (size_t)m * D, hrow, modb + 3 * D, modb + 4 * D);
            }
        }
        SEAM(20);

    moe_phases<1>(F, args, bar, lo, hi, TAB);
#undef IN
#undef INL
#undef SEAM
#undef WSB
#undef in_x
#undef in_c
#undef in_pos
#undef ada_w
#undef ada_b
#undef ln_g
#undef ln_b
#undef hyb_w_in
#undef gdn_conv_w
#undef gdn_a_log
#undef gdn_dt_bias
#undef gdn_norm_w
#undef sc_conv_w
#undef hyb_w_out
#undef mla_w_in
#undef mla_q_norm
#undef mla_kv_norm
#undef mla_w_uq
#undef mla_w_ukv
#undef mla_w_out
#undef moe_router_g
#undef moe_bias_g
#undef moe_router_e
#undef moe_bias_e
#undef moe_w_gate
#undef moe_w_up
#undef moe_w_down
#undef MOD
#undef ROPE_C
#undef ROPE_S
#undef PBA
#undef LOGITS
#undef TOK_E
#undef TOK_POS
#undef TOK_GATE
#undef EG
#undef WIN0
#undef WOUT0
#undef WMIN
#undef WUQ
#undef WUKV
#undef WMOUT
#undef WRT
#undef WGU
#undef WDN
#undef HIN
#undef XA
#undef XB
#undef RB
#undef PB
#undef GF
#undef GU
#undef GO
#undef YAB
#undef LISTP
#undef HID
#undef YS
#undef C1
#undef CQN
#undef CKVN
#undef KPE
#undef QB_
#undef KB_
#undef VB_
#undef VT
}

extern "C" void kernel_launch(void* const* d_in, const int* in_sizes, int n_in, void* d_out, int out_size, void* d_ws, size_t ws_size, hipStream_t stream) {
    static int grid = 0;
    if (grid == 0) {
        if (n_in != 27 || in_sizes[0] != T * D || out_size != T * D || ws_size < WS_END) { fprintf(stderr, "kernel_launch: unexpected problem (n_in %d, in0 %d, out %d, ws %zu)\n", n_in, n_in > 0 ? in_sizes[0] : -1, out_size, ws_size); grid = -1; return; }
        int dev = 0, cus = 0, per_cu = 0;
        if (hipGetDevice(&dev) != hipSuccess || hipDeviceGetAttribute(&cus, hipDeviceAttributeMultiprocessorCount, dev) != hipSuccess) { grid = -1; return; }
        if (hipFuncSetAttribute((const void*)mega, hipFuncAttributeMaxDynamicSharedMemorySize, LDS_BYTES) != hipSuccess) { fprintf(stderr, "kernel_launch: hipFuncSetAttribute failed\n"); grid = -1; return; }
        if (hipOccupancyMaxActiveBlocksPerMultiprocessor(&per_cu, (const void*)mega, 512, LDS_BYTES) != hipSuccess || per_cu < 1) fprintf(stderr, "kernel_launch: occupancy query reports %d\n", per_cu);
        (void)hipGetLastError();
        grid = cus;
    }
    if (grid < 0) return;
    (void)hipMemsetAsync((char*)d_ws + WS_CTL, 0, CTL_ZERO_BYTES, stream);
    Args a{};
    for (int i = 0; i < 27; ++i) a.in[i] = d_in[i];
    a.out = (float*)d_out; a.ws = (unsigned char*)d_ws;
#if MK_ONE_LAUNCH
    a.ph_lo = 0; a.ph_hi = NPH;
    hipLaunchKernelGGL(mega, dim3(grid), dim3(512), LDS_BYTES, stream, a);
#else
    for (int k = 0; k < NPH; ++k) { a.ph_lo = k; a.ph_hi = k + 1; hipLaunchKernelGGL(mega, dim3(grid), dim3(512), LDS_BYTES, stream, a); }
#endif
}
```

```cpp
#include <hip/hip_runtime.h>
#include <cstdio>
#include <cstdint>

#ifndef MK_ONE_LAUNCH
#define MK_ONE_LAUNCH 1
#endif

#define DI __device__ __forceinline__
#define GAS __attribute__((address_space(1)))
#define LAS __attribute__((address_space(3)))
typedef unsigned short bf16;
typedef float f32x4 __attribute__((ext_vector_type(4)));
typedef float f32x2 __attribute__((ext_vector_type(2)));
typedef float f32x16 __attribute__((ext_vector_type(16)));
typedef short bf16x8 __attribute__((ext_vector_type(8)));
typedef short s16x4 __attribute__((ext_vector_type(4)));
typedef unsigned u32x4 __attribute__((ext_vector_type(4)));
typedef unsigned u32x2 __attribute__((ext_vector_type(2)));
typedef __bf16 bf16x2_t __attribute__((ext_vector_type(2)));
typedef GAS unsigned gu32;
#define RLX_AGENT __ATOMIC_RELAXED, __HIP_MEMORY_SCOPE_AGENT
#define LDS_WAIT() asm volatile("s_waitcnt lgkmcnt(0)" ::: "memory")
#define VM_WAIT() asm volatile("s_waitcnt vmcnt(0)" ::: "memory")
#define MFMA32(a, b, c) __builtin_amdgcn_mfma_f32_32x32x16_bf16((a), (b), (c), 0, 0, 0)

DI unsigned cvtpk(float lo, float hi) { f32x2 v = {lo, hi}; bf16x2_t b = __builtin_convertvector(v, bf16x2_t); return __builtin_bit_cast(unsigned, b); }
DI bf16 f2bf(float f) { return (bf16)(cvtpk(f, 0.f) & 0xffffu); }
DI float bf2f(bf16 b) { return __uint_as_float(((unsigned)b) << 16); }
DI float bflo(unsigned w) { return __uint_as_float(w << 16); }
DI float bfhi(unsigned w) { return __uint_as_float(w & 0xffff0000u); }
DI int crow(int reg, int h) { return (reg & 3) + 8 * (reg >> 2) + 4 * h; }
DI int kperm(int j, int h) { return 8 * (j >> 2) + 4 * h + (j & 3); }
DI float wave_sum(float v) {
#pragma unroll
    for (int o = 1; o < 64; o <<= 1) v += __shfl_xor(v, o);
    return v;
}
DI bf16x8 pack_acc(const f32x16& x, int s) {
    u32x4 p; p.x = cvtpk(x[8 * s + 0], x[8 * s + 1]); p.y = cvtpk(x[8 * s + 2], x[8 * s + 3]); p.z = cvtpk(x[8 * s + 4], x[8 * s + 5]); p.w = cvtpk(x[8 * s + 6], x[8 * s + 7]);
    return __builtin_bit_cast(bf16x8, p);
}
DI float silu_f(float x) { return x / (1.f + __expf(-x)); }
DI size_t opaque_off(size_t o) { asm volatile("" : "+v"(o)); return o; }

constexpr int D = 2048, BATCH = 4, SEQ = 2048, T = BATCH * SEQ;
constexpr int GH = 8, GD = 128, NCHK = 32, CHK = 64, NCH = BATCH * GH * NCHK;
constexpr int HYB_IN = 7184, NIN = 7424, NP = 7168;
constexpr int MH = 16, MLA_IN = 1088, NMLA = 1280, QD = 192;
constexpr int NE = 64, FF = 512, MAXBLK = 128;
constexpr float DN_ALPHA = 1.41421356237f;
constexpr float QSCALE = 0.10411754627697264f;
constexpr int NPH = 27;

constexpr size_t MiB = 1u << 20;
constexpr size_t WS_CTL = 0, CTL_ZERO_BYTES = 1 * MiB;
constexpr size_t WS_MOD = 1 * MiB;
constexpr size_t WS_ROPE = 2 * MiB;
constexpr size_t WS_PBA = 4 * MiB;
constexpr size_t WS_LOGITS = 5 * MiB;
constexpr size_t WS_ROUTE = 9 * MiB;
constexpr size_t WS_EG = 10 * MiB;
constexpr size_t WS_WIN0 = 16 * MiB;
constexpr size_t WS_WOUT0 = 46 * MiB;
constexpr size_t WS_WMIN = 54 * MiB;
constexpr size_t WS_WUQ = 59 * MiB;
constexpr size_t WS_WUKV = 62 * MiB;
constexpr size_t WS_WMOUT = 66 * MiB;
constexpr size_t WS_WRT = 74 * MiB;
constexpr size_t WS_WGU = 80 * MiB;
constexpr size_t WS_WDN = 592 * MiB;
constexpr size_t WS_HIN = 848 * MiB;
constexpr size_t WS_XA = 880 * MiB;
constexpr size_t WS_XB = 944 * MiB;
constexpr size_t WS_R = 1008 * MiB;
constexpr size_t WS_P = 1072 * MiB;
constexpr size_t WS_GF = 1184 * MiB;
constexpr size_t WS_GU = 1240 * MiB;
constexpr size_t WS_GO = 1272 * MiB;
constexpr size_t WS_YAB = 1304 * MiB;
constexpr size_t WS_XS = 1336 * MiB;
constexpr size_t WS_HID = 1464 * MiB;
constexpr size_t WS_YS = 1496 * MiB;
constexpr size_t WS_C1 = 1624 * MiB;
constexpr size_t WS_CQN = 1664 * MiB;
constexpr size_t WS_CKVN = 1672 * MiB;
constexpr size_t WS_KPE = 1680 * MiB;
constexpr size_t WS_Q = 1684 * MiB;
constexpr size_t WS_K = 1732 * MiB;
constexpr size_t WS_V = 1780 * MiB;
constexpr size_t WS_VT = 1812 * MiB;
constexpr size_t WS_END = 1844 * MiB;
constexpr int CW_BAR = 4096;
constexpr int CW_CNT = 8192;
constexpr int CW_BLK = 8448;

constexpr int RING_BYTES = 131072;
constexpr int LDSCTL_OFF = 143360, MISC_OFF = LDSCTL_OFF + 320;
constexpr int TAB_OFF = LDSCTL_OFF + 512;
constexpr int SC_OFF = LDSCTL_OFF + 1536;
constexpr int LDS_BYTES = 147456;

namespace pg8 {
constexpr int BM = 256, BK = 64, HALF = 128, HTB = HALF * BK * 2, STAGE_BYTES = 8 * HTB, NXCD = 8, WGM = 8;
__host__ __device__ __forceinline__ int lds_byte(int r, int c) { const int st = (r >> 4) * 2 + (c >> 5), rr = r & 15, cc = c & 31, ob = rr * 64 + cc * 2; return st * 1024 + (ob ^ (((ob >> 9) & 1) << 5)); }
__host__ __device__ __forceinline__ void stage_rc(int b, int& R, int& C) { const int st = b / 1024, sb = b % 1024, swz = sb ^ (((sb >> 9) & 1) << 5); R = (st >> 1) * 16 + swz / 64; C = (st & 1) * 32 + (swz % 64) / 2; }
__host__ __device__ __forceinline__ int perm32(int rho) { const int n = rho >> 4, i = rho & 15; return 8 * (i >> 2) + 4 * n + (i & 3); }

struct Unit { int pm, pn, ex, rows; };

struct StaticOrder {
    int nM, nN, nwg, G, c; const char* A; const char* Bt; size_t tstep;
    __device__ void init(const bf16* A_, const bf16* Bt_, int M, int N, int K, int G_, int c_) { nM = M / BM; nN = N / BM; nwg = nM * nN; G = G_; c = c_; A = (const char*)A_; Bt = (const char*)Bt_; tstep = (size_t)BM * K * 2; }
    __device__ bool next(int i, Unit& u) const {
        const long L = (long)i * G + c; if (L >= nwg) return false;
        int wgid = (int)L; { const int q = nwg / NXCD, r = nwg % NXCD, xcd = wgid % NXCD, off = wgid / NXCD; wgid = (xcd < r ? xcd * (q + 1) : r * (q + 1) + (xcd - r) * q) + off; }
        const int nig = WGM * nN, gid = wgid / nig, fm = gid * WGM, gsz = (nM - fm) < WGM ? (nM - fm) : WGM;
        u.pm = fm + ((wgid % nig) % gsz); u.pn = (wgid % nig) / gsz; u.ex = 0; u.rows = 256; return true;
    }
    __device__ __forceinline__ const char* aptr(const Unit& u) const { return A + (size_t)u.pm * tstep; }
    __device__ __forceinline__ const char* bptr(const Unit& u) const { return Bt + (size_t)u.pn * tstep; }
};
struct MoeOrder {
    int nunits, NT, G, c; const LAS int* blk_e; const char* A; const char* W; size_t a_tstep, w_estride, w_tstep;
    __device__ bool next(int i, Unit& u) const {
        const long L = (long)i * G + c; if (L >= nunits) return false;
        u.pm = (int)L / NT; u.pn = (int)L % NT; u.ex = blk_e[u.pm]; u.rows = 256; return true;
    }
    __device__ __forceinline__ const char* aptr(const Unit& u) const { return A + (size_t)u.pm * a_tstep; }
    __device__ __forceinline__ const char* bptr(const Unit& u) const { return W + (size_t)u.ex * w_estride + (size_t)u.pn * w_tstep; }
};

template <class Epi, class Sched, bool ALIGN_EPI = true, bool SP2 = true>
__device__ __forceinline__ void gemm_phase(LAS unsigned char* lds, const int K_, const Sched& S, const Epi& E, const int tid, const int wid) {
    const int lane = tid & 63, wr = wid >> 2, wc = wid & 3, fr = lane & 15, fq = lane >> 4;
    int K = K_; asm volatile("" : "+s"(K));
    const int nt = K / BK;
    unsigned voffA[2], voffB[2];
#pragma unroll
    for (int i = 0; i < 2; ++i) { int R, C; stage_rc(tid * 16 + i * 8192, R, C); const int Rb = Epi::PERM ? ((R & ~31) + perm32(R & 31)) : R;
        voffA[i] = (unsigned)(R * K + C) * 2u; voffB[i] = (unsigned)(Rb * K + C) * 2u; }
    const size_t kstep = (size_t)(BK * 2);
    const size_t hstep = (size_t)HALF * K * 2;
    const unsigned ldsw = (unsigned)wid * 1024u;
    const int aoff = lds_byte(wr * 64 + fr, fq * 8), boff = lds_byte(wc * 32 + fr, fq * 8);
#define PG8_SA(b, h) (((b) * 2 + (h)) * HTB)
#define PG8_SB(b, h) ((4 + (b) * 2 + (h)) * HTB)
#define PG8_STAGE(bufoff, gbase, voff) do { _Pragma("unroll") for (int _i = 0; _i < 2; ++_i) \
        __builtin_amdgcn_global_load_lds((const unsigned*)((const char*)(gbase) + (voff)[_i]), (LAS unsigned*)(lds + (bufoff) + ldsw + _i * 8192), 16, 0, 0); } while (0)
#define PG8_LDA(dst, b, h) do { _Pragma("unroll") for (int m = 0; m < 4; ++m) _Pragma("unroll") for (int k = 0; k < 2; ++k) dst[m][k] = *(const LAS bf16x8*)(lds + PG8_SA(b, h) + aoff + m * 2048 + k * 1024); } while (0)
#define PG8_LDB(dst, b, h) do { _Pragma("unroll") for (int n = 0; n < 2; ++n) _Pragma("unroll") for (int k = 0; k < 2; ++k) dst[n][k] = *(const LAS bf16x8*)(lds + PG8_SB(b, h) + boff + n * 2048 + k * 1024); } while (0)
#define PG8_MMA(ai, bj, At, Bt) do { __builtin_amdgcn_s_setprio(1); _Pragma("unroll") for (int m = 0; m < 4; ++m) _Pragma("unroll") for (int n = 0; n < 2; ++n) _Pragma("unroll") for (int k = 0; k < 2; ++k) \
        acc[ai][bj][m][n] = __builtin_amdgcn_mfma_f32_16x16x32_bf16(Bt[n][k], At[m][k], acc[ai][bj][m][n], 0, 0, 0); __builtin_amdgcn_s_setprio(0); } while (0)
#define PG8_WAIT_V(n) asm volatile("s_waitcnt vmcnt(" #n ")" ::: "memory")
#define PG8_WAIT_L(n) asm volatile("s_waitcnt lgkmcnt(" #n ")" ::: "memory")
#define PG8_BAR __builtin_amdgcn_s_barrier()
#define PG8_SCHED __builtin_amdgcn_sched_barrier(0)
    Unit cur, nxt; int ui = 0;
    if (!S.next(0, cur)) return;
    f32x4 acc[2][2][4][2];
#pragma unroll
    for (int a = 0; a < 2; ++a)
#pragma unroll
        for (int b = 0; b < 2; ++b)
#pragma unroll
            for (int m = 0; m < 4; ++m)
#pragma unroll
                for (int n = 0; n < 2; ++n) acc[a][b][m][n] = (f32x4){0.f, 0.f, 0.f, 0.f};
    bf16x8 At[4][2], B0[2][2], B1[2][2];
    const char* cA = S.aptr(cur); const char* cB = S.bptr(cur);
    if constexpr (SP2) {
        PG8_STAGE(PG8_SB(0, 0), cB, voffB); PG8_STAGE(PG8_SB(0, 1), cB + hstep, voffB); PG8_STAGE(PG8_SA(0, 0), cA, voffA); PG8_STAGE(PG8_SA(0, 1), cA + hstep, voffA);
        if (wr == 1) PG8_BAR;
        PG8_WAIT_V(2); PG8_BAR;
        PG8_STAGE(PG8_SB(1, 0), cB + kstep, voffB); PG8_STAGE(PG8_SA(1, 0), cA + kstep, voffA); PG8_STAGE(PG8_SB(1, 1), cB + hstep + kstep, voffB);
        PG8_WAIT_V(6); PG8_BAR;
    } else {
        PG8_STAGE(PG8_SB(0, 0), cB, voffB); PG8_STAGE(PG8_SA(0, 0), cA, voffA); PG8_STAGE(PG8_SB(0, 1), cB + hstep, voffB); PG8_STAGE(PG8_SA(0, 1), cA + hstep, voffA);
        if (wr == 1) PG8_BAR;
        PG8_WAIT_V(4); PG8_BAR;
        PG8_STAGE(PG8_SB(1, 0), cB + kstep, voffB); PG8_STAGE(PG8_SA(1, 0), cA + kstep, voffA); PG8_STAGE(PG8_SB(1, 1), cB + hstep + kstep, voffB);
        PG8_WAIT_V(6); PG8_BAR;
    }
    for (;;) {
        const bool has_next = S.next(ui + 1, nxt);
        const char* nA = has_next ? S.aptr(nxt) : cA; const char* nB = has_next ? S.bptr(nxt) : cB;
        for (int t = 0; t < nt; t += 2) {
            const bool last = (t == nt - 2);
            const char* a1 = cA + (size_t)(t + 1) * kstep;
            const char* a2 = last ? nA : cA + (size_t)(t + 2) * kstep; const char* b2 = last ? nB : cB + (size_t)(t + 2) * kstep;
            const char* a3 = a2 + kstep; const char* b3 = b2 + kstep;
            if constexpr (SP2) {
            PG8_LDB(B0, 0, 0); PG8_LDB(B1, 0, 1); PG8_SCHED; PG8_LDA(At, 0, 0); PG8_STAGE(PG8_SA(1, 1), a1 + hstep, voffA);
            PG8_WAIT_V(8); PG8_WAIT_L(0); PG8_BAR; PG8_MMA(0, 0, At, B0); PG8_MMA(0, 1, At, B1); PG8_BAR; PG8_SCHED;
            PG8_LDA(At, 0, 1); PG8_STAGE(PG8_SB(0, 0), b2, voffB); PG8_STAGE(PG8_SB(0, 1), b2 + hstep, voffB); PG8_STAGE(PG8_SA(0, 0), a2, voffA);
            PG8_WAIT_V(8); PG8_WAIT_L(0); PG8_BAR; PG8_MMA(1, 0, At, B0); PG8_MMA(1, 1, At, B1); PG8_BAR; PG8_SCHED;
            PG8_LDB(B0, 1, 0); PG8_LDB(B1, 1, 1); PG8_SCHED; PG8_LDA(At, 1, 0); PG8_STAGE(PG8_SA(0, 1), a2 + hstep, voffA);
            PG8_WAIT_V(8); PG8_WAIT_L(0); PG8_BAR; PG8_MMA(0, 0, At, B0); PG8_MMA(0, 1, At, B1); PG8_BAR; PG8_SCHED;
            PG8_LDA(At, 1, 1); PG8_STAGE(PG8_SB(1, 0), b3, voffB); PG8_STAGE(PG8_SB(1, 1), b3 + hstep, voffB); PG8_STAGE(PG8_SA(1, 0), a3, voffA);
            PG8_WAIT_V(8); PG8_WAIT_L(0); PG8_BAR; PG8_MMA(1, 0, At, B0); PG8_MMA(1, 1, At, B1); PG8_BAR; PG8_SCHED;
            } else {
            PG8_LDB(B0, 0, 0); PG8_SCHED; PG8_LDA(At, 0, 0); PG8_STAGE(PG8_SA(1, 1), a1 + hstep, voffA);
            PG8_WAIT_L(8); PG8_BAR; PG8_WAIT_L(0); PG8_MMA(0, 0, At, B0); PG8_BAR; PG8_SCHED;
            PG8_LDB(B1, 0, 1); PG8_STAGE(PG8_SB(0, 0), b2, voffB);
            PG8_BAR; PG8_WAIT_L(0); PG8_MMA(0, 1, At, B1); PG8_BAR;
            PG8_LDA(At, 0, 1); PG8_STAGE(PG8_SA(0, 0), a2, voffA);
            PG8_BAR; PG8_WAIT_L(0); PG8_MMA(1, 0, At, B0); PG8_BAR; PG8_SCHED;
            PG8_STAGE(PG8_SB(0, 1), b2 + hstep, voffB);
            PG8_WAIT_V(6); PG8_BAR; PG8_MMA(1, 1, At, B1); PG8_BAR;
            PG8_LDB(B0, 1, 0); PG8_SCHED; PG8_LDA(At, 1, 0); PG8_STAGE(PG8_SA(0, 1), a2 + hstep, voffA);
            PG8_WAIT_L(8); PG8_BAR; PG8_WAIT_L(0); PG8_MMA(0, 0, At, B0); PG8_BAR; PG8_SCHED;
            PG8_LDB(B1, 1, 1); PG8_STAGE(PG8_SB(1, 0), b3, voffB);
            PG8_BAR; PG8_WAIT_L(0); PG8_MMA(0, 1, At, B1); PG8_BAR;
            PG8_LDA(At, 1, 1); PG8_STAGE(PG8_SA(1, 0), a3, voffA);
            PG8_BAR; PG8_WAIT_L(0); PG8_MMA(1, 0, At, B0); PG8_BAR; PG8_SCHED;
            PG8_STAGE(PG8_SB(1, 1), b3 + hstep, voffB);
            PG8_WAIT_V(6); PG8_BAR; PG8_MMA(1, 1, At, B1); PG8_BAR;
            }
        }
        if constexpr (ALIGN_EPI) { if (wr == 0) PG8_BAR; }
        E(acc, cur, wr, wc, fr, fq);
        if (!has_next) break;
#pragma unroll
        for (int a = 0; a < 2; ++a)
#pragma unroll
            for (int b = 0; b < 2; ++b)
#pragma unroll
                for (int m = 0; m < 4; ++m)
#pragma unroll
                    for (int n = 0; n < 2; ++n) acc[a][b][m][n] = (f32x4){0.f, 0.f, 0.f, 0.f};
        cur = nxt; cA = nA; cB = nB; ++ui;
        if constexpr (ALIGN_EPI) { if (wr == 1) PG8_BAR; }
    }
    PG8_WAIT_V(0);
    if constexpr (!ALIGN_EPI) { if (wr == 0) PG8_BAR; }
    PG8_BAR;
#undef PG8_SA
#undef PG8_SB
#undef PG8_STAGE
#undef PG8_LDA
#undef PG8_LDB
#undef PG8_MMA
#undef PG8_WAIT_V
#undef PG8_WAIT_L
#undef PG8_BAR
#undef PG8_SCHED
}


__host__ __device__ __forceinline__ int iperm32(int c) { return 16 * ((c >> 2) & 1) + 4 * (c >> 3) + (c & 3); }
struct MoeDirect {
    int nunits, NT, G, c; const LAS int* tab;
    const float* W0; const float* W1; size_t estride; int cols_per_tile, half1_off;
    __device__ bool next(int i, Unit& u) const {
        const long L = (long)i * G + c; if (L >= nunits) return false;
        u.pm = (int)L / NT; u.pn = (int)L % NT; u.ex = tab[u.pm];
        const int rem = tab[200 + u.ex] - (u.pm - tab[128 + u.ex]) * 256; u.rows = rem < 256 ? rem : 256; return true;
    }
    __device__ __forceinline__ const float* bptr(const Unit& u, int h) const { return (h ? W1 + half1_off : W0) + (size_t)u.ex * estride + (size_t)u.pn * cols_per_tile; }
};
template <class Epi, bool GATHER>
__device__ __forceinline__ void gemm_phase_moe(LAS unsigned char* lds, const int K_, const int ldw_, const MoeDirect& S, const Epi& E, const bf16* Abase, const int* LIST, const int tid, const int wid) {
    const int wr = wid >> 2, wc = wid & 3;
#define MO_LANE_CONSTS(tl) const int lane = (tl) & 63, fr = lane & 15, fq = lane >> 4; \
    const int aoff = lds_byte(wr * 64 + fr, fq * 8), boff = lds_byte(wc * 32 + fr, fq * 8); \
    const int kq = lane & 7, ng = 8 * wc + (lane >> 3); \
    const unsigned bvoff = (unsigned)((4 * kq) * ldw + 4 * ng) * 4u; \
    const int bslot0 = Epi::PERM ? (((4 * ng) & ~31) + iperm32((4 * ng) & 31)) : 4 * ng; \
    const unsigned bwbase = (unsigned)lds_byte(bslot0, 4 * kq)
    int K = K_; asm volatile("" : "+s"(K));
    int ldw = ldw_; asm volatile("" : "+s"(ldw));
    const int nt = K / BK;
    const unsigned ldsw = (unsigned)wid * 1024u;
    const size_t bkstep = (size_t)64 * ldw * 4, browb = (size_t)ldw * 4;
    f32x4 br[4];
#define MO_SA(b, h) (((b) * 2 + (h)) * HTB)
#define MO_SB(b, h) ((4 + (b) * 2 + (h)) * HTB)
#define MO_STAGE_A(bufoff, basep, o0, o1) do { \
        __builtin_amdgcn_global_load_lds((const unsigned*)((const char*)(basep) + (o0)), (LAS unsigned*)(lds + (bufoff) + ldsw), 16, 0, 0); \
        __builtin_amdgcn_global_load_lds((const unsigned*)((const char*)(basep) + (o1)), (LAS unsigned*)(lds + (bufoff) + ldsw + 8192), 16, 0, 0); } while (0)
#define MO_BISSUE(p, R) do { const char* _p = (const char*)(p) + (size_t)(32 * (R)) * browb; _Pragma("unroll") for (int _j = 0; _j < 4; ++_j) \
        asm volatile("global_load_dwordx4 %0, %1, %2" : "=v"(br[_j]) : "v"(bvoff), "s"(_p + (size_t)_j * browb) : "memory"); } while (0)
#define MO_VWAIT0() asm volatile("s_waitcnt vmcnt(0)" : "+v"(br[0]), "+v"(br[1]), "+v"(br[2]), "+v"(br[3]) :: "memory")
#define MO_BWRITE(b, R) do { _Pragma("unroll") for (int _i = 0; _i < 4; ++_i) { u32x2 _o; _o.x = cvtpk(br[0][_i], br[1][_i]); _o.y = cvtpk(br[2][_i], br[3][_i]); \
        *(LAS u32x2*)(lds + MO_SB(b, wr) + bwbase + 1024 * (R) + 64 * _i) = _o; } } while (0)
#define MO_LDA(dst, b, h) do { _Pragma("unroll") for (int m = 0; m < 4; ++m) _Pragma("unroll") for (int k = 0; k < 2; ++k) dst[m][k] = *(const LAS bf16x8*)(lds + MO_SA(b, h) + aoff + m * 2048 + k * 1024); } while (0)
#define MO_LDB(dst, b, h) do { _Pragma("unroll") for (int n = 0; n < 2; ++n) _Pragma("unroll") for (int k = 0; k < 2; ++k) dst[n][k] = *(const LAS bf16x8*)(lds + MO_SB(b, h) + boff + n * 2048 + k * 1024); } while (0)
#define MO_MMA(ai, bj, At, Bt) do { __builtin_amdgcn_s_setprio(1); _Pragma("unroll") for (int m = 0; m < 4; ++m) _Pragma("unroll") for (int n = 0; n < 2; ++n) _Pragma("unroll") for (int k = 0; k < 2; ++k) \
        acc[ai][bj][m][n] = __builtin_amdgcn_mfma_f32_16x16x32_bf16(Bt[n][k], At[m][k], acc[ai][bj][m][n], 0, 0, 0); __builtin_amdgcn_s_setprio(0); } while (0)
#define MO_WAIT_L(n) asm volatile("s_waitcnt lgkmcnt(" #n ")" ::: "memory")
#define MO_BAR __builtin_amdgcn_s_barrier()
#define MO_SCHED __builtin_amdgcn_sched_barrier(0)
#define MO_AOFF(u, dst) do { _Pragma("unroll") for (int _i = 0; _i < 2; ++_i) { int _R, _C; stage_rc(tid * 16 + _i * 8192, _R, _C); _Pragma("unroll") for (int _h = 0; _h < 2; ++_h) { const int _r = 128 * _h + _R; \
        if (GATHER) { const int _p = ((u).pm - S.tab[128 + (u).ex]) * 256 + _r; const int _t = (_r < (u).rows) ? LIST[(size_t)(u).ex * 8192 + _p] : 0; dst[_h][_i] = (unsigned)(_t * K + _C) * 2u; } \
        else dst[_h][_i] = (unsigned)(_r * K + _C) * 2u; } } } while (0)
    Unit cur, nxt; int ui = 0;
    if (!S.next(0, cur)) return;
    f32x4 acc[2][2][4][2];
#pragma unroll
    for (int a = 0; a < 2; ++a)
#pragma unroll
        for (int b = 0; b < 2; ++b)
#pragma unroll
            for (int m = 0; m < 4; ++m)
#pragma unroll
                for (int n = 0; n < 2; ++n) acc[a][b][m][n] = (f32x4){0.f, 0.f, 0.f, 0.f};
    bf16x8 At[4][2], B0[2][2], B1[2][2];
    unsigned cAo[2][2];
    LAS u32x4* const aslot = (LAS u32x4*)(lds + STAGE_BYTES) + tid;
    MO_AOFF(cur, cAo);
    const char* cAb = GATHER ? (const char*)Abase : (const char*)Abase + (size_t)cur.pm * 256 * K * 2;
    const char* cBh = (const char*)S.bptr(cur, wr);
    { MO_LANE_CONSTS(tid);
    MO_BISSUE(cBh, 0); MO_STAGE_A(MO_SA(0, 0), cAb, cAo[0][0], cAo[0][1]); MO_STAGE_A(MO_SA(0, 1), cAb, cAo[1][0], cAo[1][1]);
    if (wr == 1) MO_BAR;
    MO_VWAIT0(); MO_BWRITE(0, 0); MO_BISSUE(cBh, 1);
    MO_VWAIT0(); MO_BWRITE(0, 1);
    MO_WAIT_L(0); MO_BAR;
    MO_BISSUE(cBh + bkstep, 0); MO_STAGE_A(MO_SA(1, 0), cAb + 128, cAo[0][0], cAo[0][1]);
    MO_VWAIT0(); MO_BWRITE(1, 0); MO_BISSUE(cBh + bkstep, 1);
    MO_WAIT_L(0); MO_BAR; }
    for (;;) {
        const bool has_next = S.next(ui + 1, nxt);
        const char* nAb = cAb; const char* nBh = cBh;
        if (has_next) { nAb = GATHER ? (const char*)Abase : (const char*)Abase + (size_t)nxt.pm * 256 * K * 2; nBh = (const char*)S.bptr(nxt, wr);
            if (GATHER) { unsigned nAo[2][2]; MO_AOFF(nxt, nAo); *aslot = (u32x4){nAo[0][0], nAo[0][1], nAo[1][0], nAo[1][1]}; } }
        const bool halfu = cur.rows <= 128;
        for (int t = 0; t < nt; t += 2) {
            int tl = tid; asm volatile("" : "+v"(tl)); MO_LANE_CONSTS(tl);
            const bool last = (t == nt - 2);
            const char* a1 = cAb + (size_t)(t + 1) * 128;
            const char* a2 = last ? nAb : cAb + (size_t)(t + 2) * 128; const char* a3 = a2 + 128;
            const char* b2 = last ? nBh : cBh + (size_t)(t + 2) * bkstep; const char* b3 = b2 + bkstep;
            MO_LDB(B0, 0, 0); MO_LDB(B1, 0, 1); MO_SCHED; MO_LDA(At, 0, 0);
            MO_VWAIT0(); MO_BWRITE(1, 1); MO_STAGE_A(MO_SA(1, 1), a1, cAo[1][0], cAo[1][1]); MO_BISSUE(b2, 0);
            if (GATHER && last && has_next) { const u32x4 _n = *aslot; cAo[0][0] = _n.x; cAo[0][1] = _n.y; cAo[1][0] = _n.z; cAo[1][1] = _n.w; }
            MO_WAIT_L(0); MO_BAR; MO_MMA(0, 0, At, B0); MO_MMA(0, 1, At, B1); MO_BAR; MO_SCHED;
            MO_LDA(At, 0, 1);
            MO_VWAIT0(); MO_BWRITE(0, 0); MO_STAGE_A(MO_SA(0, 0), a2, cAo[0][0], cAo[0][1]); MO_BISSUE(b2, 1);
            MO_WAIT_L(0); MO_BAR; if (!halfu) { MO_MMA(1, 0, At, B0); MO_MMA(1, 1, At, B1); } MO_BAR; MO_SCHED;
            MO_LDB(B0, 1, 0); MO_LDB(B1, 1, 1); MO_SCHED; MO_LDA(At, 1, 0);
            MO_VWAIT0(); MO_BWRITE(0, 1); MO_STAGE_A(MO_SA(0, 1), a2, cAo[1][0], cAo[1][1]); MO_BISSUE(b3, 0);
            MO_WAIT_L(0); MO_BAR; MO_MMA(0, 0, At, B0); MO_MMA(0, 1, At, B1); MO_BAR; MO_SCHED;
            MO_LDA(At, 1, 1);
            MO_VWAIT0(); MO_BWRITE(1, 0); MO_STAGE_A(MO_SA(1, 0), a3, cAo[0][0], cAo[0][1]); MO_BISSUE(b3, 1);
            MO_WAIT_L(0); MO_BAR; if (!halfu) { MO_MMA(1, 0, At, B0); MO_MMA(1, 1, At, B1); } MO_BAR; MO_SCHED;
        }
        if (wr == 0) MO_BAR;
        { const int lane = tid & 63; E(acc, cur, wr, wc, lane & 15, lane >> 4); }
        if (!has_next) break;
#pragma unroll
        for (int a = 0; a < 2; ++a)
#pragma unroll
            for (int b = 0; b < 2; ++b)
#pragma unroll
                for (int m = 0; m < 4; ++m)
#pragma unroll
                    for (int n = 0; n < 2; ++n) acc[a][b][m][n] = (f32x4){0.f, 0.f, 0.f, 0.f};
        cur = nxt; cAb = nAb; cBh = nBh; ++ui;
        if (wr == 1) MO_BAR;
    }
    MO_VWAIT0();
    MO_BAR;
#undef MO_SA
#undef MO_SB
#undef MO_STAGE_A
#undef MO_BISSUE
#undef MO_VWAIT0
#undef MO_BWRITE
#undef MO_LDA
#undef MO_LDB
#undef MO_MMA
#undef MO_WAIT_L
#undef MO_BAR
#undef MO_SCHED
#undef MO_AOFF
#undef MO_LANE_CONSTS
}

template <class Epi, bool GATHER>
__device__ __forceinline__ void gemm_phase_moe32(LAS unsigned char* lds, const int K_, const int ldw_, const MoeDirect& S, const Epi& E, const bf16* Abase, const int* LIST, const int tid, const int wid) {
    const int wr = wid >> 2, wc = wid & 3;
#define MO_LANE_CONSTS(tl) const int lane = (tl) & 63, fr = lane & 15, fq = lane >> 4; \
    const int aoff = lds_byte(wr * 64 + fr, fq * 8), boff = lds_byte(wc * 32 + fr, fq * 8); \
    const int kq = lane & 7, ng = 8 * wc + (lane >> 3); \
    const unsigned bvoff = (unsigned)((4 * kq) * ldw + 4 * ng) * 4u; \
    const int bslot0 = Epi::PERM ? (((4 * ng) & ~31) + iperm32((4 * ng) & 31)) : 4 * ng; \
    const unsigned bwbase = (unsigned)lds_byte(bslot0, 4 * kq)
    int K = K_; asm volatile("" : "+s"(K));
    int ldw = ldw_; asm volatile("" : "+s"(ldw));
    const int nt = K / BK;
    const unsigned ldsw = (unsigned)wid * 1024u;
    const size_t bkstep = (size_t)64 * ldw * 4, browb = (size_t)ldw * 4;
    f32x4 br[8];
#define MO_SA(b, h) (((b) * 2 + (h)) * HTB)
#define MO_SB(b, h) ((4 + (b) * 2 + (h)) * HTB)
#define MO_STAGE_A(bufoff, basep, o0, o1) do { \
        __builtin_amdgcn_global_load_lds((const unsigned*)((const char*)(basep) + (o0)), (LAS unsigned*)(lds + (bufoff) + ldsw), 16, 0, 0); \
        __builtin_amdgcn_global_load_lds((const unsigned*)((const char*)(basep) + (o1)), (LAS unsigned*)(lds + (bufoff) + ldsw + 8192), 16, 0, 0); } while (0)
#define MO_BISSUE(p) do { const char* _p = (const char*)(p); _Pragma("unroll") for (int _j = 0; _j < 8; ++_j) \
        asm volatile("global_load_dwordx4 %0, %1, %2" : "=v"(br[_j]) : "v"(bvoff), "s"(_p + (size_t)(32 * (_j >> 2) + (_j & 3)) * browb) : "memory"); } while (0)
#define MO_BWAIT(n) asm volatile("s_waitcnt vmcnt(" #n ")" : "+v"(br[0]), "+v"(br[1]), "+v"(br[2]), "+v"(br[3]), "+v"(br[4]), "+v"(br[5]), "+v"(br[6]), "+v"(br[7]) :: "memory")
#define MO_WAIT_V(n) asm volatile("s_waitcnt vmcnt(" #n ")" ::: "memory")
#define MO_BWRITE(b) do { _Pragma("unroll") for (int _R = 0; _R < 2; ++_R) _Pragma("unroll") for (int _i = 0; _i < 4; ++_i) { u32x2 _o; \
        _o.x = cvtpk(br[4 * _R][_i], br[4 * _R + 1][_i]); _o.y = cvtpk(br[4 * _R + 2][_i], br[4 * _R + 3][_i]); \
        *(LAS u32x2*)(lds + MO_SB(b, wr) + bwbase + 1024 * _R + 64 * _i) = _o; } } while (0)
#define MO_LDA(dst, b, h) do { _Pragma("unroll") for (int m = 0; m < 4; ++m) _Pragma("unroll") for (int k = 0; k < 2; ++k) dst[m][k] = *(const LAS bf16x8*)(lds + MO_SA(b, h) + aoff + m * 2048 + k * 1024); } while (0)
#define MO_LDB(dst, b, h) do { _Pragma("unroll") for (int n = 0; n < 2; ++n) _Pragma("unroll") for (int k = 0; k < 2; ++k) dst[n][k] = *(const LAS bf16x8*)(lds + MO_SB(b, h) + boff + n * 2048 + k * 1024); } while (0)
#define MO_MMA(ai, bj, At, Bt) do { __builtin_amdgcn_s_setprio(1); _Pragma("unroll") for (int m = 0; m < 4; ++m) _Pragma("unroll") for (int n = 0; n < 2; ++n) _Pragma("unroll") for (int k = 0; k < 2; ++k) \
        acc[ai][bj][m][n] = __builtin_amdgcn_mfma_f32_16x16x32_bf16(Bt[n][k], At[m][k], acc[ai][bj][m][n], 0, 0, 0); __builtin_amdgcn_s_setprio(0); } while (0)
#define MO_WAIT_L(n) asm volatile("s_waitcnt lgkmcnt(" #n ")" ::: "memory")
#define MO_BAR __builtin_amdgcn_s_barrier()
#define MO_SCHED __builtin_amdgcn_sched_barrier(0)
#define MO_AOFF(u, dst) do { _Pragma("unroll") for (int _i = 0; _i < 2; ++_i) { int _R, _C; stage_rc(tid * 16 + _i * 8192, _R, _C); _Pragma("unroll") for (int _h = 0; _h < 2; ++_h) { const int _r = 128 * _h + _R; \
        if (GATHER) { const int _p = ((u).pm - S.tab[128 + (u).ex]) * 256 + _r; const int _t = (_r < (u).rows) ? LIST[(size_t)(u).ex * 8192 + _p] : 0; dst[_h][_i] = (unsigned)(_t * K + _C) * 2u; } \
        else dst[_h][_i] = (unsigned)(_r * K + _C) * 2u; } } } while (0)
    Unit cur, nxt; int ui = 0;
    if (!S.next(0, cur)) return;
    f32x4 acc[2][2][4][2];
#pragma unroll
    for (int a = 0; a < 2; ++a)
#pragma unroll
        for (int b = 0; b < 2; ++b)
#pragma unroll
            for (int m = 0; m < 4; ++m)
#pragma unroll
                for (int n = 0; n < 2; ++n) acc[a][b][m][n] = (f32x4){0.f, 0.f, 0.f, 0.f};
    bf16x8 At[4][2], B0[2][2], B1[2][2];
    unsigned cAo[2][2];
    LAS u32x4* const aslot = (LAS u32x4*)(lds + STAGE_BYTES) + tid;
    MO_AOFF(cur, cAo);
    const char* cAb = GATHER ? (const char*)Abase : (const char*)Abase + (size_t)cur.pm * 256 * K * 2;
    const char* cBh = (const char*)S.bptr(cur, wr);
    { MO_LANE_CONSTS(tid);
    MO_BISSUE(cBh); MO_STAGE_A(MO_SA(0, 0), cAb, cAo[0][0], cAo[0][1]); MO_STAGE_A(MO_SA(0, 1), cAb, cAo[1][0], cAo[1][1]);
    if (wr == 1) MO_BAR;
    MO_BWAIT(4); MO_BWRITE(0);
    MO_WAIT_V(0); MO_WAIT_L(0); MO_BAR;
    MO_STAGE_A(MO_SA(1, 0), cAb + 128, cAo[0][0], cAo[0][1]); MO_BISSUE(cBh + bkstep);
    MO_BAR; }
    for (;;) {
        const bool has_next = S.next(ui + 1, nxt);
        const char* nAb = cAb; const char* nBh = cBh;
        if (has_next) { nAb = GATHER ? (const char*)Abase : (const char*)Abase + (size_t)nxt.pm * 256 * K * 2; nBh = (const char*)S.bptr(nxt, wr);
            if (GATHER) { unsigned nAo[2][2]; MO_AOFF(nxt, nAo); *aslot = (u32x4){nAo[0][0], nAo[0][1], nAo[1][0], nAo[1][1]}; } }
        const bool halfu = cur.rows <= 128;
        for (int t = 0; t < nt; t += 2) {
            int tl = tid; asm volatile("" : "+v"(tl)); MO_LANE_CONSTS(tl);
            const bool last = (t == nt - 2);
            const char* a1 = cAb + (size_t)(t + 1) * 128;
            const char* a2 = last ? nAb : cAb + (size_t)(t + 2) * 128; const char* a3 = a2 + 128;
            const char* b2 = last ? nBh : cBh + (size_t)(t + 2) * bkstep; const char* b3 = b2 + bkstep;
            MO_LDB(B0, 0, 0); MO_LDB(B1, 0, 1); MO_SCHED; MO_LDA(At, 0, 0); MO_STAGE_A(MO_SA(1, 1), a1, cAo[1][0], cAo[1][1]);
            MO_WAIT_V(12); MO_WAIT_L(0); MO_BAR; MO_MMA(0, 0, At, B0); MO_MMA(0, 1, At, B1); MO_BAR; MO_SCHED;
            if (GATHER && last && has_next) { const u32x4 _n = *aslot; cAo[0][0] = _n.x; cAo[0][1] = _n.y; cAo[1][0] = _n.z; cAo[1][1] = _n.w; }
            MO_LDA(At, 0, 1); MO_BWAIT(2); MO_BWRITE(1); MO_STAGE_A(MO_SA(0, 0), a2, cAo[0][0], cAo[0][1]); MO_BISSUE(b2);
            MO_WAIT_L(0); MO_BAR; if (!halfu) { MO_MMA(1, 0, At, B0); MO_MMA(1, 1, At, B1); } MO_BAR; MO_SCHED;
            MO_LDB(B0, 1, 0); MO_LDB(B1, 1, 1); MO_SCHED; MO_LDA(At, 1, 0); MO_STAGE_A(MO_SA(0, 1), a2, cAo[1][0], cAo[1][1]);
            MO_WAIT_V(12); MO_WAIT_L(0); MO_BAR; MO_MMA(0, 0, At, B0); MO_MMA(0, 1, At, B1); MO_BAR; MO_SCHED;
            MO_LDA(At, 1, 1); MO_BWAIT(2); MO_BWRITE(0); MO_STAGE_A(MO_SA(1, 0), a3, cAo[0][0], cAo[0][1]); MO_BISSUE(b3);
            MO_WAIT_L(0); MO_BAR; if (!halfu) { MO_MMA(1, 0, At, B0); MO_MMA(1, 1, At, B1); } MO_BAR; MO_SCHED;
        }
        if (wr == 0) MO_BAR;
        { const int lane = tid & 63; E(acc, cur, wr, wc, lane & 15, lane >> 4); }
        if (!has_next) break;
#pragma unroll
        for (int a = 0; a < 2; ++a)
#pragma unroll
            for (int b = 0; b < 2; ++b)
#pragma unroll
                for (int m = 0; m < 4; ++m)
#pragma unroll
                    for (int n = 0; n < 2; ++n) acc[a][b][m][n] = (f32x4){0.f, 0.f, 0.f, 0.f};
        cur = nxt; cAb = nAb; cBh = nBh; ++ui;
        if (wr == 1) MO_BAR;
    }
    MO_BWAIT(0);
    MO_BAR;
#undef MO_SA
#undef MO_SB
#undef MO_STAGE_A
#undef MO_BISSUE
#undef MO_BWAIT
#undef MO_WAIT_V
#undef MO_BWRITE
#undef MO_LDA
#undef MO_LDB
#undef MO_MMA
#undef MO_WAIT_L
#undef MO_BAR
#undef MO_SCHED
#undef MO_AOFF
#undef MO_LANE_CONSTS
}


typedef const f32x4 (&AccRef)[2][2][4][2];
DI u32x4 pack8(const f32x4& v0, const f32x4& v1) { u32x4 w; w.x = cvtpk(v0[0], v0[1]); w.y = cvtpk(v0[2], v0[3]); w.z = cvtpk(v1[0], v1[1]); w.w = cvtpk(v1[2], v1[3]); return w; }

struct EpiBf16 {
    static constexpr bool PERM = true;
    bf16* O; int ldc;
    DI void operator()(AccRef acc, const Unit& u, int wr, int wc, int fr, int fq) const {
        const int row0 = u.pm * BM + wr * 64 + fr, col0 = u.pn * BM + wc * 32 + 8 * fq;
#pragma unroll
        for (int ai = 0; ai < 2; ++ai)
#pragma unroll
            for (int m = 0; m < 4; ++m) { bf16* rowp = O + (size_t)(row0 + ai * HALF + m * 16) * ldc + col0;
#pragma unroll
                for (int bj = 0; bj < 2; ++bj) *(u32x4*)(rowp + bj * HALF) = pack8(acc[ai][bj][m][0], acc[ai][bj][m][1]); }
    }
};
struct EpiF32 {
    static constexpr bool PERM = false;
    float* C; int ldc;
    DI void operator()(AccRef acc, const Unit& u, int wr, int wc, int fr, int fq) const {
        const int row0 = u.pm * BM + wr * 64 + fr, col0 = u.pn * BM + wc * 32 + 4 * fq;
#pragma unroll
        for (int ai = 0; ai < 2; ++ai)
#pragma unroll
            for (int m = 0; m < 4; ++m) { float* rowp = C + (size_t)(row0 + ai * HALF + m * 16) * ldc + col0;
#pragma unroll
                for (int bj = 0; bj < 2; ++bj)
#pragma unroll
                    for (int n = 0; n < 2; ++n) *(f32x4*)(rowp + bj * HALF + n * 16) = acc[ai][bj][m][n]; }
    }
};
struct EpiInProj {
    static constexpr bool PERM = true;
    bf16* P; float* PBA;
    DI void operator()(AccRef acc, const Unit& u, int wr, int wc, int fr, int fq) const {
        const int row0 = u.pm * BM + wr * 64 + fr;
        if (u.pn < 28) {
            const int col0 = u.pn * BM + wc * 32 + 8 * fq;
#pragma unroll
            for (int ai = 0; ai < 2; ++ai)
#pragma unroll
                for (int m = 0; m < 4; ++m) { bf16* rowp = P + (size_t)(row0 + ai * HALF + m * 16) * NP + col0;
#pragma unroll
                    for (int bj = 0; bj < 2; ++bj) *(u32x4*)(rowp + bj * HALF) = pack8(acc[ai][bj][m][0], acc[ai][bj][m][1]); }
        } else if (wc == 0 && fq < 2) {
#pragma unroll
            for (int ai = 0; ai < 2; ++ai)
#pragma unroll
                for (int m = 0; m < 4; ++m) { float* rp = PBA + (size_t)(row0 + ai * HALF + m * 16) * 16 + 8 * fq;
                    *(f32x4*)rp = acc[ai][0][m][0]; *(f32x4*)(rp + 4) = acc[ai][0][m][1]; }
        }
    }
};
struct EpiResid {
    static constexpr bool PERM = false;
    const float* x; const float* g; float* R;
    DI void operator()(AccRef acc, const Unit& u, int wr, int wc, int fr, int fq) const {
        const int row0 = u.pm * BM + wr * 64 + fr, col0 = u.pn * BM + wc * 32 + 4 * fq;
        const float* gb = g + (size_t)((u.pm * BM) / SEQ) * 12288 + col0;
        f32x4 gv[2][2];
#pragma unroll
        for (int bj = 0; bj < 2; ++bj)
#pragma unroll
            for (int n = 0; n < 2; ++n) gv[bj][n] = *(const f32x4*)(gb + bj * HALF + n * 16) + 1.0f;
#pragma unroll
        for (int ai = 0; ai < 2; ++ai)
#pragma unroll
            for (int m = 0; m < 4; ++m) { const size_t off = (size_t)(row0 + ai * HALF + m * 16) * D + col0;
#pragma unroll
                for (int bj = 0; bj < 2; ++bj)
#pragma unroll
                    for (int n = 0; n < 2; ++n) { const f32x4 xv = *(const f32x4*)(x + off + bj * HALF + n * 16);
                        *(f32x4*)(R + off + bj * HALF + n * 16) = xv * DN_ALPHA + gv[bj][n] * acc[ai][bj][m][n]; } }
    }
};
struct EpiLogits {
    static constexpr bool PERM = false;
    float* L;
    DI void operator()(AccRef acc, const Unit& u, int wr, int wc, int fr, int fq) const {
        const int row0 = u.pm * BM + wr * 64 + fr, col0 = wc * 32 + 4 * fq;
#pragma unroll
        for (int ai = 0; ai < 2; ++ai)
#pragma unroll
            for (int m = 0; m < 4; ++m) { float* rowp = L + (size_t)(row0 + ai * HALF + m * 16) * 128 + col0;
#pragma unroll
                for (int n = 0; n < 2; ++n) *(f32x4*)(rowp + n * 16) = acc[ai][0][m][n]; }
    }
};
struct EpiGateUp {
    static constexpr bool PERM = true;
    bf16* H;
    DI void operator()(AccRef acc, const Unit& u, int wr, int wc, int fr, int fq) const {
        const int row0 = u.pm * BM + wr * 64 + fr, col0 = u.pn * HALF + wc * 32 + 8 * fq;
#pragma unroll
        for (int ai = 0; ai < 2; ++ai)
#pragma unroll
            for (int m = 0; m < 4; ++m) { bf16* rowp = H + (size_t)(row0 + ai * HALF + m * 16) * FF + col0;
                f32x4 h0, h1;
#pragma unroll
                for (int j = 0; j < 4; ++j) { h0[j] = silu_f(acc[ai][0][m][0][j]) * acc[ai][1][m][0][j]; h1[j] = silu_f(acc[ai][0][m][1][j]) * acc[ai][1][m][1][j]; }
                *(u32x4*)rowp = pack8(h0, h1); }
    }
};
struct EpiQup {
    static constexpr bool PERM = true;
    bf16* Q;
    DI void operator()(AccRef acc, const Unit& u, int wr, int wc, int fr, int fq) const {
        const int row0 = u.pm * BM + wr * 64 + fr, b = (u.pm * BM) / SEQ, s0 = row0 - b * SEQ;
        const int cg0 = u.pn * BM + wc * 32 + 8 * fq, cg1 = cg0 + HALF;
        const int h0 = cg0 / QD, w0 = cg0 - h0 * QD, h1 = cg1 / QD, w1 = cg1 - h1 * QD;
        bf16* d0 = Q + ((size_t)((b * MH + h0) * SEQ + s0)) * QD + w0; bf16* d1 = Q + ((size_t)((b * MH + h1) * SEQ + s0)) * QD + w1;
#pragma unroll
        for (int ai = 0; ai < 2; ++ai)
#pragma unroll
            for (int m = 0; m < 4; ++m) { const int dr = (ai * HALF + m * 16) * QD;
                *(u32x4*)(d0 + dr) = pack8(acc[ai][0][m][0] * QSCALE, acc[ai][0][m][1] * QSCALE);
                *(u32x4*)(d1 + dr) = pack8(acc[ai][1][m][0] * QSCALE, acc[ai][1][m][1] * QSCALE);
                asm volatile("" ::: "memory"); }
    }
};
struct EpiKVup {
    static constexpr bool PERM = true;
    bf16* Kp; bf16* V;
    DI void operator()(AccRef acc, const Unit& u, int wr, int wc, int fr, int fq) const {
        const int row0 = u.pm * BM + wr * 64 + fr, c0 = wc * 32 + 8 * fq, head = u.pn, b = (u.pm * BM) / SEQ, s0 = row0 - b * SEQ;
        bf16* dk = Kp + ((size_t)((b * MH + head) * SEQ + s0)) * QD + c0; bf16* dv = V + (size_t)row0 * D + head * 128 + c0;
#pragma unroll
        for (int ai = 0; ai < 2; ++ai)
#pragma unroll
            for (int m = 0; m < 4; ++m) { const int dr = ai * HALF + m * 16;
                *(u32x4*)(dk + dr * QD) = pack8(acc[ai][0][m][0], acc[ai][0][m][1]);
                *(u32x4*)(dv + dr * D) = pack8(acc[ai][1][m][0], acc[ai][1][m][1]);
                asm volatile("" ::: "memory"); }
    }
};
}

#define XB_TMO      128
#define XB_XCNT(j)  (256  + 64 * (j))
#define XB_XSUB(j)  (1280 + 64 * (j))
#define XB_XGEN(j)  (2304 + 64 * (j))
#define XB_TOP      3328
#define XB_TOPGEN   3392
#define XCD_BAR_WORDS 3456
#define XB_SPIN_CAP (1u << 18)
__device__ __forceinline__ unsigned xb_ld(unsigned* p)              { return __hip_atomic_load(p, __ATOMIC_RELAXED, __HIP_MEMORY_SCOPE_AGENT); }
__device__ __forceinline__ unsigned xb_add(unsigned* p, unsigned v) { return __hip_atomic_fetch_add(p, v, __ATOMIC_RELAXED, __HIP_MEMORY_SCOPE_AGENT); }
__device__ __forceinline__ unsigned xb_xcc_id() { return (unsigned)__builtin_amdgcn_s_getreg((3 << 11) | 20) & 0xFu; }
#define XB_SPIN(cond, bar) do { unsigned _sp = 0; while (cond) { __builtin_amdgcn_s_sleep(1); \
    if ((++_sp & 255u) == 0u) { if (xb_ld(&(bar)[XB_TMO])) break; if (_sp > XB_SPIN_CAP) { atomicAdd(&(bar)[XB_TMO], 1u); break; } } } } while (0)
struct XcdBarrier { unsigned* bar; unsigned x; volatile LAS unsigned* st; };
__device__ __forceinline__ XcdBarrier xcd_barrier_post(unsigned* bar, volatile LAS unsigned* st, const bool leader  ) {
    XcdBarrier b; b.bar = bar; b.x = xb_xcc_id(); b.st = st;
    if (leader) (void)xb_add(&bar[XB_XCNT(b.x)], 1u);
    return b;
}
__device__ __forceinline__ void xcd_barrier_complete(unsigned* bar, unsigned x, unsigned& nloc, unsigned& nx) {
    const unsigned G = gridDim.x * gridDim.y * gridDim.z;
    unsigned sum, cnt, mine, sp = 0u;
    for (;;) {
        sum = 0u; cnt = 0u; mine = 0u;
#pragma unroll
        for (unsigned j = 0; j < 16; ++j) { const unsigned c = xb_ld(&bar[XB_XCNT(j)]); sum += c; cnt += (c > 0u) ? 1u : 0u; mine = (j == x) ? c : mine; }
        if (sum == G) break;
        __builtin_amdgcn_s_sleep(1);
        if ((++sp & 255u) == 0u) { if (xb_ld(&bar[XB_TMO])) break; if (sp > XB_SPIN_CAP) { atomicAdd(&bar[XB_TMO], 1u); break; } }
    }
    nloc = mine > 0u ? mine : 1u; nx = cnt > 0u ? cnt : 1u;
}
__device__ __forceinline__ void xcd_barrier(const XcdBarrier& b, const bool leader  ) {
    asm volatile("s_waitcnt vmcnt(0)" ::: "memory");
    __syncthreads();
    if (leader) {
        unsigned* bar = b.bar;
        __builtin_amdgcn_s_waitcnt(0);
        unsigned nloc = b.st[0], nx = b.st[1];
        if (nloc == 0u) { xcd_barrier_complete(bar, b.x, nloc, nx); b.st[0] = nloc; b.st[1] = nx; }
        const unsigned old = xb_add(&bar[XB_XSUB(b.x)], 1u);
        const unsigned gen = old / nloc;
        if (old + 1u == (gen + 1u) * nloc) {
            __builtin_amdgcn_fence(__ATOMIC_RELEASE, "agent");
            asm volatile("s_waitcnt vmcnt(0)" ::: "memory");
            const unsigned og = xb_add(&bar[XB_TOP], 1u);
            const unsigned tg = og / nx;
            if (og + 1u == (tg + 1u) * nx) xb_add(&bar[XB_TOPGEN], 1u);
            else XB_SPIN(xb_ld(&bar[XB_TOPGEN]) == tg, bar);
            __builtin_amdgcn_fence(__ATOMIC_ACQUIRE, "agent");
            xb_add(&bar[XB_XGEN(b.x)], 1u);
            asm volatile("s_waitcnt vmcnt(0)" ::: "memory");
        } else {
            XB_SPIN(xb_ld(&bar[XB_XGEN(b.x)]) == gen, bar);
            __builtin_amdgcn_fence(__ATOMIC_ACQUIRE, "agent");
            asm volatile("s_waitcnt vmcnt(0)" ::: "memory");
        }
    }
    __syncthreads();
}

struct Frame {
    LAS unsigned char* lds;
    int tid, lane, wave, vcu, G, gw, NGW;
    unsigned* ctl;
};
struct Args { const void* in[27]; float* out; unsigned char* ws; int ph_lo, ph_hi; };

__device__ const double ROPE_INVF[32] = {1, 0.74989420933245587, 0.56234132519034907, 0.42169650342858223, 0.31622776601683794, 0.23713737056616552, 0.17782794100389229, 0.1333521432163324,
    0.10000000000000001, 0.074989420933245579, 0.056234132519034911, 0.042169650342858224, 0.031622776601683791, 0.023713737056616554, 0.017782794100389229, 0.013335214321633241,
    0.01, 0.0074989420933245579, 0.005623413251903491, 0.0042169650342858229, 0.0031622776601683794, 0.0023713737056616554, 0.0017782794100389228, 0.0013335214321633241,
    0.001, 0.00074989420933245586, 0.0005623413251903491, 0.00042169650342858224, 0.00031622776601683794, 0.00023713737056616554, 0.00017782794100389227, 0.0001333521432163324};

struct TrRegs { f32x4 r[8]; };
DI void tr_load(TrRegs& t, const float* W, size_t ld, int k0, int n0, int nvalid, int lane) {
    const int ns = lane & 7, kq = lane >> 3;
    if (4 * ns < nvalid) { const float* src = W + (size_t)(k0 + 8 * kq) * ld + n0 + 4 * ns;
#pragma unroll
        for (int j = 0; j < 8; ++j) t.r[j] = *(const f32x4*)(src + (size_t)j * ld); }
}
DI void tr_store(const TrRegs& t, int k0, int nvalid, bf16* WT, int Kd, int drow0, int lane) {
    const int ns = lane & 7, kq = lane >> 3;
    if (4 * ns < nvalid) { bf16* dst = WT + (size_t)(drow0 + 4 * ns) * Kd + k0 + 8 * kq;
#pragma unroll
        for (int i = 0; i < 4; ++i) { u32x4 o; o.x = cvtpk(t.r[0][i], t.r[1][i]); o.y = cvtpk(t.r[2][i], t.r[3][i]); o.z = cvtpk(t.r[4][i], t.r[5][i]); o.w = cvtpk(t.r[6][i], t.r[7][i]);
            *(u32x4*)(dst + (size_t)i * Kd) = o; } }
}
DI void tr_job(const Frame& F, const int gw, const int NGW, const float* W, size_t smat, int nmat, int ld, int K, int col0, int ncols, bf16* WT, size_t dmat, int Kd, int row_off, int mode) {
    const int nblk = (ncols + 31) / 32, kbs = K / 64, per = nblk * kbs; const long items = (long)nmat * per;
    for (long it0 = gw; it0 < items; it0 += 2 * (long)NGW) {
        TrRegs t[2]; int k0[2], nv[2], dr[2]; bf16* wt[2];
#pragma unroll
        for (int u = 0; u < 2; ++u) {
            const long it = it0 + (long)u * NGW;
            if (it < items) {
                const int mat = (int)(it / per), rem = (int)(it - (long)mat * per), kb = rem / nblk, nb = rem - kb * nblk;
                nv[u] = (ncols - nb * 32) < 32 ? (ncols - nb * 32) : 32; k0[u] = kb * 64;
                dr[u] = (mode == 0) ? (row_off + nb * 32) : ((nb >> 2) * 256 + row_off + (nb & 3) * 32);
                wt[u] = WT + (size_t)mat * dmat;
                tr_load(t[u], W + (size_t)mat * smat, (size_t)ld, k0[u], col0 + nb * 32, nv[u], F.lane);
            } else { nv[u] = 0; k0[u] = 0; dr[u] = 0; wt[u] = WT; }
        }
#pragma unroll
        for (int u = 0; u < 2; ++u) tr_store(t[u], k0[u], nv[u], wt[u], Kd, dr[u], F.lane);
    }
}
DI void zero_fill(const Frame& F, const int gw, const int NGW, void* p, size_t bytes) {
    u32x4* q = (u32x4*)p; const size_t n = bytes / 16;
    for (size_t i = (size_t)gw * 64 + F.lane; i < n; i += (size_t)NGW * 64) q[i] = (u32x4){0u, 0u, 0u, 0u};
}

DI const void* arg_in(int k) { unsigned o = (unsigned)k * 8u; asm volatile("" : "+s"(o));
    const GAS void* p = *(const GAS void* const __attribute__((address_space(4)))*)((const __attribute__((address_space(4))) unsigned char*)__builtin_amdgcn_kernarg_segment_ptr() + o);
    return (const void*)p; }
#define WSB (args.ws)
#define in_x ((const float*)arg_in(0))
#define in_c ((const float*)arg_in(1))
#define in_pos ((const int*)arg_in(2))
#define ada_w ((const float*)arg_in(3))
#define ada_b ((const float*)arg_in(4))
#define ln_g ((const float*)arg_in(5))
#define ln_b ((const float*)arg_in(6))
#define hyb_w_in ((const float*)arg_in(7))
#define gdn_conv_w ((const float*)arg_in(8))
#define gdn_a_log ((const float*)arg_in(9))
#define gdn_dt_bias ((const float*)arg_in(10))
#define gdn_norm_w ((const float*)arg_in(11))
#define sc_conv_w ((const float*)arg_in(12))
#define hyb_w_out ((const float*)arg_in(13))
#define mla_w_in ((const float*)arg_in(14))
#define mla_q_norm ((const float*)arg_in(15))
#define mla_kv_norm ((const float*)arg_in(16))
#define mla_w_uq ((const float*)arg_in(17))
#define mla_w_ukv ((const float*)arg_in(18))
#define mla_w_out ((const float*)arg_in(19))
#define moe_router_g ((const float*)arg_in(20))
#define moe_bias_g ((const float*)arg_in(21))
#define moe_router_e ((const float*)arg_in(22))
#define moe_bias_e ((const float*)arg_in(23))
#define moe_w_gate ((const float*)arg_in(24))
#define moe_w_up ((const float*)arg_in(25))
#define moe_w_down ((const float*)arg_in(26))
#define MOD ((float*)(WSB + WS_MOD))
#define ROPE_C ((float*)(WSB + WS_ROPE))
#define ROPE_S ((float*)(ROPE_C + (size_t)T * 32))
#define PBA ((float*)(WSB + WS_PBA))
#define LOGITS ((float*)(WSB + WS_LOGITS))
#define TOK_E ((int*)(WSB + WS_ROUTE))
#define TOK_POS ((int*)(TOK_E + 2 * T))
#define TOK_GATE ((float*)(TOK_POS + 2 * T))
#define EG ((float*)(WSB + WS_EG))
#define WIN0 ((bf16*)(WSB + WS_WIN0))
#define WOUT0 ((bf16*)(WSB + WS_WOUT0))
#define WMIN ((bf16*)(WSB + WS_WMIN))
#define WUQ ((bf16*)(WSB + WS_WUQ))
#define WUKV ((bf16*)(WSB + WS_WUKV))
#define WMOUT ((bf16*)(WSB + WS_WMOUT))
#define WRT ((bf16*)(WSB + WS_WRT))
#define WGU ((bf16*)(WSB + WS_WGU))
#define WDN ((bf16*)(WSB + WS_WDN))
#define HIN ((bf16*)(WSB + WS_HIN))
#define XA ((float*)(WSB + WS_XA))
#define XB ((float*)(WSB + WS_XB))
#define RB ((float*)(WSB + WS_R))
#define PB ((bf16*)(WSB + WS_P))
#define GF ((unsigned char*)(WSB + WS_GF))
#define GU ((unsigned char*)(WSB + WS_GU))
#define GO ((float*)(WSB + WS_GO))
#define YAB ((bf16*)(WSB + WS_YAB))
#define LISTP ((int*)(WSB + WS_XS))
#define HID ((bf16*)(WSB + WS_HID))
#define YS ((bf16*)(WSB + WS_YS))
#define C1 ((float*)(WSB + WS_C1))
#define CQN ((bf16*)(WSB + WS_CQN))
#define CKVN ((bf16*)(WSB + WS_CKVN))
#define KPE ((float*)(WSB + WS_KPE))
#define QB_ ((bf16*)(WSB + WS_Q))
#define KB_ ((bf16*)(WSB + WS_K))
#define VB_ ((bf16*)(WSB + WS_V))
#define VT ((bf16*)(WSB + WS_VT))


#define LN_ROW(v, gptr, bptr) do { float _s = 0.f; _Pragma("unroll") for (int _j = 0; _j < 8; ++_j) _s += (v[_j][0] + v[_j][1]) + (v[_j][2] + v[_j][3]); \
        const float _mean = wave_sum(_s) * (1.f / D); float _q = 0.f; \
        _Pragma("unroll") for (int _j = 0; _j < 8; ++_j) { v[_j] = v[_j] - _mean; _q += (v[_j][0] * v[_j][0] + v[_j][1] * v[_j][1]) + (v[_j][2] * v[_j][2] + v[_j][3] * v[_j][3]); } \
        const float _rstd = rsqrtf(wave_sum(_q) * (1.f / D) + 1e-5f); \
        _Pragma("unroll") for (int _j = 0; _j < 8; ++_j) v[_j] = v[_j] * _rstd * ((const f32x4*)(gptr))[F.lane + 64 * _j] + ((const f32x4*)(bptr))[F.lane + 64 * _j]; } while (0)
#define WRITE_X_HIN(v, xrow, hrow, shp, scp) do { _Pragma("unroll") for (int _j = 0; _j < 8; ++_j) { ((f32x4*)(xrow))[F.lane + 64 * _j] = v[_j]; \
        if ((hrow) != nullptr) { const f32x4 _h = v[_j] * (((const f32x4*)(scp))[F.lane + 64 * _j] + 1.0f) + ((const f32x4*)(shp))[F.lane + 64 * _j]; \
            u32x2 _w; _w.x = cvtpk(_h[0], _h[1]); _w.y = cvtpk(_h[2], _h[3]); ((u32x2*)(hrow))[F.lane + 64 * _j] = _w; } } } while (0)


template <int GW> DI void ada_groups(Frame& F, const Args& args, const int cg_lo, const int cg_hi, const int bidx, const int nblocks) {
    constexpr int LPR = GW / 4, RPI = 64 / LPR, NSET = 8 * RPI;
    LAS float* cact = (LAS float*)F.lds;
    LAS float* red = (LAS float*)(F.lds + 32768);
    for (int i = F.tid; i < 4 * D; i += 512) cact[i] = silu_f(in_c[i]);
    __syncthreads();
    for (int cg = cg_lo + bidx; cg < cg_hi; cg += nblocks) {
        const int jj0 = cg * GW, l = jj0 / 12288, j0 = jj0 - l * 12288;
        const int rsub = F.lane / LPR, c4 = F.lane - rsub * LPR;
        f32x4 a0 = {0.f, 0.f, 0.f, 0.f}, a1 = a0, a2 = a0, a3 = a0;
        if (F.lane < LPR * RPI) {
            const float* wp = ada_w + ((size_t)l * D) * 12288 + j0 + 4 * c4;
#pragma unroll 8
            for (int it = 0; it < D / NSET; ++it) { const int k = it * NSET + F.wave * RPI + rsub;
                const f32x4 w4 = *(const f32x4*)(wp + (size_t)k * 12288);
                a0 += w4 * cact[k]; a1 += w4 * cact[D + k]; a2 += w4 * cact[2 * D + k]; a3 += w4 * cact[3 * D + k]; }
            LAS float* rp = red + (F.wave * RPI + rsub) * (4 * GW) + 4 * c4;
            *(LAS f32x4*)(rp) = a0; *(LAS f32x4*)(rp + GW) = a1; *(LAS f32x4*)(rp + 2 * GW) = a2; *(LAS f32x4*)(rp + 3 * GW) = a3;
        }
        __syncthreads();
        if (F.tid < 4 * GW) { const int b = F.tid / GW, col = F.tid - b * GW; float s = ada_b[(size_t)l * 12288 + j0 + col];
#pragma unroll 8
            for (int p = 0; p < NSET; ++p) s += red[p * (4 * GW) + b * GW + col];
            MOD[((size_t)l * 4 + b) * 12288 + j0 + col] = s; }
        __syncthreads();
    }
}
DI void deferred_copies(Frame& F, const Args& args, const int gw, const int NGW) {
    tr_job(F, gw, NGW, hyb_w_out, 0, 1, D, D, 0, D, WOUT0, 0, D, 0, 0);
    tr_job(F, gw, NGW, mla_w_in, 0, 1, MLA_IN, D, 0, MLA_IN, WMIN, 0, D, 0, 0);
    zero_fill(F, gw, NGW, WMIN + (size_t)MLA_IN * D, (size_t)(NMLA - MLA_IN) * D * 2);
    tr_job(F, gw, NGW, mla_w_uq, 0, 1, 3072, 512, 0, 3072, WUQ, 0, 512, 0, 0);
    tr_job(F, gw, NGW, mla_w_ukv, 0, 1, 4096, 512, 0, 4096, WUKV, 0, 512, 0, 0);
    tr_job(F, gw, NGW, mla_w_out, 0, 1, D, D, 0, D, WMOUT, 0, D, 0, 0);
    tr_job(F, gw, NGW, moe_router_g, (size_t)D * 8, 2, 8, D, 0, 8, WRT, (size_t)256 * D, D, 0, 0);
    tr_job(F, gw, NGW, moe_router_e, (size_t)D * 64, 2, 64, D, 0, 64, WRT, (size_t)256 * D, D, 8, 0);
    zero_fill(F, gw, NGW, WRT + (size_t)72 * D, (size_t)(256 - 72) * D * 2);
    zero_fill(F, gw, NGW, WRT + (size_t)256 * D + (size_t)72 * D, (size_t)(256 - 72) * D * 2);
}

#ifndef PHMASK
#define PHMASK 0xFFFFFFFFull
#endif
#define PH_EN(k) (((PHMASK) >> (k)) & 1ull)
#define IN(k) (PH_EN(k) && lo <= (k) && (k) < hi)
#define INL(k0, k1) ((L == 0) ? IN(k0) : IN(k1))
#define PHASE_FRESH() do { int _l; asm volatile("v_mbcnt_lo_u32_b32 %0, -1, 0\n\tv_mbcnt_hi_u32_b32 %0, -1, %0" : "=v"(_l)); F.lane = _l; F.tid = F.wave * 64 + _l; } while (0)
#define SEAM(k) do { if (IN(k) && IN((k) + 1)) { PHASE_FRESH(); xcd_barrier(bar, F.tid == 0); } } while (0)


template <int L> DI void ln_route_phase(Frame& F, const Args& args) {
    constexpr int HP = 2056;
    LAS bf16* HT = (LAS bf16*)F.lds;
    LAS float* PART = (LAS float*)(F.lds + 16 * HP * 2);
    LAS float* LG = PART + 8 * 16 * 80;
    unsigned* cnt = F.ctl + CW_CNT + L * 64;
    const float* bg = moe_bias_g + L * 8; const float* be = moe_bias_e + L * 64;
    const bf16* wrt = WRT + (size_t)L * 256 * D;
    for (int rg = F.vcu; rg < T / 16; rg += F.G) {
#pragma unroll
        for (int rr = 0; rr < 2; ++rr) {
            const int rl = 2 * F.wave + rr, m = rg * 16 + rl, b = m / SEQ; const float* modb = MOD + (size_t)(L * 4 + b) * 12288;
            f32x4 v[8];
#pragma unroll
            for (int j = 0; j < 8; ++j) v[j] = ((const f32x4*)(RB + (size_t)m * D))[F.lane + 64 * j];
            LN_ROW(v, ln_g + (size_t)(L * 2) * D, ln_b + (size_t)(L * 2) * D);
#pragma unroll
            for (int j = 0; j < 8; ++j) { ((f32x4*)(XA + (size_t)m * D))[F.lane + 64 * j] = v[j];
                const f32x4 h = v[j] * (((const f32x4*)(modb + 4 * D))[F.lane + 64 * j] + 1.0f) + ((const f32x4*)(modb + 3 * D))[F.lane + 64 * j];
                u32x2 w; w.x = cvtpk(h[0], h[1]); w.y = cvtpk(h[2], h[3]);
                ((u32x2*)(HIN + (size_t)m * D))[F.lane + 64 * j] = w; *(LAS u32x2*)(HT + rl * HP + 4 * (F.lane + 64 * j)) = w; }
        }
        __syncthreads();
        {
            const int mrow = F.lane & 15, g = F.lane >> 4;
            f32x4 acc[5];
#pragma unroll
            for (int nt = 0; nt < 5; ++nt) acc[nt] = (f32x4){0.f, 0.f, 0.f, 0.f};
#pragma unroll 2
            for (int ks = 0; ks < 8; ++ks) { const int kk = 32 * (8 * F.wave + ks) + 8 * g;
                const bf16x8 a = *(const LAS bf16x8*)(HT + mrow * HP + kk);
#pragma unroll
                for (int nt = 0; nt < 5; ++nt) { const bf16x8 bb = *(const bf16x8*)(wrt + (size_t)(nt * 16 + mrow) * D + kk);
                    acc[nt] = __builtin_amdgcn_mfma_f32_16x16x32_bf16(a, bb, acc[nt], 0, 0, 0); } }
#pragma unroll
            for (int nt = 0; nt < 5; ++nt)
#pragma unroll
                for (int q = 0; q < 4; ++q) PART[(F.wave * 16 + 4 * g + q) * 80 + nt * 16 + mrow] = acc[nt][q];
        }
        __syncthreads();
        for (int idx = F.tid; idx < 16 * 72; idx += 512) { const int r = idx / 72, c = idx - r * 72; float s = 0.f;
#pragma unroll
            for (int w = 0; w < 8; ++w) s += PART[(w * 16 + r) * 80 + c];
            LG[r * 80 + c] = s; }
        __syncthreads();
        if (F.tid < 16) {
            const int t = rg * 16 + F.tid; const LAS float* lg = LG + F.tid * 80;
            float l8[8]; float mx = -3.0e38f; int grp = 0;
#pragma unroll
            for (int gq = 0; gq < 8; ++gq) { l8[gq] = lg[gq] + bg[gq]; if (l8[gq] > mx) { mx = l8[gq]; grp = gq; } }
            float se = 0.f;
#pragma unroll
            for (int gq = 0; gq < 8; ++gq) se += __expf(l8[gq] - mx);
            const float pg = 1.f / se;
            float e8[8];
#pragma unroll
            for (int j = 0; j < 8; ++j) e8[j] = lg[8 + grp * 8 + j] + be[grp * 8 + j];
            int i1 = 0; float m1 = e8[0];
#pragma unroll
            for (int j = 1; j < 8; ++j) if (e8[j] > m1) { m1 = e8[j]; i1 = j; }
            int i2 = -1; float m2 = -3.0e38f;
#pragma unroll
            for (int j = 0; j < 8; ++j) if (j != i1 && e8[j] > m2) { m2 = e8[j]; i2 = j; }
            const float rrr = __expf(m2 - m1), g1 = pg / (1.f + rrr), g2 = pg * rrr / (1.f + rrr);
            const int ex1 = grp * 8 + i1, ex2 = grp * 8 + i2;
            const int p1 = (int)atomicAdd(&cnt[ex1], 1u), p2 = (int)atomicAdd(&cnt[ex2], 1u);
            TOK_E[2 * t] = ex1; TOK_E[2 * t + 1] = ex2; TOK_POS[2 * t] = p1; TOK_POS[2 * t + 1] = p2; TOK_GATE[2 * t] = g1; TOK_GATE[2 * t + 1] = g2;
            LISTP[(size_t)ex1 * 8192 + p1] = t; LISTP[(size_t)ex2 * 8192 + p2] = t;
        }
        __syncthreads();
    }
}

template <int L> DI void moe_phases(Frame& F, const Args& args, const XcdBarrier& bar, const int lo, const int hi, LAS int* TAB) {
        unsigned* cnt = F.ctl + CW_CNT + L * 64;
#define MOE_TABLE() do { if (F.tid == 0) { int _a = 0; for (int _e = 0; _e < NE; ++_e) { const int _c = (int)cnt[_e]; TAB[128 + _e] = _a; TAB[200 + _e] = _c; const int _nb = (_c + 255) >> 8; \
        for (int _q = 0; _q < _nb; ++_q) TAB[_a + _q] = _e; _a += _nb; } TAB[192] = _a; } __syncthreads(); } while (0)
    if (INL(11, 24)) { PHASE_FRESH();
        MOE_TABLE();
        pg8::MoeDirect S; S.nunits = TAB[192] * 4; S.NT = 4; S.G = F.G; S.c = F.vcu; S.tab = TAB;
        S.W0 = moe_w_gate + (size_t)L * 64 * D * FF; S.W1 = moe_w_up + (size_t)L * 64 * D * FF; S.estride = (size_t)D * FF; S.cols_per_tile = 128; S.half1_off = 0;
        pg8::EpiGateUp E{HID};
        pg8::gemm_phase_moe<pg8::EpiGateUp, true>(F.lds, D, FF, S, E, HIN, LISTP, F.tid, F.wave);
    }
    if (L == 0) SEAM(11); else SEAM(24);
    if (INL(12, 25)) { PHASE_FRESH();
        MOE_TABLE();
        pg8::MoeDirect S; S.nunits = TAB[192] * 8; S.NT = 8; S.G = F.G; S.c = F.vcu; S.tab = TAB;
        S.W0 = moe_w_down + (size_t)L * 64 * D * FF; S.W1 = S.W0; S.estride = (size_t)D * FF; S.cols_per_tile = 256; S.half1_off = 128;
        pg8::EpiBf16 E{YS, D};
        pg8::gemm_phase_moe32<pg8::EpiBf16, false>(F.lds, FF, D, S, E, HID, nullptr, F.tid, F.wave);
    }
    if (L == 0) SEAM(12); else SEAM(25);
    if (INL(13, 26)) { PHASE_FRESH();
        if (F.tid == 0) { int a = 0; for (int e = 0; e < NE; ++e) { TAB[128 + e] = a; a += ((int)cnt[e] + 255) >> 8; } }
        __syncthreads();
        float* xout = (L == 0) ? XB : args.out;
        for (int m = F.gw; m < T; m += F.NGW) {
            const int b = m / SEQ; const float* modb = MOD + (size_t)(L * 4 + b) * 12288;
            const int r0 = TAB[128 + TOK_E[2 * m]] * 256 + TOK_POS[2 * m], r1 = TAB[128 + TOK_E[2 * m + 1]] * 256 + TOK_POS[2 * m + 1];
            const float g0 = TOK_GATE[2 * m], g1 = TOK_GATE[2 * m + 1];
            f32x4 v[8];
#pragma unroll
            for (int j = 0; j < 8; ++j) {
                const f32x4 xv = ((const f32x4*)(XA + (size_t)m * D))[F.lane + 64 * j];
                const u32x2 ya = ((const u32x2*)(YS + (size_t)r0 * D))[F.lane + 64 * j], yb = ((const u32x2*)(YS + (size_t)r1 * D))[F.lane + 64 * j];
                const f32x4 gg = ((const f32x4*)(modb + 5 * D))[F.lane + 64 * j] + 1.0f;
                f32x4 y; y[0] = g0 * bflo(ya.x) + g1 * bflo(yb.x); y[1] = g0 * bfhi(ya.x) + g1 * bfhi(yb.x); y[2] = g0 * bflo(ya.y) + g1 * bflo(yb.y); y[3] = g0 * bfhi(ya.y) + g1 * bfhi(yb.y);
                v[j] = xv * DN_ALPHA + gg * y;
            }
            LN_ROW(v, ln_g + (size_t)(L * 2 + 1) * D, ln_b + (size_t)(L * 2 + 1) * D);
            bf16* hrow = (L == 0) ? HIN + (size_t)m * D : nullptr;
            const float* mod1 = MOD + (size_t)(4 + b) * 12288;
            WRITE_X_HIN(v, xout + (size_t)m * D, hrow, mod1, mod1 + D);
        }
    }
    if (L == 0) SEAM(13);
}

__global__ void __launch_bounds__(512, 2) mega(Args args) {
    extern __shared__ __attribute__((aligned(16))) unsigned char lds_raw[];
    Frame F;
    F.lds = (LAS unsigned char*)lds_raw;
    F.wave = __builtin_amdgcn_readfirstlane((int)threadIdx.x >> 6); PHASE_FRESH();
    F.G = gridDim.x; { const int bx = blockIdx.x; F.vcu = (F.G % 8 == 0) ? (bx % 8) * (F.G / 8) + bx / 8 : bx; }
    F.gw = F.vcu * 8 + F.wave; F.NGW = F.G * 8;
    F.ctl = (unsigned*)(args.ws + WS_CTL);
    volatile LAS unsigned* MISC = (volatile LAS unsigned*)(F.lds + MISC_OFF);
    LAS int* TAB = (LAS int*)(F.lds + TAB_OFF);
    for (int u = F.tid; u < (LDS_BYTES - LDSCTL_OFF) / 4; u += 512) ((LAS unsigned*)(F.lds + LDSCTL_OFF))[u] = 0u;
    __syncthreads();
    XcdBarrier bar; bar.bar = F.ctl + CW_BAR; bar.x = 0; bar.st = nullptr;
    if (MK_ONE_LAUNCH) bar = xcd_barrier_post(F.ctl + CW_BAR, MISC + 8, F.tid == 0);
    const int lo = args.ph_lo, hi = args.ph_hi;

    if (IN(0)) { PHASE_FRESH();
        const bool defer = (F.G >= 64);
        if (defer) ada_groups<16>(F, args, 0, 256, (int)blockIdx.x, F.G);
        else ada_groups<96>(F, args, 0, 256, (int)blockIdx.x, F.G);
        tr_job(F, F.gw, F.NGW, hyb_w_in, 0, 1, HYB_IN, D, 0, 4096, WIN0, 0, D, 0, 0);
        tr_job(F, F.gw, F.NGW, hyb_w_in, 0, 1, HYB_IN, D, 4112, 3072, WIN0, 0, D, 4096, 0);
        tr_job(F, F.gw, F.NGW, hyb_w_in, 0, 1, HYB_IN, D, 4096, 16, WIN0, 0, D, 7168, 0);
        zero_fill(F, F.gw, F.NGW, WIN0 + (size_t)7184 * D, (size_t)(NIN - 7184) * D * 2);
        if (!defer) deferred_copies(F, args, F.gw, F.NGW);
        for (int idx = blockIdx.x * 512 + F.tid; idx < T * 32; idx += F.G * 512) {
            const int t = idx >> 5, i = idx & 31;
            const double rev = (double)in_pos[t] * ROPE_INVF[i] * 0.15915494309189535;
            const float fr = (float)(rev - __builtin_rint(rev));
            ROPE_C[idx] = __builtin_amdgcn_cosf(fr); ROPE_S[idx] = __builtin_amdgcn_sinf(fr);
        }
    }
    SEAM(0);

    if (IN(1)) { PHASE_FRESH();
        for (int m = F.gw; m < T; m += F.NGW) {
            const int b = m / SEQ; const float* modb = MOD + (size_t)b * 12288;
            const f32x4* xr = (const f32x4*)(in_x + (size_t)m * D) + F.lane; u32x2* o = (u32x2*)(HIN + (size_t)m * D) + F.lane;
#pragma unroll
            for (int j = 0; j < 8; ++j) { const f32x4 v = xr[64 * j]; const f32x4 sh = ((const f32x4*)(modb))[F.lane + 64 * j], sc = ((const f32x4*)(modb + D))[F.lane + 64 * j];
                const f32x4 h = v * (sc + 1.0f) + sh; u32x2 w; w.x = cvtpk(h[0], h[1]); w.y = cvtpk(h[2], h[3]); o[64 * j] = w; }
        }
    }
    SEAM(1);

    if (IN(2)) { PHASE_FRESH();
        pg8::StaticOrder S; S.init(HIN, WIN0, T, NIN, D, F.G, (int)blockIdx.x);
        pg8::EpiInProj E{PB, PBA};
        pg8::gemm_phase<pg8::EpiInProj, pg8::StaticOrder>(F.lds, D, S, E, F.tid, F.wave);
    }
    SEAM(2);

    if (IN(3)) { PHASE_FRESH();
        constexpr int QS = 136;
        LAS float* MT = (LAS float*)(F.lds);
        LAS bf16* QKM = (LAS bf16*)(F.lds + 17408);
        LAS float* RAWK = (LAS float*)(F.lds);
        LAS float* VF = (LAS float*)(F.lds + 32768);
        LAS float* WL = (LAS float*)(F.lds + 65536);
        LAS bf16* QBl = (LAS bf16*)(F.lds + 98304);
        LAS bf16* KBl = (LAS bf16*)(F.lds + 115712);
        int zoff = 0; asm volatile("" : "+v"(zoff));
        LAS float* s_beta = (LAS float*)(F.lds + 133120 + zoff); LAS float* s_gc = s_beta + 64; LAS float* s_egc = s_beta + 128;
        for (int ch = blockIdx.x; ch < NCH; ch += F.G) {
            PHASE_FRESH();
            const int n = ch & 31, bh = ch >> 5, h = bh & 7, b = bh >> 3;
            const int tok0 = b * SEQ + n * CHK;
            if (F.tid < 384) {
                const int mat = F.tid >> 7, d = F.tid & 127, col = mat * 1024 + h * 128 + d;
                const float w0 = gdn_conv_w[col], w1 = gdn_conv_w[3072 + col], w2 = gdn_conv_w[2 * 3072 + col], w3 = gdn_conv_w[3 * 3072 + col];
                const bf16* pc = PB + (size_t)tok0 * NP + col;
                float xm3 = 0.f, xm2 = 0.f, xm1 = 0.f;
                if (n > 0) { xm3 = bf2f(pc[-3 * NP]); xm2 = bf2f(pc[-2 * NP]); xm1 = bf2f(pc[-NP]); }
                LAS float* dst = (mat == 0) ? WL : (mat == 1 ? RAWK : VF);
#pragma unroll 8
                for (int i = 0; i < 64; ++i) { const float xi = bf2f(pc[(size_t)i * NP]); const float y = w0 * xm3 + w1 * xm2 + w2 * xm1 + w3 * xi;
                    dst[i * 128 + d] = silu_f(y); xm3 = xm2; xm2 = xm1; xm1 = xi; }
            }
            if (F.wave == 7) {
                const int tok = tok0 + F.lane;
                const float br = PBA[(size_t)tok * 16 + h], ar = PBA[(size_t)tok * 16 + 8 + h];
                const float beta = 1.f / (1.f + __expf(-br));
                const float xsp = ar + gdn_dt_bias[h];
                const float sp = fmaxf(xsp, 0.f) + log1pf(__expf(-fabsf(xsp)));
                float g = -__expf(gdn_a_log[h]) * sp;
#pragma unroll
                for (int off = 1; off < 64; off <<= 1) { const float v = __shfl_up(g, off); if (F.lane >= off) g += v; }
                s_beta[F.lane] = beta; s_gc[F.lane] = g; s_egc[F.lane] = __expf(g);
            }
            __syncthreads();
#pragma unroll
            for (int rr = 0; rr < 8; ++rr) {
                const int i = F.wave * 8 + rr;
                const float qa = WL[i * 128 + F.lane], qb2 = WL[i * 128 + 64 + F.lane];
                const float ka = RAWK[i * 128 + F.lane], kb2 = RAWK[i * 128 + 64 + F.lane];
                const float rq = rsqrtf(wave_sum(qa * qa + qb2 * qb2) + 1e-6f) * 0.08838834764831845f;
                const float rk = rsqrtf(wave_sum(ka * ka + kb2 * kb2) + 1e-6f);
                QBl[i * QS + F.lane] = f2bf(qa * rq); QBl[i * QS + 64 + F.lane] = f2bf(qb2 * rq);
                KBl[i * QS + F.lane] = f2bf(ka * rk); KBl[i * QS + 64 + F.lane] = f2bf(kb2 * rk);
            }
            __syncthreads();
            {
                const int mat = F.wave >> 2, mi = (F.wave >> 1) & 1, ni = F.wave & 1, r = F.lane & 31, hh = F.lane >> 5;
                const LAS bf16* Am = (mat == 0) ? KBl : QBl;
                f32x16 acc;
#pragma unroll
                for (int i = 0; i < 16; ++i) acc[i] = 0.f;
#pragma unroll
                for (int ks = 0; ks < 8; ++ks) {
                    const bf16x8 a = *(const LAS bf16x8*)(Am + (32 * mi + r) * QS + 16 * ks + 8 * hh);
                    const bf16x8 bb = *(const LAS bf16x8*)(KBl + (32 * ni + r) * QS + 16 * ks + 8 * hh);
                    acc = MFMA32(a, bb, acc);
                }
                const int j = 32 * ni + r; const float gj = s_gc[j];
#pragma unroll
                for (int reg = 0; reg < 16; ++reg) {
                    const int i = 32 * mi + crow(reg, hh);
                    const float gi = s_gc[i];
                    const float dec = __expf(fminf(gi - gj, 0.f));
                    if (mat == 0) MT[j * 68 + i] = (i > j) ? s_beta[i] * acc[reg] * dec : 0.f;
                    else QKM[i * 64 + j] = f2bf((i >= j) ? acc[reg] * dec : 0.f);
                }
            }
            __syncthreads();
            if (F.tid < 256) {
                const int c = F.tid, dcol = c & 127;
                float X[64];
                if (c < 128) {
#pragma unroll
                    for (int i = 0; i < 64; ++i) X[i] = VF[i * 128 + dcol] * s_beta[i];
                } else {
#pragma unroll
                    for (int i = 0; i < 64; ++i) X[i] = bf2f(KBl[i * QS + dcol]) * s_beta[i] * s_egc[i];
                }
#pragma unroll
                for (int j = 0; j < 63; ++j) {
                    asm volatile("" ::: "memory");
                    const float xj = X[j];
#pragma unroll
                    for (int i4 = ((j + 1) & ~3); i4 < 64; i4 += 4) {
                        const f32x4 m4 = *(const LAS f32x4*)(MT + j * 68 + i4);
#pragma unroll
                        for (int q = 0; q < 4; ++q) if (i4 + q > j) X[i4 + q] -= m4[q] * xj;
                    }
                }
                LAS float* dst = (c < 128) ? VF : WL;
#pragma unroll
                for (int i = 0; i < 64; ++i) dst[i * 128 + dcol] = X[i];
            }
            __syncthreads();
            {
                const int r = F.lane & 31, hh = F.lane >> 5;
                const float gl = s_gc[63];
                unsigned char* gf = GF + (size_t)ch * 57344;
                for (int f = F.wave; f < 56; f += 8) {
                    float v[8];
                    if (f < 16) { const int mt = f >> 3, ks = f & 7; const LAS float* src = WL + (32 * mt + r) * 128 + 16 * ks + 4 * hh;
#pragma unroll
                        for (int j = 0; j < 8; ++j) v[j] = -src[8 * (j >> 2) + (j & 3)]; }
                    else if (f < 32) { const int f2 = f - 16, mt = f2 >> 3, ks = f2 & 7, i = 32 * mt + r; const float e = s_egc[i]; const LAS bf16* src = QBl + i * QS + 16 * ks + 4 * hh;
#pragma unroll
                        for (int j = 0; j < 8; ++j) v[j] = bf2f(src[8 * (j >> 2) + (j & 3)]) * e; }
                    else if (f < 40) { const int f2 = f - 32, mt = f2 >> 2, ks = f2 & 3; const LAS bf16* src = QKM + (32 * mt + r) * 64 + 16 * ks + 4 * hh;
#pragma unroll
                        for (int j = 0; j < 8; ++j) v[j] = bf2f(src[8 * (j >> 2) + (j & 3)]); }
                    else { const int f2 = f - 40, mt = f2 >> 2, ks = f2 & 3, dd = 32 * mt + r;
#pragma unroll
                        for (int j = 0; j < 8; ++j) { const int i = 16 * ks + 8 * (j >> 2) + 4 * hh + (j & 3); v[j] = bf2f(KBl[i * QS + dd]) * __expf(gl - s_gc[i]); } }
                    u32x4 o; o.x = cvtpk(v[0], v[1]); o.y = cvtpk(v[2], v[3]); o.z = cvtpk(v[4], v[5]); o.w = cvtpk(v[6], v[7]);
                    *(u32x4*)(gf + f * 1024 + F.lane * 16) = o;
                }
                { const int sl = F.wave >> 1, it = F.wave & 1, col = 32 * sl + r;
                  float* up = (float*)(GU + (size_t)ch * 32768 + (size_t)((sl * 2 + it) * 64 + F.lane) * 64);
#pragma unroll
                  for (int g4 = 0; g4 < 4; ++g4) { f32x4 t4;
#pragma unroll
                      for (int q = 0; q < 4; ++q) t4[q] = VF[(32 * it + crow(4 * g4 + q, hh)) * 128 + col];
                      *(f32x4*)(up + 4 * g4) = t4; } }
                if (F.tid == 0) EG[ch] = __expf(gl);
            }
            __syncthreads();
        }
    }
    SEAM(3);

    if (IN(4)) { PHASE_FRESH();
        if (F.G >= 64 && (int)blockIdx.x >= BATCH * GH) {
            const int bidx = (int)blockIdx.x - BATCH * GH, nb = F.G - BATCH * GH;
            ada_groups<96>(F, args, 42, 256, bidx, nb);
            deferred_copies(F, args, bidx * 8 + F.wave, nb * 8);
        }
        for (int bh = blockIdx.x; bh < BATCH * GH; bh += F.G) {
            const int b = bh >> 3, hd = bh & 7, r = F.lane & 31, hh = F.lane >> 5, sl = F.wave;
            f32x16 S[4];
#pragma unroll
            for (int dt = 0; dt < 4; ++dt)
#pragma unroll
                for (int i = 0; i < 16; ++i) S[dt][i] = 0.f;
            f32x16 un[2];
            if (F.wave >= 4) {
                const int t4 = F.tid - 256; const unsigned char* g0 = GF + opaque_off((size_t)(bh * 32) * 57344 + (size_t)t4 * 16);
#pragma unroll
                for (int q = 0; q < 14; ++q) *(LAS u32x4*)(F.lds + (t4 + 256 * q) * 16) = *(const u32x4*)(g0 + (size_t)q * 4096);
            } else {
#pragma unroll
                for (int it = 0; it < 2; ++it) { const f32x4* up = (const f32x4*)(GU + opaque_off((size_t)(bh * 32) * 32768 + (size_t)((sl * 2 + it) * 64 + F.lane) * 64));
#pragma unroll
                    for (int g4 = 0; g4 < 4; ++g4) { const f32x4 t4 = up[g4]; un[it][4 * g4] = t4[0]; un[it][4 * g4 + 1] = t4[1]; un[it][4 * g4 + 2] = t4[2]; un[it][4 * g4 + 3] = t4[3]; } }
            }
            __syncthreads();
            for (int n = 0; n < NCHK; ++n) {
                const int ch = bh * 32 + n; const bool more = (n + 1 < NCHK);
                if (F.wave >= 4) {
                    if (more) {
                        const unsigned char* gn = GF + opaque_off((size_t)(ch + 1) * 57344 + (size_t)(F.tid - 256) * 16); LAS unsigned char* nb = F.lds + ((n + 1) & 1) * 57344; const int t4 = F.tid - 256;
#pragma unroll
                        for (int q = 0; q < 14; ++q) *(LAS u32x4*)(nb + (t4 + 256 * q) * 16) = *(const u32x4*)(gn + (size_t)q * 4096);
                    }
                } else {
                    const LAS unsigned char* buf = F.lds + (n & 1) * 57344 + F.lane * 16;
                    const float eg = EG[ch];
                    bf16x8 Sb[8];
#pragma unroll
                    for (int dt = 0; dt < 4; ++dt) { Sb[2 * dt] = pack_acc(S[dt], 0); Sb[2 * dt + 1] = pack_acc(S[dt], 1); }
                    f32x16 vn[2]; vn[0] = un[0]; vn[1] = un[1];
#pragma unroll
                    for (int it = 0; it < 2; ++it)
#pragma unroll
                        for (int ks = 0; ks < 8; ++ks) vn[it] = MFMA32(*(const LAS bf16x8*)(buf + (it * 8 + ks) * 1024), Sb[ks], vn[it]);
                    __builtin_amdgcn_sched_barrier(0);
                    f32x16 oa[2];
#pragma unroll
                    for (int it = 0; it < 2; ++it) {
#pragma unroll
                        for (int i = 0; i < 16; ++i) oa[it][i] = 0.f;
#pragma unroll
                        for (int ks = 0; ks < 8; ++ks) oa[it] = MFMA32(*(const LAS bf16x8*)(buf + (16 + it * 8 + ks) * 1024), Sb[ks], oa[it]);
                    }
                    __builtin_amdgcn_sched_barrier(0);
                    bf16x8 vb[4];
#pragma unroll
                    for (int it = 0; it < 2; ++it) { vb[2 * it] = pack_acc(vn[it], 0); vb[2 * it + 1] = pack_acc(vn[it], 1); }
                    __builtin_amdgcn_sched_barrier(0);
                    {
                        const int chn = more ? ch + 1 : ch;
#pragma unroll
                        for (int it = 0; it < 2; ++it) { const f32x4* up = (const f32x4*)(GU + opaque_off((size_t)chn * 32768 + (size_t)((sl * 2 + it) * 64 + F.lane) * 64));
#pragma unroll
                            for (int g4 = 0; g4 < 4; ++g4) { const f32x4 t4 = up[g4]; un[it][4 * g4] = t4[0]; un[it][4 * g4 + 1] = t4[1]; un[it][4 * g4 + 2] = t4[2]; un[it][4 * g4 + 3] = t4[3]; } }
                    }
                    __builtin_amdgcn_sched_barrier(0);
#pragma unroll
                    for (int it = 0; it < 2; ++it)
#pragma unroll
                        for (int ks = 0; ks < 4; ++ks) oa[it] = MFMA32(*(const LAS bf16x8*)(buf + (32 + it * 4 + ks) * 1024), vb[ks], oa[it]);
#pragma unroll
                    for (int it = 0; it < 2; ++it) {
#pragma unroll
                        for (int g4 = 0; g4 < 4; ++g4) { float* op = GO + opaque_off((size_t)(b * SEQ + n * CHK + 32 * it + 8 * g4 + 4 * hh) * 1024 + hd * 128 + sl * 32 + r);
#pragma unroll
                            for (int q = 0; q < 4; ++q) op[q * 1024] = oa[it][4 * g4 + q]; } }
                    __builtin_amdgcn_sched_barrier(0);
#pragma unroll
                    for (int dt = 0; dt < 4; ++dt) {
#pragma unroll
                        for (int i = 0; i < 16; ++i) S[dt][i] *= eg;
#pragma unroll
                        for (int ks = 0; ks < 4; ++ks) S[dt] = MFMA32(*(const LAS bf16x8*)(buf + (40 + dt * 4 + ks) * 1024), vb[ks], S[dt]);
                    }
                }
                LDS_WAIT(); __builtin_amdgcn_s_barrier(); asm volatile("" ::: "memory");
            }
            __syncthreads();
        }
    }
    SEAM(4);

    if (IN(5)) { PHASE_FRESH();
        for (int m = F.gw; m < T; m += F.NGW) {
            const int s = m & (SEQ - 1), c0 = F.lane * 16;
            const bf16* prow = PB + (size_t)m * NP;
            {
                const f32x4* op = (const f32x4*)(GO + (size_t)m * 1024 + c0);
                f32x4 o[4]; float ss = 0.f;
#pragma unroll
                for (int q = 0; q < 4; ++q) { o[q] = op[q]; ss += o[q][0] * o[q][0] + o[q][1] * o[q][1] + o[q][2] * o[q][2] + o[q][3] * o[q][3]; }
                ss += __shfl_xor(ss, 1); ss += __shfl_xor(ss, 2); ss += __shfl_xor(ss, 4);
                const float rms = rsqrtf(ss * (1.f / 128.f) + 1e-6f);
                const u32x4* zp = (const u32x4*)(prow + 3072 + c0); const u32x4 z0 = zp[0], z1 = zp[1];
                const unsigned zw[8] = {z0.x, z0.y, z0.z, z0.w, z1.x, z1.y, z1.z, z1.w};
                const f32x4* nwp = (const f32x4*)(gdn_norm_w + (c0 & 127));
                unsigned ow[8];
#pragma unroll
                for (int q = 0; q < 4; ++q) { const f32x4 nw = nwp[q];
                    const float y0 = o[q][0] * rms * nw[0] * silu_f(bflo(zw[2 * q])), y1 = o[q][1] * rms * nw[1] * silu_f(bfhi(zw[2 * q]));
                    const float y2 = o[q][2] * rms * nw[2] * silu_f(bflo(zw[2 * q + 1])), y3 = o[q][3] * rms * nw[3] * silu_f(bfhi(zw[2 * q + 1]));
                    ow[2 * q] = cvtpk(y0, y1); ow[2 * q + 1] = cvtpk(y2, y3); }
                u32x4* yp = (u32x4*)(YAB + (size_t)m * D + c0);
                yp[0] = (u32x4){ow[0], ow[1], ow[2], ow[3]}; yp[1] = (u32x4){ow[4], ow[5], ow[6], ow[7]};
            }
            {
                float accv[16];
#pragma unroll
                for (int q = 0; q < 16; ++q) accv[q] = 0.f;
#pragma unroll
                for (int j = 0; j < 3; ++j) {
                    if (s - 2 + j >= 0) {
                        const bf16* pr = prow + (ptrdiff_t)(j - 2) * NP;
                        const u32x4* cp = (const u32x4*)(pr + 5120 + c0); const u32x4* hp = (const u32x4*)(pr + 6144 + c0);
                        const u32x4 ca = cp[0], cb = cp[1], ha = hp[0], hb = hp[1];
                        const unsigned cw[8] = {ca.x, ca.y, ca.z, ca.w, cb.x, cb.y, cb.z, cb.w}, hw[8] = {ha.x, ha.y, ha.z, ha.w, hb.x, hb.y, hb.z, hb.w};
                        const f32x4* wp = (const f32x4*)(sc_conv_w + j * 1024 + c0);
#pragma unroll
                        for (int q = 0; q < 4; ++q) { const f32x4 w4 = wp[q];
                            accv[4 * q] += w4[0] * bflo(cw[2 * q]) * bflo(hw[2 * q]); accv[4 * q + 1] += w4[1] * bfhi(cw[2 * q]) * bfhi(hw[2 * q]);
                            accv[4 * q + 2] += w4[2] * bflo(cw[2 * q + 1]) * bflo(hw[2 * q + 1]); accv[4 * q + 3] += w4[3] * bfhi(cw[2 * q + 1]) * bfhi(hw[2 * q + 1]); }
                    }
                }
                const u32x4* bp = (const u32x4*)(prow + 4096 + c0); const u32x4 ba = bp[0], bb = bp[1];
                const unsigned bw[8] = {ba.x, ba.y, ba.z, ba.w, bb.x, bb.y, bb.z, bb.w};
                unsigned ow[8];
#pragma unroll
                for (int q = 0; q < 8; ++q) ow[q] = cvtpk(bflo(bw[q]) * accv[2 * q], bfhi(bw[q]) * accv[2 * q + 1]);
                u32x4* yp = (u32x4*)(YAB + (size_t)m * D + 1024 + c0);
                yp[0] = (u32x4){ow[0], ow[1], ow[2], ow[3]}; yp[1] = (u32x4){ow[4], ow[5], ow[6], ow[7]};
            }
        }
    }
    SEAM(5);

    if (IN(6)) { PHASE_FRESH();
        pg8::StaticOrder S; S.init(YAB, WOUT0, T, D, D, F.G, (int)blockIdx.x);
        pg8::EpiResid E{in_x, MOD + 2 * D, RB};
        pg8::gemm_phase<pg8::EpiResid, pg8::StaticOrder>(F.lds, D, S, E, F.tid, F.wave);
    }
    SEAM(6);

    if (IN(7)) { PHASE_FRESH(); ln_route_phase<0>(F, args); }
    if (IN(7) && IN(11)) { PHASE_FRESH(); xcd_barrier(bar, F.tid == 0); }


    moe_phases<0>(F, args, bar, lo, hi, TAB);

        if (IN(14)) { PHASE_FRESH();
            pg8::StaticOrder S; S.init(HIN, WMIN, T, NMLA, D, F.G, (int)blockIdx.x);
            pg8::EpiF32 E{C1, NMLA};
            pg8::gemm_phase<pg8::EpiF32, pg8::StaticOrder>(F.lds, D, S, E, F.tid, F.wave);
        }
        SEAM(14);
        if (IN(15)) { PHASE_FRESH();
            for (int m = F.gw; m < T; m += F.NGW) {
                const float* c1 = C1 + (size_t)m * NMLA;
#pragma unroll
                for (int part = 0; part < 2; ++part) {
                    const f32x4* p = (const f32x4*)(c1 + part * 512 + 8 * F.lane); const f32x4 a0 = p[0], a1 = p[1];
                    const float ss = wave_sum((a0[0] * a0[0] + a0[1] * a0[1]) + (a0[2] * a0[2] + a0[3] * a0[3]) + (a1[0] * a1[0] + a1[1] * a1[1]) + (a1[2] * a1[2] + a1[3] * a1[3]));
                    const float rn = rsqrtf(ss * (1.f / 512.f) + 1e-6f);
                    const f32x4* wp = (const f32x4*)((part == 0 ? mla_q_norm : mla_kv_norm) + 8 * F.lane); const f32x4 w0 = wp[0], w1 = wp[1];
                    u32x4 o; o.x = cvtpk(a0[0] * rn * w0[0], a0[1] * rn * w0[1]); o.y = cvtpk(a0[2] * rn * w0[2], a0[3] * rn * w0[3]);
                    o.z = cvtpk(a1[0] * rn * w1[0], a1[1] * rn * w1[1]); o.w = cvtpk(a1[2] * rn * w1[2], a1[3] * rn * w1[3]);
                    *(u32x4*)((part == 0 ? CQN : CKVN) + (size_t)m * 512 + 8 * F.lane) = o;
                }
                if (F.lane < 32) { const float x1 = c1[1024 + F.lane], x2 = c1[1056 + F.lane], cs = ROPE_C[(size_t)m * 32 + F.lane], sn = ROPE_S[(size_t)m * 32 + F.lane];
                    KPE[(size_t)m * 64 + F.lane] = x1 * cs - x2 * sn; KPE[(size_t)m * 64 + 32 + F.lane] = x1 * sn + x2 * cs; }
            }
        }
        SEAM(15);
        if (IN(16)) { PHASE_FRESH();
            { pg8::StaticOrder S; S.init(CQN, WUQ, T, 3072, 512, F.G, (int)blockIdx.x); pg8::EpiQup E{QB_};
              pg8::gemm_phase<pg8::EpiQup, pg8::StaticOrder>(F.lds, 512, S, E, F.tid, F.wave); }
            { pg8::StaticOrder S; S.init(CKVN, WUKV, T, 4096, 512, F.G, (int)blockIdx.x); pg8::EpiKVup E{KB_, VB_};
              pg8::gemm_phase<pg8::EpiKVup, pg8::StaticOrder>(F.lds, 512, S, E, F.tid, F.wave); }
        }
        SEAM(16);
        if (IN(17)) { PHASE_FRESH();
            for (int m = F.gw; m < T; m += F.NGW) {
                const int b = m / SEQ, s = m - b * SEQ, hd = F.lane >> 2, i0 = (F.lane & 3) * 8;
                const size_t rowoff = ((size_t)((b * MH + hd) * SEQ + s)) * QD + 128;
                bf16* qp = QB_ + rowoff;
                const u32x4 xa = *(const u32x4*)(qp + i0), xb = *(const u32x4*)(qp + 32 + i0);
                const f32x4* cp = (const f32x4*)(ROPE_C + (size_t)m * 32 + i0); const f32x4* sp = (const f32x4*)(ROPE_S + (size_t)m * 32 + i0);
                const f32x4 c0 = cp[0], c1v = cp[1], s0 = sp[0], s1 = sp[1];
                const float cs[8] = {c0[0], c0[1], c0[2], c0[3], c1v[0], c1v[1], c1v[2], c1v[3]}, sn[8] = {s0[0], s0[1], s0[2], s0[3], s1[0], s1[1], s1[2], s1[3]};
                const unsigned xaw[4] = {xa.x, xa.y, xa.z, xa.w}, xbw[4] = {xb.x, xb.y, xb.z, xb.w};
                unsigned o1[4], o2[4];
#pragma unroll
                for (int q = 0; q < 4; ++q) { const float a0 = bflo(xaw[q]), a1 = bfhi(xaw[q]), b0 = bflo(xbw[q]), b1 = bfhi(xbw[q]);
                    o1[q] = cvtpk(a0 * cs[2 * q] - b0 * sn[2 * q], a1 * cs[2 * q + 1] - b1 * sn[2 * q + 1]);
                    o2[q] = cvtpk(a0 * sn[2 * q] + b0 * cs[2 * q], a1 * sn[2 * q + 1] + b1 * cs[2 * q + 1]); }
                *(u32x4*)(qp + i0) = (u32x4){o1[0], o1[1], o1[2], o1[3]}; *(u32x4*)(qp + 32 + i0) = (u32x4){o2[0], o2[1], o2[2], o2[3]};
                const f32x4* kp = (const f32x4*)(KPE + (size_t)m * 64 + i0); const f32x4* kp2 = (const f32x4*)(KPE + (size_t)m * 64 + 32 + i0);
                const f32x4 k0 = kp[0], k1 = kp[1], k2 = kp2[0], k3 = kp2[1];
                bf16* kd = KB_ + rowoff;
                *(u32x4*)(kd + i0) = (u32x4){cvtpk(k0[0], k0[1]), cvtpk(k0[2], k0[3]), cvtpk(k1[0], k1[1]), cvtpk(k1[2], k1[3])};
                *(u32x4*)(kd + 32 + i0) = (u32x4){cvtpk(k2[0], k2[1]), cvtpk(k2[2], k2[3]), cvtpk(k3[0], k3[1]), cvtpk(k3[2], k3[3])};
            }
            {
                LAS bf16* scr = (LAS bf16*)(F.lds + F.wave * 17408);
                for (int it = F.gw; it < 64 * 32; it += F.NGW) {
                    const int bhh = it >> 5, sb = it & 31, b = bhh >> 4, hd = bhh & 15, s0 = sb * 64;
#pragma unroll 4
                    for (int i = 0; i < 16; ++i) { const int row = 4 * i + (F.lane >> 4), c8 = (F.lane & 15) * 8;
                        *(LAS u32x4*)(scr + row * 136 + c8) = *(const u32x4*)(VB_ + (size_t)(b * SEQ + s0 + row) * D + hd * 128 + c8); }
                    LDS_WAIT(); asm volatile("" ::: "memory");
                    bf16* dst = VT + ((size_t)bhh * 128) * SEQ + s0 + F.lane;
#pragma unroll 8
                    for (int dv = 0; dv < 128; ++dv) dst[(size_t)dv * SEQ] = scr[F.lane * 136 + dv];
                    LDS_WAIT(); asm volatile("" ::: "memory");
                }
            }
        }
        SEAM(17);
        if (IN(18)) { PHASE_FRESH();
            constexpr int KBUF = 64 * 400, VBUF = 128 * 136;
            LAS unsigned char* KL = F.lds; LAS unsigned char* VL = F.lds + 2 * KBUF;
            const int w = F.wave;
            for (int pi = blockIdx.x; pi < 256; pi += F.G) {
                const int bhh = pi >> 2, pp = pi & 3, b = bhh >> 4, hd = bhh & 15;
                const char* kg = (const char*)(KB_ + (size_t)bhh * SEQ * QD); const char* vg = (const char*)(VT + (size_t)bhh * 128 * SEQ);
                for (int half = 0; half < 2; ++half) {
                    PHASE_FRESH(); const int r = F.lane & 31, hh = F.lane >> 5;
                    const int qb = half == 0 ? 7 - pp : pp, q0 = qb * 256, ntile = 4 * (qb + 1), qrow = q0 + 32 * w + r;
                    bf16x8 qf[12];
                    { const bf16* qp = QB_ + ((size_t)bhh * SEQ + qrow) * QD + 8 * hh;
#pragma unroll
                      for (int ks = 0; ks < 12; ++ks) qf[ks] = *(const bf16x8*)(qp + 16 * ks); }
                    f32x16 oT[4];
#pragma unroll
                    for (int mt = 0; mt < 4; ++mt)
#pragma unroll
                        for (int i = 0; i < 16; ++i) oT[mt][i] = 0.f;
                    float mrun = -1e30f, lsum = 0.f;
                    u32x4 kst[3], vst[2];
#pragma unroll
                    for (int q = 0; q < 3; ++q) kst[q] = *(const u32x4*)(kg + (size_t)(F.tid + 512 * q) * 16);
#pragma unroll
                    for (int q = 0; q < 2; ++q) { const int p = F.tid + 512 * q; vst[q] = *(const u32x4*)(vg + (size_t)(p >> 3) * (SEQ * 2) + (p & 7) * 16); }
#pragma unroll
                    for (int q = 0; q < 3; ++q) { const int p = F.tid + 512 * q; *(LAS u32x4*)(KL + (p / 24) * 400 + (p % 24) * 16) = kst[q]; }
#pragma unroll
                    for (int q = 0; q < 2; ++q) { const int p = F.tid + 512 * q; LAS unsigned char* d = VL + (p >> 3) * 136 + (p & 7) * 16;
                        *(LAS u32x2*)d = (u32x2){vst[q].x, vst[q].y}; *(LAS u32x2*)(d + 8) = (u32x2){vst[q].z, vst[q].w}; }
                    __syncthreads();
                    for (int kt = 0; kt < ntile; ++kt) {
                        const bool more = (kt + 1 < ntile); const int k0 = kt * 64;
                        if (more) {
                            const int k1 = k0 + 64;
#pragma unroll
                            for (int q = 0; q < 3; ++q) kst[q] = *(const u32x4*)(kg + (size_t)k1 * (QD * 2) + (size_t)(F.tid + 512 * q) * 16);
#pragma unroll
                            for (int q = 0; q < 2; ++q) { const int p = F.tid + 512 * q; vst[q] = *(const u32x4*)(vg + (size_t)(p >> 3) * (SEQ * 2) + (size_t)k1 * 2 + (p & 7) * 16); }
                        }
                        if (k0 <= q0 + 32 * w + 31) {
                            const LAS unsigned char* kb = KL + (kt & 1) * KBUF; const LAS unsigned char* vb_ = VL + (kt & 1) * VBUF;
                            f32x16 sT[2];
#pragma unroll
                            for (int kk = 0; kk < 2; ++kk) {
#pragma unroll
                                for (int i = 0; i < 16; ++i) sT[kk][i] = 0.f;
#pragma unroll
                                for (int ks = 0; ks < 12; ++ks) sT[kk] = MFMA32(*(const LAS bf16x8*)(kb + (32 * kk + r) * 400 + (16 * ks + 8 * hh) * 2), qf[ks], sT[kk]);
                            }
                            if (k0 + 63 > q0 + 32 * w) {
#pragma unroll
                                for (int kk = 0; kk < 2; ++kk)
#pragma unroll
                                    for (int reg = 0; reg < 16; ++reg) { const int key = k0 + 32 * kk + crow(reg, hh); if (key > qrow) sT[kk][reg] = -1e30f; }
                            }
                            float mloc = sT[0][0];
#pragma unroll
                            for (int kk = 0; kk < 2; ++kk)
#pragma unroll
                                for (int reg = 0; reg < 16; ++reg) mloc = fmaxf(mloc, sT[kk][reg]);
                            mloc = fmaxf(mloc, __shfl_xor(mloc, 32));
                            const float mnew = fmaxf(mrun, mloc), alpha = __builtin_amdgcn_exp2f(mrun - mnew);
                            float ps = 0.f;
#pragma unroll
                            for (int kk = 0; kk < 2; ++kk)
#pragma unroll
                                for (int reg = 0; reg < 16; ++reg) { const float pe = __builtin_amdgcn_exp2f(sT[kk][reg] - mnew); sT[kk][reg] = pe; ps += pe; }
                            lsum = lsum * alpha + ps; mrun = mnew;
#pragma unroll
                            for (int mt = 0; mt < 4; ++mt)
#pragma unroll
                                for (int i = 0; i < 16; ++i) oT[mt][i] *= alpha;
                            bf16x8 pb[4];
#pragma unroll
                            for (int kk = 0; kk < 2; ++kk) { pb[2 * kk] = pack_acc(sT[kk], 0); pb[2 * kk + 1] = pack_acc(sT[kk], 1); }
#pragma unroll
                            for (int mt = 0; mt < 4; ++mt)
#pragma unroll
                                for (int ks = 0; ks < 4; ++ks) { const LAS unsigned char* vp = vb_ + (32 * mt + r) * 136 + (16 * ks + 4 * hh) * 2;
                                    const u32x2 vlo = *(const LAS u32x2*)vp, vhi = *(const LAS u32x2*)(vp + 16);
                                    const u32x4 va = {vlo.x, vlo.y, vhi.x, vhi.y};
                                    oT[mt] = MFMA32(__builtin_bit_cast(bf16x8, va), pb[ks], oT[mt]); }
                        }
                        if (more) {
                            LAS unsigned char* kn = KL + ((kt + 1) & 1) * KBUF; LAS unsigned char* vn_ = VL + ((kt + 1) & 1) * VBUF;
#pragma unroll
                            for (int q = 0; q < 3; ++q) { const int p = F.tid + 512 * q; *(LAS u32x4*)(kn + (p / 24) * 400 + (p % 24) * 16) = kst[q]; }
#pragma unroll
                            for (int q = 0; q < 2; ++q) { const int p = F.tid + 512 * q; LAS unsigned char* d = vn_ + (p >> 3) * 136 + (p & 7) * 16;
                                *(LAS u32x2*)d = (u32x2){vst[q].x, vst[q].y}; *(LAS u32x2*)(d + 8) = (u32x2){vst[q].z, vst[q].w}; }
                        }
                        __syncthreads();
                    }
                    const float ltot = lsum + __shfl_xor(lsum, 32), inv = 1.f / ltot;
                    bf16* orow = YAB + (size_t)(b * SEQ + qrow) * D + hd * 128 + 4 * hh;
#pragma unroll
                    for (int mt = 0; mt < 4; ++mt)
#pragma unroll
                        for (int g4 = 0; g4 < 4; ++g4) { u32x2 o; o.x = cvtpk(oT[mt][4 * g4] * inv, oT[mt][4 * g4 + 1] * inv); o.y = cvtpk(oT[mt][4 * g4 + 2] * inv, oT[mt][4 * g4 + 3] * inv);
                            *(u32x2*)(orow + 32 * mt + 8 * g4) = o; }
                }
            }
        }
        SEAM(18);
        if (IN(19)) { PHASE_FRESH();
            pg8::StaticOrder S; S.init(YAB, WMOUT, T, D, D, F.G, (int)blockIdx.x);
            pg8::EpiResid E{XB, MOD + (size_t)4 * 12288 + 2 * D, RB};
            pg8::gemm_phase<pg8::EpiResid, pg8::StaticOrder>(F.lds, D, S, E, F.tid, F.wave);
        }
        SEAM(19);
        if (IN(20)) { PHASE_FRESH(); ln_route_phase<1>(F, args); }
        if (IN(20) && IN(24)) { PHASE_FRESH(); xcd_barrier(bar, F.tid == 0); }


    moe_phases<1>(F, args, bar, lo, hi, TAB);
#undef IN
#undef INL
#undef SEAM
#undef WSB
#undef in_x
#undef in_c
#undef in_pos
#undef ada_w
#undef ada_b
#undef ln_g
#undef ln_b
#undef hyb_w_in
#undef gdn_conv_w
#undef gdn_a_log
#undef gdn_dt_bias
#undef gdn_norm_w
#undef sc_conv_w
#undef hyb_w_out
#undef mla_w_in
#undef mla_q_norm
#undef mla_kv_norm
#undef mla_w_uq
#undef mla_w_ukv
#undef mla_w_out
#undef moe_router_g
#undef moe_bias_g
#undef moe_router_e
#undef moe_bias_e
#undef moe_w_gate
#undef moe_w_up
#undef moe_w_down
#undef MOD
#undef ROPE_C
#undef ROPE_S
#undef PBA
#undef LOGITS
#undef TOK_E
#undef TOK_POS
#undef TOK_GATE
#undef EG
#undef WIN0
#undef WOUT0
#undef WMIN
#undef WUQ
#undef WUKV
#undef WMOUT
#undef WRT
#undef WGU
#undef WDN
#undef HIN
#undef XA
#undef XB
#undef RB
#undef PB
#undef GF
#undef GU
#undef GO
#undef YAB
#undef LISTP
#undef HID
#undef YS
#undef C1
#undef CQN
#undef CKVN
#undef KPE
#undef QB_
#undef KB_
#undef VB_
#undef VT
}

extern "C" void kernel_launch(void* const* d_in, const int* in_sizes, int n_in, void* d_out, int out_size, void* d_ws, size_t ws_size, hipStream_t stream) {
    static int grid = 0;
    if (grid == 0) {
        if (n_in != 27 || in_sizes[0] != T * D || out_size != T * D || ws_size < WS_END) { fprintf(stderr, "kernel_launch: unexpected problem (n_in %d, in0 %d, out %d, ws %zu)\n", n_in, n_in > 0 ? in_sizes[0] : -1, out_size, ws_size); grid = -1; return; }
        int dev = 0, cus = 0, per_cu = 0;
        if (hipGetDevice(&dev) != hipSuccess || hipDeviceGetAttribute(&cus, hipDeviceAttributeMultiprocessorCount, dev) != hipSuccess) { grid = -1; return; }
        if (hipFuncSetAttribute((const void*)mega, hipFuncAttributeMaxDynamicSharedMemorySize, LDS_BYTES) != hipSuccess) { fprintf(stderr, "kernel_launch: hipFuncSetAttribute failed\n"); grid = -1; return; }
        if (hipOccupancyMaxActiveBlocksPerMultiprocessor(&per_cu, (const void*)mega, 512, LDS_BYTES) != hipSuccess || per_cu < 1) fprintf(stderr, "kernel_launch: occupancy query reports %d\n", per_cu);
        (void)hipGetLastError();
        grid = cus;
    }
    if (grid < 0) return;
    (void)hipMemsetAsync((char*)d_ws + WS_CTL, 0, CTL_ZERO_BYTES, stream);
    Args a{};
    for (int i = 0; i < 27; ++i) a.in[i] = d_in[i];
    a.out = (float*)d_out; a.ws = (unsigned char*)d_ws;
#if MK_ONE_LAUNCH
    a.ph_lo = 0; a.ph_hi = NPH;
    hipLaunchKernelGGL(mega, dim3(grid), dim3(512), LDS_BYTES, stream, a);
#else
    for (int k = 0; k < NPH; ++k) { a.ph_lo = k; a.ph_hi = k + 1; hipLaunchKernelGGL(mega, dim3(grid), dim3(512), LDS_BYTES, stream, a); }
#endif
}
```

```cpp
#include <hip/hip_runtime.h>
#include <cstdio>
#include <cstdint>

#ifndef MK_ONE_LAUNCH
#define MK_ONE_LAUNCH 1
#endif

#define DI __device__ __forceinline__
#define GAS __attribute__((address_space(1)))
#define LAS __attribute__((address_space(3)))
typedef unsigned short bf16;
typedef float f32x4 __attribute__((ext_vector_type(4)));
typedef float f32x2 __attribute__((ext_vector_type(2)));
typedef float f32x16 __attribute__((ext_vector_type(16)));
typedef short bf16x8 __attribute__((ext_vector_type(8)));
typedef short s16x4 __attribute__((ext_vector_type(4)));
typedef short v4i16_t __attribute__((ext_vector_type(4)));
typedef unsigned u32x4 __attribute__((ext_vector_type(4)));
typedef unsigned u32x2 __attribute__((ext_vector_type(2)));
typedef __bf16 bf16x2_t __attribute__((ext_vector_type(2)));
typedef GAS unsigned gu32;
#define RLX_AGENT __ATOMIC_RELAXED, __HIP_MEMORY_SCOPE_AGENT
#define LDS_WAIT() asm volatile("s_waitcnt lgkmcnt(0)" ::: "memory")
#define VM_WAIT() asm volatile("s_waitcnt vmcnt(0)" ::: "memory")
#define MFMA32(a, b, c) __builtin_amdgcn_mfma_f32_32x32x16_bf16((a), (b), (c), 0, 0, 0)

DI unsigned cvtpk(float lo, float hi) { f32x2 v = {lo, hi}; bf16x2_t b = __builtin_convertvector(v, bf16x2_t); return __builtin_bit_cast(unsigned, b); }
DI bf16 f2bf(float f) { return (bf16)(cvtpk(f, 0.f) & 0xffffu); }
DI float bf2f(bf16 b) { return __uint_as_float(((unsigned)b) << 16); }
DI float bflo(unsigned w) { return __uint_as_float(w << 16); }
DI float bfhi(unsigned w) { return __uint_as_float(w & 0xffff0000u); }
DI int crow(int reg, int h) { return (reg & 3) + 8 * (reg >> 2) + 4 * h; }
DI int kperm(int j, int h) { return 8 * (j >> 2) + 4 * h + (j & 3); }
DI float wave_sum(float v) {
#pragma unroll
    for (int o = 1; o < 64; o <<= 1) v += __shfl_xor(v, o);
    return v;
}
DI bf16x8 pack_acc(const f32x16& x, int s) {
    u32x4 p; p.x = cvtpk(x[8 * s + 0], x[8 * s + 1]); p.y = cvtpk(x[8 * s + 2], x[8 * s + 3]); p.z = cvtpk(x[8 * s + 4], x[8 * s + 5]); p.w = cvtpk(x[8 * s + 6], x[8 * s + 7]);
    return __builtin_bit_cast(bf16x8, p);
}
DI float silu_f(float x) { return x / (1.f + __expf(-x)); }
DI size_t opaque_off(size_t o) { asm volatile("" : "+v"(o)); return o; }

constexpr int D = 2048, BATCH = 4, SEQ = 2048, T = BATCH * SEQ;
constexpr int GH = 8, GD = 128, NCHK = 32, CHK = 64, NCH = BATCH * GH * NCHK;
constexpr int HYB_IN = 7184, NIN = 7424, NP = 7168;
constexpr int MH = 16, MLA_IN = 1088, NMLA = 1280, QD = 192;
constexpr int NE = 64, FF = 512, MAXBLK = 128;
constexpr float DN_ALPHA = 1.41421356237f;
constexpr float QSCALE = 0.10411754627697264f;
constexpr int NPH = 27;

constexpr size_t MiB = 1u << 20;
constexpr size_t WS_CTL = 0, CTL_ZERO_BYTES = 1 * MiB;
constexpr size_t WS_MOD = 1 * MiB;
constexpr size_t WS_ROPE = 2 * MiB;
constexpr size_t WS_PBA = 4 * MiB;
constexpr size_t WS_LOGITS = 5 * MiB;
constexpr size_t WS_ROUTE = 9 * MiB;
constexpr size_t WS_EG = 10 * MiB;
constexpr size_t WS_WIN0 = 16 * MiB;
constexpr size_t WS_WOUT0 = 46 * MiB;
constexpr size_t WS_WMIN = 54 * MiB;
constexpr size_t WS_WUQ = 59 * MiB;
constexpr size_t WS_WUKV = 62 * MiB;
constexpr size_t WS_WMOUT = 66 * MiB;
constexpr size_t WS_WRT = 74 * MiB;
constexpr size_t WS_WGU = 80 * MiB;
constexpr size_t WS_WDN = 592 * MiB;
constexpr size_t WS_HIN = 848 * MiB;
constexpr size_t WS_XA = 880 * MiB;
constexpr size_t WS_XB = 944 * MiB;
constexpr size_t WS_R = 1008 * MiB;
constexpr size_t WS_P = 1072 * MiB;
constexpr size_t WS_GF = 1184 * MiB;
constexpr size_t WS_GU = 1240 * MiB;
constexpr size_t WS_GO = 1272 * MiB;
constexpr size_t WS_YAB = 1304 * MiB;
constexpr size_t WS_XS = 1336 * MiB;
constexpr size_t WS_HID = 1464 * MiB;
constexpr size_t WS_YS = 1496 * MiB;
constexpr size_t WS_C1 = 1624 * MiB;
constexpr size_t WS_CQN = 1664 * MiB;
constexpr size_t WS_CKVN = 1672 * MiB;
constexpr size_t WS_KPE = 1680 * MiB;
constexpr size_t WS_Q = 1684 * MiB;
constexpr size_t WS_K = 1732 * MiB;
constexpr size_t WS_V = 1780 * MiB;
constexpr size_t WS_VT = 1812 * MiB;
constexpr size_t WS_END = 1844 * MiB;
constexpr int CW_BAR = 4096;
constexpr int CW_CNT = 8192;
constexpr int CW_BLK = 8448;

constexpr int RING_BYTES = 131072;
constexpr int LDSCTL_OFF = 143360, MISC_OFF = LDSCTL_OFF + 320;
constexpr int TAB_OFF = LDSCTL_OFF + 512;
constexpr int SC_OFF = LDSCTL_OFF + 1536;
constexpr int LDS_BYTES = 147456;

namespace pg8 {
constexpr int BM = 256, BK = 64, HALF = 128, HTB = HALF * BK * 2, STAGE_BYTES = 8 * HTB, NXCD = 8, WGM = 8;
__host__ __device__ __forceinline__ int lds_byte(int r, int c) { const int st = (r >> 4) * 2 + (c >> 5), rr = r & 15, cc = c & 31, ob = rr * 64 + cc * 2; return st * 1024 + (ob ^ (((ob >> 9) & 1) << 5)); }
__host__ __device__ __forceinline__ void stage_rc(int b, int& R, int& C) { const int st = b / 1024, sb = b % 1024, swz = sb ^ (((sb >> 9) & 1) << 5); R = (st >> 1) * 16 + swz / 64; C = (st & 1) * 32 + (swz % 64) / 2; }
__host__ __device__ __forceinline__ int perm32(int rho) { const int n = rho >> 4, i = rho & 15; return 8 * (i >> 2) + 4 * n + (i & 3); }

struct Unit { int pm, pn, ex, rows; };

struct StaticOrder {
    int nM, nN, nwg, G, c; const char* A; const char* Bt; size_t tstep;
    __device__ void init(const bf16* A_, const bf16* Bt_, int M, int N, int K, int G_, int c_) { nM = M / BM; nN = N / BM; nwg = nM * nN; G = G_; c = c_; A = (const char*)A_; Bt = (const char*)Bt_; tstep = (size_t)BM * K * 2; }
    __device__ bool next(int i, Unit& u) const {
        const long L = (long)i * G + c; if (L >= nwg) return false;
        int wgid = (int)L; { const int q = nwg / NXCD, r = nwg % NXCD, xcd = wgid % NXCD, off = wgid / NXCD; wgid = (xcd < r ? xcd * (q + 1) : r * (q + 1) + (xcd - r) * q) + off; }
        const int nig = WGM * nN, gid = wgid / nig, fm = gid * WGM, gsz = (nM - fm) < WGM ? (nM - fm) : WGM;
        u.pm = fm + ((wgid % nig) % gsz); u.pn = (wgid % nig) / gsz; u.ex = 0; u.rows = 256; return true;
    }
    __device__ __forceinline__ const char* aptr(const Unit& u) const { return A + (size_t)u.pm * tstep; }
    __device__ __forceinline__ const char* bptr(const Unit& u) const { return Bt + (size_t)u.pn * tstep; }
};
struct MoeOrder {
    int nunits, NT, G, c; const LAS int* blk_e; const char* A; const char* W; size_t a_tstep, w_estride, w_tstep;
    __device__ bool next(int i, Unit& u) const {
        const long L = (long)i * G + c; if (L >= nunits) return false;
        u.pm = (int)L / NT; u.pn = (int)L % NT; u.ex = blk_e[u.pm]; u.rows = 256; return true;
    }
    __device__ __forceinline__ const char* aptr(const Unit& u) const { return A + (size_t)u.pm * a_tstep; }
    __device__ __forceinline__ const char* bptr(const Unit& u) const { return W + (size_t)u.ex * w_estride + (size_t)u.pn * w_tstep; }
};

template <class Epi, class Sched, bool ALIGN_EPI = true, bool SP2 = true>
__device__ __forceinline__ void gemm_phase(LAS unsigned char* lds, const int K_, const Sched& S, const Epi& E, const int tid, const int wid) {
    const int lane = tid & 63, wr = wid >> 2, wc = wid & 3, fr = lane & 15, fq = lane >> 4;
    int K = K_; asm volatile("" : "+s"(K));
    const int nt = K / BK;
    unsigned voffA[2], voffB[2];
#pragma unroll
    for (int i = 0; i < 2; ++i) { int R, C; stage_rc(tid * 16 + i * 8192, R, C); const int Rb = Epi::PERM ? ((R & ~31) + perm32(R & 31)) : R;
        voffA[i] = (unsigned)(R * K + C) * 2u; voffB[i] = (unsigned)(Rb * K + C) * 2u; }
    const size_t kstep = (size_t)(BK * 2);
    const size_t hstep = (size_t)HALF * K * 2;
    const unsigned ldsw = (unsigned)wid * 1024u;
    const int aoff = lds_byte(wr * 64 + fr, fq * 8), boff = lds_byte(wc * 32 + fr, fq * 8);
#define PG8_SA(b, h) (((b) * 2 + (h)) * HTB)
#define PG8_SB(b, h) ((4 + (b) * 2 + (h)) * HTB)
#define PG8_STAGE(bufoff, gbase, voff) do { _Pragma("unroll") for (int _i = 0; _i < 2; ++_i) \
        __builtin_amdgcn_global_load_lds((const unsigned*)((const char*)(gbase) + (voff)[_i]), (LAS unsigned*)(lds + (bufoff) + ldsw + _i * 8192), 16, 0, 0); } while (0)
#define PG8_LDA(dst, b, h) do { _Pragma("unroll") for (int m = 0; m < 4; ++m) _Pragma("unroll") for (int k = 0; k < 2; ++k) dst[m][k] = *(const LAS bf16x8*)(lds + PG8_SA(b, h) + aoff + m * 2048 + k * 1024); } while (0)
#define PG8_LDB(dst, b, h) do { _Pragma("unroll") for (int n = 0; n < 2; ++n) _Pragma("unroll") for (int k = 0; k < 2; ++k) dst[n][k] = *(const LAS bf16x8*)(lds + PG8_SB(b, h) + boff + n * 2048 + k * 1024); } while (0)
#define PG8_MMA(ai, bj, At, Bt) do { __builtin_amdgcn_s_setprio(1); _Pragma("unroll") for (int m = 0; m < 4; ++m) _Pragma("unroll") for (int n = 0; n < 2; ++n) _Pragma("unroll") for (int k = 0; k < 2; ++k) \
        acc[ai][bj][m][n] = __builtin_amdgcn_mfma_f32_16x16x32_bf16(Bt[n][k], At[m][k], acc[ai][bj][m][n], 0, 0, 0); __builtin_amdgcn_s_setprio(0); } while (0)
#define PG8_WAIT_V(n) asm volatile("s_waitcnt vmcnt(" #n ")" ::: "memory")
#define PG8_WAIT_L(n) asm volatile("s_waitcnt lgkmcnt(" #n ")" ::: "memory")
#define PG8_BAR __builtin_amdgcn_s_barrier()
#define PG8_SCHED __builtin_amdgcn_sched_barrier(0)
    Unit cur, nxt; int ui = 0;
    if (!S.next(0, cur)) return;
    f32x4 acc[2][2][4][2];
#pragma unroll
    for (int a = 0; a < 2; ++a)
#pragma unroll
        for (int b = 0; b < 2; ++b)
#pragma unroll
            for (int m = 0; m < 4; ++m)
#pragma unroll
                for (int n = 0; n < 2; ++n) acc[a][b][m][n] = (f32x4){0.f, 0.f, 0.f, 0.f};
    bf16x8 At[4][2], B0[2][2], B1[2][2];
    const char* cA = S.aptr(cur); const char* cB = S.bptr(cur);
    if constexpr (SP2) {
        PG8_STAGE(PG8_SB(0, 0), cB, voffB); PG8_STAGE(PG8_SB(0, 1), cB + hstep, voffB); PG8_STAGE(PG8_SA(0, 0), cA, voffA); PG8_STAGE(PG8_SA(0, 1), cA + hstep, voffA);
        if (wr == 1) PG8_BAR;
        PG8_WAIT_V(2); PG8_BAR;
        PG8_STAGE(PG8_SB(1, 0), cB + kstep, voffB); PG8_STAGE(PG8_SA(1, 0), cA + kstep, voffA); PG8_STAGE(PG8_SB(1, 1), cB + hstep + kstep, voffB);
        PG8_WAIT_V(6); PG8_BAR;
    } else {
        PG8_STAGE(PG8_SB(0, 0), cB, voffB); PG8_STAGE(PG8_SA(0, 0), cA, voffA); PG8_STAGE(PG8_SB(0, 1), cB + hstep, voffB); PG8_STAGE(PG8_SA(0, 1), cA + hstep, voffA);
        if (wr == 1) PG8_BAR;
        PG8_WAIT_V(4); PG8_BAR;
        PG8_STAGE(PG8_SB(1, 0), cB + kstep, voffB); PG8_STAGE(PG8_SA(1, 0), cA + kstep, voffA); PG8_STAGE(PG8_SB(1, 1), cB + hstep + kstep, voffB);
        PG8_WAIT_V(6); PG8_BAR;
    }
    for (;;) {
        const bool has_next = S.next(ui + 1, nxt);
        const char* nA = has_next ? S.aptr(nxt) : cA; const char* nB = has_next ? S.bptr(nxt) : cB;
        for (int t = 0; t < nt; t += 2) {
            const bool last = (t == nt - 2);
            const char* a1 = cA + (size_t)(t + 1) * kstep;
            const char* a2 = last ? nA : cA + (size_t)(t + 2) * kstep; const char* b2 = last ? nB : cB + (size_t)(t + 2) * kstep;
            const char* a3 = a2 + kstep; const char* b3 = b2 + kstep;
            if constexpr (SP2) {
            PG8_LDB(B0, 0, 0); PG8_LDB(B1, 0, 1); PG8_SCHED; PG8_LDA(At, 0, 0); PG8_STAGE(PG8_SA(1, 1), a1 + hstep, voffA);
            PG8_WAIT_V(8); PG8_WAIT_L(0); PG8_BAR; PG8_MMA(0, 0, At, B0); PG8_MMA(0, 1, At, B1); PG8_BAR; PG8_SCHED;
            PG8_LDA(At, 0, 1); PG8_STAGE(PG8_SB(0, 0), b2, voffB); PG8_STAGE(PG8_SB(0, 1), b2 + hstep, voffB); PG8_STAGE(PG8_SA(0, 0), a2, voffA);
            PG8_WAIT_V(8); PG8_WAIT_L(0); PG8_BAR; PG8_MMA(1, 0, At, B0); PG8_MMA(1, 1, At, B1); PG8_BAR; PG8_SCHED;
            PG8_LDB(B0, 1, 0); PG8_LDB(B1, 1, 1); PG8_SCHED; PG8_LDA(At, 1, 0); PG8_STAGE(PG8_SA(0, 1), a2 + hstep, voffA);
            PG8_WAIT_V(8); PG8_WAIT_L(0); PG8_BAR; PG8_MMA(0, 0, At, B0); PG8_MMA(0, 1, At, B1); PG8_BAR; PG8_SCHED;
            PG8_LDA(At, 1, 1); PG8_STAGE(PG8_SB(1, 0), b3, voffB); PG8_STAGE(PG8_SB(1, 1), b3 + hstep, voffB); PG8_STAGE(PG8_SA(1, 0), a3, voffA);
            PG8_WAIT_V(8); PG8_WAIT_L(0); PG8_BAR; PG8_MMA(1, 0, At, B0); PG8_MMA(1, 1, At, B1); PG8_BAR; PG8_SCHED;
            } else {
            PG8_LDB(B0, 0, 0); PG8_SCHED; PG8_LDA(At, 0, 0); PG8_STAGE(PG8_SA(1, 1), a1 + hstep, voffA);
            PG8_WAIT_L(8); PG8_BAR; PG8_WAIT_L(0); PG8_MMA(0, 0, At, B0); PG8_BAR; PG8_SCHED;
            PG8_LDB(B1, 0, 1); PG8_STAGE(PG8_SB(0, 0), b2, voffB);
            PG8_BAR; PG8_WAIT_L(0); PG8_MMA(0, 1, At, B1); PG8_BAR;
            PG8_LDA(At, 0, 1); PG8_STAGE(PG8_SA(0, 0), a2, voffA);
            PG8_BAR; PG8_WAIT_L(0); PG8_MMA(1, 0, At, B0); PG8_BAR; PG8_SCHED;
            PG8_STAGE(PG8_SB(0, 1), b2 + hstep, voffB);
            PG8_WAIT_V(6); PG8_BAR; PG8_MMA(1, 1, At, B1); PG8_BAR;
            PG8_LDB(B0, 1, 0); PG8_SCHED; PG8_LDA(At, 1, 0); PG8_STAGE(PG8_SA(0, 1), a2 + hstep, voffA);
            PG8_WAIT_L(8); PG8_BAR; PG8_WAIT_L(0); PG8_MMA(0, 0, At, B0); PG8_BAR; PG8_SCHED;
            PG8_LDB(B1, 1, 1); PG8_STAGE(PG8_SB(1, 0), b3, voffB);
            PG8_BAR; PG8_WAIT_L(0); PG8_MMA(0, 1, At, B1); PG8_BAR;
            PG8_LDA(At, 1, 1); PG8_STAGE(PG8_SA(1, 0), a3, voffA);
            PG8_BAR; PG8_WAIT_L(0); PG8_MMA(1, 0, At, B0); PG8_BAR; PG8_SCHED;
            PG8_STAGE(PG8_SB(1, 1), b3 + hstep, voffB);
            PG8_WAIT_V(6); PG8_BAR; PG8_MMA(1, 1, At, B1); PG8_BAR;
            }
        }
        if constexpr (ALIGN_EPI) { if (wr == 0) PG8_BAR; }
        E(acc, cur, wr, wc, fr, fq);
        if (!has_next) break;
#pragma unroll
        for (int a = 0; a < 2; ++a)
#pragma unroll
            for (int b = 0; b < 2; ++b)
#pragma unroll
                for (int m = 0; m < 4; ++m)
#pragma unroll
                    for (int n = 0; n < 2; ++n) acc[a][b][m][n] = (f32x4){0.f, 0.f, 0.f, 0.f};
        cur = nxt; cA = nA; cB = nB; ++ui;
        if constexpr (ALIGN_EPI) { if (wr == 1) PG8_BAR; }
    }
    PG8_WAIT_V(0);
    if constexpr (!ALIGN_EPI) { if (wr == 0) PG8_BAR; }
    PG8_BAR;
#undef PG8_SA
#undef PG8_SB
#undef PG8_STAGE
#undef PG8_LDA
#undef PG8_LDB
#undef PG8_MMA
#undef PG8_WAIT_V
#undef PG8_WAIT_L
#undef PG8_BAR
#undef PG8_SCHED
}


__host__ __device__ __forceinline__ int iperm32(int c) { return 16 * ((c >> 2) & 1) + 4 * (c >> 3) + (c & 3); }
struct MoeDirect {
    int nunits, NT, G, c; const LAS int* tab;
    const float* W0; const float* W1; size_t estride; int cols_per_tile, half1_off;
    __device__ bool next(int i, Unit& u) const {
        const long L = (long)i * G + c; if (L >= nunits) return false;
        u.pm = (int)L / NT; u.pn = (int)L % NT; u.ex = tab[u.pm];
        const int rem = tab[200 + u.ex] - (u.pm - tab[128 + u.ex]) * 256; u.rows = rem < 256 ? rem : 256; return true;
    }
    __device__ __forceinline__ const float* bptr(const Unit& u, int h) const { return (h ? W1 + half1_off : W0) + (size_t)u.ex * estride + (size_t)u.pn * cols_per_tile; }
};
template <class Epi, bool GATHER>
__device__ __forceinline__ void gemm_phase_moe(LAS unsigned char* lds, const int K_, const int ldw_, const MoeDirect& S, const Epi& E, const bf16* Abase, const int* LIST, const int tid, const int wid) {
    const int wr = wid >> 2, wc = wid & 3;
#define MO_LANE_CONSTS(tl) const int lane = (tl) & 63, fr = lane & 15, fq = lane >> 4; \
    const int aoff = lds_byte(wr * 64 + fr, fq * 8), boff = lds_byte(wc * 32 + fr, fq * 8); \
    const int kq = lane & 7, ng = 8 * wc + (lane >> 3); \
    const unsigned bvoff = (unsigned)((4 * kq) * ldw + 4 * ng) * 4u; \
    const int bslot0 = Epi::PERM ? (((4 * ng) & ~31) + iperm32((4 * ng) & 31)) : 4 * ng; \
    const unsigned bwbase = (unsigned)lds_byte(bslot0, 4 * kq)
    int K = K_; asm volatile("" : "+s"(K));
    int ldw = ldw_; asm volatile("" : "+s"(ldw));
    const int nt = K / BK;
    const unsigned ldsw = (unsigned)wid * 1024u;
    const size_t bkstep = (size_t)64 * ldw * 4, browb = (size_t)ldw * 4;
    f32x4 br[4];
#define MO_SA(b, h) (((b) * 2 + (h)) * HTB)
#define MO_SB(b, h) ((4 + (b) * 2 + (h)) * HTB)
#define MO_STAGE_A(bufoff, basep, o0, o1) do { \
        __builtin_amdgcn_global_load_lds((const unsigned*)((const char*)(basep) + (o0)), (LAS unsigned*)(lds + (bufoff) + ldsw), 16, 0, 0); \
        __builtin_amdgcn_global_load_lds((const unsigned*)((const char*)(basep) + (o1)), (LAS unsigned*)(lds + (bufoff) + ldsw + 8192), 16, 0, 0); } while (0)
#define MO_BISSUE(p, R) do { const char* _p = (const char*)(p) + (size_t)(32 * (R)) * browb; _Pragma("unroll") for (int _j = 0; _j < 4; ++_j) \
        asm volatile("global_load_dwordx4 %0, %1, %2" : "=v"(br[_j]) : "v"(bvoff), "s"(_p + (size_t)_j * browb) : "memory"); } while (0)
#define MO_VWAIT0() asm volatile("s_waitcnt vmcnt(0)" : "+v"(br[0]), "+v"(br[1]), "+v"(br[2]), "+v"(br[3]) :: "memory")
#define MO_BWRITE(b, R) do { _Pragma("unroll") for (int _i = 0; _i < 4; ++_i) { u32x2 _o; _o.x = cvtpk(br[0][_i], br[1][_i]); _o.y = cvtpk(br[2][_i], br[3][_i]); \
        *(LAS u32x2*)(lds + MO_SB(b, wr) + bwbase + 1024 * (R) + 64 * _i) = _o; } } while (0)
#define MO_LDA(dst, b, h) do { _Pragma("unroll") for (int m = 0; m < 4; ++m) _Pragma("unroll") for (int k = 0; k < 2; ++k) dst[m][k] = *(const LAS bf16x8*)(lds + MO_SA(b, h) + aoff + m * 2048 + k * 1024); } while (0)
#define MO_LDB(dst, b, h) do { _Pragma("unroll") for (int n = 0; n < 2; ++n) _Pragma("unroll") for (int k = 0; k < 2; ++k) dst[n][k] = *(const LAS bf16x8*)(lds + MO_SB(b, h) + boff + n * 2048 + k * 1024); } while (0)
#define MO_MMA(ai, bj, At, Bt) do { __builtin_amdgcn_s_setprio(1); _Pragma("unroll") for (int m = 0; m < 4; ++m) _Pragma("unroll") for (int n = 0; n < 2; ++n) _Pragma("unroll") for (int k = 0; k < 2; ++k) \
        acc[ai][bj][m][n] = __builtin_amdgcn_mfma_f32_16x16x32_bf16(Bt[n][k], At[m][k], acc[ai][bj][m][n], 0, 0, 0); __builtin_amdgcn_s_setprio(0); } while (0)
#define MO_WAIT_L(n) asm volatile("s_waitcnt lgkmcnt(" #n ")" ::: "memory")
#define MO_BAR __builtin_amdgcn_s_barrier()
#define MO_SCHED __builtin_amdgcn_sched_barrier(0)
#define MO_AOFF(u, dst) do { _Pragma("unroll") for (int _i = 0; _i < 2; ++_i) { int _R, _C; stage_rc(tid * 16 + _i * 8192, _R, _C); _Pragma("unroll") for (int _h = 0; _h < 2; ++_h) { const int _r = 128 * _h + _R; \
        if (GATHER) { const int _p = ((u).pm - S.tab[128 + (u).ex]) * 256 + _r; const int _t = (_r < (u).rows) ? LIST[(size_t)(u).ex * 8192 + _p] : 0; dst[_h][_i] = (unsigned)(_t * K + _C) * 2u; } \
        else dst[_h][_i] = (unsigned)(_r * K + _C) * 2u; } } } while (0)
    Unit cur, nxt; int ui = 0;
    if (!S.next(0, cur)) return;
    f32x4 acc[2][2][4][2];
#pragma unroll
    for (int a = 0; a < 2; ++a)
#pragma unroll
        for (int b = 0; b < 2; ++b)
#pragma unroll
            for (int m = 0; m < 4; ++m)
#pragma unroll
                for (int n = 0; n < 2; ++n) acc[a][b][m][n] = (f32x4){0.f, 0.f, 0.f, 0.f};
    bf16x8 At[4][2], B0[2][2], B1[2][2];
    unsigned cAo[2][2];
    LAS u32x4* const aslot = (LAS u32x4*)(lds + STAGE_BYTES) + tid;
    MO_AOFF(cur, cAo);
    const char* cAb = GATHER ? (const char*)Abase : (const char*)Abase + (size_t)cur.pm * 256 * K * 2;
    const char* cBh = (const char*)S.bptr(cur, wr);
    { MO_LANE_CONSTS(tid);
    MO_BISSUE(cBh, 0); MO_STAGE_A(MO_SA(0, 0), cAb, cAo[0][0], cAo[0][1]); MO_STAGE_A(MO_SA(0, 1), cAb, cAo[1][0], cAo[1][1]);
    if (wr == 1) MO_BAR;
    MO_VWAIT0(); MO_BWRITE(0, 0); MO_BISSUE(cBh, 1);
    MO_VWAIT0(); MO_BWRITE(0, 1);
    MO_WAIT_L(0); MO_BAR;
    MO_BISSUE(cBh + bkstep, 0); MO_STAGE_A(MO_SA(1, 0), cAb + 128, cAo[0][0], cAo[0][1]);
    MO_VWAIT0(); MO_BWRITE(1, 0); MO_BISSUE(cBh + bkstep, 1);
    MO_WAIT_L(0); MO_BAR; }
    for (;;) {
        const bool has_next = S.next(ui + 1, nxt);
        const char* nAb = cAb; const char* nBh = cBh;
        if (has_next) { nAb = GATHER ? (const char*)Abase : (const char*)Abase + (size_t)nxt.pm * 256 * K * 2; nBh = (const char*)S.bptr(nxt, wr);
            if (GATHER) { unsigned nAo[2][2]; MO_AOFF(nxt, nAo); *aslot = (u32x4){nAo[0][0], nAo[0][1], nAo[1][0], nAo[1][1]}; } }
        const bool halfu = cur.rows <= 128;
        for (int t = 0; t < nt; t += 2) {
            int tl = tid; asm volatile("" : "+v"(tl)); MO_LANE_CONSTS(tl);
            const bool last = (t == nt - 2);
            const char* a1 = cAb + (size_t)(t + 1) * 128;
            const char* a2 = last ? nAb : cAb + (size_t)(t + 2) * 128; const char* a3 = a2 + 128;
            const char* b2 = last ? nBh : cBh + (size_t)(t + 2) * bkstep; const char* b3 = b2 + bkstep;
            MO_LDB(B0, 0, 0); MO_LDB(B1, 0, 1); MO_SCHED; MO_LDA(At, 0, 0);
            MO_VWAIT0(); MO_BWRITE(1, 1); MO_STAGE_A(MO_SA(1, 1), a1, cAo[1][0], cAo[1][1]); MO_BISSUE(b2, 0);
            if (GATHER && last && has_next) { const u32x4 _n = *aslot; cAo[0][0] = _n.x; cAo[0][1] = _n.y; cAo[1][0] = _n.z; cAo[1][1] = _n.w; }
            MO_WAIT_L(0); MO_BAR; MO_MMA(0, 0, At, B0); MO_MMA(0, 1, At, B1); MO_BAR; MO_SCHED;
            MO_LDA(At, 0, 1);
            MO_VWAIT0(); MO_BWRITE(0, 0); MO_STAGE_A(MO_SA(0, 0), a2, cAo[0][0], cAo[0][1]); MO_BISSUE(b2, 1);
            MO_WAIT_L(0); MO_BAR; if (!halfu) { MO_MMA(1, 0, At, B0); MO_MMA(1, 1, At, B1); } MO_BAR; MO_SCHED;
            MO_LDB(B0, 1, 0); MO_LDB(B1, 1, 1); MO_SCHED; MO_LDA(At, 1, 0);
            MO_VWAIT0(); MO_BWRITE(0, 1); MO_STAGE_A(MO_SA(0, 1), a2, cAo[1][0], cAo[1][1]); MO_BISSUE(b3, 0);
            MO_WAIT_L(0); MO_BAR; MO_MMA(0, 0, At, B0); MO_MMA(0, 1, At, B1); MO_BAR; MO_SCHED;
            MO_LDA(At, 1, 1);
            MO_VWAIT0(); MO_BWRITE(1, 0); MO_STAGE_A(MO_SA(1, 0), a3, cAo[0][0], cAo[0][1]); MO_BISSUE(b3, 1);
            MO_WAIT_L(0); MO_BAR; if (!halfu) { MO_MMA(1, 0, At, B0); MO_MMA(1, 1, At, B1); } MO_BAR; MO_SCHED;
        }
        if (wr == 0) MO_BAR;
        { const int lane = tid & 63; E(acc, cur, wr, wc, lane & 15, lane >> 4); }
        if (!has_next) break;
#pragma unroll
        for (int a = 0; a < 2; ++a)
#pragma unroll
            for (int b = 0; b < 2; ++b)
#pragma unroll
                for (int m = 0; m < 4; ++m)
#pragma unroll
                    for (int n = 0; n < 2; ++n) acc[a][b][m][n] = (f32x4){0.f, 0.f, 0.f, 0.f};
        cur = nxt; cAb = nAb; cBh = nBh; ++ui;
        if (wr == 1) MO_BAR;
    }
    MO_VWAIT0();
    MO_BAR;
#undef MO_SA
#undef MO_SB
#undef MO_STAGE_A
#undef MO_BISSUE
#undef MO_VWAIT0
#undef MO_BWRITE
#undef MO_LDA
#undef MO_LDB
#undef MO_MMA
#undef MO_WAIT_L
#undef MO_BAR
#undef MO_SCHED
#undef MO_AOFF
#undef MO_LANE_CONSTS
}

template <class Epi, bool GATHER>
__device__ __forceinline__ void gemm_phase_moe32(LAS unsigned char* lds, const int K_, const int ldw_, const MoeDirect& S, const Epi& E, const bf16* Abase, const int* LIST, const int tid, const int wid) {
    const int wr = wid >> 2, wc = wid & 3;
#define MO_LANE_CONSTS(tl) const int lane = (tl) & 63, fr = lane & 15, fq = lane >> 4; \
    const int aoff = lds_byte(wr * 64 + fr, fq * 8), boff = lds_byte(wc * 32 + fr, fq * 8); \
    const int kq = lane & 7, ng = 8 * wc + (lane >> 3); \
    const unsigned bvoff = (unsigned)((4 * kq) * ldw + 4 * ng) * 4u; \
    const int bslot0 = Epi::PERM ? (((4 * ng) & ~31) + iperm32((4 * ng) & 31)) : 4 * ng; \
    const unsigned bwbase = (unsigned)lds_byte(bslot0, 4 * kq)
    int K = K_; asm volatile("" : "+s"(K));
    int ldw = ldw_; asm volatile("" : "+s"(ldw));
    const int nt = K / BK;
    const unsigned ldsw = (unsigned)wid * 1024u;
    const size_t bkstep = (size_t)64 * ldw * 4, browb = (size_t)ldw * 4;
    f32x4 br[8];
#define MO_SA(b, h) (((b) * 2 + (h)) * HTB)
#define MO_SB(b, h) ((4 + (b) * 2 + (h)) * HTB)
#define MO_STAGE_A(bufoff, basep, o0, o1) do { \
        __builtin_amdgcn_global_load_lds((const unsigned*)((const char*)(basep) + (o0)), (LAS unsigned*)(lds + (bufoff) + ldsw), 16, 0, 0); \
        __builtin_amdgcn_global_load_lds((const unsigned*)((const char*)(basep) + (o1)), (LAS unsigned*)(lds + (bufoff) + ldsw + 8192), 16, 0, 0); } while (0)
#define MO_BISSUE(p) do { const char* _p = (const char*)(p); _Pragma("unroll") for (int _j = 0; _j < 8; ++_j) \
        asm volatile("global_load_dwordx4 %0, %1, %2" : "=v"(br[_j]) : "v"(bvoff), "s"(_p + (size_t)(32 * (_j >> 2) + (_j & 3)) * browb) : "memory"); } while (0)
#define MO_BWAIT(n) asm volatile("s_waitcnt vmcnt(" #n ")" : "+v"(br[0]), "+v"(br[1]), "+v"(br[2]), "+v"(br[3]), "+v"(br[4]), "+v"(br[5]), "+v"(br[6]), "+v"(br[7]) :: "memory")
#define MO_WAIT_V(n) asm volatile("s_waitcnt vmcnt(" #n ")" ::: "memory")
#define MO_BWRITE(b) do { _Pragma("unroll") for (int _R = 0; _R < 2; ++_R) _Pragma("unroll") for (int _i = 0; _i < 4; ++_i) { u32x2 _o; \
        _o.x = cvtpk(br[4 * _R][_i], br[4 * _R + 1][_i]); _o.y = cvtpk(br[4 * _R + 2][_i], br[4 * _R + 3][_i]); \
        *(LAS u32x2*)(lds + MO_SB(b, wr) + bwbase + 1024 * _R + 64 * _i) = _o; } } while (0)
#define MO_LDA(dst, b, h) do { _Pragma("unroll") for (int m = 0; m < 4; ++m) _Pragma("unroll") for (int k = 0; k < 2; ++k) dst[m][k] = *(const LAS bf16x8*)(lds + MO_SA(b, h) + aoff + m * 2048 + k * 1024); } while (0)
#define MO_LDB(dst, b, h) do { _Pragma("unroll") for (int n = 0; n < 2; ++n) _Pragma("unroll") for (int k = 0; k < 2; ++k) dst[n][k] = *(const LAS bf16x8*)(lds + MO_SB(b, h) + boff + n * 2048 + k * 1024); } while (0)
#define MO_MMA(ai, bj, At, Bt) do { __builtin_amdgcn_s_setprio(1); _Pragma("unroll") for (int m = 0; m < 4; ++m) _Pragma("unroll") for (int n = 0; n < 2; ++n) _Pragma("unroll") for (int k = 0; k < 2; ++k) \
        acc[ai][bj][m][n] = __builtin_amdgcn_mfma_f32_16x16x32_bf16(Bt[n][k], At[m][k], acc[ai][bj][m][n], 0, 0, 0); __builtin_amdgcn_s_setprio(0); } while (0)
#define MO_WAIT_L(n) asm volatile("s_waitcnt lgkmcnt(" #n ")" ::: "memory")
#define MO_BAR __builtin_amdgcn_s_barrier()
#define MO_SCHED __builtin_amdgcn_sched_barrier(0)
#define MO_AOFF(u, dst) do { _Pragma("unroll") for (int _i = 0; _i < 2; ++_i) { int _R, _C; stage_rc(tid * 16 + _i * 8192, _R, _C); _Pragma("unroll") for (int _h = 0; _h < 2; ++_h) { const int _r = 128 * _h + _R; \
        if (GATHER) { const int _p = ((u).pm - S.tab[128 + (u).ex]) * 256 + _r; const int _t = (_r < (u).rows) ? LIST[(size_t)(u).ex * 8192 + _p] : 0; dst[_h][_i] = (unsigned)(_t * K + _C) * 2u; } \
        else dst[_h][_i] = (unsigned)(_r * K + _C) * 2u; } } } while (0)
    Unit cur, nxt; int ui = 0;
    if (!S.next(0, cur)) return;
    f32x4 acc[2][2][4][2];
#pragma unroll
    for (int a = 0; a < 2; ++a)
#pragma unroll
        for (int b = 0; b < 2; ++b)
#pragma unroll
            for (int m = 0; m < 4; ++m)
#pragma unroll
                for (int n = 0; n < 2; ++n) acc[a][b][m][n] = (f32x4){0.f, 0.f, 0.f, 0.f};
    bf16x8 At[4][2], B0[2][2], B1[2][2];
    unsigned cAo[2][2];
    LAS u32x4* const aslot = (LAS u32x4*)(lds + STAGE_BYTES) + tid;
    MO_AOFF(cur, cAo);
    const char* cAb = GATHER ? (const char*)Abase : (const char*)Abase + (size_t)cur.pm * 256 * K * 2;
    const char* cBh = (const char*)S.bptr(cur, wr);
    { MO_LANE_CONSTS(tid);
    MO_BISSUE(cBh); MO_STAGE_A(MO_SA(0, 0), cAb, cAo[0][0], cAo[0][1]); MO_STAGE_A(MO_SA(0, 1), cAb, cAo[1][0], cAo[1][1]);
    if (wr == 1) MO_BAR;
    MO_BWAIT(4); MO_BWRITE(0);
    MO_WAIT_V(0); MO_WAIT_L(0); MO_BAR;
    MO_STAGE_A(MO_SA(1, 0), cAb + 128, cAo[0][0], cAo[0][1]); MO_BISSUE(cBh + bkstep);
    MO_BAR; }
    for (;;) {
        const bool has_next = S.next(ui + 1, nxt);
        const char* nAb = cAb; const char* nBh = cBh;
        if (has_next) { nAb = GATHER ? (const char*)Abase : (const char*)Abase + (size_t)nxt.pm * 256 * K * 2; nBh = (const char*)S.bptr(nxt, wr);
            if (GATHER) { unsigned nAo[2][2]; MO_AOFF(nxt, nAo); *aslot = (u32x4){nAo[0][0], nAo[0][1], nAo[1][0], nAo[1][1]}; } }
        const bool halfu = cur.rows <= 128;
        for (int t = 0; t < nt; t += 2) {
            int tl = tid; asm volatile("" : "+v"(tl)); MO_LANE_CONSTS(tl);
            const bool last = (t == nt - 2);
            const char* a1 = cAb + (size_t)(t + 1) * 128;
            const char* a2 = last ? nAb : cAb + (size_t)(t + 2) * 128; const char* a3 = a2 + 128;
            const char* b2 = last ? nBh : cBh + (size_t)(t + 2) * bkstep; const char* b3 = b2 + bkstep;
            MO_LDB(B0, 0, 0); MO_LDB(B1, 0, 1); MO_SCHED; MO_LDA(At, 0, 0); MO_STAGE_A(MO_SA(1, 1), a1, cAo[1][0], cAo[1][1]);
            MO_WAIT_V(12); MO_WAIT_L(0); MO_BAR; MO_MMA(0, 0, At, B0); MO_MMA(0, 1, At, B1); MO_BAR; MO_SCHED;
            if (GATHER && last && has_next) { const u32x4 _n = *aslot; cAo[0][0] = _n.x; cAo[0][1] = _n.y; cAo[1][0] = _n.z; cAo[1][1] = _n.w; }
            MO_LDA(At, 0, 1); MO_BWAIT(2); MO_BWRITE(1); MO_STAGE_A(MO_SA(0, 0), a2, cAo[0][0], cAo[0][1]); MO_BISSUE(b2);
            MO_WAIT_L(0); MO_BAR; if (!halfu) { MO_MMA(1, 0, At, B0); MO_MMA(1, 1, At, B1); } MO_BAR; MO_SCHED;
            MO_LDB(B0, 1, 0); MO_LDB(B1, 1, 1); MO_SCHED; MO_LDA(At, 1, 0); MO_STAGE_A(MO_SA(0, 1), a2, cAo[1][0], cAo[1][1]);
            MO_WAIT_V(12); MO_WAIT_L(0); MO_BAR; MO_MMA(0, 0, At, B0); MO_MMA(0, 1, At, B1); MO_BAR; MO_SCHED;
            MO_LDA(At, 1, 1); MO_BWAIT(2); MO_BWRITE(0); MO_STAGE_A(MO_SA(1, 0), a3, cAo[0][0], cAo[0][1]); MO_BISSUE(b3);
            MO_WAIT_L(0); MO_BAR; if (!halfu) { MO_MMA(1, 0, At, B0); MO_MMA(1, 1, At, B1); } MO_BAR; MO_SCHED;
        }
        if (wr == 0) MO_BAR;
        { const int lane = tid & 63; E(acc, cur, wr, wc, lane & 15, lane >> 4); }
        if (!has_next) break;
#pragma unroll
        for (int a = 0; a < 2; ++a)
#pragma unroll
            for (int b = 0; b < 2; ++b)
#pragma unroll
                for (int m = 0; m < 4; ++m)
#pragma unroll
                    for (int n = 0; n < 2; ++n) acc[a][b][m][n] = (f32x4){0.f, 0.f, 0.f, 0.f};
        cur = nxt; cAb = nAb; cBh = nBh; ++ui;
        if (wr == 1) MO_BAR;
    }
    MO_BWAIT(0);
    MO_BAR;
#undef MO_SA
#undef MO_SB
#undef MO_STAGE_A
#undef MO_BISSUE
#undef MO_BWAIT
#undef MO_WAIT_V
#undef MO_BWRITE
#undef MO_LDA
#undef MO_LDB
#undef MO_MMA
#undef MO_WAIT_L
#undef MO_BAR
#undef MO_SCHED
#undef MO_AOFF
#undef MO_LANE_CONSTS
}


typedef const f32x4 (&AccRef)[2][2][4][2];
DI u32x4 pack8(const f32x4& v0, const f32x4& v1) { u32x4 w; w.x = cvtpk(v0[0], v0[1]); w.y = cvtpk(v0[2], v0[3]); w.z = cvtpk(v1[0], v1[1]); w.w = cvtpk(v1[2], v1[3]); return w; }

struct EpiBf16 {
    static constexpr bool PERM = true;
    bf16* O; int ldc;
    DI void operator()(AccRef acc, const Unit& u, int wr, int wc, int fr, int fq) const {
        const int row0 = u.pm * BM + wr * 64 + fr, col0 = u.pn * BM + wc * 32 + 8 * fq;
#pragma unroll
        for (int ai = 0; ai < 2; ++ai)
#pragma unroll
            for (int m = 0; m < 4; ++m) { bf16* rowp = O + (size_t)(row0 + ai * HALF + m * 16) * ldc + col0;
#pragma unroll
                for (int bj = 0; bj < 2; ++bj) *(u32x4*)(rowp + bj * HALF) = pack8(acc[ai][bj][m][0], acc[ai][bj][m][1]); }
    }
};
struct EpiF32 {
    static constexpr bool PERM = false;
    float* C; int ldc;
    DI void operator()(AccRef acc, const Unit& u, int wr, int wc, int fr, int fq) const {
        const int row0 = u.pm * BM + wr * 64 + fr, col0 = u.pn * BM + wc * 32 + 4 * fq;
#pragma unroll
        for (int ai = 0; ai < 2; ++ai)
#pragma unroll
            for (int m = 0; m < 4; ++m) { float* rowp = C + (size_t)(row0 + ai * HALF + m * 16) * ldc + col0;
#pragma unroll
                for (int bj = 0; bj < 2; ++bj)
#pragma unroll
                    for (int n = 0; n < 2; ++n) *(f32x4*)(rowp + bj * HALF + n * 16) = acc[ai][bj][m][n]; }
    }
};
struct EpiInProj {
    static constexpr bool PERM = true;
    bf16* P; float* PBA;
    DI void operator()(AccRef acc, const Unit& u, int wr, int wc, int fr, int fq) const {
        const int row0 = u.pm * BM + wr * 64 + fr;
        if (u.pn < 28) {
            const int col0 = u.pn * BM + wc * 32 + 8 * fq;
#pragma unroll
            for (int ai = 0; ai < 2; ++ai)
#pragma unroll
                for (int m = 0; m < 4; ++m) { bf16* rowp = P + (size_t)(row0 + ai * HALF + m * 16) * NP + col0;
#pragma unroll
                    for (int bj = 0; bj < 2; ++bj) *(u32x4*)(rowp + bj * HALF) = pack8(acc[ai][bj][m][0], acc[ai][bj][m][1]); }
        } else if (wc == 0 && fq < 2) {
#pragma unroll
            for (int ai = 0; ai < 2; ++ai)
#pragma unroll
                for (int m = 0; m < 4; ++m) { float* rp = PBA + (size_t)(row0 + ai * HALF + m * 16) * 16 + 8 * fq;
                    *(f32x4*)rp = acc[ai][0][m][0]; *(f32x4*)(rp + 4) = acc[ai][0][m][1]; }
        }
    }
};
struct EpiResid {
    static constexpr bool PERM = false;
    const float* x; const float* g; float* R;
    DI void operator()(AccRef acc, const Unit& u, int wr, int wc, int fr, int fq) const {
        const int row0 = u.pm * BM + wr * 64 + fr, col0 = u.pn * BM + wc * 32 + 4 * fq;
        const float* gb = g + (size_t)((u.pm * BM) / SEQ) * 12288 + col0;
        f32x4 gv[2][2];
#pragma unroll
        for (int bj = 0; bj < 2; ++bj)
#pragma unroll
            for (int n = 0; n < 2; ++n) gv[bj][n] = *(const f32x4*)(gb + bj * HALF + n * 16) + 1.0f;
#pragma unroll
        for (int ai = 0; ai < 2; ++ai)
#pragma unroll
            for (int m = 0; m < 4; ++m) { const size_t off = (size_t)(row0 + ai * HALF + m * 16) * D + col0;
#pragma unroll
                for (int bj = 0; bj < 2; ++bj)
#pragma unroll
                    for (int n = 0; n < 2; ++n) { const f32x4 xv = *(const f32x4*)(x + off + bj * HALF + n * 16);
                        *(f32x4*)(R + off + bj * HALF + n * 16) = xv * DN_ALPHA + gv[bj][n] * acc[ai][bj][m][n]; } }
    }
};
struct EpiLogits {
    static constexpr bool PERM = false;
    float* L;
    DI void operator()(AccRef acc, const Unit& u, int wr, int wc, int fr, int fq) const {
        const int row0 = u.pm * BM + wr * 64 + fr, col0 = wc * 32 + 4 * fq;
#pragma unroll
        for (int ai = 0; ai < 2; ++ai)
#pragma unroll
            for (int m = 0; m < 4; ++m) { float* rowp = L + (size_t)(row0 + ai * HALF + m * 16) * 128 + col0;
#pragma unroll
                for (int n = 0; n < 2; ++n) *(f32x4*)(rowp + n * 16) = acc[ai][0][m][n]; }
    }
};
struct EpiGateUp {
    static constexpr bool PERM = true;
    bf16* H;
    DI void operator()(AccRef acc, const Unit& u, int wr, int wc, int fr, int fq) const {
        const int row0 = u.pm * BM + wr * 64 + fr, col0 = u.pn * HALF + wc * 32 + 8 * fq;
#pragma unroll
        for (int ai = 0; ai < 2; ++ai)
#pragma unroll
            for (int m = 0; m < 4; ++m) { bf16* rowp = H + (size_t)(row0 + ai * HALF + m * 16) * FF + col0;
                f32x4 h0, h1;
#pragma unroll
                for (int j = 0; j < 4; ++j) { h0[j] = silu_f(acc[ai][0][m][0][j]) * acc[ai][1][m][0][j]; h1[j] = silu_f(acc[ai][0][m][1][j]) * acc[ai][1][m][1][j]; }
                *(u32x4*)rowp = pack8(h0, h1); }
    }
};
struct EpiQup {
    static constexpr bool PERM = true;
    bf16* Q;
    DI void operator()(AccRef acc, const Unit& u, int wr, int wc, int fr, int fq) const {
        const int row0 = u.pm * BM + wr * 64 + fr, b = (u.pm * BM) / SEQ, s0 = row0 - b * SEQ;
        const int cg0 = u.pn * BM + wc * 32 + 8 * fq, cg1 = cg0 + HALF;
        const int h0 = cg0 / QD, w0 = cg0 - h0 * QD, h1 = cg1 / QD, w1 = cg1 - h1 * QD;
        bf16* d0 = Q + ((size_t)((b * MH + h0) * SEQ + s0)) * QD + w0; bf16* d1 = Q + ((size_t)((b * MH + h1) * SEQ + s0)) * QD + w1;
#pragma unroll
        for (int ai = 0; ai < 2; ++ai)
#pragma unroll
            for (int m = 0; m < 4; ++m) { const int dr = (ai * HALF + m * 16) * QD;
                *(u32x4*)(d0 + dr) = pack8(acc[ai][0][m][0] * QSCALE, acc[ai][0][m][1] * QSCALE);
                *(u32x4*)(d1 + dr) = pack8(acc[ai][1][m][0] * QSCALE, acc[ai][1][m][1] * QSCALE);
                asm volatile("" ::: "memory"); }
    }
};
struct EpiKVup {
    static constexpr bool PERM = true;
    bf16* Kp; bf16* V;
    DI void operator()(AccRef acc, const Unit& u, int wr, int wc, int fr, int fq) const {
        const int row0 = u.pm * BM + wr * 64 + fr, c0 = wc * 32 + 8 * fq, head = u.pn, b = (u.pm * BM) / SEQ, s0 = row0 - b * SEQ;
        bf16* dk = Kp + ((size_t)((b * MH + head) * SEQ + s0)) * QD + c0; bf16* dv = V + (size_t)row0 * D + head * 128 + c0;
#pragma unroll
        for (int ai = 0; ai < 2; ++ai)
#pragma unroll
            for (int m = 0; m < 4; ++m) { const int dr = ai * HALF + m * 16;
                *(u32x4*)(dk + dr * QD) = pack8(acc[ai][0][m][0], acc[ai][0][m][1]);
                *(u32x4*)(dv + dr * D) = pack8(acc[ai][1][m][0], acc[ai][1][m][1]);
                asm volatile("" ::: "memory"); }
    }
};
}

#define XB_TMO      128
#define XB_XCNT(j)  (256  + 64 * (j))
#define XB_XSUB(j)  (1280 + 64 * (j))
#define XB_XGEN(j)  (2304 + 64 * (j))
#define XB_TOP      3328
#define XB_TOPGEN   3392
#define XCD_BAR_WORDS 3456
#define XB_SPIN_CAP (1u << 18)
__device__ __forceinline__ unsigned xb_ld(unsigned* p)              { return __hip_atomic_load(p, __ATOMIC_RELAXED, __HIP_MEMORY_SCOPE_AGENT); }
__device__ __forceinline__ unsigned xb_add(unsigned* p, unsigned v) { return __hip_atomic_fetch_add(p, v, __ATOMIC_RELAXED, __HIP_MEMORY_SCOPE_AGENT); }
__device__ __forceinline__ unsigned xb_xcc_id() { return (unsigned)__builtin_amdgcn_s_getreg((3 << 11) | 20) & 0xFu; }
#define XB_SPIN(cond, bar) do { unsigned _sp = 0; while (cond) { __builtin_amdgcn_s_sleep(1); \
    if ((++_sp & 255u) == 0u) { if (xb_ld(&(bar)[XB_TMO])) break; if (_sp > XB_SPIN_CAP) { atomicAdd(&(bar)[XB_TMO], 1u); break; } } } } while (0)
struct XcdBarrier { unsigned* bar; unsigned x; volatile LAS unsigned* st; };
__device__ __forceinline__ XcdBarrier xcd_barrier_post(unsigned* bar, volatile LAS unsigned* st, const bool leader  ) {
    XcdBarrier b; b.bar = bar; b.x = xb_xcc_id(); b.st = st;
    if (leader) (void)xb_add(&bar[XB_XCNT(b.x)], 1u);
    return b;
}
__device__ __forceinline__ void xcd_barrier_complete(unsigned* bar, unsigned x, unsigned& nloc, unsigned& nx) {
    const unsigned G = gridDim.x * gridDim.y * gridDim.z;
    unsigned sum, cnt, mine, sp = 0u;
    for (;;) {
        sum = 0u; cnt = 0u; mine = 0u;
#pragma unroll
        for (unsigned j = 0; j < 16; ++j) { const unsigned c = xb_ld(&bar[XB_XCNT(j)]); sum += c; cnt += (c > 0u) ? 1u : 0u; mine = (j == x) ? c : mine; }
        if (sum == G) break;
        __builtin_amdgcn_s_sleep(1);
        if ((++sp & 255u) == 0u) { if (xb_ld(&bar[XB_TMO])) break; if (sp > XB_SPIN_CAP) { atomicAdd(&bar[XB_TMO], 1u); break; } }
    }
    nloc = mine > 0u ? mine : 1u; nx = cnt > 0u ? cnt : 1u;
}
__device__ __forceinline__ void xcd_barrier(const XcdBarrier& b, const bool leader  ) {
    asm volatile("s_waitcnt vmcnt(0)" ::: "memory");
    __syncthreads();
    if (leader) {
        unsigned* bar = b.bar;
        __builtin_amdgcn_s_waitcnt(0);
        unsigned nloc = b.st[0], nx = b.st[1];
        if (nloc == 0u) { xcd_barrier_complete(bar, b.x, nloc, nx); b.st[0] = nloc; b.st[1] = nx; }
        const unsigned old = xb_add(&bar[XB_XSUB(b.x)], 1u);
        const unsigned gen = old / nloc;
        if (old + 1u == (gen + 1u) * nloc) {
            __builtin_amdgcn_fence(__ATOMIC_RELEASE, "agent");
            asm volatile("s_waitcnt vmcnt(0)" ::: "memory");
            const unsigned og = xb_add(&bar[XB_TOP], 1u);
            const unsigned tg = og / nx;
            if (og + 1u == (tg + 1u) * nx) xb_add(&bar[XB_TOPGEN], 1u);
            else XB_SPIN(xb_ld(&bar[XB_TOPGEN]) == tg, bar);
            __builtin_amdgcn_fence(__ATOMIC_ACQUIRE, "agent");
            xb_add(&bar[XB_XGEN(b.x)], 1u);
            asm volatile("s_waitcnt vmcnt(0)" ::: "memory");
        } else {
            XB_SPIN(xb_ld(&bar[XB_XGEN(b.x)]) == gen, bar);
            __builtin_amdgcn_fence(__ATOMIC_ACQUIRE, "agent");
            asm volatile("s_waitcnt vmcnt(0)" ::: "memory");
        }
    }
    __syncthreads();
}

struct Frame {
    LAS unsigned char* lds;
    int tid, lane, wave, vcu, G, gw, NGW;
    unsigned* ctl;
};
struct Args { const void* in[27]; float* out; unsigned char* ws; int ph_lo, ph_hi; };

__device__ const double ROPE_INVF[32] = {1, 0.74989420933245587, 0.56234132519034907, 0.42169650342858223, 0.31622776601683794, 0.23713737056616552, 0.17782794100389229, 0.1333521432163324,
    0.10000000000000001, 0.074989420933245579, 0.056234132519034911, 0.042169650342858224, 0.031622776601683791, 0.023713737056616554, 0.017782794100389229, 0.013335214321633241,
    0.01, 0.0074989420933245579, 0.005623413251903491, 0.0042169650342858229, 0.0031622776601683794, 0.0023713737056616554, 0.0017782794100389228, 0.0013335214321633241,
    0.001, 0.00074989420933245586, 0.0005623413251903491, 0.00042169650342858224, 0.00031622776601683794, 0.00023713737056616554, 0.00017782794100389227, 0.0001333521432163324};

struct TrRegs { f32x4 r[8]; };
DI void tr_load(TrRegs& t, const float* W, size_t ld, int k0, int n0, int nvalid, int lane) {
    const int ns = lane & 7, kq = lane >> 3;
    if (4 * ns < nvalid) { const float* src = W + (size_t)(k0 + 8 * kq) * ld + n0 + 4 * ns;
#pragma unroll
        for (int j = 0; j < 8; ++j) t.r[j] = *(const f32x4*)(src + (size_t)j * ld); }
}
DI void tr_store(const TrRegs& t, int k0, int nvalid, bf16* WT, int Kd, int drow0, int lane) {
    const int ns = lane & 7, kq = lane >> 3;
    if (4 * ns < nvalid) { bf16* dst = WT + (size_t)(drow0 + 4 * ns) * Kd + k0 + 8 * kq;
#pragma unroll
        for (int i = 0; i < 4; ++i) { u32x4 o; o.x = cvtpk(t.r[0][i], t.r[1][i]); o.y = cvtpk(t.r[2][i], t.r[3][i]); o.z = cvtpk(t.r[4][i], t.r[5][i]); o.w = cvtpk(t.r[6][i], t.r[7][i]);
            *(u32x4*)(dst + (size_t)i * Kd) = o; } }
}
DI void tr_job(const Frame& F, const int gw, const int NGW, const float* W, size_t smat, int nmat, int ld, int K, int col0, int ncols, bf16* WT, size_t dmat, int Kd, int row_off, int mode) {
    const int nblk = (ncols + 31) / 32, kbs = K / 64, per = nblk * kbs; const long items = (long)nmat * per;
    for (long it0 = gw; it0 < items; it0 += 2 * (long)NGW) {
        TrRegs t[2]; int k0[2], nv[2], dr[2]; bf16* wt[2];
#pragma unroll
        for (int u = 0; u < 2; ++u) {
            const long it = it0 + (long)u * NGW;
            if (it < items) {
                const int mat = (int)(it / per), rem = (int)(it - (long)mat * per), kb = rem / nblk, nb = rem - kb * nblk;
                nv[u] = (ncols - nb * 32) < 32 ? (ncols - nb * 32) : 32; k0[u] = kb * 64;
                dr[u] = (mode == 0) ? (row_off + nb * 32) : ((nb >> 2) * 256 + row_off + (nb & 3) * 32);
                wt[u] = WT + (size_t)mat * dmat;
                tr_load(t[u], W + (size_t)mat * smat, (size_t)ld, k0[u], col0 + nb * 32, nv[u], F.lane);
            } else { nv[u] = 0; k0[u] = 0; dr[u] = 0; wt[u] = WT; }
        }
#pragma unroll
        for (int u = 0; u < 2; ++u) tr_store(t[u], k0[u], nv[u], wt[u], Kd, dr[u], F.lane);
    }
}
DI void zero_fill(const Frame& F, const int gw, const int NGW, void* p, size_t bytes) {
    u32x4* q = (u32x4*)p; const size_t n = bytes / 16;
    for (size_t i = (size_t)gw * 64 + F.lane; i < n; i += (size_t)NGW * 64) q[i] = (u32x4){0u, 0u, 0u, 0u};
}

DI const void* arg_in(int k) { unsigned o = (unsigned)k * 8u; asm volatile("" : "+s"(o));
    const GAS void* p = *(const GAS void* const __attribute__((address_space(4)))*)((const __attribute__((address_space(4))) unsigned char*)__builtin_amdgcn_kernarg_segment_ptr() + o);
    return (const void*)p; }
#define WSB (args.ws)
#define in_x ((const float*)arg_in(0))
#define in_c ((const float*)arg_in(1))
#define in_pos ((const int*)arg_in(2))
#define ada_w ((const float*)arg_in(3))
#define ada_b ((const float*)arg_in(4))
#define ln_g ((const float*)arg_in(5))
#define ln_b ((const float*)arg_in(6))
#define hyb_w_in ((const float*)arg_in(7))
#define gdn_conv_w ((const float*)arg_in(8))
#define gdn_a_log ((const float*)arg_in(9))
#define gdn_dt_bias ((const float*)arg_in(10))
#define gdn_norm_w ((const float*)arg_in(11))
#define sc_conv_w ((const float*)arg_in(12))
#define hyb_w_out ((const float*)arg_in(13))
#define mla_w_in ((const float*)arg_in(14))
#define mla_q_norm ((const float*)arg_in(15))
#define mla_kv_norm ((const float*)arg_in(16))
#define mla_w_uq ((const float*)arg_in(17))
#define mla_w_ukv ((const float*)arg_in(18))
#define mla_w_out ((const float*)arg_in(19))
#define moe_router_g ((const float*)arg_in(20))
#define moe_bias_g ((const float*)arg_in(21))
#define moe_router_e ((const float*)arg_in(22))
#define moe_bias_e ((const float*)arg_in(23))
#define moe_w_gate ((const float*)arg_in(24))
#define moe_w_up ((const float*)arg_in(25))
#define moe_w_down ((const float*)arg_in(26))
#define MOD ((float*)(WSB + WS_MOD))
#define ROPE_C ((float*)(WSB + WS_ROPE))
#define ROPE_S ((float*)(ROPE_C + (size_t)T * 32))
#define PBA ((float*)(WSB + WS_PBA))
#define LOGITS ((float*)(WSB + WS_LOGITS))
#define TOK_E ((int*)(WSB + WS_ROUTE))
#define TOK_POS ((int*)(TOK_E + 2 * T))
#define TOK_GATE ((float*)(TOK_POS + 2 * T))
#define EG ((float*)(WSB + WS_EG))
#define WIN0 ((bf16*)(WSB + WS_WIN0))
#define WOUT0 ((bf16*)(WSB + WS_WOUT0))
#define WMIN ((bf16*)(WSB + WS_WMIN))
#define WUQ ((bf16*)(WSB + WS_WUQ))
#define WUKV ((bf16*)(WSB + WS_WUKV))
#define WMOUT ((bf16*)(WSB + WS_WMOUT))
#define WRT ((bf16*)(WSB + WS_WRT))
#define WGU ((bf16*)(WSB + WS_WGU))
#define WDN ((bf16*)(WSB + WS_WDN))
#define HIN ((bf16*)(WSB + WS_HIN))
#define XA ((float*)(WSB + WS_XA))
#define XB ((float*)(WSB + WS_XB))
#define RB ((float*)(WSB + WS_R))
#define PB ((bf16*)(WSB + WS_P))
#define GF ((unsigned char*)(WSB + WS_GF))
#define GU ((unsigned char*)(WSB + WS_GU))
#define GO ((float*)(WSB + WS_GO))
#define YAB ((bf16*)(WSB + WS_YAB))
#define LISTP ((int*)(WSB + WS_XS))
#define HID ((bf16*)(WSB + WS_HID))
#define YS ((bf16*)(WSB + WS_YS))
#define C1 ((float*)(WSB + WS_C1))
#define CQN ((bf16*)(WSB + WS_CQN))
#define CKVN ((bf16*)(WSB + WS_CKVN))
#define KPE ((float*)(WSB + WS_KPE))
#define QB_ ((bf16*)(WSB + WS_Q))
#define KB_ ((bf16*)(WSB + WS_K))
#define VB_ ((bf16*)(WSB + WS_V))
#define VT ((bf16*)(WSB + WS_VT))


#define LN_ROW(v, gptr, bptr) do { float _s = 0.f; _Pragma("unroll") for (int _j = 0; _j < 8; ++_j) _s += (v[_j][0] + v[_j][1]) + (v[_j][2] + v[_j][3]); \
        const float _mean = wave_sum(_s) * (1.f / D); float _q = 0.f; \
        _Pragma("unroll") for (int _j = 0; _j < 8; ++_j) { v[_j] = v[_j] - _mean; _q += (v[_j][0] * v[_j][0] + v[_j][1] * v[_j][1]) + (v[_j][2] * v[_j][2] + v[_j][3] * v[_j][3]); } \
        const float _rstd = rsqrtf(wave_sum(_q) * (1.f / D) + 1e-5f); \
        _Pragma("unroll") for (int _j = 0; _j < 8; ++_j) v[_j] = v[_j] * _rstd * ((const f32x4*)(gptr))[F.lane + 64 * _j] + ((const f32x4*)(bptr))[F.lane + 64 * _j]; } while (0)
#define WRITE_X_HIN(v, xrow, hrow, shp, scp) do { _Pragma("unroll") for (int _j = 0; _j < 8; ++_j) { ((f32x4*)(xrow))[F.lane + 64 * _j] = v[_j]; \
        if ((hrow) != nullptr) { const f32x4 _h = v[_j] * (((const f32x4*)(scp))[F.lane + 64 * _j] + 1.0f) + ((const f32x4*)(shp))[F.lane + 64 * _j]; \
            u32x2 _w; _w.x = cvtpk(_h[0], _h[1]); _w.y = cvtpk(_h[2], _h[3]); ((u32x2*)(hrow))[F.lane + 64 * _j] = _w; } } } while (0)


template <int GW> DI void ada_groups(Frame& F, const Args& args, const int cg_lo, const int cg_hi, const int bidx, const int nblocks) {
    constexpr int LPR = GW / 4, RPI = 64 / LPR, NSET = 8 * RPI;
    LAS float* cact = (LAS float*)F.lds;
    LAS float* red = (LAS float*)(F.lds + 32768);
    for (int i = F.tid; i < 4 * D; i += 512) cact[i] = silu_f(in_c[i]);
    __syncthreads();
    for (int cg = cg_lo + bidx; cg < cg_hi; cg += nblocks) {
        const int jj0 = cg * GW, l = jj0 / 12288, j0 = jj0 - l * 12288;
        const int rsub = F.lane / LPR, c4 = F.lane - rsub * LPR;
        f32x4 a0 = {0.f, 0.f, 0.f, 0.f}, a1 = a0, a2 = a0, a3 = a0;
        if (F.lane < LPR * RPI) {
            const float* wp = ada_w + ((size_t)l * D) * 12288 + j0 + 4 * c4;
#pragma unroll 8
            for (int it = 0; it < D / NSET; ++it) { const int k = it * NSET + F.wave * RPI + rsub;
                const f32x4 w4 = *(const f32x4*)(wp + (size_t)k * 12288);
                a0 += w4 * cact[k]; a1 += w4 * cact[D + k]; a2 += w4 * cact[2 * D + k]; a3 += w4 * cact[3 * D + k]; }
            LAS float* rp = red + (F.wave * RPI + rsub) * (4 * GW) + 4 * c4;
            *(LAS f32x4*)(rp) = a0; *(LAS f32x4*)(rp + GW) = a1; *(LAS f32x4*)(rp + 2 * GW) = a2; *(LAS f32x4*)(rp + 3 * GW) = a3;
        }
        __syncthreads();
        if (F.tid < 4 * GW) { const int b = F.tid / GW, col = F.tid - b * GW; float s = ada_b[(size_t)l * 12288 + j0 + col];
#pragma unroll 8
            for (int p = 0; p < NSET; ++p) s += red[p * (4 * GW) + b * GW + col];
            MOD[((size_t)l * 4 + b) * 12288 + j0 + col] = s; }
        __syncthreads();
    }
}
DI void deferred_copies(Frame& F, const Args& args, const int gw, const int NGW) {
    tr_job(F, gw, NGW, hyb_w_out, 0, 1, D, D, 0, D, WOUT0, 0, D, 0, 0);
    tr_job(F, gw, NGW, mla_w_in, 0, 1, MLA_IN, D, 0, MLA_IN, WMIN, 0, D, 0, 0);
    zero_fill(F, gw, NGW, WMIN + (size_t)MLA_IN * D, (size_t)(NMLA - MLA_IN) * D * 2);
    tr_job(F, gw, NGW, mla_w_uq, 0, 1, 3072, 512, 0, 3072, WUQ, 0, 512, 0, 0);
    tr_job(F, gw, NGW, mla_w_ukv, 0, 1, 4096, 512, 0, 4096, WUKV, 0, 512, 0, 0);
    tr_job(F, gw, NGW, mla_w_out, 0, 1, D, D, 0, D, WMOUT, 0, D, 0, 0);
    tr_job(F, gw, NGW, moe_router_g, (size_t)D * 8, 2, 8, D, 0, 8, WRT, (size_t)256 * D, D, 0, 0);
    tr_job(F, gw, NGW, moe_router_e, (size_t)D * 64, 2, 64, D, 0, 64, WRT, (size_t)256 * D, D, 8, 0);
    zero_fill(F, gw, NGW, WRT + (size_t)72 * D, (size_t)(256 - 72) * D * 2);
    zero_fill(F, gw, NGW, WRT + (size_t)256 * D + (size_t)72 * D, (size_t)(256 - 72) * D * 2);
}

#ifndef PHMASK
#define PHMASK 0xFFFFFFFFull
#endif
#define PH_EN(k) (((PHMASK) >> (k)) & 1ull)
#define IN(k) (PH_EN(k) && lo <= (k) && (k) < hi)
#define INL(k0, k1) ((L == 0) ? IN(k0) : IN(k1))
#define PHASE_FRESH() do { int _l; asm volatile("v_mbcnt_lo_u32_b32 %0, -1, 0\n\tv_mbcnt_hi_u32_b32 %0, -1, %0" : "=v"(_l)); F.lane = _l; F.tid = F.wave * 64 + _l; } while (0)
#define SEAM(k) do { if (IN(k) && IN((k) + 1)) { PHASE_FRESH(); xcd_barrier(bar, F.tid == 0); } } while (0)


template <int L> DI void ln_route_phase(Frame& F, const Args& args) {
    constexpr int HP = 2056;
    LAS bf16* HT = (LAS bf16*)F.lds;
    LAS float* PART = (LAS float*)(F.lds + 16 * HP * 2);
    LAS float* LG = PART + 8 * 16 * 80;
    unsigned* cnt = F.ctl + CW_CNT + L * 64;
    const float* bg = moe_bias_g + L * 8; const float* be = moe_bias_e + L * 64;
    const bf16* wrt = WRT + (size_t)L * 256 * D;
    for (int rg = F.vcu; rg < T / 16; rg += F.G) {
#pragma unroll
        for (int rr = 0; rr < 2; ++rr) {
            const int rl = 2 * F.wave + rr, m = rg * 16 + rl, b = m / SEQ; const float* modb = MOD + (size_t)(L * 4 + b) * 12288;
            f32x4 v[8];
#pragma unroll
            for (int j = 0; j < 8; ++j) v[j] = ((const f32x4*)(RB + (size_t)m * D))[F.lane + 64 * j];
            LN_ROW(v, ln_g + (size_t)(L * 2) * D, ln_b + (size_t)(L * 2) * D);
#pragma unroll
            for (int j = 0; j < 8; ++j) { ((f32x4*)(XA + (size_t)m * D))[F.lane + 64 * j] = v[j];
                const f32x4 h = v[j] * (((const f32x4*)(modb + 4 * D))[F.lane + 64 * j] + 1.0f) + ((const f32x4*)(modb + 3 * D))[F.lane + 64 * j];
                u32x2 w; w.x = cvtpk(h[0], h[1]); w.y = cvtpk(h[2], h[3]);
                ((u32x2*)(HIN + (size_t)m * D))[F.lane + 64 * j] = w; *(LAS u32x2*)(HT + rl * HP + 4 * (F.lane + 64 * j)) = w; }
        }
        __syncthreads();
        {
            const int mrow = F.lane & 15, g = F.lane >> 4;
            f32x4 acc[5];
#pragma unroll
            for (int nt = 0; nt < 5; ++nt) acc[nt] = (f32x4){0.f, 0.f, 0.f, 0.f};
#pragma unroll 2
            for (int ks = 0; ks < 8; ++ks) { const int kk = 32 * (8 * F.wave + ks) + 8 * g;
                const bf16x8 a = *(const LAS bf16x8*)(HT + mrow * HP + kk);
#pragma unroll
                for (int nt = 0; nt < 5; ++nt) { const bf16x8 bb = *(const bf16x8*)(wrt + (size_t)(nt * 16 + mrow) * D + kk);
                    acc[nt] = __builtin_amdgcn_mfma_f32_16x16x32_bf16(a, bb, acc[nt], 0, 0, 0); } }
#pragma unroll
            for (int nt = 0; nt < 5; ++nt)
#pragma unroll
                for (int q = 0; q < 4; ++q) PART[(F.wave * 16 + 4 * g + q) * 80 + nt * 16 + mrow] = acc[nt][q];
        }
        __syncthreads();
        for (int idx = F.tid; idx < 16 * 72; idx += 512) { const int r = idx / 72, c = idx - r * 72; float s = 0.f;
#pragma unroll
            for (int w = 0; w < 8; ++w) s += PART[(w * 16 + r) * 80 + c];
            LG[r * 80 + c] = s; }
        __syncthreads();
        if (F.tid < 16) {
            const int t = rg * 16 + F.tid; const LAS float* lg = LG + F.tid * 80;
            float l8[8]; float mx = -3.0e38f; int grp = 0;
#pragma unroll
            for (int gq = 0; gq < 8; ++gq) { l8[gq] = lg[gq] + bg[gq]; if (l8[gq] > mx) { mx = l8[gq]; grp = gq; } }
            float se = 0.f;
#pragma unroll
            for (int gq = 0; gq < 8; ++gq) se += __expf(l8[gq] - mx);
            const float pg = 1.f / se;
            float e8[8];
#pragma unroll
            for (int j = 0; j < 8; ++j) e8[j] = lg[8 + grp * 8 + j] + be[grp * 8 + j];
            int i1 = 0; float m1 = e8[0];
#pragma unroll
            for (int j = 1; j < 8; ++j) if (e8[j] > m1) { m1 = e8[j]; i1 = j; }
            int i2 = -1; float m2 = -3.0e38f;
#pragma unroll
            for (int j = 0; j < 8; ++j) if (j != i1 && e8[j] > m2) { m2 = e8[j]; i2 = j; }
            const float rrr = __expf(m2 - m1), g1 = pg / (1.f + rrr), g2 = pg * rrr / (1.f + rrr);
            const int ex1 = grp * 8 + i1, ex2 = grp * 8 + i2;
            const int p1 = (int)atomicAdd(&cnt[ex1], 1u), p2 = (int)atomicAdd(&cnt[ex2], 1u);
            TOK_E[2 * t] = ex1; TOK_E[2 * t + 1] = ex2; TOK_POS[2 * t] = p1; TOK_POS[2 * t + 1] = p2; TOK_GATE[2 * t] = g1; TOK_GATE[2 * t + 1] = g2;
            LISTP[(size_t)ex1 * 8192 + p1] = t; LISTP[(size_t)ex2 * 8192 + p2] = t;
        }
        __syncthreads();
    }
}

template <int L> DI void moe_phases(Frame& F, const Args& args, const XcdBarrier& bar, const int lo, const int hi, LAS int* TAB) {
        unsigned* cnt = F.ctl + CW_CNT + L * 64;
#define MOE_TABLE() do { if (F.tid < NE) TAB[200 + F.tid] = (int)cnt[F.tid]; __syncthreads(); \
        if (F.tid == 0) { int _a = 0; for (int _e = 0; _e < NE; ++_e) { const int _c = TAB[200 + _e]; TAB[128 + _e] = _a; const int _nb = (_c + 255) >> 8; \
        for (int _q = 0; _q < _nb; ++_q) TAB[_a + _q] = _e; _a += _nb; } TAB[192] = _a; } __syncthreads(); } while (0)
    if (INL(11, 24)) { PHASE_FRESH();
        MOE_TABLE();
        pg8::MoeDirect S; S.nunits = TAB[192] * 4; S.NT = 4; S.G = F.G; S.c = F.vcu; S.tab = TAB;
        S.W0 = moe_w_gate + (size_t)L * 64 * D * FF; S.W1 = moe_w_up + (size_t)L * 64 * D * FF; S.estride = (size_t)D * FF; S.cols_per_tile = 128; S.half1_off = 0;
        pg8::EpiGateUp E{HID};
        pg8::gemm_phase_moe<pg8::EpiGateUp, true>(F.lds, D, FF, S, E, HIN, LISTP, F.tid, F.wave);
    }
    if (L == 0) SEAM(11); else SEAM(24);
    if (INL(12, 25)) { PHASE_FRESH();
        MOE_TABLE();
        pg8::MoeDirect S; S.nunits = TAB[192] * 8; S.NT = 8; S.G = F.G; S.c = F.vcu; S.tab = TAB;
        S.W0 = moe_w_down + (size_t)L * 64 * D * FF; S.W1 = S.W0; S.estride = (size_t)D * FF; S.cols_per_tile = 256; S.half1_off = 128;
        pg8::EpiBf16 E{YS, D};
        pg8::gemm_phase_moe32<pg8::EpiBf16, false>(F.lds, FF, D, S, E, HID, nullptr, F.tid, F.wave);
    }
    if (L == 0) SEAM(12); else SEAM(25);
    if (INL(13, 26)) { PHASE_FRESH();
        if (F.tid < NE) TAB[200 + F.tid] = (int)cnt[F.tid];
        __syncthreads();
        if (F.tid == 0) { int a = 0; for (int e = 0; e < NE; ++e) { TAB[128 + e] = a; a += (TAB[200 + e] + 255) >> 8; } }
        __syncthreads();
        float* xout = (L == 0) ? XB : args.out;
        for (int m0 = F.gw; m0 < T; m0 += 2 * F.NGW) {
            int mm[2], r0[2], r1[2]; float g0[2], g1[2];
#pragma unroll
            for (int u = 0; u < 2; ++u) { const int m = m0 + u * F.NGW < T ? m0 + u * F.NGW : m0; mm[u] = m;
                r0[u] = TAB[128 + TOK_E[2 * m]] * 256 + TOK_POS[2 * m]; r1[u] = TAB[128 + TOK_E[2 * m + 1]] * 256 + TOK_POS[2 * m + 1]; g0[u] = TOK_GATE[2 * m]; g1[u] = TOK_GATE[2 * m + 1]; }
            f32x4 v[2][8];
#pragma unroll
            for (int u = 0; u < 2; ++u) { const int m = mm[u]; const float* modb = MOD + (size_t)(L * 4 + m / SEQ) * 12288;
#pragma unroll
                for (int j = 0; j < 8; ++j) {
                    const f32x4 xv = ((const f32x4*)(XA + (size_t)m * D))[F.lane + 64 * j];
                    const u32x2 ya = ((const u32x2*)(YS + (size_t)r0[u] * D))[F.lane + 64 * j], yb = ((const u32x2*)(YS + (size_t)r1[u] * D))[F.lane + 64 * j];
                    const f32x4 gg = ((const f32x4*)(modb + 5 * D))[F.lane + 64 * j] + 1.0f;
                    f32x4 y; y[0] = g0[u] * bflo(ya.x) + g1[u] * bflo(yb.x); y[1] = g0[u] * bfhi(ya.x) + g1[u] * bfhi(yb.x); y[2] = g0[u] * bflo(ya.y) + g1[u] * bflo(yb.y); y[3] = g0[u] * bfhi(ya.y) + g1[u] * bfhi(yb.y);
                    v[u][j] = xv * DN_ALPHA + gg * y;
                } }
#pragma unroll
            for (int u = 0; u < 2; ++u) {
                const int m = mm[u];
                LN_ROW(v[u], ln_g + (size_t)(L * 2 + 1) * D, ln_b + (size_t)(L * 2 + 1) * D);
                if (u == 0 || m0 + F.NGW < T) {
                    bf16* hrow = (L == 0) ? HIN + (size_t)m * D : nullptr;
                    const float* mod1 = MOD + (size_t)(4 + m / SEQ) * 12288;
                    WRITE_X_HIN(v[u], xout + (size_t)m * D, hrow, mod1, mod1 + D);
                } }
        }
    }
    if (L == 0) SEAM(13);
}

__global__ void __launch_bounds__(512, 2) mega(Args args) {
    extern __shared__ __attribute__((aligned(16))) unsigned char lds_raw[];
    Frame F;
    F.lds = (LAS unsigned char*)lds_raw;
    F.wave = __builtin_amdgcn_readfirstlane((int)threadIdx.x >> 6); PHASE_FRESH();
    F.G = gridDim.x; { const int bx = blockIdx.x; F.vcu = (F.G % 8 == 0) ? (bx % 8) * (F.G / 8) + bx / 8 : bx; }
    F.gw = F.vcu * 8 + F.wave; F.NGW = F.G * 8;
    F.ctl = (unsigned*)(args.ws + WS_CTL);
    volatile LAS unsigned* MISC = (volatile LAS unsigned*)(F.lds + MISC_OFF);
    LAS int* TAB = (LAS int*)(F.lds + TAB_OFF);
    for (int u = F.tid; u < (LDS_BYTES - LDSCTL_OFF) / 4; u += 512) ((LAS unsigned*)(F.lds + LDSCTL_OFF))[u] = 0u;
    __syncthreads();
    XcdBarrier bar; bar.bar = F.ctl + CW_BAR; bar.x = 0; bar.st = nullptr;
    if (MK_ONE_LAUNCH) bar = xcd_barrier_post(F.ctl + CW_BAR, MISC + 8, F.tid == 0);
    const int lo = args.ph_lo, hi = args.ph_hi;

    if (IN(0)) { PHASE_FRESH();
        const bool defer = (F.G >= 64);
        if (defer) ada_groups<16>(F, args, 0, 256, (int)blockIdx.x, F.G);
        else ada_groups<96>(F, args, 0, 256, (int)blockIdx.x, F.G);
        tr_job(F, F.gw, F.NGW, hyb_w_in, 0, 1, HYB_IN, D, 0, 4096, WIN0, 0, D, 0, 0);
        tr_job(F, F.gw, F.NGW, hyb_w_in, 0, 1, HYB_IN, D, 4112, 3072, WIN0, 0, D, 4096, 0);
        tr_job(F, F.gw, F.NGW, hyb_w_in, 0, 1, HYB_IN, D, 4096, 16, WIN0, 0, D, 7168, 0);
        zero_fill(F, F.gw, F.NGW, WIN0 + (size_t)7184 * D, (size_t)(NIN - 7184) * D * 2);
        if (!defer) deferred_copies(F, args, F.gw, F.NGW);
        for (int idx = blockIdx.x * 512 + F.tid; idx < T * 32; idx += F.G * 512) {
            const int t = idx >> 5, i = idx & 31;
            const double rev = (double)in_pos[t] * ROPE_INVF[i] * 0.15915494309189535;
            const float fr = (float)(rev - __builtin_rint(rev));
            ROPE_C[idx] = __builtin_amdgcn_cosf(fr); ROPE_S[idx] = __builtin_amdgcn_sinf(fr);
        }
    }
    SEAM(0);

    if (IN(1)) { PHASE_FRESH();
        for (int m = F.gw; m < T; m += F.NGW) {
            const int b = m / SEQ; const float* modb = MOD + (size_t)b * 12288;
            const f32x4* xr = (const f32x4*)(in_x + (size_t)m * D) + F.lane; u32x2* o = (u32x2*)(HIN + (size_t)m * D) + F.lane;
#pragma unroll
            for (int j = 0; j < 8; ++j) { const f32x4 v = xr[64 * j]; const f32x4 sh = ((const f32x4*)(modb))[F.lane + 64 * j], sc = ((const f32x4*)(modb + D))[F.lane + 64 * j];
                const f32x4 h = v * (sc + 1.0f) + sh; u32x2 w; w.x = cvtpk(h[0], h[1]); w.y = cvtpk(h[2], h[3]); o[64 * j] = w; }
        }
    }
    SEAM(1);

    if (IN(2)) { PHASE_FRESH();
        pg8::StaticOrder S; S.init(HIN, WIN0, T, NIN, D, F.G, (int)blockIdx.x);
        pg8::EpiInProj E{PB, PBA};
        pg8::gemm_phase<pg8::EpiInProj, pg8::StaticOrder>(F.lds, D, S, E, F.tid, F.wave);
    }
    SEAM(2);

    if (IN(3)) { PHASE_FRESH();
        constexpr int QS = 136;
        LAS float* MT = (LAS float*)(F.lds);
        LAS bf16* QKM = (LAS bf16*)(F.lds + 17408);
        LAS float* RAWK = (LAS float*)(F.lds);
        LAS float* VF = (LAS float*)(F.lds + 32768);
        LAS float* WL = (LAS float*)(F.lds + 65536);
        LAS bf16* QBl = (LAS bf16*)(F.lds + 98304);
        LAS bf16* KBl = (LAS bf16*)(F.lds + 115712);
        int zoff = 0; asm volatile("" : "+v"(zoff));
        LAS float* s_beta = (LAS float*)(F.lds + 133120 + zoff); LAS float* s_gc = s_beta + 64; LAS float* s_egc = s_beta + 128;
        for (int ch = blockIdx.x; ch < NCH; ch += F.G) {
            PHASE_FRESH();
            const int n = ch & 31, bh = ch >> 5, h = bh & 7, b = bh >> 3;
            const int tok0 = b * SEQ + n * CHK;
            if (F.tid < 384) {
                const int mat = F.tid >> 7, d = F.tid & 127, col = mat * 1024 + h * 128 + d;
                const float w0 = gdn_conv_w[col], w1 = gdn_conv_w[3072 + col], w2 = gdn_conv_w[2 * 3072 + col], w3 = gdn_conv_w[3 * 3072 + col];
                const bf16* pc = PB + (size_t)tok0 * NP + col;
                float xm3 = 0.f, xm2 = 0.f, xm1 = 0.f;
                if (n > 0) { xm3 = bf2f(pc[-3 * NP]); xm2 = bf2f(pc[-2 * NP]); xm1 = bf2f(pc[-NP]); }
                LAS float* dst = (mat == 0) ? WL : (mat == 1 ? RAWK : VF);
                bf16 xr[64];
#pragma unroll
                for (int i = 0; i < 64; ++i) xr[i] = pc[(size_t)i * NP];
#pragma unroll
                for (int i = 0; i < 64; ++i) { const float xi = bf2f(xr[i]); const float y = w0 * xm3 + w1 * xm2 + w2 * xm1 + w3 * xi;
                    dst[i * 128 + d] = silu_f(y); xm3 = xm2; xm2 = xm1; xm1 = xi; }
            }
            if (F.wave == 7) {
                const int tok = tok0 + F.lane;
                const float br = PBA[(size_t)tok * 16 + h], ar = PBA[(size_t)tok * 16 + 8 + h];
                const float beta = 1.f / (1.f + __expf(-br));
                const float xsp = ar + gdn_dt_bias[h];
                const float sp = fmaxf(xsp, 0.f) + log1pf(__expf(-fabsf(xsp)));
                float g = -__expf(gdn_a_log[h]) * sp;
#pragma unroll
                for (int off = 1; off < 64; off <<= 1) { const float v = __shfl_up(g, off); if (F.lane >= off) g += v; }
                s_beta[F.lane] = beta; s_gc[F.lane] = g; s_egc[F.lane] = __expf(g);
            }
            __syncthreads();
#pragma unroll
            for (int rr = 0; rr < 8; ++rr) {
                const int i = F.wave * 8 + rr;
                const float qa = WL[i * 128 + F.lane], qb2 = WL[i * 128 + 64 + F.lane];
                const float ka = RAWK[i * 128 + F.lane], kb2 = RAWK[i * 128 + 64 + F.lane];
                const float rq = rsqrtf(wave_sum(qa * qa + qb2 * qb2) + 1e-6f) * 0.08838834764831845f;
                const float rk = rsqrtf(wave_sum(ka * ka + kb2 * kb2) + 1e-6f);
                QBl[i * QS + F.lane] = f2bf(qa * rq); QBl[i * QS + 64 + F.lane] = f2bf(qb2 * rq);
                KBl[i * QS + F.lane] = f2bf(ka * rk); KBl[i * QS + 64 + F.lane] = f2bf(kb2 * rk);
            }
            __syncthreads();
            {
                const int mat = F.wave >> 2, mi = (F.wave >> 1) & 1, ni = F.wave & 1, r = F.lane & 31, hh = F.lane >> 5;
                const LAS bf16* Am = (mat == 0) ? KBl : QBl;
                f32x16 acc;
#pragma unroll
                for (int i = 0; i < 16; ++i) acc[i] = 0.f;
#pragma unroll
                for (int ks = 0; ks < 8; ++ks) {
                    const bf16x8 a = *(const LAS bf16x8*)(Am + (32 * mi + r) * QS + 16 * ks + 8 * hh);
                    const bf16x8 bb = *(const LAS bf16x8*)(KBl + (32 * ni + r) * QS + 16 * ks + 8 * hh);
                    acc = MFMA32(a, bb, acc);
                }
                const int j = 32 * ni + r; const float gj = s_gc[j];
#pragma unroll
                for (int reg = 0; reg < 16; ++reg) {
                    const int i = 32 * mi + crow(reg, hh);
                    const float gi = s_gc[i];
                    const float dec = __expf(fminf(gi - gj, 0.f));
                    if (mat == 0) MT[j * 68 + i] = (i > j) ? s_beta[i] * acc[reg] * dec : 0.f;
                    else QKM[i * 64 + j] = f2bf((i >= j) ? acc[reg] * dec : 0.f);
                }
            }
            __syncthreads();
            if (F.tid < 256) {
                const int c = F.tid, dcol = c & 127;
                float X[64];
                if (c < 128) {
#pragma unroll
                    for (int i = 0; i < 64; ++i) X[i] = VF[i * 128 + dcol] * s_beta[i];
                } else {
#pragma unroll
                    for (int i = 0; i < 64; ++i) X[i] = bf2f(KBl[i * QS + dcol]) * s_beta[i] * s_egc[i];
                }
#pragma unroll
                for (int j = 0; j < 63; ++j) {
                    asm volatile("" ::: "memory");
                    const float xj = X[j];
#pragma unroll
                    for (int i4 = ((j + 1) & ~3); i4 < 64; i4 += 4) {
                        const f32x4 m4 = *(const LAS f32x4*)(MT + j * 68 + i4);
#pragma unroll
                        for (int q = 0; q < 4; ++q) if (i4 + q > j) X[i4 + q] -= m4[q] * xj;
                    }
                }
                LAS float* dst = (c < 128) ? VF : WL;
#pragma unroll
                for (int i = 0; i < 64; ++i) dst[i * 128 + dcol] = X[i];
            }
            __syncthreads();
            {
                const int r = F.lane & 31, hh = F.lane >> 5;
                const float gl = s_gc[63];
                unsigned char* gf = GF + (size_t)ch * 57344;
                for (int f = F.wave; f < 56; f += 8) {
                    float v[8];
                    if (f < 16) { const int mt = f >> 3, ks = f & 7; const LAS float* src = WL + (32 * mt + r) * 128 + 16 * ks + 4 * hh;
#pragma unroll
                        for (int j = 0; j < 8; ++j) v[j] = -src[8 * (j >> 2) + (j & 3)]; }
                    else if (f < 32) { const int f2 = f - 16, mt = f2 >> 3, ks = f2 & 7, i = 32 * mt + r; const float e = s_egc[i]; const LAS bf16* src = QBl + i * QS + 16 * ks + 4 * hh;
#pragma unroll
                        for (int j = 0; j < 8; ++j) v[j] = bf2f(src[8 * (j >> 2) + (j & 3)]) * e; }
                    else if (f < 40) { const int f2 = f - 32, mt = f2 >> 2, ks = f2 & 3; const LAS bf16* src = QKM + (32 * mt + r) * 64 + 16 * ks + 4 * hh;
#pragma unroll
                        for (int j = 0; j < 8; ++j) v[j] = bf2f(src[8 * (j >> 2) + (j & 3)]); }
                    else { const int f2 = f - 40, mt = f2 >> 2, ks = f2 & 3, dd = 32 * mt + r;
#pragma unroll
                        for (int j = 0; j < 8; ++j) { const int i = 16 * ks + 8 * (j >> 2) + 4 * hh + (j & 3); v[j] = bf2f(KBl[i * QS + dd]) * __expf(gl - s_gc[i]); } }
                    u32x4 o; o.x = cvtpk(v[0], v[1]); o.y = cvtpk(v[2], v[3]); o.z = cvtpk(v[4], v[5]); o.w = cvtpk(v[6], v[7]);
                    *(u32x4*)(gf + f * 1024 + F.lane * 16) = o;
                }
                { const int sl = F.wave >> 1, it = F.wave & 1, col = 32 * sl + r;
                  float* up = (float*)(GU + (size_t)ch * 32768 + (size_t)((sl * 2 + it) * 64 + F.lane) * 64);
#pragma unroll
                  for (int g4 = 0; g4 < 4; ++g4) { f32x4 t4;
#pragma unroll
                      for (int q = 0; q < 4; ++q) t4[q] = VF[(32 * it + crow(4 * g4 + q, hh)) * 128 + col];
                      *(f32x4*)(up + 4 * g4) = t4; } }
                if (F.tid == 0) EG[ch] = __expf(gl);
            }
            __syncthreads();
        }
    }
    SEAM(3);

    if (IN(4)) { PHASE_FRESH();
        if (F.G >= 64 && (int)blockIdx.x >= BATCH * GH) {
            const int bidx = (int)blockIdx.x - BATCH * GH, nb = F.G - BATCH * GH;
            ada_groups<96>(F, args, 42, 256, bidx, nb);
            deferred_copies(F, args, bidx * 8 + F.wave, nb * 8);
        }
        for (int bh = blockIdx.x; bh < BATCH * GH; bh += F.G) {
            const int b = bh >> 3, hd = bh & 7, r = F.lane & 31, hh = F.lane >> 5, sl = F.wave;
            f32x16 S[4];
#pragma unroll
            for (int dt = 0; dt < 4; ++dt)
#pragma unroll
                for (int i = 0; i < 16; ++i) S[dt][i] = 0.f;
            f32x16 un[2];
            if (F.wave >= 4) {
                const int t4 = F.tid - 256; const unsigned char* g0 = GF + opaque_off((size_t)(bh * 32) * 57344 + (size_t)t4 * 16);
#pragma unroll
                for (int q = 0; q < 14; ++q) *(LAS u32x4*)(F.lds + (t4 + 256 * q) * 16) = *(const u32x4*)(g0 + (size_t)q * 4096);
            } else {
#pragma unroll
                for (int it = 0; it < 2; ++it) { const f32x4* up = (const f32x4*)(GU + opaque_off((size_t)(bh * 32) * 32768 + (size_t)((sl * 2 + it) * 64 + F.lane) * 64));
#pragma unroll
                    for (int g4 = 0; g4 < 4; ++g4) { const f32x4 t4 = up[g4]; un[it][4 * g4] = t4[0]; un[it][4 * g4 + 1] = t4[1]; un[it][4 * g4 + 2] = t4[2]; un[it][4 * g4 + 3] = t4[3]; } }
            }
            __syncthreads();
            for (int n = 0; n < NCHK; ++n) {
                const int ch = bh * 32 + n; const bool more = (n + 1 < NCHK);
                if (F.wave >= 4) {
                    if (more) {
                        const unsigned char* gn = GF + opaque_off((size_t)(ch + 1) * 57344 + (size_t)(F.tid - 256) * 16); LAS unsigned char* nb = F.lds + ((n + 1) & 1) * 57344; const int t4 = F.tid - 256;
#pragma unroll
                        for (int q = 0; q < 14; ++q) *(LAS u32x4*)(nb + (t4 + 256 * q) * 16) = *(const u32x4*)(gn + (size_t)q * 4096);
                    }
                } else {
                    const LAS unsigned char* buf = F.lds + (n & 1) * 57344 + F.lane * 16;
                    const float eg = EG[ch];
                    bf16x8 Sb[8];
#pragma unroll
                    for (int dt = 0; dt < 4; ++dt) { Sb[2 * dt] = pack_acc(S[dt], 0); Sb[2 * dt + 1] = pack_acc(S[dt], 1); }
                    f32x16 vn[2]; vn[0] = un[0]; vn[1] = un[1];
#pragma unroll
                    for (int it = 0; it < 2; ++it)
#pragma unroll
                        for (int ks = 0; ks < 8; ++ks) vn[it] = MFMA32(*(const LAS bf16x8*)(buf + (it * 8 + ks) * 1024), Sb[ks], vn[it]);
                    __builtin_amdgcn_sched_barrier(0);
                    f32x16 oa[2];
#pragma unroll
                    for (int it = 0; it < 2; ++it) {
#pragma unroll
                        for (int i = 0; i < 16; ++i) oa[it][i] = 0.f;
#pragma unroll
                        for (int ks = 0; ks < 8; ++ks) oa[it] = MFMA32(*(const LAS bf16x8*)(buf + (16 + it * 8 + ks) * 1024), Sb[ks], oa[it]);
                    }
                    __builtin_amdgcn_sched_barrier(0);
                    bf16x8 vb[4];
#pragma unroll
                    for (int it = 0; it < 2; ++it) { vb[2 * it] = pack_acc(vn[it], 0); vb[2 * it + 1] = pack_acc(vn[it], 1); }
                    __builtin_amdgcn_sched_barrier(0);
                    {
                        const int chn = more ? ch + 1 : ch;
#pragma unroll
                        for (int it = 0; it < 2; ++it) { const f32x4* up = (const f32x4*)(GU + opaque_off((size_t)chn * 32768 + (size_t)((sl * 2 + it) * 64 + F.lane) * 64));
#pragma unroll
                            for (int g4 = 0; g4 < 4; ++g4) { const f32x4 t4 = up[g4]; un[it][4 * g4] = t4[0]; un[it][4 * g4 + 1] = t4[1]; un[it][4 * g4 + 2] = t4[2]; un[it][4 * g4 + 3] = t4[3]; } }
                    }
                    __builtin_amdgcn_sched_barrier(0);
#pragma unroll
                    for (int it = 0; it < 2; ++it)
#pragma unroll
                        for (int ks = 0; ks < 4; ++ks) oa[it] = MFMA32(*(const LAS bf16x8*)(buf + (32 + it * 4 + ks) * 1024), vb[ks], oa[it]);
#pragma unroll
                    for (int it = 0; it < 2; ++it) {
#pragma unroll
                        for (int g4 = 0; g4 < 4; ++g4) { float* op = GO + opaque_off((size_t)(b * SEQ + n * CHK + 32 * it + 8 * g4 + 4 * hh) * 1024 + hd * 128 + sl * 32 + r);
#pragma unroll
                            for (int q = 0; q < 4; ++q) op[q * 1024] = oa[it][4 * g4 + q]; } }
                    __builtin_amdgcn_sched_barrier(0);
#pragma unroll
                    for (int dt = 0; dt < 4; ++dt) {
#pragma unroll
                        for (int i = 0; i < 16; ++i) S[dt][i] *= eg;
#pragma unroll
                        for (int ks = 0; ks < 4; ++ks) S[dt] = MFMA32(*(const LAS bf16x8*)(buf + (40 + dt * 4 + ks) * 1024), vb[ks], S[dt]);
                    }
                }
                LDS_WAIT(); __builtin_amdgcn_s_barrier(); asm volatile("" ::: "memory");
            }
            __syncthreads();
        }
    }
    SEAM(4);

    if (IN(5)) { PHASE_FRESH();
        for (int m = F.gw; m < T; m += F.NGW) {
            const int s = m & (SEQ - 1), c0 = F.lane * 16;
            const bf16* prow = PB + (size_t)m * NP;
            {
                const f32x4* op = (const f32x4*)(GO + (size_t)m * 1024 + c0);
                f32x4 o[4]; float ss = 0.f;
#pragma unroll
                for (int q = 0; q < 4; ++q) { o[q] = op[q]; ss += o[q][0] * o[q][0] + o[q][1] * o[q][1] + o[q][2] * o[q][2] + o[q][3] * o[q][3]; }
                ss += __shfl_xor(ss, 1); ss += __shfl_xor(ss, 2); ss += __shfl_xor(ss, 4);
                const float rms = rsqrtf(ss * (1.f / 128.f) + 1e-6f);
                const u32x4* zp = (const u32x4*)(prow + 3072 + c0); const u32x4 z0 = zp[0], z1 = zp[1];
                const unsigned zw[8] = {z0.x, z0.y, z0.z, z0.w, z1.x, z1.y, z1.z, z1.w};
                const f32x4* nwp = (const f32x4*)(gdn_norm_w + (c0 & 127));
                unsigned ow[8];
#pragma unroll
                for (int q = 0; q < 4; ++q) { const f32x4 nw = nwp[q];
                    const float y0 = o[q][0] * rms * nw[0] * silu_f(bflo(zw[2 * q])), y1 = o[q][1] * rms * nw[1] * silu_f(bfhi(zw[2 * q]));
                    const float y2 = o[q][2] * rms * nw[2] * silu_f(bflo(zw[2 * q + 1])), y3 = o[q][3] * rms * nw[3] * silu_f(bfhi(zw[2 * q + 1]));
                    ow[2 * q] = cvtpk(y0, y1); ow[2 * q + 1] = cvtpk(y2, y3); }
                u32x4* yp = (u32x4*)(YAB + (size_t)m * D + c0);
                yp[0] = (u32x4){ow[0], ow[1], ow[2], ow[3]}; yp[1] = (u32x4){ow[4], ow[5], ow[6], ow[7]};
            }
            {
                float accv[16];
#pragma unroll
                for (int q = 0; q < 16; ++q) accv[q] = 0.f;
#pragma unroll
                for (int j = 0; j < 3; ++j) {
                    if (s - 2 + j >= 0) {
                        const bf16* pr = prow + (ptrdiff_t)(j - 2) * NP;
                        const u32x4* cp = (const u32x4*)(pr + 5120 + c0); const u32x4* hp = (const u32x4*)(pr + 6144 + c0);
                        const u32x4 ca = cp[0], cb = cp[1], ha = hp[0], hb = hp[1];
                        const unsigned cw[8] = {ca.x, ca.y, ca.z, ca.w, cb.x, cb.y, cb.z, cb.w}, hw[8] = {ha.x, ha.y, ha.z, ha.w, hb.x, hb.y, hb.z, hb.w};
                        const f32x4* wp = (const f32x4*)(sc_conv_w + j * 1024 + c0);
#pragma unroll
                        for (int q = 0; q < 4; ++q) { const f32x4 w4 = wp[q];
                            accv[4 * q] += w4[0] * bflo(cw[2 * q]) * bflo(hw[2 * q]); accv[4 * q + 1] += w4[1] * bfhi(cw[2 * q]) * bfhi(hw[2 * q]);
                            accv[4 * q + 2] += w4[2] * bflo(cw[2 * q + 1]) * bflo(hw[2 * q + 1]); accv[4 * q + 3] += w4[3] * bfhi(cw[2 * q + 1]) * bfhi(hw[2 * q + 1]); }
                    }
                }
                const u32x4* bp = (const u32x4*)(prow + 4096 + c0); const u32x4 ba = bp[0], bb = bp[1];
                const unsigned bw[8] = {ba.x, ba.y, ba.z, ba.w, bb.x, bb.y, bb.z, bb.w};
                unsigned ow[8];
#pragma unroll
                for (int q = 0; q < 8; ++q) ow[q] = cvtpk(bflo(bw[q]) * accv[2 * q], bfhi(bw[q]) * accv[2 * q + 1]);
                u32x4* yp = (u32x4*)(YAB + (size_t)m * D + 1024 + c0);
                yp[0] = (u32x4){ow[0], ow[1], ow[2], ow[3]}; yp[1] = (u32x4){ow[4], ow[5], ow[6], ow[7]};
            }
        }
    }
    SEAM(5);

    if (IN(6)) { PHASE_FRESH();
        pg8::StaticOrder S; S.init(YAB, WOUT0, T, D, D, F.G, (int)blockIdx.x);
        pg8::EpiResid E{in_x, MOD + 2 * D, RB};
        pg8::gemm_phase<pg8::EpiResid, pg8::StaticOrder>(F.lds, D, S, E, F.tid, F.wave);
    }
    SEAM(6);

    if (IN(7)) { PHASE_FRESH(); ln_route_phase<0>(F, args); }
    if (IN(7) && IN(11)) { PHASE_FRESH(); xcd_barrier(bar, F.tid == 0); }


    moe_phases<0>(F, args, bar, lo, hi, TAB);

        if (IN(14)) { PHASE_FRESH();
            pg8::StaticOrder S; S.init(HIN, WMIN, T, NMLA, D, F.G, (int)blockIdx.x);
            pg8::EpiF32 E{C1, NMLA};
            pg8::gemm_phase<pg8::EpiF32, pg8::StaticOrder>(F.lds, D, S, E, F.tid, F.wave);
        }
        SEAM(14);
        if (IN(15)) { PHASE_FRESH();
            for (int m = F.gw; m < T; m += F.NGW) {
                const float* c1 = C1 + (size_t)m * NMLA;
#pragma unroll
                for (int part = 0; part < 2; ++part) {
                    const f32x4* p = (const f32x4*)(c1 + part * 512 + 8 * F.lane); const f32x4 a0 = p[0], a1 = p[1];
                    const float ss = wave_sum((a0[0] * a0[0] + a0[1] * a0[1]) + (a0[2] * a0[2] + a0[3] * a0[3]) + (a1[0] * a1[0] + a1[1] * a1[1]) + (a1[2] * a1[2] + a1[3] * a1[3]));
                    const float rn = rsqrtf(ss * (1.f / 512.f) + 1e-6f);
                    const f32x4* wp = (const f32x4*)((part == 0 ? mla_q_norm : mla_kv_norm) + 8 * F.lane); const f32x4 w0 = wp[0], w1 = wp[1];
                    u32x4 o; o.x = cvtpk(a0[0] * rn * w0[0], a0[1] * rn * w0[1]); o.y = cvtpk(a0[2] * rn * w0[2], a0[3] * rn * w0[3]);
                    o.z = cvtpk(a1[0] * rn * w1[0], a1[1] * rn * w1[1]); o.w = cvtpk(a1[2] * rn * w1[2], a1[3] * rn * w1[3]);
                    *(u32x4*)((part == 0 ? CQN : CKVN) + (size_t)m * 512 + 8 * F.lane) = o;
                }
                if (F.lane < 32) { const float x1 = c1[1024 + F.lane], x2 = c1[1056 + F.lane], cs = ROPE_C[(size_t)m * 32 + F.lane], sn = ROPE_S[(size_t)m * 32 + F.lane];
                    KPE[(size_t)m * 64 + F.lane] = x1 * cs - x2 * sn; KPE[(size_t)m * 64 + 32 + F.lane] = x1 * sn + x2 * cs; }
            }
        }
        SEAM(15);
        if (IN(16)) { PHASE_FRESH();
            { pg8::StaticOrder S; S.init(CQN, WUQ, T, 3072, 512, F.G, (int)blockIdx.x); pg8::EpiQup E{QB_};
              pg8::gemm_phase<pg8::EpiQup, pg8::StaticOrder>(F.lds, 512, S, E, F.tid, F.wave); }
            { pg8::StaticOrder S; S.init(CKVN, WUKV, T, 4096, 512, F.G, (int)blockIdx.x); pg8::EpiKVup E{KB_, VB_};
              pg8::gemm_phase<pg8::EpiKVup, pg8::StaticOrder>(F.lds, 512, S, E, F.tid, F.wave); }
        }
        SEAM(16);
        if (IN(17)) { PHASE_FRESH();
            for (int m = F.gw; m < T; m += F.NGW) {
                const int b = m / SEQ, s = m - b * SEQ, hd = F.lane >> 2, i0 = (F.lane & 3) * 8;
                const size_t rowoff = ((size_t)((b * MH + hd) * SEQ + s)) * QD + 128;
                bf16* qp = QB_ + rowoff;
                const u32x4 xa = *(const u32x4*)(qp + i0), xb = *(const u32x4*)(qp + 32 + i0);
                const f32x4* cp = (const f32x4*)(ROPE_C + (size_t)m * 32 + i0); const f32x4* sp = (const f32x4*)(ROPE_S + (size_t)m * 32 + i0);
                const f32x4 c0 = cp[0], c1v = cp[1], s0 = sp[0], s1 = sp[1];
                const float cs[8] = {c0[0], c0[1], c0[2], c0[3], c1v[0], c1v[1], c1v[2], c1v[3]}, sn[8] = {s0[0], s0[1], s0[2], s0[3], s1[0], s1[1], s1[2], s1[3]};
                const unsigned xaw[4] = {xa.x, xa.y, xa.z, xa.w}, xbw[4] = {xb.x, xb.y, xb.z, xb.w};
                unsigned o1[4], o2[4];
#pragma unroll
                for (int q = 0; q < 4; ++q) { const float a0 = bflo(xaw[q]), a1 = bfhi(xaw[q]), b0 = bflo(xbw[q]), b1 = bfhi(xbw[q]);
                    o1[q] = cvtpk(a0 * cs[2 * q] - b0 * sn[2 * q], a1 * cs[2 * q + 1] - b1 * sn[2 * q + 1]);
                    o2[q] = cvtpk(a0 * sn[2 * q] + b0 * cs[2 * q], a1 * sn[2 * q + 1] + b1 * cs[2 * q + 1]); }
                *(u32x4*)(qp + i0) = (u32x4){o1[0], o1[1], o1[2], o1[3]}; *(u32x4*)(qp + 32 + i0) = (u32x4){o2[0], o2[1], o2[2], o2[3]};
                const f32x4* kp = (const f32x4*)(KPE + (size_t)m * 64 + i0); const f32x4* kp2 = (const f32x4*)(KPE + (size_t)m * 64 + 32 + i0);
                const f32x4 k0 = kp[0], k1 = kp[1], k2 = kp2[0], k3 = kp2[1];
                bf16* kd = KB_ + rowoff;
                *(u32x4*)(kd + i0) = (u32x4){cvtpk(k0[0], k0[1]), cvtpk(k0[2], k0[3]), cvtpk(k1[0], k1[1]), cvtpk(k1[2], k1[3])};
                *(u32x4*)(kd + 32 + i0) = (u32x4){cvtpk(k2[0], k2[1]), cvtpk(k2[2], k2[3]), cvtpk(k3[0], k3[1]), cvtpk(k3[2], k3[3])};
            }
        }
        SEAM(17);
        if (IN(18)) { PHASE_FRESH();
            constexpr int KBUF = 64 * 400, VBUF = 64 * 320;
            LAS unsigned char* KL = F.lds; LAS unsigned char* VL = F.lds + 2 * KBUF;
            const int w = F.wave;
            for (int pi = blockIdx.x; pi < 256; pi += F.G) {
                const int bhh = pi >> 2, pp = pi & 3, b = bhh >> 4, hd = bhh & 15;
                const char* kg = (const char*)(KB_ + (size_t)bhh * SEQ * QD); const char* vg = (const char*)(VB_ + (size_t)b * SEQ * D + hd * 128);
                for (int half = 0; half < 2; ++half) {
                    PHASE_FRESH(); const int r = F.lane & 31, hh = F.lane >> 5;
                    const int qb = half == 0 ? 7 - pp : pp, q0 = qb * 256, ntile = 4 * (qb + 1), qrow = q0 + 32 * w + r;
                    bf16x8 qf[12];
                    { const bf16* qp = QB_ + ((size_t)bhh * SEQ + qrow) * QD + 8 * hh;
#pragma unroll
                      for (int ks = 0; ks < 12; ++ks) qf[ks] = *(const bf16x8*)(qp + 16 * ks); }
                    f32x16 oT[4];
#pragma unroll
                    for (int mt = 0; mt < 4; ++mt)
#pragma unroll
                        for (int i = 0; i < 16; ++i) oT[mt][i] = 0.f;
                    float mrun = -1e30f, lsum = 0.f;
                    u32x4 kst[3], vst[2];
#pragma unroll
                    for (int q = 0; q < 3; ++q) kst[q] = *(const u32x4*)(kg + (size_t)(F.tid + 512 * q) * 16);
#pragma unroll
                    for (int q = 0; q < 2; ++q) { const int p = F.tid + 512 * q; vst[q] = *(const u32x4*)(vg + (size_t)(p >> 4) * (D * 2) + (p & 15) * 16); }
#pragma unroll
                    for (int q = 0; q < 3; ++q) { const int p = F.tid + 512 * q; *(LAS u32x4*)(KL + (p / 24) * 400 + (p % 24) * 16) = kst[q]; }
#pragma unroll
                    for (int q = 0; q < 2; ++q) { const int p = F.tid + 512 * q; *(LAS u32x4*)(VL + (p >> 4) * 320 + (p & 15) * 16) = vst[q]; }
                    __syncthreads();
                    for (int kt = 0; kt < ntile; ++kt) {
                        const bool more = (kt + 1 < ntile); const int k0 = kt * 64;
                        if (more) {
                            const int k1 = k0 + 64;
#pragma unroll
                            for (int q = 0; q < 3; ++q) kst[q] = *(const u32x4*)(kg + (size_t)k1 * (QD * 2) + (size_t)(F.tid + 512 * q) * 16);
#pragma unroll
                            for (int q = 0; q < 2; ++q) { const int p = F.tid + 512 * q; vst[q] = *(const u32x4*)(vg + (size_t)(k1 + (p >> 4)) * (D * 2) + (p & 15) * 16); }
                        }
                        if (k0 <= q0 + 32 * w + 31) {
                            const LAS unsigned char* kb = KL + (kt & 1) * KBUF; const LAS unsigned char* vb_ = VL + (kt & 1) * VBUF;
                            f32x16 sT[2];
#pragma unroll
                            for (int kk = 0; kk < 2; ++kk) {
#pragma unroll
                                for (int i = 0; i < 16; ++i) sT[kk][i] = 0.f;
#pragma unroll
                                for (int ks = 0; ks < 12; ++ks) sT[kk] = MFMA32(*(const LAS bf16x8*)(kb + (32 * kk + r) * 400 + (16 * ks + 8 * hh) * 2), qf[ks], sT[kk]);
                            }
                            if (k0 + 63 > q0 + 32 * w) {
#pragma unroll
                                for (int kk = 0; kk < 2; ++kk)
#pragma unroll
                                    for (int reg = 0; reg < 16; ++reg) { const int key = k0 + 32 * kk + crow(reg, hh); if (key > qrow) sT[kk][reg] = -1e30f; }
                            }
                            float mloc = sT[0][0];
#pragma unroll
                            for (int kk = 0; kk < 2; ++kk)
#pragma unroll
                                for (int reg = 0; reg < 16; ++reg) mloc = fmaxf(mloc, sT[kk][reg]);
                            mloc = fmaxf(mloc, __shfl_xor(mloc, 32));
                            const float mnew = fmaxf(mrun, mloc), alpha = __builtin_amdgcn_exp2f(mrun - mnew);
                            float ps = 0.f;
#pragma unroll
                            for (int kk = 0; kk < 2; ++kk)
#pragma unroll
                                for (int reg = 0; reg < 16; ++reg) { const float pe = __builtin_amdgcn_exp2f(sT[kk][reg] - mnew); sT[kk][reg] = pe; ps += pe; }
                            lsum = lsum * alpha + ps; mrun = mnew;
#pragma unroll
                            for (int mt = 0; mt < 4; ++mt)
#pragma unroll
                                for (int i = 0; i < 16; ++i) oT[mt][i] *= alpha;
                            bf16x8 pb[4];
#pragma unroll
                            for (int kk = 0; kk < 2; ++kk) { pb[2 * kk] = pack_acc(sT[kk], 0); pb[2 * kk + 1] = pack_acc(sT[kk], 1); }
#pragma unroll
                            for (int mt = 0; mt < 4; ++mt)
#pragma unroll
                                for (int ks = 0; ks < 4; ++ks) {
                                const LAS unsigned char* vp = vb_ + (16 * ks + 4 * hh + ((F.lane & 15) >> 2)) * 320 + (32 * mt + 16 * ((F.lane >> 4) & 1) + 4 * (F.lane & 3)) * 2;
                                const s16x4 vlo = __builtin_bit_cast(s16x4, __builtin_amdgcn_ds_read_tr16_b64_v4i16((LAS v4i16_t*)vp));
                                const s16x4 vhi = __builtin_bit_cast(s16x4, __builtin_amdgcn_ds_read_tr16_b64_v4i16((LAS v4i16_t*)(vp + 8 * 320)));
                                const bf16x8 va = __builtin_shufflevector(vlo, vhi, 0, 1, 2, 3, 4, 5, 6, 7);
                                oT[mt] = MFMA32(va, pb[ks], oT[mt]); }
                        }
                        if (more) {
                            LAS unsigned char* kn = KL + ((kt + 1) & 1) * KBUF; LAS unsigned char* vn_ = VL + ((kt + 1) & 1) * VBUF;
#pragma unroll
                            for (int q = 0; q < 3; ++q) { const int p = F.tid + 512 * q; *(LAS u32x4*)(kn + (p / 24) * 400 + (p % 24) * 16) = kst[q]; }
#pragma unroll
                            for (int q = 0; q < 2; ++q) { const int p = F.tid + 512 * q; *(LAS u32x4*)(vn_ + (p >> 4) * 320 + (p & 15) * 16) = vst[q]; }
                        }
                        __syncthreads();
                    }
                    const float ltot = lsum + __shfl_xor(lsum, 32), inv = 1.f / ltot;
                    bf16* orow = YAB + (size_t)(b * SEQ + qrow) * D + hd * 128 + 4 * hh;
#pragma unroll
                    for (int mt = 0; mt < 4; ++mt)
#pragma unroll
                        for (int g4 = 0; g4 < 4; ++g4) { u32x2 o; o.x = cvtpk(oT[mt][4 * g4] * inv, oT[mt][4 * g4 + 1] * inv); o.y = cvtpk(oT[mt][4 * g4 + 2] * inv, oT[mt][4 * g4 + 3] * inv);
                            *(u32x2*)(orow + 32 * mt + 8 * g4) = o; }
                }
            }
        }
        SEAM(18);
        if (IN(19)) { PHASE_FRESH();
            pg8::StaticOrder S; S.init(YAB, WMOUT, T, D, D, F.G, (int)blockIdx.x);
            pg8::EpiResid E{XB, MOD + (size_t)4 * 12288 + 2 * D, RB};
            pg8::gemm_phase<pg8::EpiResid, pg8::StaticOrder>(F.lds, D, S, E, F.tid, F.wave);
        }
        SEAM(19);
        if (IN(20)) { PHASE_FRESH(); ln_route_phase<1>(F, args); }
        if (IN(20) && IN(24)) { PHASE_FRESH(); xcd_barrier(bar, F.tid == 0); }


    moe_phases<1>(F, args, bar, lo, hi, TAB);
#undef IN
#undef INL
#undef SEAM
#undef WSB
#undef in_x
#undef in_c
#undef in_pos
#undef ada_w
#undef ada_b
#undef ln_g
#undef ln_b
#undef hyb_w_in
#undef gdn_conv_w
#undef gdn_a_log
#undef gdn_dt_bias
#undef gdn_norm_w
#undef sc_conv_w
#undef hyb_w_out
#undef mla_w_in
#undef mla_q_norm
#undef mla_kv_norm
#undef mla_w_uq
#undef mla_w_ukv
#undef mla_w_out
#undef moe_router_g
#undef moe_bias_g
#undef moe_router_e
#undef moe_bias_e
#undef moe_w_gate
#undef moe_w_up
#undef moe_w_down
#undef MOD
#undef ROPE_C
#undef ROPE_S
#undef PBA
#undef LOGITS
#undef TOK_E
#undef TOK_POS
#undef TOK_GATE
#undef EG
#undef WIN0
#undef WOUT0
#undef WMIN
#undef WUQ
#undef WUKV
#undef WMOUT
#undef WRT
#undef WGU
#undef WDN
#undef HIN
#undef XA
#undef XB
#undef RB
#undef PB
#undef GF
#undef GU
#undef GO
#undef YAB
#undef LISTP
#undef HID
#undef YS
#undef C1
#undef CQN
#undef CKVN
#undef KPE
#undef QB_
#undef KB_
#undef VB_
#undef VT
}

extern "C" void kernel_launch(void* const* d_in, const int* in_sizes, int n_in, void* d_out, int out_size, void* d_ws, size_t ws_size, hipStream_t stream) {
    static int grid = 0;
    if (grid == 0) {
        if (n_in != 27 || in_sizes[0] != T * D || out_size != T * D || ws_size < WS_END) { fprintf(stderr, "kernel_launch: unexpected problem (n_in %d, in0 %d, out %d, ws %zu)\n", n_in, n_in > 0 ? in_sizes[0] : -1, out_size, ws_size); grid = -1; return; }
        int dev = 0, cus = 0, per_cu = 0;
        if (hipGetDevice(&dev) != hipSuccess || hipDeviceGetAttribute(&cus, hipDeviceAttributeMultiprocessorCount, dev) != hipSuccess) { grid = -1; return; }
        if (hipFuncSetAttribute((const void*)mega, hipFuncAttributeMaxDynamicSharedMemorySize, LDS_BYTES) != hipSuccess) { fprintf(stderr, "kernel_launch: hipFuncSetAttribute failed\n"); grid = -1; return; }
        if (hipOccupancyMaxActiveBlocksPerMultiprocessor(&per_cu, (const void*)mega, 512, LDS_BYTES) != hipSuccess || per_cu < 1) fprintf(stderr, "kernel_launch: occupancy query reports %d\n", per_cu);
        (void)hipGetLastError();
        grid = cus;
    }
    if (grid < 0) return;
    (void)hipMemsetAsync((char*)d_ws + WS_CTL, 0, CTL_ZERO_BYTES, stream);
    Args a{};
    for (int i = 0; i < 27; ++i) a.in[i] = d_in[i];
    a.out = (float*)d_out; a.ws = (unsigned char*)d_ws;
#if MK_ONE_LAUNCH
    a.ph_lo = 0; a.ph_hi = NPH;
    hipLaunchKernelGGL(mega, dim3(grid), dim3(512), LDS_BYTES, stream, a);
#else
    for (int k = 0; k < NPH; ++k) { a.ph_lo = k; a.ph_hi = k + 1; hipLaunchKernelGGL(mega, dim3(grid), dim3(512), LDS_BYTES, stream, a); }
#endif
}
```

```cpp
#include <hip/hip_runtime.h>
#include <cstdio>
#include <cstdint>

#ifndef MK_ONE_LAUNCH
#define MK_ONE_LAUNCH 1
#endif

#define DI __device__ __forceinline__
#define GAS __attribute__((address_space(1)))
#define LAS __attribute__((address_space(3)))
typedef unsigned short bf16;
typedef float f32x4 __attribute__((ext_vector_type(4)));
typedef float f32x2 __attribute__((ext_vector_type(2)));
typedef float f32x16 __attribute__((ext_vector_type(16)));
typedef short bf16x8 __attribute__((ext_vector_type(8)));
typedef short s16x4 __attribute__((ext_vector_type(4)));
typedef short v4i16_t __attribute__((ext_vector_type(4)));
typedef unsigned u32x4 __attribute__((ext_vector_type(4)));
typedef unsigned u32x2 __attribute__((ext_vector_type(2)));
typedef __bf16 bf16x2_t __attribute__((ext_vector_type(2)));
typedef GAS unsigned gu32;
#define RLX_AGENT __ATOMIC_RELAXED, __HIP_MEMORY_SCOPE_AGENT
#define LDS_WAIT() asm volatile("s_waitcnt lgkmcnt(0)" ::: "memory")
#define VM_WAIT() asm volatile("s_waitcnt vmcnt(0)" ::: "memory")
#define MFMA32(a, b, c) __builtin_amdgcn_mfma_f32_32x32x16_bf16((a), (b), (c), 0, 0, 0)

DI unsigned cvtpk(float lo, float hi) { f32x2 v = {lo, hi}; bf16x2_t b = __builtin_convertvector(v, bf16x2_t); return __builtin_bit_cast(unsigned, b); }
DI bf16 f2bf(float f) { return (bf16)(cvtpk(f, 0.f) & 0xffffu); }
DI float bf2f(bf16 b) { return __uint_as_float(((unsigned)b) << 16); }
DI float bflo(unsigned w) { return __uint_as_float(w << 16); }
DI float bfhi(unsigned w) { return __uint_as_float(w & 0xffff0000u); }
DI int crow(int reg, int h) { return (reg & 3) + 8 * (reg >> 2) + 4 * h; }
DI int kperm(int j, int h) { return 8 * (j >> 2) + 4 * h + (j & 3); }
DI float wave_sum(float v) {
#pragma unroll
    for (int o = 1; o < 64; o <<= 1) v += __shfl_xor(v, o);
    return v;
}
DI bf16x8 pack_acc(const f32x16& x, int s) {
    u32x4 p; p.x = cvtpk(x[8 * s + 0], x[8 * s + 1]); p.y = cvtpk(x[8 * s + 2], x[8 * s + 3]); p.z = cvtpk(x[8 * s + 4], x[8 * s + 5]); p.w = cvtpk(x[8 * s + 6], x[8 * s + 7]);
    return __builtin_bit_cast(bf16x8, p);
}
DI float silu_f(float x) { return x / (1.f + __expf(-x)); }
DI size_t opaque_off(size_t o) { asm volatile("" : "+v"(o)); return o; }

constexpr int D = 2048, BATCH = 4, SEQ = 2048, T = BATCH * SEQ;
constexpr int GH = 8, GD = 128, NCHK = 32, CHK = 64, NCH = BATCH * GH * NCHK;
constexpr int HYB_IN = 7184, NIN = 7424, NP = 7168;
constexpr int MH = 16, MLA_IN = 1088, NMLA = 1280, QD = 192;
constexpr int NE = 64, FF = 512, MAXBLK = 128;
constexpr float DN_ALPHA = 1.41421356237f;
constexpr float QSCALE = 0.10411754627697264f;
constexpr int NPH = 27;
constexpr int GREC = 73728;

constexpr size_t MiB = 1u << 20;
constexpr size_t WS_CTL = 0, CTL_ZERO_BYTES = 1 * MiB;
constexpr size_t WS_MOD = 1 * MiB;
constexpr size_t WS_ROPE = 2 * MiB;
constexpr size_t WS_PBA = 4 * MiB;
constexpr size_t WS_LOGITS = 5 * MiB;
constexpr size_t WS_ROUTE = 9 * MiB;
constexpr size_t WS_EG = 10 * MiB;
constexpr size_t WS_WIN0 = 16 * MiB;
constexpr size_t WS_WOUT0 = 46 * MiB;
constexpr size_t WS_WMIN = 54 * MiB;
constexpr size_t WS_WUQ = 59 * MiB;
constexpr size_t WS_WUKV = 62 * MiB;
constexpr size_t WS_WMOUT = 66 * MiB;
constexpr size_t WS_WRT = 74 * MiB;
constexpr size_t WS_WGU = 80 * MiB;
constexpr size_t WS_WDN = 592 * MiB;
constexpr size_t WS_HIN = 848 * MiB;
constexpr size_t WS_XA = 880 * MiB;
constexpr size_t WS_XB = 944 * MiB;
constexpr size_t WS_R = 1008 * MiB;
constexpr size_t WS_P = 1072 * MiB;
constexpr size_t WS_GF = 1184 * MiB;
constexpr size_t WS_GU = 1240 * MiB;
constexpr size_t WS_GO = 1272 * MiB;
constexpr size_t WS_YAB = 1304 * MiB;
constexpr size_t WS_XS = 1336 * MiB;
constexpr size_t WS_HID = 1464 * MiB;
constexpr size_t WS_YS = 1496 * MiB;
constexpr size_t WS_C1 = 1624 * MiB;
constexpr size_t WS_CQN = 1664 * MiB;
constexpr size_t WS_CKVN = 1672 * MiB;
constexpr size_t WS_KPE = 1680 * MiB;
constexpr size_t WS_Q = 1684 * MiB;
constexpr size_t WS_K = 1732 * MiB;
constexpr size_t WS_V = 1780 * MiB;
constexpr size_t WS_VT = 1812 * MiB;
constexpr size_t WS_END = 1844 * MiB;
constexpr int CW_BAR = 4096;
constexpr int CW_CNT = 8192;
constexpr int CW_BLK = 8448;

constexpr int RING_BYTES = 131072;
constexpr int LDSCTL_OFF = 155648, MISC_OFF = LDSCTL_OFF + 320;
constexpr int TAB_OFF = LDSCTL_OFF + 512;
constexpr int SC_OFF = LDSCTL_OFF + 1536;
constexpr int LDS_BYTES = 159744;

namespace pg8 {
constexpr int BM = 256, BK = 64, HALF = 128, HTB = HALF * BK * 2, STAGE_BYTES = 8 * HTB, NXCD = 8, WGM = 8;
__host__ __device__ __forceinline__ int lds_byte(int r, int c) { const int st = (r >> 4) * 2 + (c >> 5), rr = r & 15, cc = c & 31, ob = rr * 64 + cc * 2; return st * 1024 + (ob ^ (((ob >> 9) & 1) << 5)); }
__host__ __device__ __forceinline__ void stage_rc(int b, int& R, int& C) { const int st = b / 1024, sb = b % 1024, swz = sb ^ (((sb >> 9) & 1) << 5); R = (st >> 1) * 16 + swz / 64; C = (st & 1) * 32 + (swz % 64) / 2; }
__host__ __device__ __forceinline__ int perm32(int rho) { const int n = rho >> 4, i = rho & 15; return 8 * (i >> 2) + 4 * n + (i & 3); }

struct Unit { int pm, pn, ex, rows; };

struct StaticOrder {
    int nM, nN, nwg, G, c; const char* A; const char* Bt; size_t tstep;
    __device__ void init(const bf16* A_, const bf16* Bt_, int M, int N, int K, int G_, int c_) { nM = M / BM; nN = N / BM; nwg = nM * nN; G = G_; c = c_; A = (const char*)A_; Bt = (const char*)Bt_; tstep = (size_t)BM * K * 2; }
    __device__ bool next(int i, Unit& u) const {
        const long L = (long)i * G + c; if (L >= nwg) return false;
        int wgid = (int)L; { const int q = nwg / NXCD, r = nwg % NXCD, xcd = wgid % NXCD, off = wgid / NXCD; wgid = (xcd < r ? xcd * (q + 1) : r * (q + 1) + (xcd - r) * q) + off; }
        const int nig = WGM * nN, gid = wgid / nig, fm = gid * WGM, gsz = (nM - fm) < WGM ? (nM - fm) : WGM;
        u.pm = fm + ((wgid % nig) % gsz); u.pn = (wgid % nig) / gsz; u.ex = 0; u.rows = 256; return true;
    }
    __device__ __forceinline__ const char* aptr(const Unit& u) const { return A + (size_t)u.pm * tstep; }
    __device__ __forceinline__ const char* bptr(const Unit& u) const { return Bt + (size_t)u.pn * tstep; }
};
struct MapOrder : StaticOrder {
    int first, nfirst, extra;
    __device__ bool next(int i, Unit& u) const { if (!StaticOrder::next(i, u)) return false; u.pn = (u.pn < nfirst) ? first + u.pn : extra; return true; }
};
struct MoeOrder {
    int nunits, NT, G, c; const LAS int* blk_e; const char* A; const char* W; size_t a_tstep, w_estride, w_tstep;
    __device__ bool next(int i, Unit& u) const {
        const long L = (long)i * G + c; if (L >= nunits) return false;
        u.pm = (int)L / NT; u.pn = (int)L % NT; u.ex = blk_e[u.pm]; u.rows = 256; return true;
    }
    __device__ __forceinline__ const char* aptr(const Unit& u) const { return A + (size_t)u.pm * a_tstep; }
    __device__ __forceinline__ const char* bptr(const Unit& u) const { return W + (size_t)u.ex * w_estride + (size_t)u.pn * w_tstep; }
};

template <class Epi, class Sched, bool ALIGN_EPI = true, bool SP2 = true>
__device__ __forceinline__ void gemm_phase(LAS unsigned char* lds, const int K_, const Sched& S, const Epi& E, const int tid, const int wid) {
    const int lane = tid & 63, wr = wid >> 2, wc = wid & 3, fr = lane & 15, fq = lane >> 4;
    int K = K_; asm volatile("" : "+s"(K));
    const int nt = K / BK;
    unsigned voffA[2], voffB[2];
#pragma unroll
    for (int i = 0; i < 2; ++i) { int R, C; stage_rc(tid * 16 + i * 8192, R, C); const int Rb = Epi::PERM ? ((R & ~31) + perm32(R & 31)) : R;
        voffA[i] = (unsigned)(R * K + C) * 2u; voffB[i] = (unsigned)(Rb * K + C) * 2u; }
    const size_t kstep = (size_t)(BK * 2);
    const size_t hstep = (size_t)HALF * K * 2;
    const unsigned ldsw = (unsigned)wid * 1024u;
    const int aoff = lds_byte(wr * 64 + fr, fq * 8), boff = lds_byte(wc * 32 + fr, fq * 8);
#define PG8_SA(b, h) (((b) * 2 + (h)) * HTB)
#define PG8_SB(b, h) ((4 + (b) * 2 + (h)) * HTB)
#define PG8_STAGE(bufoff, gbase, voff) do { _Pragma("unroll") for (int _i = 0; _i < 2; ++_i) \
        __builtin_amdgcn_global_load_lds((const unsigned*)((const char*)(gbase) + (voff)[_i]), (LAS unsigned*)(lds + (bufoff) + ldsw + _i * 8192), 16, 0, 0); } while (0)
#define PG8_LDA(dst, b, h) do { _Pragma("unroll") for (int m = 0; m < 4; ++m) _Pragma("unroll") for (int k = 0; k < 2; ++k) dst[m][k] = *(const LAS bf16x8*)(lds + PG8_SA(b, h) + aoff + m * 2048 + k * 1024); } while (0)
#define PG8_LDB(dst, b, h) do { _Pragma("unroll") for (int n = 0; n < 2; ++n) _Pragma("unroll") for (int k = 0; k < 2; ++k) dst[n][k] = *(const LAS bf16x8*)(lds + PG8_SB(b, h) + boff + n * 2048 + k * 1024); } while (0)
#define PG8_MMA(ai, bj, At, Bt) do { __builtin_amdgcn_s_setprio(1); _Pragma("unroll") for (int m = 0; m < 4; ++m) _Pragma("unroll") for (int n = 0; n < 2; ++n) _Pragma("unroll") for (int k = 0; k < 2; ++k) \
        acc[ai][bj][m][n] = __builtin_amdgcn_mfma_f32_16x16x32_bf16(Bt[n][k], At[m][k], acc[ai][bj][m][n], 0, 0, 0); __builtin_amdgcn_s_setprio(0); } while (0)
#define PG8_WAIT_V(n) asm volatile("s_waitcnt vmcnt(" #n ")" ::: "memory")
#define PG8_WAIT_L(n) asm volatile("s_waitcnt lgkmcnt(" #n ")" ::: "memory")
#define PG8_BAR __builtin_amdgcn_s_barrier()
#define PG8_SCHED __builtin_amdgcn_sched_barrier(0)
    Unit cur, nxt; int ui = 0;
    if (!S.next(0, cur)) return;
    f32x4 acc[2][2][4][2];
#pragma unroll
    for (int a = 0; a < 2; ++a)
#pragma unroll
        for (int b = 0; b < 2; ++b)
#pragma unroll
            for (int m = 0; m < 4; ++m)
#pragma unroll
                for (int n = 0; n < 2; ++n) acc[a][b][m][n] = (f32x4){0.f, 0.f, 0.f, 0.f};
    bf16x8 At[4][2], B0[2][2], B1[2][2];
    const char* cA = S.aptr(cur); const char* cB = S.bptr(cur);
    if constexpr (SP2) {
        PG8_STAGE(PG8_SB(0, 0), cB, voffB); PG8_STAGE(PG8_SB(0, 1), cB + hstep, voffB); PG8_STAGE(PG8_SA(0, 0), cA, voffA); PG8_STAGE(PG8_SA(0, 1), cA + hstep, voffA);
        if (wr == 1) PG8_BAR;
        PG8_WAIT_V(2); PG8_BAR;
        PG8_STAGE(PG8_SB(1, 0), cB + kstep, voffB); PG8_STAGE(PG8_SA(1, 0), cA + kstep, voffA); PG8_STAGE(PG8_SB(1, 1), cB + hstep + kstep, voffB);
        PG8_WAIT_V(6); PG8_BAR;
    } else {
        PG8_STAGE(PG8_SB(0, 0), cB, voffB); PG8_STAGE(PG8_SA(0, 0), cA, voffA); PG8_STAGE(PG8_SB(0, 1), cB + hstep, voffB); PG8_STAGE(PG8_SA(0, 1), cA + hstep, voffA);
        if (wr == 1) PG8_BAR;
        PG8_WAIT_V(4); PG8_BAR;
        PG8_STAGE(PG8_SB(1, 0), cB + kstep, voffB); PG8_STAGE(PG8_SA(1, 0), cA + kstep, voffA); PG8_STAGE(PG8_SB(1, 1), cB + hstep + kstep, voffB);
        PG8_WAIT_V(6); PG8_BAR;
    }
    for (;;) {
        const bool has_next = S.next(ui + 1, nxt);
        const char* nA = has_next ? S.aptr(nxt) : cA; const char* nB = has_next ? S.bptr(nxt) : cB;
        for (int t = 0; t < nt; t += 2) {
            const bool last = (t == nt - 2);
            const char* a1 = cA + (size_t)(t + 1) * kstep;
            const char* a2 = last ? nA : cA + (size_t)(t + 2) * kstep; const char* b2 = last ? nB : cB + (size_t)(t + 2) * kstep;
            const char* a3 = a2 + kstep; const char* b3 = b2 + kstep;
            if constexpr (SP2) {
            PG8_LDB(B0, 0, 0); PG8_LDB(B1, 0, 1); PG8_SCHED; PG8_LDA(At, 0, 0); PG8_STAGE(PG8_SA(1, 1), a1 + hstep, voffA);
            PG8_WAIT_V(8); PG8_WAIT_L(0); PG8_BAR; PG8_MMA(0, 0, At, B0); PG8_MMA(0, 1, At, B1); PG8_BAR; PG8_SCHED;
            PG8_LDA(At, 0, 1); PG8_STAGE(PG8_SB(0, 0), b2, voffB); PG8_STAGE(PG8_SB(0, 1), b2 + hstep, voffB); PG8_STAGE(PG8_SA(0, 0), a2, voffA);
            PG8_WAIT_V(8); PG8_WAIT_L(0); PG8_BAR; PG8_MMA(1, 0, At, B0); PG8_MMA(1, 1, At, B1); PG8_BAR; PG8_SCHED;
            PG8_LDB(B0, 1, 0); PG8_LDB(B1, 1, 1); PG8_SCHED; PG8_LDA(At, 1, 0); PG8_STAGE(PG8_SA(0, 1), a2 + hstep, voffA);
            PG8_WAIT_V(8); PG8_WAIT_L(0); PG8_BAR; PG8_MMA(0, 0, At, B0); PG8_MMA(0, 1, At, B1); PG8_BAR; PG8_SCHED;
            PG8_LDA(At, 1, 1); PG8_STAGE(PG8_SB(1, 0), b3, voffB); PG8_STAGE(PG8_SB(1, 1), b3 + hstep, voffB); PG8_STAGE(PG8_SA(1, 0), a3, voffA);
            PG8_WAIT_V(8); PG8_WAIT_L(0); PG8_BAR; PG8_MMA(1, 0, At, B0); PG8_MMA(1, 1, At, B1); PG8_BAR; PG8_SCHED;
            } else {
            PG8_LDB(B0, 0, 0); PG8_SCHED; PG8_LDA(At, 0, 0); PG8_STAGE(PG8_SA(1, 1), a1 + hstep, voffA);
            PG8_WAIT_L(8); PG8_BAR; PG8_WAIT_L(0); PG8_MMA(0, 0, At, B0); PG8_BAR; PG8_SCHED;
            PG8_LDB(B1, 0, 1); PG8_STAGE(PG8_SB(0, 0), b2, voffB);
            PG8_BAR; PG8_WAIT_L(0); PG8_MMA(0, 1, At, B1); PG8_BAR;
            PG8_LDA(At, 0, 1); PG8_STAGE(PG8_SA(0, 0), a2, voffA);
            PG8_BAR; PG8_WAIT_L(0); PG8_MMA(1, 0, At, B0); PG8_BAR; PG8_SCHED;
            PG8_STAGE(PG8_SB(0, 1), b2 + hstep, voffB);
            PG8_WAIT_V(6); PG8_BAR; PG8_MMA(1, 1, At, B1); PG8_BAR;
            PG8_LDB(B0, 1, 0); PG8_SCHED; PG8_LDA(At, 1, 0); PG8_STAGE(PG8_SA(0, 1), a2 + hstep, voffA);
            PG8_WAIT_L(8); PG8_BAR; PG8_WAIT_L(0); PG8_MMA(0, 0, At, B0); PG8_BAR; PG8_SCHED;
            PG8_LDB(B1, 1, 1); PG8_STAGE(PG8_SB(1, 0), b3, voffB);
            PG8_BAR; PG8_WAIT_L(0); PG8_MMA(0, 1, At, B1); PG8_BAR;
            PG8_LDA(At, 1, 1); PG8_STAGE(PG8_SA(1, 0), a3, voffA);
            PG8_BAR; PG8_WAIT_L(0); PG8_MMA(1, 0, At, B0); PG8_BAR; PG8_SCHED;
            PG8_STAGE(PG8_SB(1, 1), b3 + hstep, voffB);
            PG8_WAIT_V(6); PG8_BAR; PG8_MMA(1, 1, At, B1); PG8_BAR;
            }
        }
        if constexpr (ALIGN_EPI) { if (wr == 0) PG8_BAR; }
        E(acc, cur, wr, wc, fr, fq);
        if (!has_next) break;
#pragma unroll
        for (int a = 0; a < 2; ++a)
#pragma unroll
            for (int b = 0; b < 2; ++b)
#pragma unroll
                for (int m = 0; m < 4; ++m)
#pragma unroll
                    for (int n = 0; n < 2; ++n) acc[a][b][m][n] = (f32x4){0.f, 0.f, 0.f, 0.f};
        cur = nxt; cA = nA; cB = nB; ++ui;
        if constexpr (ALIGN_EPI) { if (wr == 1) PG8_BAR; }
    }
    PG8_WAIT_V(0);
    if constexpr (!ALIGN_EPI) { if (wr == 0) PG8_BAR; }
    PG8_BAR;
#undef PG8_SA
#undef PG8_SB
#undef PG8_STAGE
#undef PG8_LDA
#undef PG8_LDB
#undef PG8_MMA
#undef PG8_WAIT_V
#undef PG8_WAIT_L
#undef PG8_BAR
#undef PG8_SCHED
}


__host__ __device__ __forceinline__ int iperm32(int c) { return 16 * ((c >> 2) & 1) + 4 * (c >> 3) + (c & 3); }
struct MoeDirect {
    int nunits, NT, G, c; const LAS int* tab;
    const float* W0; const float* W1; size_t estride; int cols_per_tile, half1_off;
    __device__ bool next(int i, Unit& u) const {
        const long L = (long)i * G + c; if (L >= nunits) return false;
        u.pm = (int)L / NT; u.pn = (int)L % NT; u.ex = tab[u.pm];
        const int rem = tab[200 + u.ex] - (u.pm - tab[128 + u.ex]) * 256; u.rows = rem < 256 ? rem : 256; return true;
    }
    __device__ __forceinline__ const float* bptr(const Unit& u, int h) const { return (h ? W1 + half1_off : W0) + (size_t)u.ex * estride + (size_t)u.pn * cols_per_tile; }
};
template <class Epi, bool GATHER>
__device__ __forceinline__ void gemm_phase_moe(LAS unsigned char* lds, const int K_, const int ldw_, const MoeDirect& S, const Epi& E, const bf16* Abase, const int* LIST, const int tid, const int wid) {
    const int wr = wid >> 2, wc = wid & 3;
#define MO_LANE_CONSTS(tl) const int lane = (tl) & 63, fr = lane & 15, fq = lane >> 4; \
    const int aoff = lds_byte(wr * 64 + fr, fq * 8), boff = lds_byte(wc * 32 + fr, fq * 8); \
    const int kq = lane & 7, ng = 8 * wc + (lane >> 3); \
    const unsigned bvoff = (unsigned)((4 * kq) * ldw + 4 * ng) * 4u; \
    const int bslot0 = Epi::PERM ? (((4 * ng) & ~31) + iperm32((4 * ng) & 31)) : 4 * ng; \
    const unsigned bwbase = (unsigned)lds_byte(bslot0, 4 * kq)
    int K = K_; asm volatile("" : "+s"(K));
    int ldw = ldw_; asm volatile("" : "+s"(ldw));
    const int nt = K / BK;
    const unsigned ldsw = (unsigned)wid * 1024u;
    const size_t bkstep = (size_t)64 * ldw * 4, browb = (size_t)ldw * 4;
    f32x4 br[4];
#define MO_SA(b, h) (((b) * 2 + (h)) * HTB)
#define MO_SB(b, h) ((4 + (b) * 2 + (h)) * HTB)
#define MO_STAGE_A(bufoff, basep, o0, o1) do { \
        __builtin_amdgcn_global_load_lds((const unsigned*)((const char*)(basep) + (o0)), (LAS unsigned*)(lds + (bufoff) + ldsw), 16, 0, 0); \
        __builtin_amdgcn_global_load_lds((const unsigned*)((const char*)(basep) + (o1)), (LAS unsigned*)(lds + (bufoff) + ldsw + 8192), 16, 0, 0); } while (0)
#define MO_BISSUE(p, R) do { const char* _p = (const char*)(p) + (size_t)(32 * (R)) * browb; _Pragma("unroll") for (int _j = 0; _j < 4; ++_j) \
        asm volatile("global_load_dwordx4 %0, %1, %2" : "=v"(br[_j]) : "v"(bvoff), "s"(_p + (size_t)_j * browb) : "memory"); } while (0)
#define MO_VWAIT0() asm volatile("s_waitcnt vmcnt(0)" : "+v"(br[0]), "+v"(br[1]), "+v"(br[2]), "+v"(br[3]) :: "memory")
#define MO_BWRITE(b, R) do { _Pragma("unroll") for (int _i = 0; _i < 4; ++_i) { u32x2 _o; _o.x = cvtpk(br[0][_i], br[1][_i]); _o.y = cvtpk(br[2][_i], br[3][_i]); \
        *(LAS u32x2*)(lds + MO_SB(b, wr) + bwbase + 1024 * (R) + 64 * _i) = _o; } } while (0)
#define MO_LDA(dst, b, h) do { _Pragma("unroll") for (int m = 0; m < 4; ++m) _Pragma("unroll") for (int k = 0; k < 2; ++k) dst[m][k] = *(const LAS bf16x8*)(lds + MO_SA(b, h) + aoff + m * 2048 + k * 1024); } while (0)
#define MO_LDB(dst, b, h) do { _Pragma("unroll") for (int n = 0; n < 2; ++n) _Pragma("unroll") for (int k = 0; k < 2; ++k) dst[n][k] = *(const LAS bf16x8*)(lds + MO_SB(b, h) + boff + n * 2048 + k * 1024); } while (0)
#define MO_MMA(ai, bj, At, Bt) do { __builtin_amdgcn_s_setprio(1); _Pragma("unroll") for (int m = 0; m < 4; ++m) _Pragma("unroll") for (int n = 0; n < 2; ++n) _Pragma("unroll") for (int k = 0; k < 2; ++k) \
        acc[ai][bj][m][n] = __builtin_amdgcn_mfma_f32_16x16x32_bf16(Bt[n][k], At[m][k], acc[ai][bj][m][n], 0, 0, 0); __builtin_amdgcn_s_setprio(0); } while (0)
#define MO_WAIT_L(n) asm volatile("s_waitcnt lgkmcnt(" #n ")" ::: "memory")
#define MO_BAR __builtin_amdgcn_s_barrier()
#define MO_SCHED __builtin_amdgcn_sched_barrier(0)
#define MO_AOFF(u, dst) do { _Pragma("unroll") for (int _i = 0; _i < 2; ++_i) { int _R, _C; stage_rc(tid * 16 + _i * 8192, _R, _C); _Pragma("unroll") for (int _h = 0; _h < 2; ++_h) { const int _r = 128 * _h + _R; \
        if (GATHER) { const int _p = ((u).pm - S.tab[128 + (u).ex]) * 256 + _r; const int _t = (_r < (u).rows) ? LIST[(size_t)(u).ex * 8192 + _p] : 0; dst[_h][_i] = (unsigned)(_t * K + _C) * 2u; } \
        else dst[_h][_i] = (unsigned)(_r * K + _C) * 2u; } } } while (0)
    Unit cur, nxt; int ui = 0;
    if (!S.next(0, cur)) return;
    f32x4 acc[2][2][4][2];
#pragma unroll
    for (int a = 0; a < 2; ++a)
#pragma unroll
        for (int b = 0; b < 2; ++b)
#pragma unroll
            for (int m = 0; m < 4; ++m)
#pragma unroll
                for (int n = 0; n < 2; ++n) acc[a][b][m][n] = (f32x4){0.f, 0.f, 0.f, 0.f};
    bf16x8 At[4][2], B0[2][2], B1[2][2];
    unsigned cAo[2][2];
    LAS u32x4* const aslot = (LAS u32x4*)(lds + STAGE_BYTES) + tid;
    MO_AOFF(cur, cAo);
    const char* cAb = GATHER ? (const char*)Abase : (const char*)Abase + (size_t)cur.pm * 256 * K * 2;
    const char* cBh = (const char*)S.bptr(cur, wr);
    { MO_LANE_CONSTS(tid);
    MO_BISSUE(cBh, 0); MO_STAGE_A(MO_SA(0, 0), cAb, cAo[0][0], cAo[0][1]); MO_STAGE_A(MO_SA(0, 1), cAb, cAo[1][0], cAo[1][1]);
    if (wr == 1) MO_BAR;
    MO_VWAIT0(); MO_BWRITE(0, 0); MO_BISSUE(cBh, 1);
    MO_VWAIT0(); MO_BWRITE(0, 1);
    MO_WAIT_L(0); MO_BAR;
    MO_BISSUE(cBh + bkstep, 0); MO_STAGE_A(MO_SA(1, 0), cAb + 128, cAo[0][0], cAo[0][1]);
    MO_VWAIT0(); MO_BWRITE(1, 0); MO_BISSUE(cBh + bkstep, 1);
    MO_WAIT_L(0); MO_BAR; }
    for (;;) {
        const bool has_next = S.next(ui + 1, nxt);
        const char* nAb = cAb; const char* nBh = cBh;
        if (has_next) { nAb = GATHER ? (const char*)Abase : (const char*)Abase + (size_t)nxt.pm * 256 * K * 2; nBh = (const char*)S.bptr(nxt, wr);
            if (GATHER) { unsigned nAo[2][2]; MO_AOFF(nxt, nAo); *aslot = (u32x4){nAo[0][0], nAo[0][1], nAo[1][0], nAo[1][1]}; } }
        const bool halfu = cur.rows <= 128;
        for (int t = 0; t < nt; t += 2) {
            int tl = tid; asm volatile("" : "+v"(tl)); MO_LANE_CONSTS(tl);
            const bool last = (t == nt - 2);
            const char* a1 = cAb + (size_t)(t + 1) * 128;
            const char* a2 = last ? nAb : cAb + (size_t)(t + 2) * 128; const char* a3 = a2 + 128;
            const char* b2 = last ? nBh : cBh + (size_t)(t + 2) * bkstep; const char* b3 = b2 + bkstep;
            MO_LDB(B0, 0, 0); MO_LDB(B1, 0, 1); MO_SCHED; MO_LDA(At, 0, 0);
            MO_VWAIT0(); MO_BWRITE(1, 1); MO_STAGE_A(MO_SA(1, 1), a1, cAo[1][0], cAo[1][1]); MO_BISSUE(b2, 0);
            if (GATHER && last && has_next) { const u32x4 _n = *aslot; cAo[0][0] = _n.x; cAo[0][1] = _n.y; cAo[1][0] = _n.z; cAo[1][1] = _n.w; }
            MO_WAIT_L(0); MO_BAR; MO_MMA(0, 0, At, B0); MO_MMA(0, 1, At, B1); MO_BAR; MO_SCHED;
            MO_LDA(At, 0, 1);
            MO_VWAIT0(); MO_BWRITE(0, 0); MO_STAGE_A(MO_SA(0, 0), a2, cAo[0][0], cAo[0][1]); MO_BISSUE(b2, 1);
            MO_WAIT_L(0); MO_BAR; if (!halfu) { MO_MMA(1, 0, At, B0); MO_MMA(1, 1, At, B1); } MO_BAR; MO_SCHED;
            MO_LDB(B0, 1, 0); MO_LDB(B1, 1, 1); MO_SCHED; MO_LDA(At, 1, 0);
            MO_VWAIT0(); MO_BWRITE(0, 1); MO_STAGE_A(MO_SA(0, 1), a2, cAo[1][0], cAo[1][1]); MO_BISSUE(b3, 0);
            MO_WAIT_L(0); MO_BAR; MO_MMA(0, 0, At, B0); MO_MMA(0, 1, At, B1); MO_BAR; MO_SCHED;
            MO_LDA(At, 1, 1);
            MO_VWAIT0(); MO_BWRITE(1, 0); MO_STAGE_A(MO_SA(1, 0), a3, cAo[0][0], cAo[0][1]); MO_BISSUE(b3, 1);
            MO_WAIT_L(0); MO_BAR; if (!halfu) { MO_MMA(1, 0, At, B0); MO_MMA(1, 1, At, B1); } MO_BAR; MO_SCHED;
        }
        if (wr == 0) MO_BAR;
        { const int lane = tid & 63; E(acc, cur, wr, wc, lane & 15, lane >> 4); }
        if (!has_next) break;
#pragma unroll
        for (int a = 0; a < 2; ++a)
#pragma unroll
            for (int b = 0; b < 2; ++b)
#pragma unroll
                for (int m = 0; m < 4; ++m)
#pragma unroll
                    for (int n = 0; n < 2; ++n) acc[a][b][m][n] = (f32x4){0.f, 0.f, 0.f, 0.f};
        cur = nxt; cAb = nAb; cBh = nBh; ++ui;
        if (wr == 1) MO_BAR;
    }
    MO_VWAIT0();
    MO_BAR;
#undef MO_SA
#undef MO_SB
#undef MO_STAGE_A
#undef MO_BISSUE
#undef MO_VWAIT0
#undef MO_BWRITE
#undef MO_LDA
#undef MO_LDB
#undef MO_MMA
#undef MO_WAIT_L
#undef MO_BAR
#undef MO_SCHED
#undef MO_AOFF
#undef MO_LANE_CONSTS
}

template <class Epi, bool GATHER>
__device__ __forceinline__ void gemm_phase_moe32(LAS unsigned char* lds, const int K_, const int ldw_, const MoeDirect& S, const Epi& E, const bf16* Abase, const int* LIST, const int tid, const int wid) {
    const int wr = wid >> 2, wc = wid & 3;
#define MO_LANE_CONSTS(tl) const int lane = (tl) & 63, fr = lane & 15, fq = lane >> 4; \
    const int aoff = lds_byte(wr * 64 + fr, fq * 8), boff = lds_byte(wc * 32 + fr, fq * 8); \
    const int kq = lane & 7, ng = 8 * wc + (lane >> 3); \
    const unsigned bvoff = (unsigned)((4 * kq) * ldw + 4 * ng) * 4u; \
    const int bslot0 = Epi::PERM ? (((4 * ng) & ~31) + iperm32((4 * ng) & 31)) : 4 * ng; \
    const unsigned bwbase = (unsigned)lds_byte(bslot0, 4 * kq)
    int K = K_; asm volatile("" : "+s"(K));
    int ldw = ldw_; asm volatile("" : "+s"(ldw));
    const int nt = K / BK;
    const unsigned ldsw = (unsigned)wid * 1024u;
    const size_t bkstep = (size_t)64 * ldw * 4, browb = (size_t)ldw * 4;
    f32x4 br[8];
#define MO_SA(b, h) (((b) * 2 + (h)) * HTB)
#define MO_SB(b, h) ((4 + (b) * 2 + (h)) * HTB)
#define MO_STAGE_A(bufoff, basep, o0, o1) do { \
        __builtin_amdgcn_global_load_lds((const unsigned*)((const char*)(basep) + (o0)), (LAS unsigned*)(lds + (bufoff) + ldsw), 16, 0, 0); \
        __builtin_amdgcn_global_load_lds((const unsigned*)((const char*)(basep) + (o1)), (LAS unsigned*)(lds + (bufoff) + ldsw + 8192), 16, 0, 0); } while (0)
#define MO_BISSUE(p) do { const char* _p = (const char*)(p); _Pragma("unroll") for (int _j = 0; _j < 8; ++_j) \
        asm volatile("global_load_dwordx4 %0, %1, %2" : "=v"(br[_j]) : "v"(bvoff), "s"(_p + (size_t)(32 * (_j >> 2) + (_j & 3)) * browb) : "memory"); } while (0)
#define MO_BWAIT(n) asm volatile("s_waitcnt vmcnt(" #n ")" : "+v"(br[0]), "+v"(br[1]), "+v"(br[2]), "+v"(br[3]), "+v"(br[4]), "+v"(br[5]), "+v"(br[6]), "+v"(br[7]) :: "memory")
#define MO_WAIT_V(n) asm volatile("s_waitcnt vmcnt(" #n ")" ::: "memory")
#define MO_BWRITE(b) do { _Pragma("unroll") for (int _R = 0; _R < 2; ++_R) _Pragma("unroll") for (int _i = 0; _i < 4; ++_i) { u32x2 _o; \
        _o.x = cvtpk(br[4 * _R][_i], br[4 * _R + 1][_i]); _o.y = cvtpk(br[4 * _R + 2][_i], br[4 * _R + 3][_i]); \
        *(LAS u32x2*)(lds + MO_SB(b, wr) + bwbase + 1024 * _R + 64 * _i) = _o; } } while (0)
#define MO_LDA(dst, b, h) do { _Pragma("unroll") for (int m = 0; m < 4; ++m) _Pragma("unroll") for (int k = 0; k < 2; ++k) dst[m][k] = *(const LAS bf16x8*)(lds + MO_SA(b, h) + aoff + m * 2048 + k * 1024); } while (0)
#define MO_LDB(dst, b, h) do { _Pragma("unroll") for (int n = 0; n < 2; ++n) _Pragma("unroll") for (int k = 0; k < 2; ++k) dst[n][k] = *(const LAS bf16x8*)(lds + MO_SB(b, h) + boff + n * 2048 + k * 1024); } while (0)
#define MO_MMA(ai, bj, At, Bt) do { __builtin_amdgcn_s_setprio(1); _Pragma("unroll") for (int m = 0; m < 4; ++m) _Pragma("unroll") for (int n = 0; n < 2; ++n) _Pragma("unroll") for (int k = 0; k < 2; ++k) \
        acc[ai][bj][m][n] = __builtin_amdgcn_mfma_f32_16x16x32_bf16(Bt[n][k], At[m][k], acc[ai][bj][m][n], 0, 0, 0); __builtin_amdgcn_s_setprio(0); } while (0)
#define MO_WAIT_L(n) asm volatile("s_waitcnt lgkmcnt(" #n ")" ::: "memory")
#define MO_BAR __builtin_amdgcn_s_barrier()
#define MO_SCHED __builtin_amdgcn_sched_barrier(0)
#define MO_AOFF(u, dst) do { _Pragma("unroll") for (int _i = 0; _i < 2; ++_i) { int _R, _C; stage_rc(tid * 16 + _i * 8192, _R, _C); _Pragma("unroll") for (int _h = 0; _h < 2; ++_h) { const int _r = 128 * _h + _R; \
        if (GATHER) { const int _p = ((u).pm - S.tab[128 + (u).ex]) * 256 + _r; const int _t = (_r < (u).rows) ? LIST[(size_t)(u).ex * 8192 + _p] : 0; dst[_h][_i] = (unsigned)(_t * K + _C) * 2u; } \
        else dst[_h][_i] = (unsigned)(_r * K + _C) * 2u; } } } while (0)
    Unit cur, nxt; int ui = 0;
    if (!S.next(0, cur)) return;
    f32x4 acc[2][2][4][2];
#pragma unroll
    for (int a = 0; a < 2; ++a)
#pragma unroll
        for (int b = 0; b < 2; ++b)
#pragma unroll
            for (int m = 0; m < 4; ++m)
#pragma unroll
                for (int n = 0; n < 2; ++n) acc[a][b][m][n] = (f32x4){0.f, 0.f, 0.f, 0.f};
    bf16x8 At[4][2], B0[2][2], B1[2][2];
    unsigned cAo[2][2];
    LAS u32x4* const aslot = (LAS u32x4*)(lds + STAGE_BYTES) + tid;
    MO_AOFF(cur, cAo);
    const char* cAb = GATHER ? (const char*)Abase : (const char*)Abase + (size_t)cur.pm * 256 * K * 2;
    const char* cBh = (const char*)S.bptr(cur, wr);
    { MO_LANE_CONSTS(tid);
    MO_BISSUE(cBh); MO_STAGE_A(MO_SA(0, 0), cAb, cAo[0][0], cAo[0][1]); MO_STAGE_A(MO_SA(0, 1), cAb, cAo[1][0], cAo[1][1]);
    if (wr == 1) MO_BAR;
    MO_BWAIT(4); MO_BWRITE(0);
    MO_WAIT_V(0); MO_WAIT_L(0); MO_BAR;
    MO_STAGE_A(MO_SA(1, 0), cAb + 128, cAo[0][0], cAo[0][1]); MO_BISSUE(cBh + bkstep);
    MO_BAR; }
    for (;;) {
        const bool has_next = S.next(ui + 1, nxt);
        const char* nAb = cAb; const char* nBh = cBh;
        if (has_next) { nAb = GATHER ? (const char*)Abase : (const char*)Abase + (size_t)nxt.pm * 256 * K * 2; nBh = (const char*)S.bptr(nxt, wr);
            if (GATHER) { unsigned nAo[2][2]; MO_AOFF(nxt, nAo); *aslot = (u32x4){nAo[0][0], nAo[0][1], nAo[1][0], nAo[1][1]}; } }
        const bool halfu = cur.rows <= 128;
        for (int t = 0; t < nt; t += 2) {
            int tl = tid; asm volatile("" : "+v"(tl)); MO_LANE_CONSTS(tl);
            const bool last = (t == nt - 2);
            const char* a1 = cAb + (size_t)(t + 1) * 128;
            const char* a2 = last ? nAb : cAb + (size_t)(t + 2) * 128; const char* a3 = a2 + 128;
            const char* b2 = last ? nBh : cBh + (size_t)(t + 2) * bkstep; const char* b3 = b2 + bkstep;
            MO_LDB(B0, 0, 0); MO_LDB(B1, 0, 1); MO_SCHED; MO_LDA(At, 0, 0); MO_STAGE_A(MO_SA(1, 1), a1, cAo[1][0], cAo[1][1]);
            MO_WAIT_V(12); MO_WAIT_L(0); MO_BAR; MO_MMA(0, 0, At, B0); MO_MMA(0, 1, At, B1); MO_BAR; MO_SCHED;
            if (GATHER && last && has_next) { const u32x4 _n = *aslot; cAo[0][0] = _n.x; cAo[0][1] = _n.y; cAo[1][0] = _n.z; cAo[1][1] = _n.w; }
            MO_LDA(At, 0, 1); MO_BWAIT(2); MO_BWRITE(1); MO_STAGE_A(MO_SA(0, 0), a2, cAo[0][0], cAo[0][1]); MO_BISSUE(b2);
            MO_WAIT_L(0); MO_BAR; if (!halfu) { MO_MMA(1, 0, At, B0); MO_MMA(1, 1, At, B1); } MO_BAR; MO_SCHED;
            MO_LDB(B0, 1, 0); MO_LDB(B1, 1, 1); MO_SCHED; MO_LDA(At, 1, 0); MO_STAGE_A(MO_SA(0, 1), a2, cAo[1][0], cAo[1][1]);
            MO_WAIT_V(12); MO_WAIT_L(0); MO_BAR; MO_MMA(0, 0, At, B0); MO_MMA(0, 1, At, B1); MO_BAR; MO_SCHED;
            MO_LDA(At, 1, 1); MO_BWAIT(2); MO_BWRITE(0); MO_STAGE_A(MO_SA(1, 0), a3, cAo[0][0], cAo[0][1]); MO_BISSUE(b3);
            MO_WAIT_L(0); MO_BAR; if (!halfu) { MO_MMA(1, 0, At, B0); MO_MMA(1, 1, At, B1); } MO_BAR; MO_SCHED;
        }
        if (wr == 0) MO_BAR;
        { const int lane = tid & 63; E(acc, cur, wr, wc, lane & 15, lane >> 4); }
        if (!has_next) break;
#pragma unroll
        for (int a = 0; a < 2; ++a)
#pragma unroll
            for (int b = 0; b < 2; ++b)
#pragma unroll
                for (int m = 0; m < 4; ++m)
#pragma unroll
                    for (int n = 0; n < 2; ++n) acc[a][b][m][n] = (f32x4){0.f, 0.f, 0.f, 0.f};
        cur = nxt; cAb = nAb; cBh = nBh; ++ui;
        if (wr == 1) MO_BAR;
    }
    MO_BWAIT(0);
    MO_BAR;
#undef MO_SA
#undef MO_SB
#undef MO_STAGE_A
#undef MO_BISSUE
#undef MO_BWAIT
#undef MO_WAIT_V
#undef MO_BWRITE
#undef MO_LDA
#undef MO_LDB
#undef MO_MMA
#undef MO_WAIT_L
#undef MO_BAR
#undef MO_SCHED
#undef MO_AOFF
#undef MO_LANE_CONSTS
}


typedef const f32x4 (&AccRef)[2][2][4][2];
DI u32x4 pack8(const f32x4& v0, const f32x4& v1) { u32x4 w; w.x = cvtpk(v0[0], v0[1]); w.y = cvtpk(v0[2], v0[3]); w.z = cvtpk(v1[0], v1[1]); w.w = cvtpk(v1[2], v1[3]); return w; }

struct EpiBf16 {
    static constexpr bool PERM = true;
    bf16* O; int ldc;
    DI void operator()(AccRef acc, const Unit& u, int wr, int wc, int fr, int fq) const {
        const int row0 = u.pm * BM + wr * 64 + fr, col0 = u.pn * BM + wc * 32 + 8 * fq;
#pragma unroll
        for (int ai = 0; ai < 2; ++ai)
#pragma unroll
            for (int m = 0; m < 4; ++m) { bf16* rowp = O + (size_t)(row0 + ai * HALF + m * 16) * ldc + col0;
#pragma unroll
                for (int bj = 0; bj < 2; ++bj) *(u32x4*)(rowp + bj * HALF) = pack8(acc[ai][bj][m][0], acc[ai][bj][m][1]); }
    }
};
struct EpiF32 {
    static constexpr bool PERM = false;
    float* C; int ldc;
    DI void operator()(AccRef acc, const Unit& u, int wr, int wc, int fr, int fq) const {
        const int row0 = u.pm * BM + wr * 64 + fr, col0 = u.pn * BM + wc * 32 + 4 * fq;
#pragma unroll
        for (int ai = 0; ai < 2; ++ai)
#pragma unroll
            for (int m = 0; m < 4; ++m) { float* rowp = C + (size_t)(row0 + ai * HALF + m * 16) * ldc + col0;
#pragma unroll
                for (int bj = 0; bj < 2; ++bj)
#pragma unroll
                    for (int n = 0; n < 2; ++n) *(f32x4*)(rowp + bj * HALF + n * 16) = acc[ai][bj][m][n]; }
    }
};
struct EpiInProj {
    static constexpr bool PERM = true;
    bf16* P; float* PBA;
    DI void operator()(AccRef acc, const Unit& u, int wr, int wc, int fr, int fq) const {
        const int row0 = u.pm * BM + wr * 64 + fr;
        if (u.pn < 28) {
            const int col0 = u.pn * BM + wc * 32 + 8 * fq;
#pragma unroll
            for (int ai = 0; ai < 2; ++ai)
#pragma unroll
                for (int m = 0; m < 4; ++m) { bf16* rowp = P + (size_t)(row0 + ai * HALF + m * 16) * NP + col0;
#pragma unroll
                    for (int bj = 0; bj < 2; ++bj) *(u32x4*)(rowp + bj * HALF) = pack8(acc[ai][bj][m][0], acc[ai][bj][m][1]); }
        } else if (wc == 0 && fq < 2) {
#pragma unroll
            for (int ai = 0; ai < 2; ++ai)
#pragma unroll
                for (int m = 0; m < 4; ++m) { float* rp = PBA + (size_t)(row0 + ai * HALF + m * 16) * 16 + 8 * fq;
                    *(f32x4*)rp = acc[ai][0][m][0]; *(f32x4*)(rp + 4) = acc[ai][0][m][1]; }
        }
    }
};
struct EpiResid {
    static constexpr bool PERM = false;
    const float* x; const float* g; float* R;
    DI void operator()(AccRef acc, const Unit& u, int wr, int wc, int fr, int fq) const {
        const int row0 = u.pm * BM + wr * 64 + fr, col0 = u.pn * BM + wc * 32 + 4 * fq;
        const float* gb = g + (size_t)((u.pm * BM) / SEQ) * 12288 + col0;
        f32x4 gv[2][2];
#pragma unroll
        for (int bj = 0; bj < 2; ++bj)
#pragma unroll
            for (int n = 0; n < 2; ++n) gv[bj][n] = *(const f32x4*)(gb + bj * HALF + n * 16) + 1.0f;
#pragma unroll
        for (int ai = 0; ai < 2; ++ai)
#pragma unroll
            for (int m = 0; m < 4; ++m) { const size_t off = (size_t)(row0 + ai * HALF + m * 16) * D + col0;
#pragma unroll
                for (int bj = 0; bj < 2; ++bj)
#pragma unroll
                    for (int n = 0; n < 2; ++n) { const f32x4 xv = *(const f32x4*)(x + off + bj * HALF + n * 16);
                        *(f32x4*)(R + off + bj * HALF + n * 16) = xv * DN_ALPHA + gv[bj][n] * acc[ai][bj][m][n]; } }
    }
};
struct EpiLogits {
    static constexpr bool PERM = false;
    float* L;
    DI void operator()(AccRef acc, const Unit& u, int wr, int wc, int fr, int fq) const {
        const int row0 = u.pm * BM + wr * 64 + fr, col0 = wc * 32 + 4 * fq;
#pragma unroll
        for (int ai = 0; ai < 2; ++ai)
#pragma unroll
            for (int m = 0; m < 4; ++m) { float* rowp = L + (size_t)(row0 + ai * HALF + m * 16) * 128 + col0;
#pragma unroll
                for (int n = 0; n < 2; ++n) *(f32x4*)(rowp + n * 16) = acc[ai][0][m][n]; }
    }
};
struct EpiGateUp {
    static constexpr bool PERM = true;
    bf16* H;
    DI void operator()(AccRef acc, const Unit& u, int wr, int wc, int fr, int fq) const {
        const int row0 = u.pm * BM + wr * 64 + fr, col0 = u.pn * HALF + wc * 32 + 8 * fq;
#pragma unroll
        for (int ai = 0; ai < 2; ++ai)
#pragma unroll
            for (int m = 0; m < 4; ++m) { bf16* rowp = H + (size_t)(row0 + ai * HALF + m * 16) * FF + col0;
                f32x4 h0, h1;
#pragma unroll
                for (int j = 0; j < 4; ++j) { h0[j] = silu_f(acc[ai][0][m][0][j]) * acc[ai][1][m][0][j]; h1[j] = silu_f(acc[ai][0][m][1][j]) * acc[ai][1][m][1][j]; }
                *(u32x4*)rowp = pack8(h0, h1); }
    }
};
struct EpiQup {
    static constexpr bool PERM = true;
    bf16* Q;
    DI void operator()(AccRef acc, const Unit& u, int wr, int wc, int fr, int fq) const {
        const int row0 = u.pm * BM + wr * 64 + fr, b = (u.pm * BM) / SEQ, s0 = row0 - b * SEQ;
        const int cg0 = u.pn * BM + wc * 32 + 8 * fq, cg1 = cg0 + HALF;
        const int h0 = cg0 / QD, w0 = cg0 - h0 * QD, h1 = cg1 / QD, w1 = cg1 - h1 * QD;
        bf16* d0 = Q + ((size_t)((b * MH + h0) * SEQ + s0)) * QD + w0; bf16* d1 = Q + ((size_t)((b * MH + h1) * SEQ + s0)) * QD + w1;
#pragma unroll
        for (int ai = 0; ai < 2; ++ai)
#pragma unroll
            for (int m = 0; m < 4; ++m) { const int dr = (ai * HALF + m * 16) * QD;
                *(u32x4*)(d0 + dr) = pack8(acc[ai][0][m][0] * QSCALE, acc[ai][0][m][1] * QSCALE);
                *(u32x4*)(d1 + dr) = pack8(acc[ai][1][m][0] * QSCALE, acc[ai][1][m][1] * QSCALE);
                asm volatile("" ::: "memory"); }
    }
};
struct EpiKVup {
    static constexpr bool PERM = true;
    bf16* Kp; bf16* V;
    DI void operator()(AccRef acc, const Unit& u, int wr, int wc, int fr, int fq) const {
        const int row0 = u.pm * BM + wr * 64 + fr, c0 = wc * 32 + 8 * fq, head = u.pn, b = (u.pm * BM) / SEQ, s0 = row0 - b * SEQ;
        bf16* dk = Kp + ((size_t)((b * MH + head) * SEQ + s0)) * QD + c0; bf16* dv = V + (size_t)row0 * D + head * 128 + c0;
#pragma unroll
        for (int ai = 0; ai < 2; ++ai)
#pragma unroll
            for (int m = 0; m < 4; ++m) { const int dr = ai * HALF + m * 16;
                *(u32x4*)(dk + dr * QD) = pack8(acc[ai][0][m][0], acc[ai][0][m][1]);
                *(u32x4*)(dv + dr * D) = pack8(acc[ai][1][m][0], acc[ai][1][m][1]);
                asm volatile("" ::: "memory"); }
    }
};
}

#define XB_TMO      128
#define XB_XCNT(j)  (256  + 64 * (j))
#define XB_XSUB(j)  (1280 + 64 * (j))
#define XB_XGEN(j)  (2304 + 64 * (j))
#define XB_TOP      3328
#define XB_TOPGEN   3392
#define XCD_BAR_WORDS 3456
#define XB_SPIN_CAP (1u << 18)
__device__ __forceinline__ unsigned xb_ld(unsigned* p)              { return __hip_atomic_load(p, __ATOMIC_RELAXED, __HIP_MEMORY_SCOPE_AGENT); }
__device__ __forceinline__ unsigned xb_add(unsigned* p, unsigned v) { return __hip_atomic_fetch_add(p, v, __ATOMIC_RELAXED, __HIP_MEMORY_SCOPE_AGENT); }
__device__ __forceinline__ unsigned xb_xcc_id() { return (unsigned)__builtin_amdgcn_s_getreg((3 << 11) | 20) & 0xFu; }
#define XB_SPIN(cond, bar) do { unsigned _sp = 0; while (cond) { __builtin_amdgcn_s_sleep(1); \
    if ((++_sp & 255u) == 0u) { if (xb_ld(&(bar)[XB_TMO])) break; if (_sp > XB_SPIN_CAP) { atomicAdd(&(bar)[XB_TMO], 1u); break; } } } } while (0)
struct XcdBarrier { unsigned* bar; unsigned x; volatile LAS unsigned* st; };
__device__ __forceinline__ XcdBarrier xcd_barrier_post(unsigned* bar, volatile LAS unsigned* st, const bool leader  ) {
    XcdBarrier b; b.bar = bar; b.x = xb_xcc_id(); b.st = st;
    if (leader) (void)xb_add(&bar[XB_XCNT(b.x)], 1u);
    return b;
}
__device__ __forceinline__ void xcd_barrier_complete(unsigned* bar, unsigned x, unsigned& nloc, unsigned& nx) {
    const unsigned G = gridDim.x * gridDim.y * gridDim.z;
    unsigned sum, cnt, mine, sp = 0u;
    for (;;) {
        sum = 0u; cnt = 0u; mine = 0u;
#pragma unroll
        for (unsigned j = 0; j < 16; ++j) { const unsigned c = xb_ld(&bar[XB_XCNT(j)]); sum += c; cnt += (c > 0u) ? 1u : 0u; mine = (j == x) ? c : mine; }
        if (sum == G) break;
        __builtin_amdgcn_s_sleep(1);
        if ((++sp & 255u) == 0u) { if (xb_ld(&bar[XB_TMO])) break; if (sp > XB_SPIN_CAP) { atomicAdd(&bar[XB_TMO], 1u); break; } }
    }
    nloc = mine > 0u ? mine : 1u; nx = cnt > 0u ? cnt : 1u;
}
__device__ __forceinline__ void xcd_barrier(const XcdBarrier& b, const bool leader  ) {
    asm volatile("s_waitcnt vmcnt(0)" ::: "memory");
    __syncthreads();
    if (leader) {
        unsigned* bar = b.bar;
        __builtin_amdgcn_s_waitcnt(0);
        unsigned nloc = b.st[0], nx = b.st[1];
        if (nloc == 0u) { xcd_barrier_complete(bar, b.x, nloc, nx); b.st[0] = nloc; b.st[1] = nx; }
        const unsigned old = xb_add(&bar[XB_XSUB(b.x)], 1u);
        const unsigned gen = old / nloc;
        if (old + 1u == (gen + 1u) * nloc) {
            __builtin_amdgcn_fence(__ATOMIC_RELEASE, "agent");
            asm volatile("s_waitcnt vmcnt(0)" ::: "memory");
            const unsigned og = xb_add(&bar[XB_TOP], 1u);
            const unsigned tg = og / nx;
            if (og + 1u == (tg + 1u) * nx) xb_add(&bar[XB_TOPGEN], 1u);
            else XB_SPIN(xb_ld(&bar[XB_TOPGEN]) == tg, bar);
            __builtin_amdgcn_fence(__ATOMIC_ACQUIRE, "agent");
            xb_add(&bar[XB_XGEN(b.x)], 1u);
            asm volatile("s_waitcnt vmcnt(0)" ::: "memory");
        } else {
            XB_SPIN(xb_ld(&bar[XB_XGEN(b.x)]) == gen, bar);
            __builtin_amdgcn_fence(__ATOMIC_ACQUIRE, "agent");
            asm volatile("s_waitcnt vmcnt(0)" ::: "memory");
        }
    }
    __syncthreads();
}

struct Frame {
    LAS unsigned char* lds;
    int tid, lane, wave, vcu, G, gw, NGW;
    unsigned* ctl;
};
struct Args { const void* in[27]; float* out; unsigned char* ws; int ph_lo, ph_hi; };

__device__ const double ROPE_INVF[32] = {1, 0.74989420933245587, 0.56234132519034907, 0.42169650342858223, 0.31622776601683794, 0.23713737056616552, 0.17782794100389229, 0.1333521432163324,
    0.10000000000000001, 0.074989420933245579, 0.056234132519034911, 0.042169650342858224, 0.031622776601683791, 0.023713737056616554, 0.017782794100389229, 0.013335214321633241,
    0.01, 0.0074989420933245579, 0.005623413251903491, 0.0042169650342858229, 0.0031622776601683794, 0.0023713737056616554, 0.0017782794100389228, 0.0013335214321633241,
    0.001, 0.00074989420933245586, 0.0005623413251903491, 0.00042169650342858224, 0.00031622776601683794, 0.00023713737056616554, 0.00017782794100389227, 0.0001333521432163324};

struct TrRegs { f32x4 r[8]; };
DI void tr_load(TrRegs& t, const float* W, size_t ld, int k0, int n0, int nvalid, int lane) {
    const int ns = lane & 7, kq = lane >> 3;
    if (4 * ns < nvalid) { const float* src = W + (size_t)(k0 + 8 * kq) * ld + n0 + 4 * ns;
#pragma unroll
        for (int j = 0; j < 8; ++j) t.r[j] = *(const f32x4*)(src + (size_t)j * ld); }
}
DI void tr_store(const TrRegs& t, int k0, int nvalid, bf16* WT, int Kd, int drow0, int lane) {
    const int ns = lane & 7, kq = lane >> 3;
    if (4 * ns < nvalid) { bf16* dst = WT + (size_t)(drow0 + 4 * ns) * Kd + k0 + 8 * kq;
#pragma unroll
        for (int i = 0; i < 4; ++i) { u32x4 o; o.x = cvtpk(t.r[0][i], t.r[1][i]); o.y = cvtpk(t.r[2][i], t.r[3][i]); o.z = cvtpk(t.r[4][i], t.r[5][i]); o.w = cvtpk(t.r[6][i], t.r[7][i]);
            *(u32x4*)(dst + (size_t)i * Kd) = o; } }
}
DI void tr_job(const Frame& F, const int gw, const int NGW, const float* W, size_t smat, int nmat, int ld, int K, int col0, int ncols, bf16* WT, size_t dmat, int Kd, int row_off, int mode) {
    const int nblk = (ncols + 31) / 32, kbs = K / 64, per = nblk * kbs; const long items = (long)nmat * per;
    for (long it0 = gw; it0 < items; it0 += 2 * (long)NGW) {
        TrRegs t[2]; int k0[2], nv[2], dr[2]; bf16* wt[2];
#pragma unroll
        for (int u = 0; u < 2; ++u) {
            const long it = it0 + (long)u * NGW;
            if (it < items) {
                const int mat = (int)(it / per), rem = (int)(it - (long)mat * per), kb = rem / nblk, nb = rem - kb * nblk;
                nv[u] = (ncols - nb * 32) < 32 ? (ncols - nb * 32) : 32; k0[u] = kb * 64;
                dr[u] = (mode == 0) ? (row_off + nb * 32) : ((nb >> 2) * 256 + row_off + (nb & 3) * 32);
                wt[u] = WT + (size_t)mat * dmat;
                tr_load(t[u], W + (size_t)mat * smat, (size_t)ld, k0[u], col0 + nb * 32, nv[u], F.lane);
            } else { nv[u] = 0; k0[u] = 0; dr[u] = 0; wt[u] = WT; }
        }
#pragma unroll
        for (int u = 0; u < 2; ++u) tr_store(t[u], k0[u], nv[u], wt[u], Kd, dr[u], F.lane);
    }
}
DI void zero_fill(const Frame& F, const int gw, const int NGW, void* p, size_t bytes) {
    u32x4* q = (u32x4*)p; const size_t n = bytes / 16;
    for (size_t i = (size_t)gw * 64 + F.lane; i < n; i += (size_t)NGW * 64) q[i] = (u32x4){0u, 0u, 0u, 0u};
}

DI const void* arg_in(int k) { unsigned o = (unsigned)k * 8u; asm volatile("" : "+s"(o));
    const GAS void* p = *(const GAS void* const __attribute__((address_space(4)))*)((const __attribute__((address_space(4))) unsigned char*)__builtin_amdgcn_kernarg_segment_ptr() + o);
    return (const void*)p; }
#define WSB (args.ws)
#define in_x ((const float*)arg_in(0))
#define in_c ((const float*)arg_in(1))
#define in_pos ((const int*)arg_in(2))
#define ada_w ((const float*)arg_in(3))
#define ada_b ((const float*)arg_in(4))
#define ln_g ((const float*)arg_in(5))
#define ln_b ((const float*)arg_in(6))
#define hyb_w_in ((const float*)arg_in(7))
#define gdn_conv_w ((const float*)arg_in(8))
#define gdn_a_log ((const float*)arg_in(9))
#define gdn_dt_bias ((const float*)arg_in(10))
#define gdn_norm_w ((const float*)arg_in(11))
#define sc_conv_w ((const float*)arg_in(12))
#define hyb_w_out ((const float*)arg_in(13))
#define mla_w_in ((const float*)arg_in(14))
#define mla_q_norm ((const float*)arg_in(15))
#define mla_kv_norm ((const float*)arg_in(16))
#define mla_w_uq ((const float*)arg_in(17))
#define mla_w_ukv ((const float*)arg_in(18))
#define mla_w_out ((const float*)arg_in(19))
#define moe_router_g ((const float*)arg_in(20))
#define moe_bias_g ((const float*)arg_in(21))
#define moe_router_e ((const float*)arg_in(22))
#define moe_bias_e ((const float*)arg_in(23))
#define moe_w_gate ((const float*)arg_in(24))
#define moe_w_up ((const float*)arg_in(25))
#define moe_w_down ((const float*)arg_in(26))
#define MOD ((float*)(WSB + WS_MOD))
#define ROPE_C ((float*)(WSB + WS_ROPE))
#define ROPE_S ((float*)(ROPE_C + (size_t)T * 32))
#define PBA ((float*)(WSB + WS_PBA))
#define LOGITS ((float*)(WSB + WS_LOGITS))
#define TOK_E ((int*)(WSB + WS_ROUTE))
#define TOK_POS ((int*)(TOK_E + 2 * T))
#define TOK_GATE ((float*)(TOK_POS + 2 * T))
#define EG ((float*)(WSB + WS_EG))
#define WIN0 ((bf16*)(WSB + WS_WIN0))
#define WOUT0 ((bf16*)(WSB + WS_WOUT0))
#define WMIN ((bf16*)(WSB + WS_WMIN))
#define WUQ ((bf16*)(WSB + WS_WUQ))
#define WUKV ((bf16*)(WSB + WS_WUKV))
#define WMOUT ((bf16*)(WSB + WS_WMOUT))
#define WRT ((bf16*)(WSB + WS_WRT))
#define WGU ((bf16*)(WSB + WS_WGU))
#define ADAP ((float*)(WSB + WS_WGU))
#define WDN ((bf16*)(WSB + WS_WDN))
#define HIN ((bf16*)(WSB + WS_HIN))
#define XA ((float*)(WSB + WS_XA))
#define XB ((float*)(WSB + WS_XB))
#define RB ((float*)(WSB + WS_R))
#define PB ((bf16*)(WSB + WS_P))
#define GF ((unsigned char*)(WSB + WS_GF))
#define GU ((unsigned char*)(WSB + WS_GU))
#define GO ((float*)(WSB + WS_GO))
#define YAB ((bf16*)(WSB + WS_YAB))
#define LISTP ((int*)(WSB + WS_XS))
#define HID ((bf16*)(WSB + WS_HID))
#define YS ((bf16*)(WSB + WS_YS))
#define C1 ((float*)(WSB + WS_C1))
#define CQN ((bf16*)(WSB + WS_CQN))
#define CKVN ((bf16*)(WSB + WS_CKVN))
#define KPE ((float*)(WSB + WS_KPE))
#define QB_ ((bf16*)(WSB + WS_Q))
#define KB_ ((bf16*)(WSB + WS_K))
#define VB_ ((bf16*)(WSB + WS_V))
#define VT ((bf16*)(WSB + WS_VT))


#define LN_ROW(v, gptr, bptr) do { float _s = 0.f; _Pragma("unroll") for (int _j = 0; _j < 8; ++_j) _s += (v[_j][0] + v[_j][1]) + (v[_j][2] + v[_j][3]); \
        const float _mean = wave_sum(_s) * (1.f / D); float _q = 0.f; \
        _Pragma("unroll") for (int _j = 0; _j < 8; ++_j) { v[_j] = v[_j] - _mean; _q += (v[_j][0] * v[_j][0] + v[_j][1] * v[_j][1]) + (v[_j][2] * v[_j][2] + v[_j][3] * v[_j][3]); } \
        const float _rstd = rsqrtf(wave_sum(_q) * (1.f / D) + 1e-5f); \
        _Pragma("unroll") for (int _j = 0; _j < 8; ++_j) v[_j] = v[_j] * _rstd * ((const f32x4*)(gptr))[F.lane + 64 * _j] + ((const f32x4*)(bptr))[F.lane + 64 * _j]; } while (0)
#define WRITE_X_HIN(v, xrow, hrow, shp, scp) do { _Pragma("unroll") for (int _j = 0; _j < 8; ++_j) { ((f32x4*)(xrow))[F.lane + 64 * _j] = v[_j]; \
        if ((hrow) != nullptr) { const f32x4 _h = v[_j] * (((const f32x4*)(scp))[F.lane + 64 * _j] + 1.0f) + ((const f32x4*)(shp))[F.lane + 64 * _j]; \
            u32x2 _w; _w.x = cvtpk(_h[0], _h[1]); _w.y = cvtpk(_h[2], _h[3]); ((u32x2*)(hrow))[F.lane + 64 * _j] = _w; } } } while (0)


template <int GW> DI void ada_groups(Frame& F, const Args& args, const int cg_lo, const int cg_hi, const int bidx, const int nblocks) {
    constexpr int LPR = GW / 4, RPI = 64 / LPR, NSET = 8 * RPI;
    LAS float* cact = (LAS float*)F.lds;
    LAS float* red = (LAS float*)(F.lds + 32768);
    for (int i = F.tid; i < 4 * D; i += 512) cact[i] = silu_f(in_c[i]);
    __syncthreads();
    for (int cg = cg_lo + bidx; cg < cg_hi; cg += nblocks) {
        const int jj0 = cg * GW, l = jj0 / 12288, j0 = jj0 - l * 12288;
        const int rsub = F.lane / LPR, c4 = F.lane - rsub * LPR;
        f32x4 a0 = {0.f, 0.f, 0.f, 0.f}, a1 = a0, a2 = a0, a3 = a0;
        if (F.lane < LPR * RPI) {
            const float* wp = ada_w + ((size_t)l * D) * 12288 + j0 + 4 * c4;
#pragma unroll 8
            for (int it = 0; it < D / NSET; ++it) { const int k = it * NSET + F.wave * RPI + rsub;
                const f32x4 w4 = *(const f32x4*)(wp + (size_t)k * 12288);
                a0 += w4 * cact[k]; a1 += w4 * cact[D + k]; a2 += w4 * cact[2 * D + k]; a3 += w4 * cact[3 * D + k]; }
            LAS float* rp = red + (F.wave * RPI + rsub) * (4 * GW) + 4 * c4;
            *(LAS f32x4*)(rp) = a0; *(LAS f32x4*)(rp + GW) = a1; *(LAS f32x4*)(rp + 2 * GW) = a2; *(LAS f32x4*)(rp + 3 * GW) = a3;
        }
        __syncthreads();
        if (F.tid < 4 * GW) { const int b = F.tid / GW, col = F.tid - b * GW; float s = ada_b[(size_t)l * 12288 + j0 + col];
#pragma unroll 8
            for (int p = 0; p < NSET; ++p) s += red[p * (4 * GW) + b * GW + col];
            MOD[((size_t)l * 4 + b) * 12288 + j0 + col] = s; }
        __syncthreads();
    }
}

DI void ada_partials(Frame& F, const Args& args) {
    LAS float* cact = (LAS float*)F.lds;
    for (int blk = blockIdx.x; blk < 256; blk += F.G) {
        const int rs = blk >> 4, cs = blk & 15, jj0 = cs * 1536, l = jj0 / 12288, j0 = jj0 - l * 12288;
        __syncthreads();
        { const int b = F.tid >> 7, k = F.tid & 127; cact[b * 128 + k] = silu_f(in_c[b * D + 128 * rs + k]); }
        __syncthreads();
        if (F.tid < 384) {
            const float* wp = ada_w + ((size_t)l * D + 128 * rs) * 12288 + j0 + 4 * F.tid;
            f32x4 a0 = {0.f, 0.f, 0.f, 0.f}, a1 = a0, a2 = a0, a3 = a0;
#pragma unroll 16
            for (int k = 0; k < 128; ++k) { const f32x4 w4 = *(const f32x4*)(wp + (size_t)k * 12288);
                a0 += w4 * cact[k]; a1 += w4 * cact[128 + k]; a2 += w4 * cact[256 + k]; a3 += w4 * cact[384 + k]; }
            float* pp = ADAP + ((size_t)rs * 4) * 24576 + jj0 + 4 * F.tid;
            *(f32x4*)pp = a0; *(f32x4*)(pp + 24576) = a1; *(f32x4*)(pp + 2 * 24576) = a2; *(f32x4*)(pp + 3 * 24576) = a3;
        }
    }
    __syncthreads();
}

DI void deferred_copies(Frame& F, const Args& args, const int gw, const int NGW) {
    tr_job(F, gw, NGW, hyb_w_out, 0, 1, D, D, 0, D, WOUT0, 0, D, 0, 0);
    tr_job(F, gw, NGW, mla_w_in, 0, 1, MLA_IN, D, 0, MLA_IN, WMIN, 0, D, 0, 0);
    zero_fill(F, gw, NGW, WMIN + (size_t)MLA_IN * D, (size_t)(NMLA - MLA_IN) * D * 2);
    tr_job(F, gw, NGW, mla_w_uq, 0, 1, 3072, 512, 0, 3072, WUQ, 0, 512, 0, 0);
    tr_job(F, gw, NGW, mla_w_ukv, 0, 1, 4096, 512, 0, 4096, WUKV, 0, 512, 0, 0);
    tr_job(F, gw, NGW, mla_w_out, 0, 1, D, D, 0, D, WMOUT, 0, D, 0, 0);
    tr_job(F, gw, NGW, moe_router_g, (size_t)D * 8, 2, 8, D, 0, 8, WRT, (size_t)256 * D, D, 0, 0);
    tr_job(F, gw, NGW, moe_router_e, (size_t)D * 64, 2, 64, D, 0, 64, WRT, (size_t)256 * D, D, 8, 0);
    zero_fill(F, gw, NGW, WRT + (size_t)72 * D, (size_t)(256 - 72) * D * 2);
    zero_fill(F, gw, NGW, WRT + (size_t)256 * D + (size_t)72 * D, (size_t)(256 - 72) * D * 2);
}

DI void copy_jobs(Frame& F, const Args& args, const int gw, const int NGW) {
    constexpr int N0 = (D / 64) * (D / 32), N1 = (D / 64) * (MLA_IN / 32), N2 = (512 / 64) * (3072 / 32), N3 = (512 / 64) * (4096 / 32), N4 = N0, N5 = 2 * (D / 64), N6 = 2 * (D / 64) * 2;
    constexpr int TOTAL = N0 + N1 + N2 + N3 + N4 + N5 + N6;
    for (int it0 = gw; it0 < TOTAL; it0 += 2 * NGW) {
        TrRegs t[2]; int k0[2], nv[2], dr[2], kd[2]; bf16* wt[2];
#pragma unroll
        for (int u = 0; u < 2; ++u) {
            int it = it0 + u * NGW; nv[u] = 0; k0[u] = 0; dr[u] = 0; kd[u] = D; wt[u] = WOUT0;
            if (it < TOTAL) {
                const float* W; int ld, ncols, nblk, row_off = 0; size_t smat = 0, dmat = 0;
                if (it < N0) { W = hyb_w_out; ld = D; ncols = D; nblk = D / 32; wt[u] = WOUT0; kd[u] = D; }
                else if ((it -= N0) < N1) { W = mla_w_in; ld = MLA_IN; ncols = MLA_IN; nblk = MLA_IN / 32; wt[u] = WMIN; kd[u] = D; }
                else if ((it -= N1) < N2) { W = mla_w_uq; ld = 3072; ncols = 3072; nblk = 96; wt[u] = WUQ; kd[u] = 512; }
                else if ((it -= N2) < N3) { W = mla_w_ukv; ld = 4096; ncols = 4096; nblk = 128; wt[u] = WUKV; kd[u] = 512; }
                else if ((it -= N3) < N4) { W = mla_w_out; ld = D; ncols = D; nblk = D / 32; wt[u] = WMOUT; kd[u] = D; }
                else if ((it -= N4) < N5) { W = moe_router_g; ld = 8; ncols = 8; nblk = 1; wt[u] = WRT; kd[u] = D; smat = (size_t)D * 8; dmat = (size_t)256 * D; }
                else { it -= N5; W = moe_router_e; ld = 64; ncols = 64; nblk = 2; wt[u] = WRT; kd[u] = D; smat = (size_t)D * 64; dmat = (size_t)256 * D; row_off = 8; }
                const int kbs = kd[u] / 64, per = nblk * kbs, mat = it / per, rem = it - mat * per, kb = rem / nblk, nb = rem - kb * nblk;
                nv[u] = (ncols - nb * 32) < 32 ? (ncols - nb * 32) : 32; k0[u] = kb * 64; dr[u] = row_off + nb * 32; wt[u] += (size_t)mat * dmat;
                tr_load(t[u], W + (size_t)mat * smat, (size_t)ld, k0[u], nb * 32, nv[u], F.lane);
            }
        }
#pragma unroll
        for (int u = 0; u < 2; ++u) tr_store(t[u], k0[u], nv[u], wt[u], kd[u], dr[u], F.lane);
    }
    zero_fill(F, gw, NGW, WMIN + (size_t)MLA_IN * D, (size_t)(NMLA - MLA_IN) * D * 2);
    zero_fill(F, gw, NGW, WRT + (size_t)72 * D, (size_t)(256 - 72) * D * 2);
    zero_fill(F, gw, NGW, WRT + (size_t)256 * D + (size_t)72 * D, (size_t)(256 - 72) * D * 2);
}

#ifndef PHMASK
#define PHMASK 0xFFFFFFFFull
#endif
#define PH_EN(k) (((PHMASK) >> (k)) & 1ull)
#define IN(k) (PH_EN(k) && lo <= (k) && (k) < hi)
#define INL(k0, k1) ((L == 0) ? IN(k0) : IN(k1))
#define PHASE_FRESH() do { int _l; asm volatile("v_mbcnt_lo_u32_b32 %0, -1, 0\n\tv_mbcnt_hi_u32_b32 %0, -1, %0" : "=v"(_l)); F.lane = _l; F.tid = F.wave * 64 + _l; } while (0)
#define SEAM(k) do { if (IN(k) && IN((k) + 1)) { PHASE_FRESH(); xcd_barrier(bar, F.tid == 0); } } while (0)


template <int L> DI void ln_route_phase(Frame& F, const Args& args) {
    constexpr int HP = 2056;
    LAS bf16* HT = (LAS bf16*)F.lds;
    LAS float* PART = (LAS float*)(F.lds + 16 * HP * 2);
    LAS float* LG = PART + 8 * 16 * 80;
    unsigned* cnt = F.ctl + CW_CNT + L * 64;
    const float* bg = moe_bias_g + L * 8; const float* be = moe_bias_e + L * 64;
    const bf16* wrt = WRT + (size_t)L * 256 * D;
    for (int rg = F.vcu; rg < T / 16; rg += F.G) {
#pragma unroll
        for (int rr = 0; rr < 2; ++rr) {
            const int rl = 2 * F.wave + rr, m = rg * 16 + rl, b = m / SEQ; const float* modb = MOD + (size_t)(L * 4 + b) * 12288;
            f32x4 v[8];
#pragma unroll
            for (int j = 0; j < 8; ++j) v[j] = ((const f32x4*)(RB + (size_t)m * D))[F.lane + 64 * j];
            LN_ROW(v, ln_g + (size_t)(L * 2) * D, ln_b + (size_t)(L * 2) * D);
#pragma unroll
            for (int j = 0; j < 8; ++j) { ((f32x4*)(XA + (size_t)m * D))[F.lane + 64 * j] = v[j];
                const f32x4 h = v[j] * (((const f32x4*)(modb + 4 * D))[F.lane + 64 * j] + 1.0f) + ((const f32x4*)(modb + 3 * D))[F.lane + 64 * j];
                u32x2 w; w.x = cvtpk(h[0], h[1]); w.y = cvtpk(h[2], h[3]);
                ((u32x2*)(HIN + (size_t)m * D))[F.lane + 64 * j] = w; *(LAS u32x2*)(HT + rl * HP + 4 * (F.lane + 64 * j)) = w; }
        }
        __syncthreads();
        {
            const int mrow = F.lane & 15, g = F.lane >> 4;
            f32x4 acc[5];
#pragma unroll
            for (int nt = 0; nt < 5; ++nt) acc[nt] = (f32x4){0.f, 0.f, 0.f, 0.f};
#pragma unroll 2
            for (int ks = 0; ks < 8; ++ks) { const int kk = 32 * (8 * F.wave + ks) + 8 * g;
                const bf16x8 a = *(const LAS bf16x8*)(HT + mrow * HP + kk);
#pragma unroll
                for (int nt = 0; nt < 5; ++nt) { const bf16x8 bb = *(const bf16x8*)(wrt + (size_t)(nt * 16 + mrow) * D + kk);
                    acc[nt] = __builtin_amdgcn_mfma_f32_16x16x32_bf16(a, bb, acc[nt], 0, 0, 0); } }
#pragma unroll
            for (int nt = 0; nt < 5; ++nt)
#pragma unroll
                for (int q = 0; q < 4; ++q) PART[(F.wave * 16 + 4 * g + q) * 80 + nt * 16 + mrow] = acc[nt][q];
        }
        __syncthreads();
        for (int idx = F.tid; idx < 16 * 72; idx += 512) { const int r = idx / 72, c = idx - r * 72; float s = 0.f;
#pragma unroll
            for (int w = 0; w < 8; ++w) s += PART[(w * 16 + r) * 80 + c];
            LG[r * 80 + c] = s; }
        __syncthreads();
        if (F.tid < 16) {
            const int t = rg * 16 + F.tid; const LAS float* lg = LG + F.tid * 80;
            float l8[8]; float mx = -3.0e38f; int grp = 0;
#pragma unroll
            for (int gq = 0; gq < 8; ++gq) { l8[gq] = lg[gq] + bg[gq]; if (l8[gq] > mx) { mx = l8[gq]; grp = gq; } }
            float se = 0.f;
#pragma unroll
            for (int gq = 0; gq < 8; ++gq) se += __expf(l8[gq] - mx);
            const float pg = 1.f / se;
            float e8[8];
#pragma unroll
            for (int j = 0; j < 8; ++j) e8[j] = lg[8 + grp * 8 + j] + be[grp * 8 + j];
            int i1 = 0; float m1 = e8[0];
#pragma unroll
            for (int j = 1; j < 8; ++j) if (e8[j] > m1) { m1 = e8[j]; i1 = j; }
            int i2 = -1; float m2 = -3.0e38f;
#pragma unroll
            for (int j = 0; j < 8; ++j) if (j != i1 && e8[j] > m2) { m2 = e8[j]; i2 = j; }
            const float rrr = __expf(m2 - m1), g1 = pg / (1.f + rrr), g2 = pg * rrr / (1.f + rrr);
            const int ex1 = grp * 8 + i1, ex2 = grp * 8 + i2;
            const int p1 = (int)atomicAdd(&cnt[ex1], 1u), p2 = (int)atomicAdd(&cnt[ex2], 1u);
            TOK_E[2 * t] = ex1; TOK_E[2 * t + 1] = ex2; TOK_POS[2 * t] = p1; TOK_POS[2 * t + 1] = p2; TOK_GATE[2 * t] = g1; TOK_GATE[2 * t + 1] = g2;
            LISTP[(size_t)ex1 * 8192 + p1] = t; LISTP[(size_t)ex2 * 8192 + p2] = t;
        }
        __syncthreads();
    }
}

template <int L> DI void moe_phases(Frame& F, const Args& args, const XcdBarrier& bar, const int lo, const int hi, LAS int* TAB) {
        unsigned* cnt = F.ctl + CW_CNT + L * 64;
#define MOE_TABLE() do { if (F.tid < NE) TAB[200 + F.tid] = (int)cnt[F.tid]; __syncthreads(); \
        if (F.tid == 0) { int _a = 0; for (int _e = 0; _e < NE; ++_e) { const int _c = TAB[200 + _e]; TAB[128 + _e] = _a; const int _nb = (_c + 255) >> 8; \
        for (int _q = 0; _q < _nb; ++_q) TAB[_a + _q] = _e; _a += _nb; } TAB[192] = _a; } __syncthreads(); } while (0)
    if (INL(11, 24)) { PHASE_FRESH();
        MOE_TABLE();
        pg8::MoeDirect S; S.nunits = TAB[192] * 4; S.NT = 4; S.G = F.G; S.c = F.vcu; S.tab = TAB;
        S.W0 = moe_w_gate + (size_t)L * 64 * D * FF; S.W1 = moe_w_up + (size_t)L * 64 * D * FF; S.estride = (size_t)D * FF; S.cols_per_tile = 128; S.half1_off = 0;
        pg8::EpiGateUp E{HID};
        pg8::gemm_phase_moe<pg8::EpiGateUp, true>(F.lds, D, FF, S, E, HIN, LISTP, F.tid, F.wave);
    }
    if (L == 0) SEAM(11); else SEAM(24);
    if (INL(12, 25)) { PHASE_FRESH();
        MOE_TABLE();
        pg8::MoeDirect S; S.nunits = TAB[192] * 8; S.NT = 8; S.G = F.G; S.c = F.vcu; S.tab = TAB;
        S.W0 = moe_w_down + (size_t)L * 64 * D * FF; S.W1 = S.W0; S.estride = (size_t)D * FF; S.cols_per_tile = 256; S.half1_off = 128;
        pg8::EpiBf16 E{YS, D};
        pg8::gemm_phase_moe32<pg8::EpiBf16, false>(F.lds, FF, D, S, E, HID, nullptr, F.tid, F.wave);
    }
    if (L == 0) SEAM(12); else SEAM(25);
    if (INL(13, 26)) { PHASE_FRESH();
        if (F.tid < NE) TAB[200 + F.tid] = (int)cnt[F.tid];
        __syncthreads();
        if (F.tid == 0) { int a = 0; for (int e = 0; e < NE; ++e) { TAB[128 + e] = a; a += (TAB[200 + e] + 255) >> 8; } }
        __syncthreads();
        float* xout = (L == 0) ? XB : args.out;
        for (int m0 = F.gw; m0 < T; m0 += 2 * F.NGW) {
            int mm[2], r0[2], r1[2]; float g0[2], g1[2];
#pragma unroll
            for (int u = 0; u < 2; ++u) { const int m = m0 + u * F.NGW < T ? m0 + u * F.NGW : m0; mm[u] = m;
                r0[u] = TAB[128 + TOK_E[2 * m]] * 256 + TOK_POS[2 * m]; r1[u] = TAB[128 + TOK_E[2 * m + 1]] * 256 + TOK_POS[2 * m + 1]; g0[u] = TOK_GATE[2 * m]; g1[u] = TOK_GATE[2 * m + 1]; }
            f32x4 v[2][8];
#pragma unroll
            for (int u = 0; u < 2; ++u) { const int m = mm[u]; const float* modb = MOD + (size_t)(L * 4 + m / SEQ) * 12288;
#pragma unroll
                for (int j = 0; j < 8; ++j) {
                    const f32x4 xv = ((const f32x4*)(XA + (size_t)m * D))[F.lane + 64 * j];
                    const u32x2 ya = ((const u32x2*)(YS + (size_t)r0[u] * D))[F.lane + 64 * j], yb = ((const u32x2*)(YS + (size_t)r1[u] * D))[F.lane + 64 * j];
                    const f32x4 gg = ((const f32x4*)(modb + 5 * D))[F.lane + 64 * j] + 1.0f;
                    f32x4 y; y[0] = g0[u] * bflo(ya.x) + g1[u] * bflo(yb.x); y[1] = g0[u] * bfhi(ya.x) + g1[u] * bfhi(yb.x); y[2] = g0[u] * bflo(ya.y) + g1[u] * bflo(yb.y); y[3] = g0[u] * bfhi(ya.y) + g1[u] * bfhi(yb.y);
                    v[u][j] = xv * DN_ALPHA + gg * y;
                } }
#pragma unroll
            for (int u = 0; u < 2; ++u) {
                const int m = mm[u];
                LN_ROW(v[u], ln_g + (size_t)(L * 2 + 1) * D, ln_b + (size_t)(L * 2 + 1) * D);
                if (u == 0 || m0 + F.NGW < T) {
                    bf16* hrow = (L == 0) ? HIN + (size_t)m * D : nullptr;
                    const float* mod1 = MOD + (size_t)(4 + m / SEQ) * 12288;
                    WRITE_X_HIN(v[u], xout + (size_t)m * D, hrow, mod1, mod1 + D);
                } }
        }
    }
    if (L == 0) SEAM(13);
}

__global__ void __launch_bounds__(512, 2) mega(Args args) {
    extern __shared__ __attribute__((aligned(16))) unsigned char lds_raw[];
    Frame F;
    F.lds = (LAS unsigned char*)lds_raw;
    F.wave = __builtin_amdgcn_readfirstlane((int)threadIdx.x >> 6); PHASE_FRESH();
    F.G = gridDim.x; { const int bx = blockIdx.x; F.vcu = (F.G % 8 == 0) ? (bx % 8) * (F.G / 8) + bx / 8 : bx; }
    F.gw = F.vcu * 8 + F.wave; F.NGW = F.G * 8;
    F.ctl = (unsigned*)(args.ws + WS_CTL);
    volatile LAS unsigned* MISC = (volatile LAS unsigned*)(F.lds + MISC_OFF);
    LAS int* TAB = (LAS int*)(F.lds + TAB_OFF);
    for (int u = F.tid; u < (LDS_BYTES - LDSCTL_OFF) / 4; u += 512) ((LAS unsigned*)(F.lds + LDSCTL_OFF))[u] = 0u;
    __syncthreads();
    XcdBarrier bar; bar.bar = F.ctl + CW_BAR; bar.x = 0; bar.st = nullptr;
    if (MK_ONE_LAUNCH) bar = xcd_barrier_post(F.ctl + CW_BAR, MISC + 8, F.tid == 0);
    const int lo = args.ph_lo, hi = args.ph_hi;

    if (IN(0)) { PHASE_FRESH();
        ada_partials(F, args);
        tr_job(F, F.gw, F.NGW, hyb_w_in, 0, 1, HYB_IN, D, 0, 4096, WIN0, 0, D, 0, 0);
        tr_job(F, F.gw, F.NGW, hyb_w_in, 0, 1, HYB_IN, D, 4112, 3072, WIN0, 0, D, 4096, 0);
        tr_job(F, F.gw, F.NGW, hyb_w_in, 0, 1, HYB_IN, D, 4096, 16, WIN0, 0, D, 7168, 0);
        zero_fill(F, F.gw, F.NGW, WIN0 + (size_t)7184 * D, (size_t)(NIN - 7184) * D * 2);
        copy_jobs(F, args, F.gw, F.NGW);
        for (int idx = blockIdx.x * 512 + F.tid; idx < T * 32; idx += F.G * 512) {
            const int t = idx >> 5, i = idx & 31;
            const double rev = (double)in_pos[t] * ROPE_INVF[i] * 0.15915494309189535;
            const float fr = (float)(rev - __builtin_rint(rev));
            ROPE_C[idx] = __builtin_amdgcn_cosf(fr); ROPE_S[idx] = __builtin_amdgcn_sinf(fr);
        }
    }
    SEAM(0);

    if (IN(1)) { PHASE_FRESH();
        for (int o = blockIdx.x * 512 + F.tid; o < 2 * 4 * 12288; o += F.G * 512) {
            const int l = o / 49152, r = o - l * 49152, b = r / 12288, j = r - b * 12288;
            const float* pp = ADAP + (size_t)b * 24576 + l * 12288 + j; float s = ada_b[l * 12288 + j];
#pragma unroll
            for (int rs = 0; rs < 16; ++rs) s += pp[(size_t)rs * 4 * 24576];
            MOD[o] = s; }
        LAS float* SHSC = (LAS float*)F.lds;
        for (int rb = blockIdx.x; rb < T / 32; rb += F.G) {
            const int b = rb / (SEQ / 32);
            __syncthreads();
            for (int c = F.tid; c < 2 * D; c += 512) { const float* pp = ADAP + (size_t)b * 24576 + c; float s = ada_b[c];
#pragma unroll
                for (int rs = 0; rs < 16; ++rs) s += pp[(size_t)rs * 4 * 24576];
                SHSC[c] = s; }
            __syncthreads();
#pragma unroll
            for (int rr = 0; rr < 4; ++rr) { const int m = rb * 32 + 4 * F.wave + rr;
                const f32x4* xr = (const f32x4*)(in_x + (size_t)m * D) + F.lane; u32x2* o = (u32x2*)(HIN + (size_t)m * D) + F.lane;
#pragma unroll
                for (int j = 0; j < 8; ++j) { const f32x4 v = xr[64 * j]; const f32x4 sh = ((const LAS f32x4*)SHSC)[F.lane + 64 * j], sc = ((const LAS f32x4*)(SHSC + D))[F.lane + 64 * j];
                    const f32x4 h = v * (sc + 1.0f) + sh; u32x2 w; w.x = cvtpk(h[0], h[1]); w.y = cvtpk(h[2], h[3]); o[64 * j] = w; } }
        }
    }
    SEAM(1);

    if (IN(2)) { PHASE_FRESH();
        const bool split = (F.G == 256);
        pg8::MapOrder S; S.init(HIN, WIN0, T, split ? 24 * 256 : NIN, D, F.G, (int)blockIdx.x); S.first = 0; S.nfirst = split ? 23 : 29; S.extra = 28;
        pg8::EpiInProj E{PB, PBA};
        pg8::gemm_phase<pg8::EpiInProj, pg8::MapOrder>(F.lds, D, S, E, F.tid, F.wave);
    }
    SEAM(2);

    if (IN(3)) { PHASE_FRESH();
        constexpr int QS = 136;
        LAS float* MT = (LAS float*)(F.lds);
        LAS bf16* QKM = (LAS bf16*)(F.lds + 17408);
        LAS float* RAWK = (LAS float*)(F.lds);
        LAS float* VF = (LAS float*)(F.lds + 32768);
        LAS float* WL = (LAS float*)(F.lds + 65536);
        LAS bf16* QBl = (LAS bf16*)(F.lds + 98304);
        LAS bf16* KBl = (LAS bf16*)(F.lds + 115712);
        int zoff = 0; asm volatile("" : "+v"(zoff));
        LAS float* s_beta = (LAS float*)(F.lds + 133120 + zoff); LAS float* s_gc = s_beta + 64; LAS float* s_egc = s_beta + 128;
        for (int ch = blockIdx.x; ch < NCH; ch += F.G) {
            PHASE_FRESH();
            const int n = ch & 31, bh = ch >> 5, h = bh & 7, b = bh >> 3;
            const int tok0 = b * SEQ + n * CHK;
            if (F.tid < 384) {
                const int mat = F.tid >> 7, d = F.tid & 127, col = mat * 1024 + h * 128 + d;
                const float w0 = gdn_conv_w[col], w1 = gdn_conv_w[3072 + col], w2 = gdn_conv_w[2 * 3072 + col], w3 = gdn_conv_w[3 * 3072 + col];
                const bf16* pc = PB + (size_t)tok0 * NP + col;
                float xm3 = 0.f, xm2 = 0.f, xm1 = 0.f;
                if (n > 0) { xm3 = bf2f(pc[-3 * NP]); xm2 = bf2f(pc[-2 * NP]); xm1 = bf2f(pc[-NP]); }
                LAS float* dst = (mat == 0) ? WL : (mat == 1 ? RAWK : VF);
                bf16 xr[64];
#pragma unroll
                for (int i = 0; i < 64; ++i) xr[i] = pc[(size_t)i * NP];
#pragma unroll
                for (int i = 0; i < 64; ++i) { const float xi = bf2f(xr[i]); const float y = w0 * xm3 + w1 * xm2 + w2 * xm1 + w3 * xi;
                    dst[i * 128 + d] = silu_f(y); xm3 = xm2; xm2 = xm1; xm1 = xi; }
            }
            if (F.wave == 7) {
                const int tok = tok0 + F.lane;
                const float br = PBA[(size_t)tok * 16 + h], ar = PBA[(size_t)tok * 16 + 8 + h];
                const float beta = 1.f / (1.f + __expf(-br));
                const float xsp = ar + gdn_dt_bias[h];
                const float sp = fmaxf(xsp, 0.f) + log1pf(__expf(-fabsf(xsp)));
                float g = -__expf(gdn_a_log[h]) * sp;
#pragma unroll
                for (int off = 1; off < 64; off <<= 1) { const float v = __shfl_up(g, off); if (F.lane >= off) g += v; }
                s_beta[F.lane] = beta; s_gc[F.lane] = g; s_egc[F.lane] = __expf(g);
            }
            __syncthreads();
#pragma unroll
            for (int rr = 0; rr < 8; ++rr) {
                const int i = F.wave * 8 + rr;
                const float qa = WL[i * 128 + F.lane], qb2 = WL[i * 128 + 64 + F.lane];
                const float ka = RAWK[i * 128 + F.lane], kb2 = RAWK[i * 128 + 64 + F.lane];
                const float rq = rsqrtf(wave_sum(qa * qa + qb2 * qb2) + 1e-6f) * 0.08838834764831845f;
                const float rk = rsqrtf(wave_sum(ka * ka + kb2 * kb2) + 1e-6f);
                QBl[i * QS + F.lane] = f2bf(qa * rq); QBl[i * QS + 64 + F.lane] = f2bf(qb2 * rq);
                KBl[i * QS + F.lane] = f2bf(ka * rk); KBl[i * QS + 64 + F.lane] = f2bf(kb2 * rk);
            }
            __syncthreads();
            {
                const int mat = F.wave >> 2, mi = (F.wave >> 1) & 1, ni = F.wave & 1, r = F.lane & 31, hh = F.lane >> 5;
                const LAS bf16* Am = (mat == 0) ? KBl : QBl;
                f32x16 acc;
#pragma unroll
                for (int i = 0; i < 16; ++i) acc[i] = 0.f;
#pragma unroll
                for (int ks = 0; ks < 8; ++ks) {
                    const bf16x8 a = *(const LAS bf16x8*)(Am + (32 * mi + r) * QS + 16 * ks + 8 * hh);
                    const bf16x8 bb = *(const LAS bf16x8*)(KBl + (32 * ni + r) * QS + 16 * ks + 8 * hh);
                    acc = MFMA32(a, bb, acc);
                }
                const int j = 32 * ni + r; const float gj = s_gc[j];
#pragma unroll
                for (int reg = 0; reg < 16; ++reg) {
                    const int i = 32 * mi + crow(reg, hh);
                    const float gi = s_gc[i];
                    const float dec = __expf(fminf(gi - gj, 0.f));
                    if (mat == 0) MT[j * 68 + i] = (i > j) ? s_beta[i] * acc[reg] * dec : 0.f;
                    else QKM[i * 64 + j] = f2bf((i >= j) ? acc[reg] * dec : 0.f);
                }
            }
            __syncthreads();
            if (F.tid < 256) {
                const int c = F.tid, dcol = c & 127;
                float X[64];
                if (c < 128) {
#pragma unroll
                    for (int i = 0; i < 64; ++i) X[i] = VF[i * 128 + dcol] * s_beta[i];
                } else {
#pragma unroll
                    for (int i = 0; i < 64; ++i) X[i] = bf2f(KBl[i * QS + dcol]) * s_beta[i] * s_egc[i];
                }
#pragma unroll
                for (int j = 0; j < 63; ++j) {
                    asm volatile("" ::: "memory");
                    const float xj = X[j];
#pragma unroll
                    for (int i4 = ((j + 1) & ~3); i4 < 64; i4 += 4) {
                        const f32x4 m4 = *(const LAS f32x4*)(MT + j * 68 + i4);
#pragma unroll
                        for (int q = 0; q < 4; ++q) if (i4 + q > j) X[i4 + q] -= m4[q] * xj;
                    }
                }
                LAS float* dst = (c < 128) ? VF : WL;
#pragma unroll
                for (int i = 0; i < 64; ++i) dst[i * 128 + dcol] = X[i];
            }
            __syncthreads();
            {
                const int r = F.lane & 31, hh = F.lane >> 5;
                const float gl = s_gc[63];
                unsigned char* gf = GF + (size_t)ch * GREC;
                for (int f = F.wave; f < 56; f += 8) {
                    float v[8];
                    if (f < 16) { const int mt = f >> 3, ks = f & 7; const LAS float* src = WL + (32 * mt + r) * 128 + 16 * ks + 4 * hh;
#pragma unroll
                        for (int j = 0; j < 8; ++j) v[j] = -src[8 * (j >> 2) + (j & 3)]; }
                    else if (f < 32) { const int f2 = f - 16, mt = f2 >> 3, ks = f2 & 7, i = 32 * mt + r; const float e = s_egc[i]; const LAS bf16* src = QBl + i * QS + 16 * ks + 4 * hh;
#pragma unroll
                        for (int j = 0; j < 8; ++j) v[j] = bf2f(src[8 * (j >> 2) + (j & 3)]) * e; }
                    else if (f < 40) { const int f2 = f - 32, mt = f2 >> 2, ks = f2 & 3; const LAS bf16* src = QKM + (32 * mt + r) * 64 + 16 * ks + 4 * hh;
#pragma unroll
                        for (int j = 0; j < 8; ++j) v[j] = bf2f(src[8 * (j >> 2) + (j & 3)]); }
                    else { const int f2 = f - 40, mt = f2 >> 2, ks = f2 & 3, dd = 32 * mt + r;
#pragma unroll
                        for (int j = 0; j < 8; ++j) { const int i = 16 * ks + 8 * (j >> 2) + 4 * hh + (j & 3); v[j] = bf2f(KBl[i * QS + dd]) * __expf(gl - s_gc[i]); } }
                    u32x4 o; o.x = cvtpk(v[0], v[1]); o.y = cvtpk(v[2], v[3]); o.z = cvtpk(v[4], v[5]); o.w = cvtpk(v[6], v[7]);
                    *(u32x4*)(gf + f * 1024 + F.lane * 16) = o;
                }
                { const int sl = F.wave >> 1, it = F.wave & 1, col = 32 * sl + r;
                  unsigned uw[8];
#pragma unroll
                  for (int q = 0; q < 8; ++q) uw[q] = cvtpk(VF[(32 * it + crow(2 * q, hh)) * 128 + col], VF[(32 * it + crow(2 * q + 1, hh)) * 128 + col]);
                  u32x4* up = (u32x4*)(gf + 57344 + (size_t)((sl * 2 + it) * 64 + F.lane) * 32);
                  up[0] = (u32x4){uw[0], uw[1], uw[2], uw[3]}; up[1] = (u32x4){uw[4], uw[5], uw[6], uw[7]}; }
                if (F.tid == 0) EG[ch] = __expf(gl);
            }
            __syncthreads();
        }
    }
    SEAM(3);

    if (IN(4)) { PHASE_FRESH();
        if (F.G == 256 && (int)blockIdx.x >= BATCH * GH) {
            pg8::MapOrder S; S.init(HIN, WIN0, T, 5 * 256, D, F.G - BATCH * GH, (int)blockIdx.x - BATCH * GH); S.first = 23; S.nfirst = 5; S.extra = 28;
            pg8::EpiInProj E{PB, PBA};
            pg8::gemm_phase<pg8::EpiInProj, pg8::MapOrder>(F.lds, D, S, E, F.tid, F.wave);
        }
        for (int bh = blockIdx.x; bh < BATCH * GH; bh += F.G) {
            const int b = bh >> 3, hd = bh & 7, r = F.lane & 31, hh = F.lane >> 5, sl = F.wave;
            const unsigned char* g0 = GF + (size_t)(bh * 32) * GREC;
#define SCAN_BAR() do { LDS_WAIT(); __builtin_amdgcn_s_barrier(); asm volatile("" ::: "memory"); } while (0)
            if (F.wave >= 4) {
                const int t4 = F.tid - 256;
                const unsigned char* gl0 = g0 + opaque_off((size_t)t4 * 16);
                u32x4 ra[18], rb[18];
#pragma unroll
                for (int q = 0; q < 18; ++q) ra[q] = *(const u32x4*)(gl0 + (size_t)q * 4096);
#pragma unroll
                for (int q = 0; q < 18; ++q) *(LAS u32x4*)(F.lds + (t4 + 256 * q) * 16) = ra[q];
#pragma unroll
                for (int q = 0; q < 18; ++q) ra[q] = *(const u32x4*)(gl0 + (size_t)GREC + (size_t)q * 4096);
#pragma unroll
                for (int q = 0; q < 18; ++q) rb[q] = *(const u32x4*)(gl0 + (size_t)2 * GREC + (size_t)q * 4096);
                SCAN_BAR();
                for (int n = 0; n < NCHK; n += 2) {
                    const unsigned char* gn = g0 + opaque_off((size_t)(n + 3) * GREC + (size_t)t4 * 16);
#pragma unroll
                    for (int q = 0; q < 18; ++q) *(LAS u32x4*)(F.lds + GREC + (t4 + 256 * q) * 16) = ra[q];
                    if (n + 3 < NCHK) {
#pragma unroll
                        for (int q = 0; q < 18; ++q) ra[q] = *(const u32x4*)(gn + (size_t)q * 4096); }
                    SCAN_BAR();
                    if (n + 2 < NCHK) {
#pragma unroll
                        for (int q = 0; q < 18; ++q) *(LAS u32x4*)(F.lds + (t4 + 256 * q) * 16) = rb[q]; }
                    if (n + 4 < NCHK) {
#pragma unroll
                        for (int q = 0; q < 18; ++q) rb[q] = *(const u32x4*)(gn + (size_t)GREC + (size_t)q * 4096); }
                    SCAN_BAR();
                }
            } else {
                f32x16 S[4];
#pragma unroll
                for (int dt = 0; dt < 4; ++dt)
#pragma unroll
                    for (int i = 0; i < 16; ++i) S[dt][i] = 0.f;
                SCAN_BAR();
                for (int n = 0; n < NCHK; ++n) {
                    const int ch = bh * 32 + n;
                    const LAS unsigned char* buf = F.lds + (n & 1) * GREC + F.lane * 16;
                    const float eg = EG[ch];
                    bf16x8 Sb[8];
#pragma unroll
                    for (int dt = 0; dt < 4; ++dt) { Sb[2 * dt] = pack_acc(S[dt], 0); Sb[2 * dt + 1] = pack_acc(S[dt], 1); }
                    f32x16 vn[2];
#pragma unroll
                    for (int it = 0; it < 2; ++it) { const LAS u32x4* up = (const LAS u32x4*)(F.lds + (n & 1) * GREC + 57344 + ((sl * 2 + it) * 64 + F.lane) * 32);
                        const u32x4 u0 = up[0], u1 = up[1]; const unsigned uw[8] = {u0.x, u0.y, u0.z, u0.w, u1.x, u1.y, u1.z, u1.w};
#pragma unroll
                        for (int q = 0; q < 8; ++q) { vn[it][2 * q] = bflo(uw[q]); vn[it][2 * q + 1] = bfhi(uw[q]); } }
#pragma unroll
                    for (int it = 0; it < 2; ++it)
#pragma unroll
                        for (int ks = 0; ks < 8; ++ks) vn[it] = MFMA32(*(const LAS bf16x8*)(buf + (it * 8 + ks) * 1024), Sb[ks], vn[it]);
                    __builtin_amdgcn_sched_barrier(0);
                    f32x16 oa[2];
#pragma unroll
                    for (int it = 0; it < 2; ++it) {
#pragma unroll
                        for (int i = 0; i < 16; ++i) oa[it][i] = 0.f;
#pragma unroll
                        for (int ks = 0; ks < 8; ++ks) oa[it] = MFMA32(*(const LAS bf16x8*)(buf + (16 + it * 8 + ks) * 1024), Sb[ks], oa[it]);
                    }
                    __builtin_amdgcn_sched_barrier(0);
                    bf16x8 vb[4];
#pragma unroll
                    for (int it = 0; it < 2; ++it) { vb[2 * it] = pack_acc(vn[it], 0); vb[2 * it + 1] = pack_acc(vn[it], 1); }
                    __builtin_amdgcn_sched_barrier(0);
#pragma unroll
                    for (int it = 0; it < 2; ++it)
#pragma unroll
                        for (int ks = 0; ks < 4; ++ks) oa[it] = MFMA32(*(const LAS bf16x8*)(buf + (32 + it * 4 + ks) * 1024), vb[ks], oa[it]);
#pragma unroll
                    for (int it = 0; it < 2; ++it) {
#pragma unroll
                        for (int g4 = 0; g4 < 4; ++g4) { float* op = GO + opaque_off((size_t)(b * SEQ + n * CHK + 32 * it + 8 * g4 + 4 * hh) * 1024 + hd * 128 + sl * 32 + r);
#pragma unroll
                            for (int q = 0; q < 4; ++q) op[q * 1024] = oa[it][4 * g4 + q]; } }
                    __builtin_amdgcn_sched_barrier(0);
#pragma unroll
                    for (int dt = 0; dt < 4; ++dt) {
#pragma unroll
                        for (int i = 0; i < 16; ++i) S[dt][i] *= eg;
#pragma unroll
                        for (int ks = 0; ks < 4; ++ks) S[dt] = MFMA32(*(const LAS bf16x8*)(buf + (40 + dt * 4 + ks) * 1024), vb[ks], S[dt]);
                    }
                    SCAN_BAR();
                }
            }
#undef SCAN_BAR
            __syncthreads();
        }
    }
    SEAM(4);

    if (IN(5)) { PHASE_FRESH();
        for (int m = F.gw; m < T; m += F.NGW) {
            const int s = m & (SEQ - 1), c0 = F.lane * 16;
            const bf16* prow = PB + (size_t)m * NP;
            {
                const f32x4* op = (const f32x4*)(GO + (size_t)m * 1024 + c0);
                f32x4 o[4]; float ss = 0.f;
#pragma unroll
                for (int q = 0; q < 4; ++q) { o[q] = op[q]; ss += o[q][0] * o[q][0] + o[q][1] * o[q][1] + o[q][2] * o[q][2] + o[q][3] * o[q][3]; }
                ss += __shfl_xor(ss, 1); ss += __shfl_xor(ss, 2); ss += __shfl_xor(ss, 4);
                const float rms = rsqrtf(ss * (1.f / 128.f) + 1e-6f);
                const u32x4* zp = (const u32x4*)(prow + 3072 + c0); const u32x4 z0 = zp[0], z1 = zp[1];
                const unsigned zw[8] = {z0.x, z0.y, z0.z, z0.w, z1.x, z1.y, z1.z, z1.w};
                const f32x4* nwp = (const f32x4*)(gdn_norm_w + (c0 & 127));
                unsigned ow[8];
#pragma unroll
                for (int q = 0; q < 4; ++q) { const f32x4 nw = nwp[q];
                    const float y0 = o[q][0] * rms * nw[0] * silu_f(bflo(zw[2 * q])), y1 = o[q][1] * rms * nw[1] * silu_f(bfhi(zw[2 * q]));
                    const float y2 = o[q][2] * rms * nw[2] * silu_f(bflo(zw[2 * q + 1])), y3 = o[q][3] * rms * nw[3] * silu_f(bfhi(zw[2 * q + 1]));
                    ow[2 * q] = cvtpk(y0, y1); ow[2 * q + 1] = cvtpk(y2, y3); }
                u32x4* yp = (u32x4*)(YAB + (size_t)m * D + c0);
                yp[0] = (u32x4){ow[0], ow[1], ow[2], ow[3]}; yp[1] = (u32x4){ow[4], ow[5], ow[6], ow[7]};
            }
            {
                float accv[16];
#pragma unroll
                for (int q = 0; q < 16; ++q) accv[q] = 0.f;
#pragma unroll
                for (int j = 0; j < 3; ++j) {
                    if (s - 2 + j >= 0) {
                        const bf16* pr = prow + (ptrdiff_t)(j - 2) * NP;
                        const u32x4* cp = (const u32x4*)(pr + 5120 + c0); const u32x4* hp = (const u32x4*)(pr + 6144 + c0);
                        const u32x4 ca = cp[0], cb = cp[1], ha = hp[0], hb = hp[1];
                        const unsigned cw[8] = {ca.x, ca.y, ca.z, ca.w, cb.x, cb.y, cb.z, cb.w}, hw[8] = {ha.x, ha.y, ha.z, ha.w, hb.x, hb.y, hb.z, hb.w};
                        const f32x4* wp = (const f32x4*)(sc_conv_w + j * 1024 + c0);
#pragma unroll
                        for (int q = 0; q < 4; ++q) { const f32x4 w4 = wp[q];
                            accv[4 * q] += w4[0] * bflo(cw[2 * q]) * bflo(hw[2 * q]); accv[4 * q + 1] += w4[1] * bfhi(cw[2 * q]) * bfhi(hw[2 * q]);
                            accv[4 * q + 2] += w4[2] * bflo(cw[2 * q + 1]) * bflo(hw[2 * q + 1]); accv[4 * q + 3] += w4[3] * bfhi(cw[2 * q + 1]) * bfhi(hw[2 * q + 1]); }
                    }
                }
                const u32x4* bp = (const u32x4*)(prow + 4096 + c0); const u32x4 ba = bp[0], bb = bp[1];
                const unsigned bw[8] = {ba.x, ba.y, ba.z, ba.w, bb.x, bb.y, bb.z, bb.w};
                unsigned ow[8];
#pragma unroll
                for (int q = 0; q < 8; ++q) ow[q] = cvtpk(bflo(bw[q]) * accv[2 * q], bfhi(bw[q]) * accv[2 * q + 1]);
                u32x4* yp = (u32x4*)(YAB + (size_t)m * D + 1024 + c0);
                yp[0] = (u32x4){ow[0], ow[1], ow[2], ow[3]}; yp[1] = (u32x4){ow[4], ow[5], ow[6], ow[7]};
            }
        }
    }
    SEAM(5);

    if (IN(6)) { PHASE_FRESH();
        pg8::StaticOrder S; S.init(YAB, WOUT0, T, D, D, F.G, (int)blockIdx.x);
        pg8::EpiResid E{in_x, MOD + 2 * D, RB};
        pg8::gemm_phase<pg8::EpiResid, pg8::StaticOrder>(F.lds, D, S, E, F.tid, F.wave);
    }
    SEAM(6);

    if (IN(7)) { PHASE_FRESH(); ln_route_phase<0>(F, args); }
    if (IN(7) && IN(11)) { PHASE_FRESH(); xcd_barrier(bar, F.tid == 0); }


    moe_phases<0>(F, args, bar, lo, hi, TAB);

        if (IN(14)) { PHASE_FRESH();
            pg8::StaticOrder S; S.init(HIN, WMIN, T, NMLA, D, F.G, (int)blockIdx.x);
            pg8::EpiF32 E{C1, NMLA};
            pg8::gemm_phase<pg8::EpiF32, pg8::StaticOrder>(F.lds, D, S, E, F.tid, F.wave);
        }
        SEAM(14);
        if (IN(15)) { PHASE_FRESH();
            for (int m = F.gw; m < T; m += F.NGW) {
                const float* c1 = C1 + (size_t)m * NMLA;
#pragma unroll
                for (int part = 0; part < 2; ++part) {
                    const f32x4* p = (const f32x4*)(c1 + part * 512 + 8 * F.lane); const f32x4 a0 = p[0], a1 = p[1];
                    const float ss = wave_sum((a0[0] * a0[0] + a0[1] * a0[1]) + (a0[2] * a0[2] + a0[3] * a0[3]) + (a1[0] * a1[0] + a1[1] * a1[1]) + (a1[2] * a1[2] + a1[3] * a1[3]));
                    const float rn = rsqrtf(ss * (1.f / 512.f) + 1e-6f);
                    const f32x4* wp = (const f32x4*)((part == 0 ? mla_q_norm : mla_kv_norm) + 8 * F.lane); const f32x4 w0 = wp[0], w1 = wp[1];
                    u32x4 o; o.x = cvtpk(a0[0] * rn * w0[0], a0[1] * rn * w0[1]); o.y = cvtpk(a0[2] * rn * w0[2], a0[3] * rn * w0[3]);
                    o.z = cvtpk(a1[0] * rn * w1[0], a1[1] * rn * w1[1]); o.w = cvtpk(a1[2] * rn * w1[2], a1[3] * rn * w1[3]);
                    *(u32x4*)((part == 0 ? CQN : CKVN) + (size_t)m * 512 + 8 * F.lane) = o;
                }
                if (F.lane < 32) { const float x1 = c1[1024 + F.lane], x2 = c1[1056 + F.lane], cs = ROPE_C[(size_t)m * 32 + F.lane], sn = ROPE_S[(size_t)m * 32 + F.lane];
                    KPE[(size_t)m * 64 + F.lane] = x1 * cs - x2 * sn; KPE[(size_t)m * 64 + 32 + F.lane] = x1 * sn + x2 * cs; }
            }
        }
        SEAM(15);
        if (IN(16)) { PHASE_FRESH();
            { pg8::StaticOrder S; S.init(CQN, WUQ, T, 3072, 512, F.G, (int)blockIdx.x); pg8::EpiQup E{QB_};
              pg8::gemm_phase<pg8::EpiQup, pg8::StaticOrder>(F.lds, 512, S, E, F.tid, F.wave); }
            { pg8::StaticOrder S; S.init(CKVN, WUKV, T, 4096, 512, F.G, (int)blockIdx.x); pg8::EpiKVup E{KB_, VB_};
              pg8::gemm_phase<pg8::EpiKVup, pg8::StaticOrder>(F.lds, 512, S, E, F.tid, F.wave); }
        }
        SEAM(16);
        if (IN(17)) { PHASE_FRESH();
            for (int m = F.gw; m < T; m += F.NGW) {
                const int b = m / SEQ, s = m - b * SEQ, hd = F.lane >> 2, i0 = (F.lane & 3) * 8;
                const size_t rowoff = ((size_t)((b * MH + hd) * SEQ + s)) * QD + 128;
                bf16* qp = QB_ + rowoff;
                const u32x4 xa = *(const u32x4*)(qp + i0), xb = *(const u32x4*)(qp + 32 + i0);
                const f32x4* cp = (const f32x4*)(ROPE_C + (size_t)m * 32 + i0); const f32x4* sp = (const f32x4*)(ROPE_S + (size_t)m * 32 + i0);
                const f32x4 c0 = cp[0], c1v = cp[1], s0 = sp[0], s1 = sp[1];
                const float cs[8] = {c0[0], c0[1], c0[2], c0[3], c1v[0], c1v[1], c1v[2], c1v[3]}, sn[8] = {s0[0], s0[1], s0[2], s0[3], s1[0], s1[1], s1[2], s1[3]};
                const unsigned xaw[4] = {xa.x, xa.y, xa.z, xa.w}, xbw[4] = {xb.x, xb.y, xb.z, xb.w};
                unsigned o1[4], o2[4];
#pragma unroll
                for (int q = 0; q < 4; ++q) { const float a0 = bflo(xaw[q]), a1 = bfhi(xaw[q]), b0 = bflo(xbw[q]), b1 = bfhi(xbw[q]);
                    o1[q] = cvtpk(a0 * cs[2 * q] - b0 * sn[2 * q], a1 * cs[2 * q + 1] - b1 * sn[2 * q + 1]);
                    o2[q] = cvtpk(a0 * sn[2 * q] + b0 * cs[2 * q], a1 * sn[2 * q + 1] + b1 * cs[2 * q + 1]); }
                *(u32x4*)(qp + i0) = (u32x4){o1[0], o1[1], o1[2], o1[3]}; *(u32x4*)(qp + 32 + i0) = (u32x4){o2[0], o2[1], o2[2], o2[3]};
                const f32x4* kp = (const f32x4*)(KPE + (size_t)m * 64 + i0); const f32x4* kp2 = (const f32x4*)(KPE + (size_t)m * 64 + 32 + i0);
                const f32x4 k0 = kp[0], k1 = kp[1], k2 = kp2[0], k3 = kp2[1];
                bf16* kd = KB_ + rowoff;
                *(u32x4*)(kd + i0) = (u32x4){cvtpk(k0[0], k0[1]), cvtpk(k0[2], k0[3]), cvtpk(k1[0], k1[1]), cvtpk(k1[2], k1[3])};
                *(u32x4*)(kd + 32 + i0) = (u32x4){cvtpk(k2[0], k2[1]), cvtpk(k2[2], k2[3]), cvtpk(k3[0], k3[1]), cvtpk(k3[2], k3[3])};
            }
        }
        SEAM(17);
        if (IN(18)) { PHASE_FRESH();
            constexpr int KBUF = 64 * 400, VBUF = 64 * 320;
            LAS unsigned char* KL = F.lds; LAS unsigned char* VL = F.lds + 2 * KBUF;
            const int w = F.wave;
            for (int pi = blockIdx.x; pi < 256; pi += F.G) {
                const int bhh = pi >> 2, pp = pi & 3, b = bhh >> 4, hd = bhh & 15;
                const char* kg = (const char*)(KB_ + (size_t)bhh * SEQ * QD); const char* vg = (const char*)(VB_ + (size_t)b * SEQ * D + hd * 128);
                for (int half = 0; half < 2; ++half) {
                    PHASE_FRESH(); const int r = F.lane & 31, hh = F.lane >> 5;
                    const int qb = half == 0 ? 7 - pp : pp, q0 = qb * 256, ntile = 4 * (qb + 1), qrow = q0 + 32 * w + r;
                    bf16x8 qf[12];
                    { const bf16* qp = QB_ + ((size_t)bhh * SEQ + qrow) * QD + 8 * hh;
#pragma unroll
                      for (int ks = 0; ks < 12; ++ks) qf[ks] = *(const bf16x8*)(qp + 16 * ks); }
                    f32x16 oT[4];
#pragma unroll
                    for (int mt = 0; mt < 4; ++mt)
#pragma unroll
                        for (int i = 0; i < 16; ++i) oT[mt][i] = 0.f;
                    float mrun = -1e30f, lsum = 0.f;
                    u32x4 kst[3], vst[2];
#pragma unroll
                    for (int q = 0; q < 3; ++q) kst[q] = *(const u32x4*)(kg + (size_t)(F.tid + 512 * q) * 16);
#pragma unroll
                    for (int q = 0; q < 2; ++q) { const int p = F.tid + 512 * q; vst[q] = *(const u32x4*)(vg + (size_t)(p >> 4) * (D * 2) + (p & 15) * 16); }
#pragma unroll
                    for (int q = 0; q < 3; ++q) { const int p = F.tid + 512 * q; *(LAS u32x4*)(KL + (p / 24) * 400 + (p % 24) * 16) = kst[q]; }
#pragma unroll
                    for (int q = 0; q < 2; ++q) { const int p = F.tid + 512 * q; *(LAS u32x4*)(VL + (p >> 4) * 320 + (p & 15) * 16) = vst[q]; }
                    __syncthreads();
                    for (int kt = 0; kt < ntile; ++kt) {
                        const bool more = (kt + 1 < ntile); const int k0 = kt * 64;
                        if (more) {
                            const int k1 = k0 + 64;
#pragma unroll
                            for (int q = 0; q < 3; ++q) kst[q] = *(const u32x4*)(kg + (size_t)k1 * (QD * 2) + (size_t)(F.tid + 512 * q) * 16);
#pragma unroll
                            for (int q = 0; q < 2; ++q) { const int p = F.tid + 512 * q; vst[q] = *(const u32x4*)(vg + (size_t)(k1 + (p >> 4)) * (D * 2) + (p & 15) * 16); }
                        }
                        if (k0 <= q0 + 32 * w + 31) {
                            const LAS unsigned char* kb = KL + (kt & 1) * KBUF; const LAS unsigned char* vb_ = VL + (kt & 1) * VBUF;
                            f32x16 sT[2];
#pragma unroll
                            for (int kk = 0; kk < 2; ++kk) {
#pragma unroll
                                for (int i = 0; i < 16; ++i) sT[kk][i] = 0.f;
#pragma unroll
                                for (int ks = 0; ks < 12; ++ks) sT[kk] = MFMA32(*(const LAS bf16x8*)(kb + (32 * kk + r) * 400 + (16 * ks + 8 * hh) * 2), qf[ks], sT[kk]);
                            }
                            if (k0 + 63 > q0 + 32 * w) {
#pragma unroll
                                for (int kk = 0; kk < 2; ++kk)
#pragma unroll
                                    for (int reg = 0; reg < 16; ++reg) { const int key = k0 + 32 * kk + crow(reg, hh); if (key > qrow) sT[kk][reg] = -1e30f; }
                            }
                            float mloc = sT[0][0];
#pragma unroll
                            for (int kk = 0; kk < 2; ++kk)
#pragma unroll
                                for (int reg = 0; reg < 16; ++reg) mloc = fmaxf(mloc, sT[kk][reg]);
                            mloc = fmaxf(mloc, __shfl_xor(mloc, 32));
                            const float mnew = fmaxf(mrun, mloc), alpha = __builtin_amdgcn_exp2f(mrun - mnew);
                            float ps = 0.f;
#pragma unroll
                            for (int kk = 0; kk < 2; ++kk)
#pragma unroll
                                for (int reg = 0; reg < 16; ++reg) { const float pe = __builtin_amdgcn_exp2f(sT[kk][reg] - mnew); sT[kk][reg] = pe; ps += pe; }
                            lsum = lsum * alpha + ps; mrun = mnew;
#pragma unroll
                            for (int mt = 0; mt < 4; ++mt)
#pragma unroll
                                for (int i = 0; i < 16; ++i) oT[mt][i] *= alpha;
                            bf16x8 pb[4];
#pragma unroll
                            for (int kk = 0; kk < 2; ++kk) { pb[2 * kk] = pack_acc(sT[kk], 0); pb[2 * kk + 1] = pack_acc(sT[kk], 1); }
#pragma unroll
                            for (int mt = 0; mt < 4; ++mt)
#pragma unroll
                                for (int ks = 0; ks < 4; ++ks) {
                                const LAS unsigned char* vp = vb_ + (16 * ks + 4 * hh + ((F.lane & 15) >> 2)) * 320 + (32 * mt + 16 * ((F.lane >> 4) & 1) + 4 * (F.lane & 3)) * 2;
                                const s16x4 vlo = __builtin_bit_cast(s16x4, __builtin_amdgcn_ds_read_tr16_b64_v4i16((LAS v4i16_t*)vp));
                                const s16x4 vhi = __builtin_bit_cast(s16x4, __builtin_amdgcn_ds_read_tr16_b64_v4i16((LAS v4i16_t*)(vp + 8 * 320)));
                                const bf16x8 va = __builtin_shufflevector(vlo, vhi, 0, 1, 2, 3, 4, 5, 6, 7);
                                oT[mt] = MFMA32(va, pb[ks], oT[mt]); }
                        }
                        if (more) {
                            LAS unsigned char* kn = KL + ((kt + 1) & 1) * KBUF; LAS unsigned char* vn_ = VL + ((kt + 1) & 1) * VBUF;
#pragma unroll
                            for (int q = 0; q < 3; ++q) { const int p = F.tid + 512 * q; *(LAS u32x4*)(kn + (p / 24) * 400 + (p % 24) * 16) = kst[q]; }
#pragma unroll
                            for (int q = 0; q < 2; ++q) { const int p = F.tid + 512 * q; *(LAS u32x4*)(vn_ + (p >> 4) * 320 + (p & 15) * 16) = vst[q]; }
                        }
                        __syncthreads();
                    }
                    const float ltot = lsum + __shfl_xor(lsum, 32), inv = 1.f / ltot;
                    bf16* orow = YAB + (size_t)(b * SEQ + qrow) * D + hd * 128 + 4 * hh;
#pragma unroll
                    for (int mt = 0; mt < 4; ++mt)
#pragma unroll
                        for (int g4 = 0; g4 < 4; ++g4) { u32x2 o; o.x = cvtpk(oT[mt][4 * g4] * inv, oT[mt][4 * g4 + 1] * inv); o.y = cvtpk(oT[mt][4 * g4 + 2] * inv, oT[mt][4 * g4 + 3] * inv);
                            *(u32x2*)(orow + 32 * mt + 8 * g4) = o; }
                }
            }
        }
        SEAM(18);
        if (IN(19)) { PHASE_FRESH();
            pg8::StaticOrder S; S.init(YAB, WMOUT, T, D, D, F.G, (int)blockIdx.x);
            pg8::EpiResid E{XB, MOD + (size_t)4 * 12288 + 2 * D, RB};
            pg8::gemm_phase<pg8::EpiResid, pg8::StaticOrder>(F.lds, D, S, E, F.tid, F.wave);
        }
        SEAM(19);
        if (IN(20)) { PHASE_FRESH(); ln_route_phase<1>(F, args); }
        if (IN(20) && IN(24)) { PHASE_FRESH(); xcd_barrier(bar, F.tid == 0); }


    moe_phases<1>(F, args, bar, lo, hi, TAB);
#undef IN
#undef INL
#undef SEAM
#undef WSB
#undef in_x
#undef in_c
#undef in_pos
#undef ada_w
#undef ada_b
#undef ln_g
#undef ln_b
#undef hyb_w_in
#undef gdn_conv_w
#undef gdn_a_log
#undef gdn_dt_bias
#undef gdn_norm_w
#undef sc_conv_w
#undef hyb_w_out
#undef mla_w_in
#undef mla_q_norm
#undef mla_kv_norm
#undef mla_w_uq
#undef mla_w_ukv
#undef mla_w_out
#undef moe_router_g
#undef moe_bias_g
#undef moe_router_e
#undef moe_bias_e
#undef moe_w_gate
#undef moe_w_up
#undef moe_w_down
#undef MOD
#undef ROPE_C
#undef ROPE_S
#undef PBA
#undef LOGITS
#undef TOK_E
#undef TOK_POS
#undef TOK_GATE
#undef EG
#undef WIN0
#undef WOUT0
#undef WMIN
#undef WUQ
#undef WUKV
#undef WMOUT
#undef WRT
#undef WGU
#undef ADAP
#undef WDN
#undef HIN
#undef XA
#undef XB
#undef RB
#undef PB
#undef GF
#undef GU
#undef GO
#undef YAB
#undef LISTP
#undef HID
#undef YS
#undef C1
#undef CQN
#undef CKVN
#undef KPE
#undef QB_
#undef KB_
#undef VB_
#undef VT
}

extern "C" void kernel_launch(void* const* d_in, const int* in_sizes, int n_in, void* d_out, int out_size, void* d_ws, size_t ws_size, hipStream_t stream) {
    static int grid = 0;
    if (grid == 0) {
        if (n_in != 27 || in_sizes[0] != T * D || out_size != T * D || ws_size < WS_END) { fprintf(stderr, "kernel_launch: unexpected problem (n_in %d, in0 %d, out %d, ws %zu)\n", n_in, n_in > 0 ? in_sizes[0] : -1, out_size, ws_size); grid = -1; return; }
        int dev = 0, cus = 0, per_cu = 0;
        if (hipGetDevice(&dev) != hipSuccess || hipDeviceGetAttribute(&cus, hipDeviceAttributeMultiprocessorCount, dev) != hipSuccess) { grid = -1; return; }
        if (hipFuncSetAttribute((const void*)mega, hipFuncAttributeMaxDynamicSharedMemorySize, LDS_BYTES) != hipSuccess) { fprintf(stderr, "kernel_launch: hipFuncSetAttribute failed\n"); grid = -1; return; }
        if (hipOccupancyMaxActiveBlocksPerMultiprocessor(&per_cu, (const void*)mega, 512, LDS_BYTES) != hipSuccess || per_cu < 1) fprintf(stderr, "kernel_launch: occupancy query reports %d\n", per_cu);
        (void)hipGetLastError();
        grid = cus;
    }
    if (grid < 0) return;
    (void)hipMemsetAsync((char*)d_ws + WS_CTL, 0, CTL_ZERO_BYTES, stream);
    Args a{};
    for (int i = 0; i < 27; ++i) a.in[i] = d_in[i];
    a.out = (float*)d_out; a.ws = (unsigned char*)d_ws;
#if MK_ONE_LAUNCH
    a.ph_lo = 0; a.ph_hi = NPH;
    hipLaunchKernelGGL(mega, dim3(grid), dim3(512), LDS_BYTES, stream, a);
#else
    for (int k = 0; k < NPH; ++k) { a.ph_lo = k; a.ph_hi = k + 1; hipLaunchKernelGGL(mega, dim3(grid), dim3(512), LDS_BYTES, stream, a); }
#endif
}
```

```cpp
#include <hip/hip_runtime.h>
#include <cstdio>
#include <cstdint>

#ifndef MK_ONE_LAUNCH
#define MK_ONE_LAUNCH 1
#endif

#define DI __device__ __forceinline__
#define GAS __attribute__((address_space(1)))
#define LAS __attribute__((address_space(3)))
typedef unsigned short bf16;
typedef float f32x4 __attribute__((ext_vector_type(4)));
typedef float f32x2 __attribute__((ext_vector_type(2)));
typedef float f32x16 __attribute__((ext_vector_type(16)));
typedef short bf16x8 __attribute__((ext_vector_type(8)));
typedef short s16x4 __attribute__((ext_vector_type(4)));
typedef short v4i16_t __attribute__((ext_vector_type(4)));
typedef unsigned u32x4 __attribute__((ext_vector_type(4)));
typedef unsigned u32x2 __attribute__((ext_vector_type(2)));
typedef __bf16 bf16x2_t __attribute__((ext_vector_type(2)));
typedef GAS unsigned gu32;
#define RLX_AGENT __ATOMIC_RELAXED, __HIP_MEMORY_SCOPE_AGENT
#define LDS_WAIT() asm volatile("s_waitcnt lgkmcnt(0)" ::: "memory")
#define VM_WAIT() asm volatile("s_waitcnt vmcnt(0)" ::: "memory")
#define MFMA32(a, b, c) __builtin_amdgcn_mfma_f32_32x32x16_bf16((a), (b), (c), 0, 0, 0)

DI unsigned cvtpk(float lo, float hi) { f32x2 v = {lo, hi}; bf16x2_t b = __builtin_convertvector(v, bf16x2_t); return __builtin_bit_cast(unsigned, b); }
DI bf16 f2bf(float f) { return (bf16)(cvtpk(f, 0.f) & 0xffffu); }
DI float bf2f(bf16 b) { return __uint_as_float(((unsigned)b) << 16); }
DI float bflo(unsigned w) { return __uint_as_float(w << 16); }
DI float bfhi(unsigned w) { return __uint_as_float(w & 0xffff0000u); }
DI int crow(int reg, int h) { return (reg & 3) + 8 * (reg >> 2) + 4 * h; }
DI int kperm(int j, int h) { return 8 * (j >> 2) + 4 * h + (j & 3); }
DI float wave_sum(float v) {
#pragma unroll
    for (int o = 1; o < 64; o <<= 1) v += __shfl_xor(v, o);
    return v;
}
DI bf16x8 pack_acc(const f32x16& x, int s) {
    u32x4 p; p.x = cvtpk(x[8 * s + 0], x[8 * s + 1]); p.y = cvtpk(x[8 * s + 2], x[8 * s + 3]); p.z = cvtpk(x[8 * s + 4], x[8 * s + 5]); p.w = cvtpk(x[8 * s + 6], x[8 * s + 7]);
    return __builtin_bit_cast(bf16x8, p);
}
DI float silu_f(float x) { return x / (1.f + __expf(-x)); }
DI size_t opaque_off(size_t o) { asm volatile("" : "+v"(o)); return o; }

constexpr int D = 2048, BATCH = 4, SEQ = 2048, T = BATCH * SEQ;
constexpr int GH = 8, GD = 128, NCHK = 32, CHK = 64, NCH = BATCH * GH * NCHK;
constexpr int HYB_IN = 7184, NIN = 7424, NP = 7168;
constexpr int MH = 16, MLA_IN = 1088, NMLA = 1280, QD = 192;
constexpr int NE = 64, FF = 512, MAXBLK = 128;
constexpr float DN_ALPHA = 1.41421356237f;
constexpr float QSCALE = 0.10411754627697264f;
constexpr int NPH = 27;
constexpr int GREC = 73728;

constexpr size_t MiB = 1u << 20;
constexpr size_t WS_CTL = 0, CTL_ZERO_BYTES = 1 * MiB;
constexpr size_t WS_MOD = 1 * MiB;
constexpr size_t WS_ROPE = 2 * MiB;
constexpr size_t WS_PBA = 4 * MiB;
constexpr size_t WS_LOGITS = 5 * MiB;
constexpr size_t WS_ROUTE = 9 * MiB;
constexpr size_t WS_EG = 10 * MiB;
constexpr size_t WS_WIN0 = 16 * MiB;
constexpr size_t WS_WOUT0 = 46 * MiB;
constexpr size_t WS_WMIN = 54 * MiB;
constexpr size_t WS_WUQ = 59 * MiB;
constexpr size_t WS_WUKV = 62 * MiB;
constexpr size_t WS_WMOUT = 66 * MiB;
constexpr size_t WS_WRT = 74 * MiB;
constexpr size_t WS_WGU = 80 * MiB;
constexpr size_t WS_WDN = 592 * MiB;
constexpr size_t WS_HIN = 848 * MiB;
constexpr size_t WS_XA = 880 * MiB;
constexpr size_t WS_XB = 944 * MiB;
constexpr size_t WS_R = 1008 * MiB;
constexpr size_t WS_P = 1072 * MiB;
constexpr size_t WS_GF = 1184 * MiB;
constexpr size_t WS_GU = 1240 * MiB;
constexpr size_t WS_GO = 1272 * MiB;
constexpr size_t WS_YAB = 1304 * MiB;
constexpr size_t WS_XS = 1336 * MiB;
constexpr size_t WS_HID = 1464 * MiB;
constexpr size_t WS_YS = 1496 * MiB;
constexpr size_t WS_C1 = 1624 * MiB;
constexpr size_t WS_CQN = 1664 * MiB;
constexpr size_t WS_CKVN = 1672 * MiB;
constexpr size_t WS_KPE = 1680 * MiB;
constexpr size_t WS_Q = 1684 * MiB;
constexpr size_t WS_K = 1732 * MiB;
constexpr size_t WS_V = 1780 * MiB;
constexpr size_t WS_VT = 1812 * MiB;
constexpr size_t WS_END = 1844 * MiB;
constexpr int CW_BAR = 4096;
constexpr int CW_CNT = 8192;
constexpr int CW_BLK = 8448;

constexpr int RING_BYTES = 131072;
constexpr int LDSCTL_OFF = 155648, MISC_OFF = LDSCTL_OFF + 320;
constexpr int TAB_OFF = LDSCTL_OFF + 512;
constexpr int SC_OFF = LDSCTL_OFF + 1536;
constexpr int LDS_BYTES = 159744;

namespace pg8 {
constexpr int BM = 256, BK = 64, HALF = 128, HTB = HALF * BK * 2, STAGE_BYTES = 8 * HTB, NXCD = 8, WGM = 8;
__host__ __device__ __forceinline__ int lds_byte(int r, int c) { const int st = (r >> 4) * 2 + (c >> 5), rr = r & 15, cc = c & 31, ob = rr * 64 + cc * 2; return st * 1024 + (ob ^ (((ob >> 9) & 1) << 5)); }
__host__ __device__ __forceinline__ void stage_rc(int b, int& R, int& C) { const int st = b / 1024, sb = b % 1024, swz = sb ^ (((sb >> 9) & 1) << 5); R = (st >> 1) * 16 + swz / 64; C = (st & 1) * 32 + (swz % 64) / 2; }
__host__ __device__ __forceinline__ int perm32(int rho) { const int n = rho >> 4, i = rho & 15; return 8 * (i >> 2) + 4 * n + (i & 3); }

struct Unit { int pm, pn, ex, rows; };

struct StaticOrder {
    int nM, nN, nwg, G, c; const char* A; const char* Bt; size_t tstep;
    __device__ void init(const bf16* A_, const bf16* Bt_, int M, int N, int K, int G_, int c_) { nM = M / BM; nN = N / BM; nwg = nM * nN; G = G_; c = c_; A = (const char*)A_; Bt = (const char*)Bt_; tstep = (size_t)BM * K * 2; }
    __device__ bool next(int i, Unit& u) const {
        const long L = (long)i * G + c; if (L >= nwg) return false;
        int wgid = (int)L; { const int q = nwg / NXCD, r = nwg % NXCD, xcd = wgid % NXCD, off = wgid / NXCD; wgid = (xcd < r ? xcd * (q + 1) : r * (q + 1) + (xcd - r) * q) + off; }
        const int nig = WGM * nN, gid = wgid / nig, fm = gid * WGM, gsz = (nM - fm) < WGM ? (nM - fm) : WGM;
        u.pm = fm + ((wgid % nig) % gsz); u.pn = (wgid % nig) / gsz; u.ex = 0; u.rows = 256; return true;
    }
    __device__ __forceinline__ const char* aptr(const Unit& u) const { return A + (size_t)u.pm * tstep; }
    __device__ __forceinline__ const char* bptr(const Unit& u) const { return Bt + (size_t)u.pn * tstep; }
};
struct MapOrder : StaticOrder {
    int first, nfirst, extra;
    __device__ bool next(int i, Unit& u) const { if (!StaticOrder::next(i, u)) return false; u.pn = (u.pn < nfirst) ? first + u.pn : extra; return true; }
};
struct MoeOrder {
    int nunits, NT, G, c; const LAS int* blk_e; const char* A; const char* W; size_t a_tstep, w_estride, w_tstep;
    __device__ bool next(int i, Unit& u) const {
        const long L = (long)i * G + c; if (L >= nunits) return false;
        u.pm = (int)L / NT; u.pn = (int)L % NT; u.ex = blk_e[u.pm]; u.rows = 256; return true;
    }
    __device__ __forceinline__ const char* aptr(const Unit& u) const { return A + (size_t)u.pm * a_tstep; }
    __device__ __forceinline__ const char* bptr(const Unit& u) const { return W + (size_t)u.ex * w_estride + (size_t)u.pn * w_tstep; }
};

template <class Epi, class Sched, bool ALIGN_EPI = true, bool SP2 = true>
__device__ __forceinline__ void gemm_phase(LAS unsigned char* lds, const int K_, const Sched& S, const Epi& E, const int tid, const int wid) {
    const int lane = tid & 63, wr = wid >> 2, wc = wid & 3, fr = lane & 15, fq = lane >> 4;
    int K = K_; asm volatile("" : "+s"(K));
    const int nt = K / BK;
    unsigned voffA[2], voffB[2];
#pragma unroll
    for (int i = 0; i < 2; ++i) { int R, C; stage_rc(tid * 16 + i * 8192, R, C); const int Rb = Epi::PERM ? ((R & ~31) + perm32(R & 31)) : R;
        voffA[i] = (unsigned)(R * K + C) * 2u; voffB[i] = (unsigned)(Rb * K + C) * 2u; }
    const size_t kstep = (size_t)(BK * 2);
    const size_t hstep = (size_t)HALF * K * 2;
    const unsigned ldsw = (unsigned)wid * 1024u;
    const int aoff = lds_byte(wr * 64 + fr, fq * 8), boff = lds_byte(wc * 32 + fr, fq * 8);
#define PG8_SA(b, h) (((b) * 2 + (h)) * HTB)
#define PG8_SB(b, h) ((4 + (b) * 2 + (h)) * HTB)
#define PG8_STAGE(bufoff, gbase, voff) do { _Pragma("unroll") for (int _i = 0; _i < 2; ++_i) \
        __builtin_amdgcn_global_load_lds((const unsigned*)((const char*)(gbase) + (voff)[_i]), (LAS unsigned*)(lds + (bufoff) + ldsw + _i * 8192), 16, 0, 0); } while (0)
#define PG8_LDA(dst, b, h) do { _Pragma("unroll") for (int m = 0; m < 4; ++m) _Pragma("unroll") for (int k = 0; k < 2; ++k) dst[m][k] = *(const LAS bf16x8*)(lds + PG8_SA(b, h) + aoff + m * 2048 + k * 1024); } while (0)
#define PG8_LDB(dst, b, h) do { _Pragma("unroll") for (int n = 0; n < 2; ++n) _Pragma("unroll") for (int k = 0; k < 2; ++k) dst[n][k] = *(const LAS bf16x8*)(lds + PG8_SB(b, h) + boff + n * 2048 + k * 1024); } while (0)
#define PG8_MMA(ai, bj, At, Bt) do { __builtin_amdgcn_s_setprio(1); _Pragma("unroll") for (int m = 0; m < 4; ++m) _Pragma("unroll") for (int n = 0; n < 2; ++n) _Pragma("unroll") for (int k = 0; k < 2; ++k) \
        acc[ai][bj][m][n] = __builtin_amdgcn_mfma_f32_16x16x32_bf16(Bt[n][k], At[m][k], acc[ai][bj][m][n], 0, 0, 0); __builtin_amdgcn_s_setprio(0); } while (0)
#define PG8_WAIT_V(n) asm volatile("s_waitcnt vmcnt(" #n ")" ::: "memory")
#define PG8_WAIT_L(n) asm volatile("s_waitcnt lgkmcnt(" #n ")" ::: "memory")
#define PG8_BAR __builtin_amdgcn_s_barrier()
#define PG8_SCHED __builtin_amdgcn_sched_barrier(0)
    Unit cur, nxt; int ui = 0;
    if (!S.next(0, cur)) return;
    f32x4 acc[2][2][4][2];
#pragma unroll
    for (int a = 0; a < 2; ++a)
#pragma unroll
        for (int b = 0; b < 2; ++b)
#pragma unroll
            for (int m = 0; m < 4; ++m)
#pragma unroll
                for (int n = 0; n < 2; ++n) acc[a][b][m][n] = (f32x4){0.f, 0.f, 0.f, 0.f};
    bf16x8 At[4][2], B0[2][2], B1[2][2];
    const char* cA = S.aptr(cur); const char* cB = S.bptr(cur);
    if constexpr (SP2) {
        PG8_STAGE(PG8_SB(0, 0), cB, voffB); PG8_STAGE(PG8_SB(0, 1), cB + hstep, voffB); PG8_STAGE(PG8_SA(0, 0), cA, voffA); PG8_STAGE(PG8_SA(0, 1), cA + hstep, voffA);
        if (wr == 1) PG8_BAR;
        PG8_WAIT_V(2); PG8_BAR;
        PG8_STAGE(PG8_SB(1, 0), cB + kstep, voffB); PG8_STAGE(PG8_SA(1, 0), cA + kstep, voffA); PG8_STAGE(PG8_SB(1, 1), cB + hstep + kstep, voffB);
        PG8_WAIT_V(6); PG8_BAR;
    } else {
        PG8_STAGE(PG8_SB(0, 0), cB, voffB); PG8_STAGE(PG8_SA(0, 0), cA, voffA); PG8_STAGE(PG8_SB(0, 1), cB + hstep, voffB); PG8_STAGE(PG8_SA(0, 1), cA + hstep, voffA);
        if (wr == 1) PG8_BAR;
        PG8_WAIT_V(4); PG8_BAR;
        PG8_STAGE(PG8_SB(1, 0), cB + kstep, voffB); PG8_STAGE(PG8_SA(1, 0), cA + kstep, voffA); PG8_STAGE(PG8_SB(1, 1), cB + hstep + kstep, voffB);
        PG8_WAIT_V(6); PG8_BAR;
    }
    for (;;) {
        const bool has_next = S.next(ui + 1, nxt);
        const char* nA = has_next ? S.aptr(nxt) : cA; const char* nB = has_next ? S.bptr(nxt) : cB;
        for (int t = 0; t < nt; t += 2) {
            const bool last = (t == nt - 2);
            const char* a1 = cA + (size_t)(t + 1) * kstep;
            const char* a2 = last ? nA : cA + (size_t)(t + 2) * kstep; const char* b2 = last ? nB : cB + (size_t)(t + 2) * kstep;
            const char* a3 = a2 + kstep; const char* b3 = b2 + kstep;
            if constexpr (SP2) {
            PG8_LDB(B0, 0, 0); PG8_LDB(B1, 0, 1); PG8_SCHED; PG8_LDA(At, 0, 0); PG8_STAGE(PG8_SA(1, 1), a1 + hstep, voffA);
            PG8_WAIT_V(8); PG8_WAIT_L(0); PG8_BAR; PG8_MMA(0, 0, At, B0); PG8_MMA(0, 1, At, B1); PG8_BAR; PG8_SCHED;
            PG8_LDA(At, 0, 1); PG8_STAGE(PG8_SB(0, 0), b2, voffB); PG8_STAGE(PG8_SB(0, 1), b2 + hstep, voffB); PG8_STAGE(PG8_SA(0, 0), a2, voffA);
            PG8_WAIT_V(8); PG8_WAIT_L(0); PG8_BAR; PG8_MMA(1, 0, At, B0); PG8_MMA(1, 1, At, B1); PG8_BAR; PG8_SCHED;
            PG8_LDB(B0, 1, 0); PG8_LDB(B1, 1, 1); PG8_SCHED; PG8_LDA(At, 1, 0); PG8_STAGE(PG8_SA(0, 1), a2 + hstep, voffA);
            PG8_WAIT_V(8); PG8_WAIT_L(0); PG8_BAR; PG8_MMA(0, 0, At, B0); PG8_MMA(0, 1, At, B1); PG8_BAR; PG8_SCHED;
            PG8_LDA(At, 1, 1); PG8_STAGE(PG8_SB(1, 0), b3, voffB); PG8_STAGE(PG8_SB(1, 1), b3 + hstep, voffB); PG8_STAGE(PG8_SA(1, 0), a3, voffA);
            PG8_WAIT_V(8); PG8_WAIT_L(0); PG8_BAR; PG8_MMA(1, 0, At, B0); PG8_MMA(1, 1, At, B1); PG8_BAR; PG8_SCHED;
            } else {
            PG8_LDB(B0, 0, 0); PG8_SCHED; PG8_LDA(At, 0, 0); PG8_STAGE(PG8_SA(1, 1), a1 + hstep, voffA);
            PG8_WAIT_L(8); PG8_BAR; PG8_WAIT_L(0); PG8_MMA(0, 0, At, B0); PG8_BAR; PG8_SCHED;
            PG8_LDB(B1, 0, 1); PG8_STAGE(PG8_SB(0, 0), b2, voffB);
            PG8_BAR; PG8_WAIT_L(0); PG8_MMA(0, 1, At, B1); PG8_BAR;
            PG8_LDA(At, 0, 1); PG8_STAGE(PG8_SA(0, 0), a2, voffA);
            PG8_BAR; PG8_WAIT_L(0); PG8_MMA(1, 0, At, B0); PG8_BAR; PG8_SCHED;
            PG8_STAGE(PG8_SB(0, 1), b2 + hstep, voffB);
            PG8_WAIT_V(6); PG8_BAR; PG8_MMA(1, 1, At, B1); PG8_BAR;
            PG8_LDB(B0, 1, 0); PG8_SCHED; PG8_LDA(At, 1, 0); PG8_STAGE(PG8_SA(0, 1), a2 + hstep, voffA);
            PG8_WAIT_L(8); PG8_BAR; PG8_WAIT_L(0); PG8_MMA(0, 0, At, B0); PG8_BAR; PG8_SCHED;
            PG8_LDB(B1, 1, 1); PG8_STAGE(PG8_SB(1, 0), b3, voffB);
            PG8_BAR; PG8_WAIT_L(0); PG8_MMA(0, 1, At, B1); PG8_BAR;
            PG8_LDA(At, 1, 1); PG8_STAGE(PG8_SA(1, 0), a3, voffA);
            PG8_BAR; PG8_WAIT_L(0); PG8_MMA(1, 0, At, B0); PG8_BAR; PG8_SCHED;
            PG8_STAGE(PG8_SB(1, 1), b3 + hstep, voffB);
            PG8_WAIT_V(6); PG8_BAR; PG8_MMA(1, 1, At, B1); PG8_BAR;
            }
        }
        if constexpr (ALIGN_EPI) { if (wr == 0) PG8_BAR; }
        E(acc, cur, wr, wc, fr, fq);
        if (!has_next) break;
#pragma unroll
        for (int a = 0; a < 2; ++a)
#pragma unroll
            for (int b = 0; b < 2; ++b)
#pragma unroll
                for (int m = 0; m < 4; ++m)
#pragma unroll
                    for (int n = 0; n < 2; ++n) acc[a][b][m][n] = (f32x4){0.f, 0.f, 0.f, 0.f};
        cur = nxt; cA = nA; cB = nB; ++ui;
        if constexpr (ALIGN_EPI) { if (wr == 1) PG8_BAR; }
    }
    PG8_WAIT_V(0);
    if constexpr (!ALIGN_EPI) { if (wr == 0) PG8_BAR; }
    PG8_BAR;
#undef PG8_SA
#undef PG8_SB
#undef PG8_STAGE
#undef PG8_LDA
#undef PG8_LDB
#undef PG8_MMA
#undef PG8_WAIT_V
#undef PG8_WAIT_L
#undef PG8_BAR
#undef PG8_SCHED
}


__host__ __device__ __forceinline__ int iperm32(int c) { return 16 * ((c >> 2) & 1) + 4 * (c >> 3) + (c & 3); }
struct MoeDirect {
    int nunits, NT, G, c; const LAS int* tab;
    const float* W0; const float* W1; size_t estride; int cols_per_tile, half1_off;
    __device__ bool next(int i, Unit& u) const {
        const long L = (long)i * G + c; if (L >= nunits) return false;
        u.pm = (int)L / NT; u.pn = (int)L % NT; u.ex = tab[u.pm];
        const int rem = tab[200 + u.ex] - (u.pm - tab[128 + u.ex]) * 256; u.rows = rem < 256 ? rem : 256; return true;
    }
    __device__ __forceinline__ const float* bptr(const Unit& u, int h) const { return (h ? W1 + half1_off : W0) + (size_t)u.ex * estride + (size_t)u.pn * cols_per_tile; }
};
template <class Epi, bool GATHER>
__device__ __forceinline__ void gemm_phase_moe(LAS unsigned char* lds, const int K_, const int ldw_, const MoeDirect& S, const Epi& E, const bf16* Abase, const int* LIST, const int tid, const int wid) {
    const int wr = wid >> 2, wc = wid & 3;
#define MO_LANE_CONSTS(tl) const int lane = (tl) & 63, fr = lane & 15, fq = lane >> 4; \
    const int aoff = lds_byte(wr * 64 + fr, fq * 8), boff = lds_byte(wc * 32 + fr, fq * 8); \
    const int kq = lane & 7, ng = 8 * wc + (lane >> 3); \
    const unsigned bvoff = (unsigned)((4 * kq) * ldw + 4 * ng) * 4u; \
    const int bslot0 = Epi::PERM ? (((4 * ng) & ~31) + iperm32((4 * ng) & 31)) : 4 * ng; \
    const unsigned bwbase = (unsigned)lds_byte(bslot0, 4 * kq)
    int K = K_; asm volatile("" : "+s"(K));
    int ldw = ldw_; asm volatile("" : "+s"(ldw));
    const int nt = K / BK;
    const unsigned ldsw = (unsigned)wid * 1024u;
    const size_t bkstep = (size_t)64 * ldw * 4, browb = (size_t)ldw * 4;
    f32x4 br[4];
#define MO_SA(b, h) (((b) * 2 + (h)) * HTB)
#define MO_SB(b, h) ((4 + (b) * 2 + (h)) * HTB)
#define MO_STAGE_A(bufoff, basep, o0, o1) do { \
        __builtin_amdgcn_global_load_lds((const unsigned*)((const char*)(basep) + (o0)), (LAS unsigned*)(lds + (bufoff) + ldsw), 16, 0, 0); \
        __builtin_amdgcn_global_load_lds((const unsigned*)((const char*)(basep) + (o1)), (LAS unsigned*)(lds + (bufoff) + ldsw + 8192), 16, 0, 0); } while (0)
#define MO_BISSUE(p, R) do { const char* _p = (const char*)(p) + (size_t)(32 * (R)) * browb; _Pragma("unroll") for (int _j = 0; _j < 4; ++_j) \
        asm volatile("global_load_dwordx4 %0, %1, %2" : "=v"(br[_j]) : "v"(bvoff), "s"(_p + (size_t)_j * browb) : "memory"); } while (0)
#define MO_VWAIT0() asm volatile("s_waitcnt vmcnt(0)" : "+v"(br[0]), "+v"(br[1]), "+v"(br[2]), "+v"(br[3]) :: "memory")
#define MO_BWRITE(b, R) do { _Pragma("unroll") for (int _i = 0; _i < 4; ++_i) { u32x2 _o; _o.x = cvtpk(br[0][_i], br[1][_i]); _o.y = cvtpk(br[2][_i], br[3][_i]); \
        *(LAS u32x2*)(lds + MO_SB(b, wr) + bwbase + 1024 * (R) + 64 * _i) = _o; } } while (0)
#define MO_LDA(dst, b, h) do { _Pragma("unroll") for (int m = 0; m < 4; ++m) _Pragma("unroll") for (int k = 0; k < 2; ++k) dst[m][k] = *(const LAS bf16x8*)(lds + MO_SA(b, h) + aoff + m * 2048 + k * 1024); } while (0)
#define MO_LDB(dst, b, h) do { _Pragma("unroll") for (int n = 0; n < 2; ++n) _Pragma("unroll") for (int k = 0; k < 2; ++k) dst[n][k] = *(const LAS bf16x8*)(lds + MO_SB(b, h) + boff + n * 2048 + k * 1024); } while (0)
#define MO_MMA(ai, bj, At, Bt) do { __builtin_amdgcn_s_setprio(1); _Pragma("unroll") for (int m = 0; m < 4; ++m) _Pragma("unroll") for (int n = 0; n < 2; ++n) _Pragma("unroll") for (int k = 0; k < 2; ++k) \
        acc[ai][bj][m][n] = __builtin_amdgcn_mfma_f32_16x16x32_bf16(Bt[n][k], At[m][k], acc[ai][bj][m][n], 0, 0, 0); __builtin_amdgcn_s_setprio(0); } while (0)
#define MO_WAIT_L(n) asm volatile("s_waitcnt lgkmcnt(" #n ")" ::: "memory")
#define MO_BAR __builtin_amdgcn_s_barrier()
#define MO_SCHED __builtin_amdgcn_sched_barrier(0)
#define MO_AOFF(u, dst) do { _Pragma("unroll") for (int _i = 0; _i < 2; ++_i) { int _R, _C; stage_rc(tid * 16 + _i * 8192, _R, _C); _Pragma("unroll") for (int _h = 0; _h < 2; ++_h) { const int _r = 128 * _h + _R; \
        if (GATHER) { const int _p = ((u).pm - S.tab[128 + (u).ex]) * 256 + _r; const int _t = (_r < (u).rows) ? LIST[(size_t)(u).ex * 8192 + _p] : 0; dst[_h][_i] = (unsigned)(_t * K + _C) * 2u; } \
        else dst[_h][_i] = (unsigned)(_r * K + _C) * 2u; } } } while (0)
    Unit cur, nxt; int ui = 0;
    if (!S.next(0, cur)) return;
    f32x4 acc[2][2][4][2];
#pragma unroll
    for (int a = 0; a < 2; ++a)
#pragma unroll
        for (int b = 0; b < 2; ++b)
#pragma unroll
            for (int m = 0; m < 4; ++m)
#pragma unroll
                for (int n = 0; n < 2; ++n) acc[a][b][m][n] = (f32x4){0.f, 0.f, 0.f, 0.f};
    bf16x8 At[4][2], B0[2][2], B1[2][2];
    unsigned cAo[2][2];
    LAS u32x4* const aslot = (LAS u32x4*)(lds + STAGE_BYTES) + tid;
    MO_AOFF(cur, cAo);
    const char* cAb = GATHER ? (const char*)Abase : (const char*)Abase + (size_t)cur.pm * 256 * K * 2;
    const char* cBh = (const char*)S.bptr(cur, wr);
    { MO_LANE_CONSTS(tid);
    MO_BISSUE(cBh, 0); MO_STAGE_A(MO_SA(0, 0), cAb, cAo[0][0], cAo[0][1]); MO_STAGE_A(MO_SA(0, 1), cAb, cAo[1][0], cAo[1][1]);
    if (wr == 1) MO_BAR;
    MO_VWAIT0(); MO_BWRITE(0, 0); MO_BISSUE(cBh, 1);
    MO_VWAIT0(); MO_BWRITE(0, 1);
    MO_WAIT_L(0); MO_BAR;
    MO_BISSUE(cBh + bkstep, 0); MO_STAGE_A(MO_SA(1, 0), cAb + 128, cAo[0][0], cAo[0][1]);
    MO_VWAIT0(); MO_BWRITE(1, 0); MO_BISSUE(cBh + bkstep, 1);
    MO_WAIT_L(0); MO_BAR; }
    for (;;) {
        const bool has_next = S.next(ui + 1, nxt);
        const char* nAb = cAb; const char* nBh = cBh;
        if (has_next) { nAb = GATHER ? (const char*)Abase : (const char*)Abase + (size_t)nxt.pm * 256 * K * 2; nBh = (const char*)S.bptr(nxt, wr);
            if (GATHER) { unsigned nAo[2][2]; MO_AOFF(nxt, nAo); *aslot = (u32x4){nAo[0][0], nAo[0][1], nAo[1][0], nAo[1][1]}; } }
        const bool halfu = cur.rows <= 128;
        for (int t = 0; t < nt; t += 2) {
            int tl = tid; asm volatile("" : "+v"(tl)); MO_LANE_CONSTS(tl);
            const bool last = (t == nt - 2);
            const char* a1 = cAb + (size_t)(t + 1) * 128;
            const char* a2 = last ? nAb : cAb + (size_t)(t + 2) * 128; const char* a3 = a2 + 128;
            const char* b2 = last ? nBh : cBh + (size_t)(t + 2) * bkstep; const char* b3 = b2 + bkstep;
            MO_LDB(B0, 0, 0); MO_LDB(B1, 0, 1); MO_SCHED; MO_LDA(At, 0, 0);
            MO_VWAIT0(); MO_BWRITE(1, 1); MO_STAGE_A(MO_SA(1, 1), a1, cAo[1][0], cAo[1][1]); MO_BISSUE(b2, 0);
            if (GATHER && last && has_next) { const u32x4 _n = *aslot; cAo[0][0] = _n.x; cAo[0][1] = _n.y; cAo[1][0] = _n.z; cAo[1][1] = _n.w; }
            MO_WAIT_L(0); MO_BAR; MO_MMA(0, 0, At, B0); MO_MMA(0, 1, At, B1); MO_BAR; MO_SCHED;
            MO_LDA(At, 0, 1);
            MO_VWAIT0(); MO_BWRITE(0, 0); MO_STAGE_A(MO_SA(0, 0), a2, cAo[0][0], cAo[0][1]); MO_BISSUE(b2, 1);
            MO_WAIT_L(0); MO_BAR; if (!halfu) { MO_MMA(1, 0, At, B0); MO_MMA(1, 1, At, B1); } MO_BAR; MO_SCHED;
            MO_LDB(B0, 1, 0); MO_LDB(B1, 1, 1); MO_SCHED; MO_LDA(At, 1, 0);
            MO_VWAIT0(); MO_BWRITE(0, 1); MO_STAGE_A(MO_SA(0, 1), a2, cAo[1][0], cAo[1][1]); MO_BISSUE(b3, 0);
            MO_WAIT_L(0); MO_BAR; MO_MMA(0, 0, At, B0); MO_MMA(0, 1, At, B1); MO_BAR; MO_SCHED;
            MO_LDA(At, 1, 1);
            MO_VWAIT0(); MO_BWRITE(1, 0); MO_STAGE_A(MO_SA(1, 0), a3, cAo[0][0], cAo[0][1]); MO_BISSUE(b3, 1);
            MO_WAIT_L(0); MO_BAR; if (!halfu) { MO_MMA(1, 0, At, B0); MO_MMA(1, 1, At, B1); } MO_BAR; MO_SCHED;
        }
        if (wr == 0) MO_BAR;
        { const int lane = tid & 63; E(acc, cur, wr, wc, lane & 15, lane >> 4); }
        if (!has_next) break;
#pragma unroll
        for (int a = 0; a < 2; ++a)
#pragma unroll
            for (int b = 0; b < 2; ++b)
#pragma unroll
                for (int m = 0; m < 4; ++m)
#pragma unroll
                    for (int n = 0; n < 2; ++n) acc[a][b][m][n] = (f32x4){0.f, 0.f, 0.f, 0.f};
        cur = nxt; cAb = nAb; cBh = nBh; ++ui;
        if (wr == 1) MO_BAR;
    }
    MO_VWAIT0();
    MO_BAR;
#undef MO_SA
#undef MO_SB
#undef MO_STAGE_A
#undef MO_BISSUE
#undef MO_VWAIT0
#undef MO_BWRITE
#undef MO_LDA
#undef MO_LDB
#undef MO_MMA
#undef MO_WAIT_L
#undef MO_BAR
#undef MO_SCHED
#undef MO_AOFF
#undef MO_LANE_CONSTS
}

template <class Epi, bool GATHER>
__device__ __forceinline__ void gemm_phase_moe32(LAS unsigned char* lds, const int K_, const int ldw_, const MoeDirect& S, const Epi& E, const bf16* Abase, const int* LIST, const int tid, const int wid) {
    const int wr = wid >> 2, wc = wid & 3;
#define MO_LANE_CONSTS(tl) const int lane = (tl) & 63, fr = lane & 15, fq = lane >> 4; \
    const int aoff = lds_byte(wr * 64 + fr, fq * 8), boff = lds_byte(wc * 32 + fr, fq * 8); \
    const int kq = lane & 7, ng = 8 * wc + (lane >> 3); \
    const unsigned bvoff = (unsigned)((4 * kq) * ldw + 4 * ng) * 4u; \
    const int bslot0 = Epi::PERM ? (((4 * ng) & ~31) + iperm32((4 * ng) & 31)) : 4 * ng; \
    const unsigned bwbase = (unsigned)lds_byte(bslot0, 4 * kq)
    int K = K_; asm volatile("" : "+s"(K));
    int ldw = ldw_; asm volatile("" : "+s"(ldw));
    const int nt = K / BK;
    const unsigned ldsw = (unsigned)wid * 1024u;
    const size_t bkstep = (size_t)64 * ldw * 4, browb = (size_t)ldw * 4;
    f32x4 br[8];
#define MO_SA(b, h) (((b) * 2 + (h)) * HTB)
#define MO_SB(b, h) ((4 + (b) * 2 + (h)) * HTB)
#define MO_STAGE_A(bufoff, basep, o0, o1) do { \
        __builtin_amdgcn_global_load_lds((const unsigned*)((const char*)(basep) + (o0)), (LAS unsigned*)(lds + (bufoff) + ldsw), 16, 0, 0); \
        __builtin_amdgcn_global_load_lds((const unsigned*)((const char*)(basep) + (o1)), (LAS unsigned*)(lds + (bufoff) + ldsw + 8192), 16, 0, 0); } while (0)
#define MO_BISSUE(p) do { const char* _p = (const char*)(p); _Pragma("unroll") for (int _j = 0; _j < 8; ++_j) \
        asm volatile("global_load_dwordx4 %0, %1, %2" : "=v"(br[_j]) : "v"(bvoff), "s"(_p + (size_t)(32 * (_j >> 2) + (_j & 3)) * browb) : "memory"); } while (0)
#define MO_BWAIT(n) asm volatile("s_waitcnt vmcnt(" #n ")" : "+v"(br[0]), "+v"(br[1]), "+v"(br[2]), "+v"(br[3]), "+v"(br[4]), "+v"(br[5]), "+v"(br[6]), "+v"(br[7]) :: "memory")
#define MO_WAIT_V(n) asm volatile("s_waitcnt vmcnt(" #n ")" ::: "memory")
#define MO_BWRITE(b) do { _Pragma("unroll") for (int _R = 0; _R < 2; ++_R) _Pragma("unroll") for (int _i = 0; _i < 4; ++_i) { u32x2 _o; \
        _o.x = cvtpk(br[4 * _R][_i], br[4 * _R + 1][_i]); _o.y = cvtpk(br[4 * _R + 2][_i], br[4 * _R + 3][_i]); \
        *(LAS u32x2*)(lds + MO_SB(b, wr) + bwbase + 1024 * _R + 64 * _i) = _o; } } while (0)
#define MO_LDA(dst, b, h) do { _Pragma("unroll") for (int m = 0; m < 4; ++m) _Pragma("unroll") for (int k = 0; k < 2; ++k) dst[m][k] = *(const LAS bf16x8*)(lds + MO_SA(b, h) + aoff + m * 2048 + k * 1024); } while (0)
#define MO_LDB(dst, b, h) do { _Pragma("unroll") for (int n = 0; n < 2; ++n) _Pragma("unroll") for (int k = 0; k < 2; ++k) dst[n][k] = *(const LAS bf16x8*)(lds + MO_SB(b, h) + boff + n * 2048 + k * 1024); } while (0)
#define MO_MMA(ai, bj, At, Bt) do { __builtin_amdgcn_s_setprio(1); _Pragma("unroll") for (int m = 0; m < 4; ++m) _Pragma("unroll") for (int n = 0; n < 2; ++n) _Pragma("unroll") for (int k = 0; k < 2; ++k) \
        acc[ai][bj][m][n] = __builtin_amdgcn_mfma_f32_16x16x32_bf16(Bt[n][k], At[m][k], acc[ai][bj][m][n], 0, 0, 0); __builtin_amdgcn_s_setprio(0); } while (0)
#define MO_WAIT_L(n) asm volatile("s_waitcnt lgkmcnt(" #n ")" ::: "memory")
#define MO_BAR __builtin_amdgcn_s_barrier()
#define MO_SCHED __builtin_amdgcn_sched_barrier(0)
#define MO_AOFF(u, dst) do { _Pragma("unroll") for (int _i = 0; _i < 2; ++_i) { int _R, _C; stage_rc(tid * 16 + _i * 8192, _R, _C); _Pragma("unroll") for (int _h = 0; _h < 2; ++_h) { const int _r = 128 * _h + _R; \
        if (GATHER) { const int _p = ((u).pm - S.tab[128 + (u).ex]) * 256 + _r; const int _t = (_r < (u).rows) ? LIST[(size_t)(u).ex * 8192 + _p] : 0; dst[_h][_i] = (unsigned)(_t * K + _C) * 2u; } \
        else dst[_h][_i] = (unsigned)(_r * K + _C) * 2u; } } } while (0)
    Unit cur, nxt; int ui = 0;
    if (!S.next(0, cur)) return;
    f32x4 acc[2][2][4][2];
#pragma unroll
    for (int a = 0; a < 2; ++a)
#pragma unroll
        for (int b = 0; b < 2; ++b)
#pragma unroll
            for (int m = 0; m < 4; ++m)
#pragma unroll
                for (int n = 0; n < 2; ++n) acc[a][b][m][n] = (f32x4){0.f, 0.f, 0.f, 0.f};
    bf16x8 At[4][2], B0[2][2], B1[2][2];
    int csel = 0;
    LAS unsigned char* const aslots = lds + STAGE_BYTES + tid * 16;
    { unsigned t0[2][2]; MO_AOFF(cur, t0); if (GATHER) *(LAS u32x4*)aslots = (u32x4){t0[0][0], t0[0][1], t0[1][0], t0[1][1]}; }
#define MO_OFFS(sel, h, o0, o1) unsigned o0, o1; if (GATHER) { const u32x2 _p = *(const LAS u32x2*)(aslots + 8192 * (sel) + 8 * (h)); o0 = _p.x; o1 = _p.y; } \
        else { int _R0, _C0, _R1, _C1; stage_rc(tid * 16, _R0, _C0); stage_rc(tid * 16 + 8192, _R1, _C1); o0 = (unsigned)((128 * (h) + _R0) * K + _C0) * 2u; o1 = (unsigned)((128 * (h) + _R1) * K + _C1) * 2u; }
    const char* cAb = GATHER ? (const char*)Abase : (const char*)Abase + (size_t)cur.pm * 256 * K * 2;
    const char* cBh = (const char*)S.bptr(cur, wr);
    { MO_LANE_CONSTS(tid);
    MO_BISSUE(cBh); { MO_OFFS(0, 0, p0, p1); MO_STAGE_A(MO_SA(0, 0), cAb, p0, p1); } { MO_OFFS(0, 1, p2, p3); MO_STAGE_A(MO_SA(0, 1), cAb, p2, p3); }
    if (wr == 1) MO_BAR;
    MO_BWAIT(4); MO_BWRITE(0);
    MO_WAIT_V(0); MO_WAIT_L(0); MO_BAR;
    { MO_OFFS(0, 0, p0, p1); MO_STAGE_A(MO_SA(1, 0), cAb + 128, p0, p1); } MO_BISSUE(cBh + bkstep);
    MO_BAR; }
    for (;;) {
        const bool has_next = S.next(ui + 1, nxt);
        const char* nAb = cAb; const char* nBh = cBh;
        if (has_next) { nAb = GATHER ? (const char*)Abase : (const char*)Abase + (size_t)nxt.pm * 256 * K * 2; nBh = (const char*)S.bptr(nxt, wr);
            if (GATHER) { unsigned nAo[2][2]; MO_AOFF(nxt, nAo); *(LAS u32x4*)(aslots + 8192 * (csel ^ 1)) = (u32x4){nAo[0][0], nAo[0][1], nAo[1][0], nAo[1][1]}; } }
        const bool halfu = cur.rows <= 128;
        for (int t = 0; t < nt; t += 2) {
            int tl = tid; asm volatile("" : "+v"(tl)); MO_LANE_CONSTS(tl);
            const bool last = (t == nt - 2);
            const char* a1 = cAb + (size_t)(t + 1) * 128;
            const char* a2 = last ? nAb : cAb + (size_t)(t + 2) * 128; const char* a3 = a2 + 128;
            const char* b2 = last ? nBh : cBh + (size_t)(t + 2) * bkstep; const char* b3 = b2 + bkstep;
            MO_LDB(B0, 0, 0); MO_LDB(B1, 0, 1); MO_SCHED; MO_LDA(At, 0, 0); { MO_OFFS(csel, 1, p0, p1); MO_STAGE_A(MO_SA(1, 1), a1, p0, p1); }
            MO_WAIT_V(12); MO_WAIT_L(0); MO_BAR; MO_MMA(0, 0, At, B0); MO_MMA(0, 1, At, B1); MO_BAR; MO_SCHED;
            const int nsel = (last && has_next) ? (csel ^ 1) : csel;
            MO_LDA(At, 0, 1); MO_BWAIT(2); MO_BWRITE(1); { MO_OFFS(nsel, 0, p0, p1); MO_STAGE_A(MO_SA(0, 0), a2, p0, p1); } MO_BISSUE(b2);
            MO_WAIT_L(0); MO_BAR; if (!halfu) { MO_MMA(1, 0, At, B0); MO_MMA(1, 1, At, B1); } MO_BAR; MO_SCHED;
            MO_LDB(B0, 1, 0); MO_LDB(B1, 1, 1); MO_SCHED; MO_LDA(At, 1, 0); { MO_OFFS(nsel, 1, p0, p1); MO_STAGE_A(MO_SA(0, 1), a2, p0, p1); }
            MO_WAIT_V(12); MO_WAIT_L(0); MO_BAR; MO_MMA(0, 0, At, B0); MO_MMA(0, 1, At, B1); MO_BAR; MO_SCHED;
            MO_LDA(At, 1, 1); MO_BWAIT(2); MO_BWRITE(0); { MO_OFFS(nsel, 0, p0, p1); MO_STAGE_A(MO_SA(1, 0), a3, p0, p1); } MO_BISSUE(b3);
            MO_WAIT_L(0); MO_BAR; if (!halfu) { MO_MMA(1, 0, At, B0); MO_MMA(1, 1, At, B1); } MO_BAR; MO_SCHED;
        }
        if (wr == 0) MO_BAR;
        { const int lane = tid & 63; E(acc, cur, wr, wc, lane & 15, lane >> 4); }
        if (!has_next) break;
#pragma unroll
        for (int a = 0; a < 2; ++a)
#pragma unroll
            for (int b = 0; b < 2; ++b)
#pragma unroll
                for (int m = 0; m < 4; ++m)
#pragma unroll
                    for (int n = 0; n < 2; ++n) acc[a][b][m][n] = (f32x4){0.f, 0.f, 0.f, 0.f};
        cur = nxt; cAb = nAb; cBh = nBh; ++ui; csel ^= 1;
        if (wr == 1) MO_BAR;
    }
    MO_BWAIT(0);
    MO_BAR;
#undef MO_SA
#undef MO_SB
#undef MO_STAGE_A
#undef MO_BISSUE
#undef MO_BWAIT
#undef MO_WAIT_V
#undef MO_BWRITE
#undef MO_LDA
#undef MO_LDB
#undef MO_MMA
#undef MO_WAIT_L
#undef MO_BAR
#undef MO_SCHED
#undef MO_AOFF
#undef MO_OFFS
#undef MO_LANE_CONSTS
}


typedef const f32x4 (&AccRef)[2][2][4][2];
DI u32x4 pack8(const f32x4& v0, const f32x4& v1) { u32x4 w; w.x = cvtpk(v0[0], v0[1]); w.y = cvtpk(v0[2], v0[3]); w.z = cvtpk(v1[0], v1[1]); w.w = cvtpk(v1[2], v1[3]); return w; }

struct EpiBf16 {
    static constexpr bool PERM = true;
    bf16* O; int ldc;
    DI void operator()(AccRef acc, const Unit& u, int wr, int wc, int fr, int fq) const {
        const int row0 = u.pm * BM + wr * 64 + fr, col0 = u.pn * BM + wc * 32 + 8 * fq;
#pragma unroll
        for (int ai = 0; ai < 2; ++ai)
#pragma unroll
            for (int m = 0; m < 4; ++m) { bf16* rowp = O + (size_t)(row0 + ai * HALF + m * 16) * ldc + col0;
#pragma unroll
                for (int bj = 0; bj < 2; ++bj) *(u32x4*)(rowp + bj * HALF) = pack8(acc[ai][bj][m][0], acc[ai][bj][m][1]); }
    }
};
struct EpiF32 {
    static constexpr bool PERM = false;
    float* C; int ldc;
    DI void operator()(AccRef acc, const Unit& u, int wr, int wc, int fr, int fq) const {
        const int row0 = u.pm * BM + wr * 64 + fr, col0 = u.pn * BM + wc * 32 + 4 * fq;
#pragma unroll
        for (int ai = 0; ai < 2; ++ai)
#pragma unroll
            for (int m = 0; m < 4; ++m) { float* rowp = C + (size_t)(row0 + ai * HALF + m * 16) * ldc + col0;
#pragma unroll
                for (int bj = 0; bj < 2; ++bj)
#pragma unroll
                    for (int n = 0; n < 2; ++n) *(f32x4*)(rowp + bj * HALF + n * 16) = acc[ai][bj][m][n]; }
    }
};
struct EpiInProj {
    static constexpr bool PERM = true;
    bf16* P; float* PBA;
    DI void operator()(AccRef acc, const Unit& u, int wr, int wc, int fr, int fq) const {
        const int row0 = u.pm * BM + wr * 64 + fr;
        if (u.pn < 28) {
            const int col0 = u.pn * BM + wc * 32 + 8 * fq;
#pragma unroll
            for (int ai = 0; ai < 2; ++ai)
#pragma unroll
                for (int m = 0; m < 4; ++m) { bf16* rowp = P + (size_t)(row0 + ai * HALF + m * 16) * NP + col0;
#pragma unroll
                    for (int bj = 0; bj < 2; ++bj) *(u32x4*)(rowp + bj * HALF) = pack8(acc[ai][bj][m][0], acc[ai][bj][m][1]); }
        } else if (wc == 0 && fq < 2) {
#pragma unroll
            for (int ai = 0; ai < 2; ++ai)
#pragma unroll
                for (int m = 0; m < 4; ++m) { float* rp = PBA + (size_t)(row0 + ai * HALF + m * 16) * 16 + 8 * fq;
                    *(f32x4*)rp = acc[ai][0][m][0]; *(f32x4*)(rp + 4) = acc[ai][0][m][1]; }
        }
    }
};
struct EpiResid {
    static constexpr bool PERM = false;
    const float* x; const float* g; float* R;
    DI void operator()(AccRef acc, const Unit& u, int wr, int wc, int fr, int fq) const {
        const int row0 = u.pm * BM + wr * 64 + fr, col0 = u.pn * BM + wc * 32 + 4 * fq;
        const float* gb = g + (size_t)((u.pm * BM) / SEQ) * 12288 + col0;
        f32x4 gv[2][2];
#pragma unroll
        for (int bj = 0; bj < 2; ++bj)
#pragma unroll
            for (int n = 0; n < 2; ++n) gv[bj][n] = *(const f32x4*)(gb + bj * HALF + n * 16) + 1.0f;
#pragma unroll
        for (int ai = 0; ai < 2; ++ai)
#pragma unroll
            for (int m = 0; m < 4; ++m) { const size_t off = (size_t)(row0 + ai * HALF + m * 16) * D + col0;
#pragma unroll
                for (int bj = 0; bj < 2; ++bj)
#pragma unroll
                    for (int n = 0; n < 2; ++n) { const f32x4 xv = *(const f32x4*)(x + off + bj * HALF + n * 16);
                        *(f32x4*)(R + off + bj * HALF + n * 16) = xv * DN_ALPHA + gv[bj][n] * acc[ai][bj][m][n]; } }
    }
};
struct EpiLogits {
    static constexpr bool PERM = false;
    float* L;
    DI void operator()(AccRef acc, const Unit& u, int wr, int wc, int fr, int fq) const {
        const int row0 = u.pm * BM + wr * 64 + fr, col0 = wc * 32 + 4 * fq;
#pragma unroll
        for (int ai = 0; ai < 2; ++ai)
#pragma unroll
            for (int m = 0; m < 4; ++m) { float* rowp = L + (size_t)(row0 + ai * HALF + m * 16) * 128 + col0;
#pragma unroll
                for (int n = 0; n < 2; ++n) *(f32x4*)(rowp + n * 16) = acc[ai][0][m][n]; }
    }
};
struct EpiGateUp {
    static constexpr bool PERM = true;
    bf16* H;
    DI void operator()(AccRef acc, const Unit& u, int wr, int wc, int fr, int fq) const {
        const int row0 = u.pm * BM + wr * 64 + fr, col0 = u.pn * HALF + wc * 32 + 8 * fq;
#pragma unroll
        for (int ai = 0; ai < 2; ++ai)
#pragma unroll
            for (int m = 0; m < 4; ++m) { bf16* rowp = H + (size_t)(row0 + ai * HALF + m * 16) * FF + col0;
                f32x4 h0, h1;
#pragma unroll
                for (int j = 0; j < 4; ++j) { h0[j] = silu_f(acc[ai][0][m][0][j]) * acc[ai][1][m][0][j]; h1[j] = silu_f(acc[ai][0][m][1][j]) * acc[ai][1][m][1][j]; }
                *(u32x4*)rowp = pack8(h0, h1); }
    }
};
struct EpiQup {
    static constexpr bool PERM = true;
    bf16* Q;
    DI void operator()(AccRef acc, const Unit& u, int wr, int wc, int fr, int fq) const {
        const int row0 = u.pm * BM + wr * 64 + fr, b = (u.pm * BM) / SEQ, s0 = row0 - b * SEQ;
        const int cg0 = u.pn * BM + wc * 32 + 8 * fq, cg1 = cg0 + HALF;
        const int h0 = cg0 / QD, w0 = cg0 - h0 * QD, h1 = cg1 / QD, w1 = cg1 - h1 * QD;
        bf16* d0 = Q + ((size_t)((b * MH + h0) * SEQ + s0)) * QD + w0; bf16* d1 = Q + ((size_t)((b * MH + h1) * SEQ + s0)) * QD + w1;
#pragma unroll
        for (int ai = 0; ai < 2; ++ai)
#pragma unroll
            for (int m = 0; m < 4; ++m) { const int dr = (ai * HALF + m * 16) * QD;
                *(u32x4*)(d0 + dr) = pack8(acc[ai][0][m][0] * QSCALE, acc[ai][0][m][1] * QSCALE);
                *(u32x4*)(d1 + dr) = pack8(acc[ai][1][m][0] * QSCALE, acc[ai][1][m][1] * QSCALE);
                asm volatile("" ::: "memory"); }
    }
};
struct EpiKVup {
    static constexpr bool PERM = true;
    bf16* Kp; bf16* V;
    DI void operator()(AccRef acc, const Unit& u, int wr, int wc, int fr, int fq) const {
        const int row0 = u.pm * BM + wr * 64 + fr, c0 = wc * 32 + 8 * fq, head = u.pn, b = (u.pm * BM) / SEQ, s0 = row0 - b * SEQ;
        bf16* dk = Kp + ((size_t)((b * MH + head) * SEQ + s0)) * QD + c0; bf16* dv = V + (size_t)row0 * D + head * 128 + c0;
#pragma unroll
        for (int ai = 0; ai < 2; ++ai)
#pragma unroll
            for (int m = 0; m < 4; ++m) { const int dr = ai * HALF + m * 16;
                *(u32x4*)(dk + dr * QD) = pack8(acc[ai][0][m][0], acc[ai][0][m][1]);
                *(u32x4*)(dv + dr * D) = pack8(acc[ai][1][m][0], acc[ai][1][m][1]);
                asm volatile("" ::: "memory"); }
    }
};
}

#define XB_TMO      128
#define XB_XCNT(j)  (256  + 64 * (j))
#define XB_XSUB(j)  (1280 + 64 * (j))
#define XB_XGEN(j)  (2304 + 64 * (j))
#define XB_TOP      3328
#define XB_TOPGEN   3392
#define XCD_BAR_WORDS 3456
#define XB_SPIN_CAP (1u << 18)
__device__ __forceinline__ unsigned xb_ld(unsigned* p)              { return __hip_atomic_load(p, __ATOMIC_RELAXED, __HIP_MEMORY_SCOPE_AGENT); }
__device__ __forceinline__ unsigned xb_add(unsigned* p, unsigned v) { return __hip_atomic_fetch_add(p, v, __ATOMIC_RELAXED, __HIP_MEMORY_SCOPE_AGENT); }
__device__ __forceinline__ unsigned xb_xcc_id() { return (unsigned)__builtin_amdgcn_s_getreg((3 << 11) | 20) & 0xFu; }
#define XB_SPIN(cond, bar) do { unsigned _sp = 0; while (cond) { __builtin_amdgcn_s_sleep(1); \
    if ((++_sp & 255u) == 0u) { if (xb_ld(&(bar)[XB_TMO])) break; if (_sp > XB_SPIN_CAP) { atomicAdd(&(bar)[XB_TMO], 1u); break; } } } } while (0)
struct XcdBarrier { unsigned* bar; unsigned x; volatile LAS unsigned* st; };
__device__ __forceinline__ XcdBarrier xcd_barrier_post(unsigned* bar, volatile LAS unsigned* st, const bool leader  ) {
    XcdBarrier b; b.bar = bar; b.x = xb_xcc_id(); b.st = st;
    if (leader) (void)xb_add(&bar[XB_XCNT(b.x)], 1u);
    return b;
}
__device__ __forceinline__ void xcd_barrier_complete(unsigned* bar, unsigned x, unsigned& nloc, unsigned& nx) {
    const unsigned G = gridDim.x * gridDim.y * gridDim.z;
    unsigned sum, cnt, mine, sp = 0u;
    for (;;) {
        sum = 0u; cnt = 0u; mine = 0u;
#pragma unroll
        for (unsigned j = 0; j < 16; ++j) { const unsigned c = xb_ld(&bar[XB_XCNT(j)]); sum += c; cnt += (c > 0u) ? 1u : 0u; mine = (j == x) ? c : mine; }
        if (sum == G) break;
        __builtin_amdgcn_s_sleep(1);
        if ((++sp & 255u) == 0u) { if (xb_ld(&bar[XB_TMO])) break; if (sp > XB_SPIN_CAP) { atomicAdd(&bar[XB_TMO], 1u); break; } }
    }
    nloc = mine > 0u ? mine : 1u; nx = cnt > 0u ? cnt : 1u;
}
__device__ __forceinline__ void xcd_barrier(const XcdBarrier& b, const bool leader  ) {
    asm volatile("s_waitcnt vmcnt(0)" ::: "memory");
    __syncthreads();
    if (leader) {
        unsigned* bar = b.bar;
        __builtin_amdgcn_s_waitcnt(0);
        unsigned nloc = b.st[0], nx = b.st[1];
        if (nloc == 0u) { xcd_barrier_complete(bar, b.x, nloc, nx); b.st[0] = nloc; b.st[1] = nx; }
        const unsigned old = xb_add(&bar[XB_XSUB(b.x)], 1u);
        const unsigned gen = old / nloc;
        if (old + 1u == (gen + 1u) * nloc) {
            __builtin_amdgcn_fence(__ATOMIC_RELEASE, "agent");
            asm volatile("s_waitcnt vmcnt(0)" ::: "memory");
            const unsigned og = xb_add(&bar[XB_TOP], 1u);
            const unsigned tg = og / nx;
            if (og + 1u == (tg + 1u) * nx) xb_add(&bar[XB_TOPGEN], 1u);
            else XB_SPIN(xb_ld(&bar[XB_TOPGEN]) == tg, bar);
            __builtin_amdgcn_fence(__ATOMIC_ACQUIRE, "agent");
            xb_add(&bar[XB_XGEN(b.x)], 1u);
            asm volatile("s_waitcnt vmcnt(0)" ::: "memory");
        } else {
            XB_SPIN(xb_ld(&bar[XB_XGEN(b.x)]) == gen, bar);
            __builtin_amdgcn_fence(__ATOMIC_ACQUIRE, "agent");
            asm volatile("s_waitcnt vmcnt(0)" ::: "memory");
        }
    }
    __syncthreads();
}

struct Frame {
    LAS unsigned char* lds;
    int tid, lane, wave, vcu, G, gw, NGW;
    unsigned* ctl;
};
struct Args { const void* in[27]; float* out; unsigned char* ws; int ph_lo, ph_hi; };

__device__ const double ROPE_INVF[32] = {1, 0.74989420933245587, 0.56234132519034907, 0.42169650342858223, 0.31622776601683794, 0.23713737056616552, 0.17782794100389229, 0.1333521432163324,
    0.10000000000000001, 0.074989420933245579, 0.056234132519034911, 0.042169650342858224, 0.031622776601683791, 0.023713737056616554, 0.017782794100389229, 0.013335214321633241,
    0.01, 0.0074989420933245579, 0.005623413251903491, 0.0042169650342858229, 0.0031622776601683794, 0.0023713737056616554, 0.0017782794100389228, 0.0013335214321633241,
    0.001, 0.00074989420933245586, 0.0005623413251903491, 0.00042169650342858224, 0.00031622776601683794, 0.00023713737056616554, 0.00017782794100389227, 0.0001333521432163324};

struct TrRegs { f32x4 r[8]; };
DI void tr_load(TrRegs& t, const float* W, size_t ld, int k0, int n0, int nvalid, int lane) {
    const int ns = lane & 7, kq = lane >> 3;
    if (4 * ns < nvalid) { const float* src = W + (size_t)(k0 + 8 * kq) * ld + n0 + 4 * ns;
#pragma unroll
        for (int j = 0; j < 8; ++j) t.r[j] = *(const f32x4*)(src + (size_t)j * ld); }
}
DI void tr_store(const TrRegs& t, int k0, int nvalid, bf16* WT, int Kd, int drow0, int lane) {
    const int ns = lane & 7, kq = lane >> 3;
    if (4 * ns < nvalid) { bf16* dst = WT + (size_t)(drow0 + 4 * ns) * Kd + k0 + 8 * kq;
#pragma unroll
        for (int i = 0; i < 4; ++i) { u32x4 o; o.x = cvtpk(t.r[0][i], t.r[1][i]); o.y = cvtpk(t.r[2][i], t.r[3][i]); o.z = cvtpk(t.r[4][i], t.r[5][i]); o.w = cvtpk(t.r[6][i], t.r[7][i]);
            *(u32x4*)(dst + (size_t)i * Kd) = o; } }
}
DI void tr_job(const Frame& F, const int gw, const int NGW, const float* W, size_t smat, int nmat, int ld, int K, int col0, int ncols, bf16* WT, size_t dmat, int Kd, int row_off, int mode) {
    const int nblk = (ncols + 31) / 32, kbs = K / 64, per = nblk * kbs; const long items = (long)nmat * per;
    for (long it0 = gw; it0 < items; it0 += 2 * (long)NGW) {
        TrRegs t[2]; int k0[2], nv[2], dr[2]; bf16* wt[2];
#pragma unroll
        for (int u = 0; u < 2; ++u) {
            const long it = it0 + (long)u * NGW;
            if (it < items) {
                const int mat = (int)(it / per), rem = (int)(it - (long)mat * per), kb = rem / nblk, nb = rem - kb * nblk;
                nv[u] = (ncols - nb * 32) < 32 ? (ncols - nb * 32) : 32; k0[u] = kb * 64;
                dr[u] = (mode == 0) ? (row_off + nb * 32) : ((nb >> 2) * 256 + row_off + (nb & 3) * 32);
                wt[u] = WT + (size_t)mat * dmat;
                tr_load(t[u], W + (size_t)mat * smat, (size_t)ld, k0[u], col0 + nb * 32, nv[u], F.lane);
            } else { nv[u] = 0; k0[u] = 0; dr[u] = 0; wt[u] = WT; }
        }
#pragma unroll
        for (int u = 0; u < 2; ++u) tr_store(t[u], k0[u], nv[u], wt[u], Kd, dr[u], F.lane);
    }
}
DI void zero_fill(const Frame& F, const int gw, const int NGW, void* p, size_t bytes) {
    u32x4* q = (u32x4*)p; const size_t n = bytes / 16;
    for (size_t i = (size_t)gw * 64 + F.lane; i < n; i += (size_t)NGW * 64) q[i] = (u32x4){0u, 0u, 0u, 0u};
}

DI const void* arg_in(int k) { unsigned o = (unsigned)k * 8u; asm volatile("" : "+s"(o));
    const GAS void* p = *(const GAS void* const __attribute__((address_space(4)))*)((const __attribute__((address_space(4))) unsigned char*)__builtin_amdgcn_kernarg_segment_ptr() + o);
    return (const void*)p; }
#define WSB (args.ws)
#define in_x ((const float*)arg_in(0))
#define in_c ((const float*)arg_in(1))
#define in_pos ((const int*)arg_in(2))
#define ada_w ((const float*)arg_in(3))
#define ada_b ((const float*)arg_in(4))
#define ln_g ((const float*)arg_in(5))
#define ln_b ((const float*)arg_in(6))
#define hyb_w_in ((const float*)arg_in(7))
#define gdn_conv_w ((const float*)arg_in(8))
#define gdn_a_log ((const float*)arg_in(9))
#define gdn_dt_bias ((const float*)arg_in(10))
#define gdn_norm_w ((const float*)arg_in(11))
#define sc_conv_w ((const float*)arg_in(12))
#define hyb_w_out ((const float*)arg_in(13))
#define mla_w_in ((const float*)arg_in(14))
#define mla_q_norm ((const float*)arg_in(15))
#define mla_kv_norm ((const float*)arg_in(16))
#define mla_w_uq ((const float*)arg_in(17))
#define mla_w_ukv ((const float*)arg_in(18))
#define mla_w_out ((const float*)arg_in(19))
#define moe_router_g ((const float*)arg_in(20))
#define moe_bias_g ((const float*)arg_in(21))
#define moe_router_e ((const float*)arg_in(22))
#define moe_bias_e ((const float*)arg_in(23))
#define moe_w_gate ((const float*)arg_in(24))
#define moe_w_up ((const float*)arg_in(25))
#define moe_w_down ((const float*)arg_in(26))
#define MOD ((float*)(WSB + WS_MOD))
#define ROPE_C ((float*)(WSB + WS_ROPE))
#define ROPE_S ((float*)(ROPE_C + (size_t)T * 32))
#define PBA ((float*)(WSB + WS_PBA))
#define LOGITS ((float*)(WSB + WS_LOGITS))
#define TOK_E ((int*)(WSB + WS_ROUTE))
#define TOK_POS ((int*)(TOK_E + 2 * T))
#define TOK_GATE ((float*)(TOK_POS + 2 * T))
#define EG ((float*)(WSB + WS_EG))
#define WIN0 ((bf16*)(WSB + WS_WIN0))
#define WOUT0 ((bf16*)(WSB + WS_WOUT0))
#define WMIN ((bf16*)(WSB + WS_WMIN))
#define WUQ ((bf16*)(WSB + WS_WUQ))
#define WUKV ((bf16*)(WSB + WS_WUKV))
#define WMOUT ((bf16*)(WSB + WS_WMOUT))
#define WRT ((bf16*)(WSB + WS_WRT))
#define WGU ((bf16*)(WSB + WS_WGU))
#define ADAP ((float*)(WSB + WS_WGU))
#define WDN ((bf16*)(WSB + WS_WDN))
#define HIN ((bf16*)(WSB + WS_HIN))
#define XA ((float*)(WSB + WS_XA))
#define XB ((float*)(WSB + WS_XB))
#define RB ((float*)(WSB + WS_R))
#define PB ((bf16*)(WSB + WS_P))
#define GF ((unsigned char*)(WSB + WS_GF))
#define GU ((unsigned char*)(WSB + WS_GU))
#define GO ((float*)(WSB + WS_GO))
#define YAB ((bf16*)(WSB + WS_YAB))
#define LISTP ((int*)(WSB + WS_XS))
#define HID ((bf16*)(WSB + WS_HID))
#define YS ((bf16*)(WSB + WS_YS))
#define C1 ((float*)(WSB + WS_C1))
#define CQN ((bf16*)(WSB + WS_CQN))
#define CKVN ((bf16*)(WSB + WS_CKVN))
#define KPE ((float*)(WSB + WS_KPE))
#define QB_ ((bf16*)(WSB + WS_Q))
#define KB_ ((bf16*)(WSB + WS_K))
#define VB_ ((bf16*)(WSB + WS_V))
#define VT ((bf16*)(WSB + WS_VT))


#define LN_ROW(v, gptr, bptr) do { float _s = 0.f; _Pragma("unroll") for (int _j = 0; _j < 8; ++_j) _s += (v[_j][0] + v[_j][1]) + (v[_j][2] + v[_j][3]); \
        const float _mean = wave_sum(_s) * (1.f / D); float _q = 0.f; \
        _Pragma("unroll") for (int _j = 0; _j < 8; ++_j) { v[_j] = v[_j] - _mean; _q += (v[_j][0] * v[_j][0] + v[_j][1] * v[_j][1]) + (v[_j][2] * v[_j][2] + v[_j][3] * v[_j][3]); } \
        const float _rstd = rsqrtf(wave_sum(_q) * (1.f / D) + 1e-5f); \
        _Pragma("unroll") for (int _j = 0; _j < 8; ++_j) v[_j] = v[_j] * _rstd * ((const f32x4*)(gptr))[F.lane + 64 * _j] + ((const f32x4*)(bptr))[F.lane + 64 * _j]; } while (0)
#define WRITE_X_HIN(v, xrow, hrow, shp, scp) do { _Pragma("unroll") for (int _j = 0; _j < 8; ++_j) { ((f32x4*)(xrow))[F.lane + 64 * _j] = v[_j]; \
        if ((hrow) != nullptr) { const f32x4 _h = v[_j] * (((const f32x4*)(scp))[F.lane + 64 * _j] + 1.0f) + ((const f32x4*)(shp))[F.lane + 64 * _j]; \
            u32x2 _w; _w.x = cvtpk(_h[0], _h[1]); _w.y = cvtpk(_h[2], _h[3]); ((u32x2*)(hrow))[F.lane + 64 * _j] = _w; } } } while (0)


template <int GW> DI void ada_groups(Frame& F, const Args& args, const int cg_lo, const int cg_hi, const int bidx, const int nblocks) {
    constexpr int LPR = GW / 4, RPI = 64 / LPR, NSET = 8 * RPI;
    LAS float* cact = (LAS float*)F.lds;
    LAS float* red = (LAS float*)(F.lds + 32768);
    for (int i = F.tid; i < 4 * D; i += 512) cact[i] = silu_f(in_c[i]);
    __syncthreads();
    for (int cg = cg_lo + bidx; cg < cg_hi; cg += nblocks) {
        const int jj0 = cg * GW, l = jj0 / 12288, j0 = jj0 - l * 12288;
        const int rsub = F.lane / LPR, c4 = F.lane - rsub * LPR;
        f32x4 a0 = {0.f, 0.f, 0.f, 0.f}, a1 = a0, a2 = a0, a3 = a0;
        if (F.lane < LPR * RPI) {
            const float* wp = ada_w + ((size_t)l * D) * 12288 + j0 + 4 * c4;
#pragma unroll 8
            for (int it = 0; it < D / NSET; ++it) { const int k = it * NSET + F.wave * RPI + rsub;
                const f32x4 w4 = *(const f32x4*)(wp + (size_t)k * 12288);
                a0 += w4 * cact[k]; a1 += w4 * cact[D + k]; a2 += w4 * cact[2 * D + k]; a3 += w4 * cact[3 * D + k]; }
            LAS float* rp = red + (F.wave * RPI + rsub) * (4 * GW) + 4 * c4;
            *(LAS f32x4*)(rp) = a0; *(LAS f32x4*)(rp + GW) = a1; *(LAS f32x4*)(rp + 2 * GW) = a2; *(LAS f32x4*)(rp + 3 * GW) = a3;
        }
        __syncthreads();
        if (F.tid < 4 * GW) { const int b = F.tid / GW, col = F.tid - b * GW; float s = ada_b[(size_t)l * 12288 + j0 + col];
#pragma unroll 8
            for (int p = 0; p < NSET; ++p) s += red[p * (4 * GW) + b * GW + col];
            MOD[((size_t)l * 4 + b) * 12288 + j0 + col] = s; }
        __syncthreads();
    }
}

DI void ada_partials(Frame& F, const Args& args) {
    LAS float* cact = (LAS float*)F.lds;
    for (int blk = blockIdx.x; blk < 256; blk += F.G) {
        const int rs = blk >> 4, cs = blk & 15, jj0 = cs * 1536, l = jj0 / 12288, j0 = jj0 - l * 12288;
        __syncthreads();
        { const int b = F.tid >> 7, k = F.tid & 127; cact[b * 128 + k] = silu_f(in_c[b * D + 128 * rs + k]); }
        __syncthreads();
        if (F.tid < 384) {
            const float* wp = ada_w + ((size_t)l * D + 128 * rs) * 12288 + j0 + 4 * F.tid;
            f32x4 a0 = {0.f, 0.f, 0.f, 0.f}, a1 = a0, a2 = a0, a3 = a0;
#pragma unroll 16
            for (int k = 0; k < 128; ++k) { const f32x4 w4 = *(const f32x4*)(wp + (size_t)k * 12288);
                a0 += w4 * cact[k]; a1 += w4 * cact[128 + k]; a2 += w4 * cact[256 + k]; a3 += w4 * cact[384 + k]; }
            float* pp = ADAP + ((size_t)rs * 4) * 24576 + jj0 + 4 * F.tid;
            *(f32x4*)pp = a0; *(f32x4*)(pp + 24576) = a1; *(f32x4*)(pp + 2 * 24576) = a2; *(f32x4*)(pp + 3 * 24576) = a3;
        }
    }
    __syncthreads();
}

DI void deferred_copies(Frame& F, const Args& args, const int gw, const int NGW) {
    tr_job(F, gw, NGW, hyb_w_out, 0, 1, D, D, 0, D, WOUT0, 0, D, 0, 0);
    tr_job(F, gw, NGW, mla_w_in, 0, 1, MLA_IN, D, 0, MLA_IN, WMIN, 0, D, 0, 0);
    zero_fill(F, gw, NGW, WMIN + (size_t)MLA_IN * D, (size_t)(NMLA - MLA_IN) * D * 2);
    tr_job(F, gw, NGW, mla_w_uq, 0, 1, 3072, 512, 0, 3072, WUQ, 0, 512, 0, 0);
    tr_job(F, gw, NGW, mla_w_ukv, 0, 1, 4096, 512, 0, 4096, WUKV, 0, 512, 0, 0);
    tr_job(F, gw, NGW, mla_w_out, 0, 1, D, D, 0, D, WMOUT, 0, D, 0, 0);
    tr_job(F, gw, NGW, moe_router_g, (size_t)D * 8, 2, 8, D, 0, 8, WRT, (size_t)256 * D, D, 0, 0);
    tr_job(F, gw, NGW, moe_router_e, (size_t)D * 64, 2, 64, D, 0, 64, WRT, (size_t)256 * D, D, 8, 0);
    zero_fill(F, gw, NGW, WRT + (size_t)72 * D, (size_t)(256 - 72) * D * 2);
    zero_fill(F, gw, NGW, WRT + (size_t)256 * D + (size_t)72 * D, (size_t)(256 - 72) * D * 2);
}

DI void copy_jobs(Frame& F, const Args& args, const int gw, const int NGW) {
    constexpr int N0 = (D / 64) * (D / 32), N1 = (D / 64) * (MLA_IN / 32), N2 = (512 / 64) * (3072 / 32), N3 = (512 / 64) * (4096 / 32), N4 = N0, N5 = 2 * (D / 64), N6 = 2 * (D / 64) * 2;
    constexpr int TOTAL = N0 + N1 + N2 + N3 + N4 + N5 + N6;
    for (int it0 = gw; it0 < TOTAL; it0 += 2 * NGW) {
        TrRegs t[2]; int k0[2], nv[2], dr[2], kd[2]; bf16* wt[2];
#pragma unroll
        for (int u = 0; u < 2; ++u) {
            int it = it0 + u * NGW; nv[u] = 0; k0[u] = 0; dr[u] = 0; kd[u] = D; wt[u] = WOUT0;
            if (it < TOTAL) {
                const float* W; int ld, ncols, nblk, row_off = 0; size_t smat = 0, dmat = 0;
                if (it < N0) { W = hyb_w_out; ld = D; ncols = D; nblk = D / 32; wt[u] = WOUT0; kd[u] = D; }
                else if ((it -= N0) < N1) { W = mla_w_in; ld = MLA_IN; ncols = MLA_IN; nblk = MLA_IN / 32; wt[u] = WMIN; kd[u] = D; }
                else if ((it -= N1) < N2) { W = mla_w_uq; ld = 3072; ncols = 3072; nblk = 96; wt[u] = WUQ; kd[u] = 512; }
                else if ((it -= N2) < N3) { W = mla_w_ukv; ld = 4096; ncols = 4096; nblk = 128; wt[u] = WUKV; kd[u] = 512; }
                else if ((it -= N3) < N4) { W = mla_w_out; ld = D; ncols = D; nblk = D / 32; wt[u] = WMOUT; kd[u] = D; }
                else if ((it -= N4) < N5) { W = moe_router_g; ld = 8; ncols = 8; nblk = 1; wt[u] = WRT; kd[u] = D; smat = (size_t)D * 8; dmat = (size_t)256 * D; }
                else { it -= N5; W = moe_router_e; ld = 64; ncols = 64; nblk = 2; wt[u] = WRT; kd[u] = D; smat = (size_t)D * 64; dmat = (size_t)256 * D; row_off = 8; }
                const int kbs = kd[u] / 64, per = nblk * kbs, mat = it / per, rem = it - mat * per, kb = rem / nblk, nb = rem - kb * nblk;
                nv[u] = (ncols - nb * 32) < 32 ? (ncols - nb * 32) : 32; k0[u] = kb * 64; dr[u] = row_off + nb * 32; wt[u] += (size_t)mat * dmat;
                tr_load(t[u], W + (size_t)mat * smat, (size_t)ld, k0[u], nb * 32, nv[u], F.lane);
            }
        }
#pragma unroll
        for (int u = 0; u < 2; ++u) tr_store(t[u], k0[u], nv[u], wt[u], kd[u], dr[u], F.lane);
    }
    zero_fill(F, gw, NGW, WMIN + (size_t)MLA_IN * D, (size_t)(NMLA - MLA_IN) * D * 2);
    zero_fill(F, gw, NGW, WRT + (size_t)72 * D, (size_t)(256 - 72) * D * 2);
    zero_fill(F, gw, NGW, WRT + (size_t)256 * D + (size_t)72 * D, (size_t)(256 - 72) * D * 2);
}

#ifndef PHMASK
#define PHMASK 0xFFFFFFFFull
#endif
#define PH_EN(k) (((PHMASK) >> (k)) & 1ull)
#define IN(k) (PH_EN(k) && lo <= (k) && (k) < hi)
#define INL(k0, k1) ((L == 0) ? IN(k0) : IN(k1))
#define PHASE_FRESH() do { int _l; asm volatile("v_mbcnt_lo_u32_b32 %0, -1, 0\n\tv_mbcnt_hi_u32_b32 %0, -1, %0" : "=v"(_l)); F.lane = _l; F.tid = F.wave * 64 + _l; } while (0)
#define SEAM(k) do { if (IN(k) && IN((k) + 1)) { PHASE_FRESH(); xcd_barrier(bar, F.tid == 0); } } while (0)


template <int L> DI void ln_route_phase(Frame& F, const Args& args) {
    constexpr int HP = 2056;
    LAS bf16* HT = (LAS bf16*)F.lds;
    LAS float* PART = (LAS float*)(F.lds + 16 * HP * 2);
    LAS float* LG = PART + 8 * 16 * 80;
    unsigned* cnt = F.ctl + CW_CNT + L * 64;
    const float* bg = moe_bias_g + L * 8; const float* be = moe_bias_e + L * 64;
    const bf16* wrt = WRT + (size_t)L * 256 * D;
    for (int rg = F.vcu; rg < T / 16; rg += F.G) {
#pragma unroll
        for (int rr = 0; rr < 2; ++rr) {
            const int rl = 2 * F.wave + rr, m = rg * 16 + rl, b = m / SEQ; const float* modb = MOD + (size_t)(L * 4 + b) * 12288;
            f32x4 v[8];
#pragma unroll
            for (int j = 0; j < 8; ++j) v[j] = ((const f32x4*)(RB + (size_t)m * D))[F.lane + 64 * j];
            LN_ROW(v, ln_g + (size_t)(L * 2) * D, ln_b + (size_t)(L * 2) * D);
#pragma unroll
            for (int j = 0; j < 8; ++j) { ((f32x4*)(XA + (size_t)m * D))[F.lane + 64 * j] = v[j];
                const f32x4 h = v[j] * (((const f32x4*)(modb + 4 * D))[F.lane + 64 * j] + 1.0f) + ((const f32x4*)(modb + 3 * D))[F.lane + 64 * j];
                u32x2 w; w.x = cvtpk(h[0], h[1]); w.y = cvtpk(h[2], h[3]);
                ((u32x2*)(HIN + (size_t)m * D))[F.lane + 64 * j] = w; *(LAS u32x2*)(HT + rl * HP + 4 * (F.lane + 64 * j)) = w; }
        }
        __syncthreads();
        {
            const int mrow = F.lane & 15, g = F.lane >> 4;
            f32x4 acc[5];
#pragma unroll
            for (int nt = 0; nt < 5; ++nt) acc[nt] = (f32x4){0.f, 0.f, 0.f, 0.f};
#pragma unroll 2
            for (int ks = 0; ks < 8; ++ks) { const int kk = 32 * (8 * F.wave + ks) + 8 * g;
                const bf16x8 a = *(const LAS bf16x8*)(HT + mrow * HP + kk);
#pragma unroll
                for (int nt = 0; nt < 5; ++nt) { const bf16x8 bb = *(const bf16x8*)(wrt + (size_t)(nt * 16 + mrow) * D + kk);
                    acc[nt] = __builtin_amdgcn_mfma_f32_16x16x32_bf16(a, bb, acc[nt], 0, 0, 0); } }
#pragma unroll
            for (int nt = 0; nt < 5; ++nt)
#pragma unroll
                for (int q = 0; q < 4; ++q) PART[(F.wave * 16 + 4 * g + q) * 80 + nt * 16 + mrow] = acc[nt][q];
        }
        __syncthreads();
        for (int idx = F.tid; idx < 16 * 72; idx += 512) { const int r = idx / 72, c = idx - r * 72; float s = 0.f;
#pragma unroll
            for (int w = 0; w < 8; ++w) s += PART[(w * 16 + r) * 80 + c];
            LG[r * 80 + c] = s; }
        __syncthreads();
        if (F.tid < 16) {
            const int t = rg * 16 + F.tid; const LAS float* lg = LG + F.tid * 80;
            float l8[8]; float mx = -3.0e38f; int grp = 0;
#pragma unroll
            for (int gq = 0; gq < 8; ++gq) { l8[gq] = lg[gq] + bg[gq]; if (l8[gq] > mx) { mx = l8[gq]; grp = gq; } }
            float se = 0.f;
#pragma unroll
            for (int gq = 0; gq < 8; ++gq) se += __expf(l8[gq] - mx);
            const float pg = 1.f / se;
            float e8[8];
#pragma unroll
            for (int j = 0; j < 8; ++j) e8[j] = lg[8 + grp * 8 + j] + be[grp * 8 + j];
            int i1 = 0; float m1 = e8[0];
#pragma unroll
            for (int j = 1; j < 8; ++j) if (e8[j] > m1) { m1 = e8[j]; i1 = j; }
            int i2 = -1; float m2 = -3.0e38f;
#pragma unroll
            for (int j = 0; j < 8; ++j) if (j != i1 && e8[j] > m2) { m2 = e8[j]; i2 = j; }
            const float rrr = __expf(m2 - m1), g1 = pg / (1.f + rrr), g2 = pg * rrr / (1.f + rrr);
            const int ex1 = grp * 8 + i1, ex2 = grp * 8 + i2;
            const int p1 = (int)atomicAdd(&cnt[ex1], 1u), p2 = (int)atomicAdd(&cnt[ex2], 1u);
            TOK_E[2 * t] = ex1; TOK_E[2 * t + 1] = ex2; TOK_POS[2 * t] = p1; TOK_POS[2 * t + 1] = p2; TOK_GATE[2 * t] = g1; TOK_GATE[2 * t + 1] = g2;
            LISTP[(size_t)ex1 * 8192 + p1] = t; LISTP[(size_t)ex2 * 8192 + p2] = t;
        }
        __syncthreads();
    }
}

template <int L> DI void moe_phases(Frame& F, const Args& args, const XcdBarrier& bar, const int lo, const int hi, LAS int* TAB) {
        unsigned* cnt = F.ctl + CW_CNT + L * 64;
#define MOE_TABLE() do { if (F.tid < NE) TAB[200 + F.tid] = (int)cnt[F.tid]; __syncthreads(); \
        if (F.tid == 0) { int _a = 0; for (int _e = 0; _e < NE; ++_e) { const int _c = TAB[200 + _e]; TAB[128 + _e] = _a; const int _nb = (_c + 255) >> 8; \
        for (int _q = 0; _q < _nb; ++_q) TAB[_a + _q] = _e; _a += _nb; } TAB[192] = _a; } __syncthreads(); } while (0)
    if (INL(11, 24)) { PHASE_FRESH();
        MOE_TABLE();
        pg8::MoeDirect S; S.nunits = TAB[192] * 4; S.NT = 4; S.G = F.G; S.c = F.vcu; S.tab = TAB;
        S.W0 = moe_w_gate + (size_t)L * 64 * D * FF; S.W1 = moe_w_up + (size_t)L * 64 * D * FF; S.estride = (size_t)D * FF; S.cols_per_tile = 128; S.half1_off = 0;
        pg8::EpiGateUp E{HID};
        pg8::gemm_phase_moe32<pg8::EpiGateUp, true>(F.lds, D, FF, S, E, HIN, LISTP, F.tid, F.wave);
    }
    if (L == 0) SEAM(11); else SEAM(24);
    if (INL(12, 25)) { PHASE_FRESH();
        MOE_TABLE();
        pg8::MoeDirect S; S.nunits = TAB[192] * 8; S.NT = 8; S.G = F.G; S.c = F.vcu; S.tab = TAB;
        S.W0 = moe_w_down + (size_t)L * 64 * D * FF; S.W1 = S.W0; S.estride = (size_t)D * FF; S.cols_per_tile = 256; S.half1_off = 128;
        pg8::EpiBf16 E{YS, D};
        pg8::gemm_phase_moe32<pg8::EpiBf16, false>(F.lds, FF, D, S, E, HID, nullptr, F.tid, F.wave);
    }
    if (L == 0) SEAM(12); else SEAM(25);
    if (INL(13, 26)) { PHASE_FRESH();
        if (F.tid < NE) TAB[200 + F.tid] = (int)cnt[F.tid];
        __syncthreads();
        if (F.tid == 0) { int a = 0; for (int e = 0; e < NE; ++e) { TAB[128 + e] = a; a += (TAB[200 + e] + 255) >> 8; } }
        __syncthreads();
        float* xout = (L == 0) ? XB : args.out;
        for (int m0 = F.gw; m0 < T; m0 += 2 * F.NGW) {
            int mm[2], r0[2], r1[2]; float g0[2], g1[2];
#pragma unroll
            for (int u = 0; u < 2; ++u) { const int m = m0 + u * F.NGW < T ? m0 + u * F.NGW : m0; mm[u] = m;
                r0[u] = TAB[128 + TOK_E[2 * m]] * 256 + TOK_POS[2 * m]; r1[u] = TAB[128 + TOK_E[2 * m + 1]] * 256 + TOK_POS[2 * m + 1]; g0[u] = TOK_GATE[2 * m]; g1[u] = TOK_GATE[2 * m + 1]; }
            f32x4 v[2][8];
#pragma unroll
            for (int u = 0; u < 2; ++u) { const int m = mm[u]; const float* modb = MOD + (size_t)(L * 4 + m / SEQ) * 12288;
#pragma unroll
                for (int j = 0; j < 8; ++j) {
                    const f32x4 xv = ((const f32x4*)(XA + (size_t)m * D))[F.lane + 64 * j];
                    const u32x2 ya = ((const u32x2*)(YS + (size_t)r0[u] * D))[F.lane + 64 * j], yb = ((const u32x2*)(YS + (size_t)r1[u] * D))[F.lane + 64 * j];
                    const f32x4 gg = ((const f32x4*)(modb + 5 * D))[F.lane + 64 * j] + 1.0f;
                    f32x4 y; y[0] = g0[u] * bflo(ya.x) + g1[u] * bflo(yb.x); y[1] = g0[u] * bfhi(ya.x) + g1[u] * bfhi(yb.x); y[2] = g0[u] * bflo(ya.y) + g1[u] * bflo(yb.y); y[3] = g0[u] * bfhi(ya.y) + g1[u] * bfhi(yb.y);
                    v[u][j] = xv * DN_ALPHA + gg * y;
                } }
#pragma unroll
            for (int u = 0; u < 2; ++u) {
                const int m = mm[u];
                LN_ROW(v[u], ln_g + (size_t)(L * 2 + 1) * D, ln_b + (size_t)(L * 2 + 1) * D);
                if (u == 0 || m0 + F.NGW < T) {
                    bf16* hrow = (L == 0) ? HIN + (size_t)m * D : nullptr;
                    const float* mod1 = MOD + (size_t)(4 + m / SEQ) * 12288;
                    WRITE_X_HIN(v[u], xout + (size_t)m * D, hrow, mod1, mod1 + D);
                } }
        }
    }
    if (L == 0) SEAM(13);
}

__global__ void __launch_bounds__(512, 2) mega(Args args) {
    extern __shared__ __attribute__((aligned(16))) unsigned char lds_raw[];
    Frame F;
    F.lds = (LAS unsigned char*)lds_raw;
    F.wave = __builtin_amdgcn_readfirstlane((int)threadIdx.x >> 6); PHASE_FRESH();
    F.G = gridDim.x; { const int bx = blockIdx.x; F.vcu = (F.G % 8 == 0) ? (bx % 8) * (F.G / 8) + bx / 8 : bx; }
    F.gw = F.vcu * 8 + F.wave; F.NGW = F.G * 8;
    F.ctl = (unsigned*)(args.ws + WS_CTL);
    volatile LAS unsigned* MISC = (volatile LAS unsigned*)(F.lds + MISC_OFF);
    LAS int* TAB = (LAS int*)(F.lds + TAB_OFF);
    for (int u = F.tid; u < (LDS_BYTES - LDSCTL_OFF) / 4; u += 512) ((LAS unsigned*)(F.lds + LDSCTL_OFF))[u] = 0u;
    __syncthreads();
    XcdBarrier bar; bar.bar = F.ctl + CW_BAR; bar.x = 0; bar.st = nullptr;
    if (MK_ONE_LAUNCH) bar = xcd_barrier_post(F.ctl + CW_BAR, MISC + 8, F.tid == 0);
    const int lo = args.ph_lo, hi = args.ph_hi;

    if (IN(0)) { PHASE_FRESH();
        ada_partials(F, args);
        tr_job(F, F.gw, F.NGW, hyb_w_in, 0, 1, HYB_IN, D, 0, 4096, WIN0, 0, D, 0, 0);
        tr_job(F, F.gw, F.NGW, hyb_w_in, 0, 1, HYB_IN, D, 4112, 3072, WIN0, 0, D, 4096, 0);
        tr_job(F, F.gw, F.NGW, hyb_w_in, 0, 1, HYB_IN, D, 4096, 16, WIN0, 0, D, 7168, 0);
        zero_fill(F, F.gw, F.NGW, WIN0 + (size_t)7184 * D, (size_t)(NIN - 7184) * D * 2);
        copy_jobs(F, args, F.gw, F.NGW);
        for (int idx = blockIdx.x * 512 + F.tid; idx < T * 32; idx += F.G * 512) {
            const int t = idx >> 5, i = idx & 31;
            const double rev = (double)in_pos[t] * ROPE_INVF[i] * 0.15915494309189535;
            const float fr = (float)(rev - __builtin_rint(rev));
            ROPE_C[idx] = __builtin_amdgcn_cosf(fr); ROPE_S[idx] = __builtin_amdgcn_sinf(fr);
        }
    }
    SEAM(0);

    if (IN(1)) { PHASE_FRESH();
        for (int o = blockIdx.x * 512 + F.tid; o < 2 * 4 * 12288; o += F.G * 512) {
            const int l = o / 49152, r = o - l * 49152, b = r / 12288, j = r - b * 12288;
            const float* pp = ADAP + (size_t)b * 24576 + l * 12288 + j; float s = ada_b[l * 12288 + j];
#pragma unroll
            for (int rs = 0; rs < 16; ++rs) s += pp[(size_t)rs * 4 * 24576];
            MOD[o] = s; }
        LAS float* SHSC = (LAS float*)F.lds;
        for (int rb = blockIdx.x; rb < T / 32; rb += F.G) {
            const int b = rb / (SEQ / 32);
            __syncthreads();
            for (int c = F.tid; c < 2 * D; c += 512) { const float* pp = ADAP + (size_t)b * 24576 + c; float s = ada_b[c];
#pragma unroll
                for (int rs = 0; rs < 16; ++rs) s += pp[(size_t)rs * 4 * 24576];
                SHSC[c] = s; }
            __syncthreads();
#pragma unroll
            for (int rr = 0; rr < 4; ++rr) { const int m = rb * 32 + 4 * F.wave + rr;
                const f32x4* xr = (const f32x4*)(in_x + (size_t)m * D) + F.lane; u32x2* o = (u32x2*)(HIN + (size_t)m * D) + F.lane;
#pragma unroll
                for (int j = 0; j < 8; ++j) { const f32x4 v = xr[64 * j]; const f32x4 sh = ((const LAS f32x4*)SHSC)[F.lane + 64 * j], sc = ((const LAS f32x4*)(SHSC + D))[F.lane + 64 * j];
                    const f32x4 h = v * (sc + 1.0f) + sh; u32x2 w; w.x = cvtpk(h[0], h[1]); w.y = cvtpk(h[2], h[3]); o[64 * j] = w; } }
        }
    }
    SEAM(1);

    if (IN(2)) { PHASE_FRESH();
        const bool split = (F.G == 256);
        pg8::MapOrder S; S.init(HIN, WIN0, T, split ? 24 * 256 : NIN, D, F.G, (int)blockIdx.x); S.first = 0; S.nfirst = split ? 23 : 29; S.extra = 28;
        pg8::EpiInProj E{PB, PBA};
        pg8::gemm_phase<pg8::EpiInProj, pg8::MapOrder>(F.lds, D, S, E, F.tid, F.wave);
    }
    SEAM(2);

    if (IN(3)) { PHASE_FRESH();
        constexpr int QS = 136;
        LAS float* MT = (LAS float*)(F.lds);
        LAS bf16* QKM = (LAS bf16*)(F.lds + 17408);
        LAS float* RAWK = (LAS float*)(F.lds);
        LAS float* VF = (LAS float*)(F.lds + 32768);
        LAS float* WL = (LAS float*)(F.lds + 65536);
        LAS bf16* QBl = (LAS bf16*)(F.lds + 98304);
        LAS bf16* KBl = (LAS bf16*)(F.lds + 115712);
        int zoff = 0; asm volatile("" : "+v"(zoff));
        LAS float* s_beta = (LAS float*)(F.lds + 133120 + zoff); LAS float* s_gc = s_beta + 64; LAS float* s_egc = s_beta + 128;
        for (int ch = blockIdx.x; ch < NCH; ch += F.G) {
            PHASE_FRESH();
            const int n = ch & 31, bh = ch >> 5, h = bh & 7, b = bh >> 3;
            const int tok0 = b * SEQ + n * CHK;
            if (F.tid < 384) {
                const int mat = F.tid >> 7, d = F.tid & 127, col = mat * 1024 + h * 128 + d;
                const float w0 = gdn_conv_w[col], w1 = gdn_conv_w[3072 + col], w2 = gdn_conv_w[2 * 3072 + col], w3 = gdn_conv_w[3 * 3072 + col];
                const bf16* pc = PB + (size_t)tok0 * NP + col;
                float xm3 = 0.f, xm2 = 0.f, xm1 = 0.f;
                if (n > 0) { xm3 = bf2f(pc[-3 * NP]); xm2 = bf2f(pc[-2 * NP]); xm1 = bf2f(pc[-NP]); }
                LAS float* dst = (mat == 0) ? WL : (mat == 1 ? RAWK : VF);
                bf16 xr[64];
#pragma unroll
                for (int i = 0; i < 64; ++i) xr[i] = pc[(size_t)i * NP];
#pragma unroll
                for (int i = 0; i < 64; ++i) { const float xi = bf2f(xr[i]); const float y = w0 * xm3 + w1 * xm2 + w2 * xm1 + w3 * xi;
                    dst[i * 128 + d] = silu_f(y); xm3 = xm2; xm2 = xm1; xm1 = xi; }
            }
            if (F.wave == 7) {
                const int tok = tok0 + F.lane;
                const float br = PBA[(size_t)tok * 16 + h], ar = PBA[(size_t)tok * 16 + 8 + h];
                const float beta = 1.f / (1.f + __expf(-br));
                const float xsp = ar + gdn_dt_bias[h];
                const float sp = fmaxf(xsp, 0.f) + log1pf(__expf(-fabsf(xsp)));
                float g = -__expf(gdn_a_log[h]) * sp;
#pragma unroll
                for (int off = 1; off < 64; off <<= 1) { const float v = __shfl_up(g, off); if (F.lane >= off) g += v; }
                s_beta[F.lane] = beta; s_gc[F.lane] = g; s_egc[F.lane] = __expf(g);
            }
            __syncthreads();
#pragma unroll
            for (int rr = 0; rr < 8; ++rr) {
                const int i = F.wave * 8 + rr;
                const float qa = WL[i * 128 + F.lane], qb2 = WL[i * 128 + 64 + F.lane];
                const float ka = RAWK[i * 128 + F.lane], kb2 = RAWK[i * 128 + 64 + F.lane];
                const float rq = rsqrtf(wave_sum(qa * qa + qb2 * qb2) + 1e-6f) * 0.08838834764831845f;
                const float rk = rsqrtf(wave_sum(ka * ka + kb2 * kb2) + 1e-6f);
                QBl[i * QS + F.lane] = f2bf(qa * rq); QBl[i * QS + 64 + F.lane] = f2bf(qb2 * rq);
                KBl[i * QS + F.lane] = f2bf(ka * rk); KBl[i * QS + 64 + F.lane] = f2bf(kb2 * rk);
            }
            __syncthreads();
            {
                const int mat = F.wave >> 2, mi = (F.wave >> 1) & 1, ni = F.wave & 1, r = F.lane & 31, hh = F.lane >> 5;
                const LAS bf16* Am = (mat == 0) ? KBl : QBl;
                f32x16 acc;
#pragma unroll
                for (int i = 0; i < 16; ++i) acc[i] = 0.f;
#pragma unroll
                for (int ks = 0; ks < 8; ++ks) {
                    const bf16x8 a = *(const LAS bf16x8*)(Am + (32 * mi + r) * QS + 16 * ks + 8 * hh);
                    const bf16x8 bb = *(const LAS bf16x8*)(KBl + (32 * ni + r) * QS + 16 * ks + 8 * hh);
                    acc = MFMA32(a, bb, acc);
                }
                const int j = 32 * ni + r; const float gj = s_gc[j];
#pragma unroll
                for (int reg = 0; reg < 16; ++reg) {
                    const int i = 32 * mi + crow(reg, hh);
                    const float gi = s_gc[i];
                    const float dec = __expf(fminf(gi - gj, 0.f));
                    if (mat == 0) MT[j * 68 + i] = (i > j) ? s_beta[i] * acc[reg] * dec : 0.f;
                    else QKM[i * 64 + j] = f2bf((i >= j) ? acc[reg] * dec : 0.f);
                }
            }
            __syncthreads();
            if (F.tid < 256) {
                const int c = F.tid, dcol = c & 127;
                float X[64];
                if (c < 128) {
#pragma unroll
                    for (int i = 0; i < 64; ++i) X[i] = VF[i * 128 + dcol] * s_beta[i];
                } else {
#pragma unroll
                    for (int i = 0; i < 64; ++i) X[i] = bf2f(KBl[i * QS + dcol]) * s_beta[i] * s_egc[i];
                }
#pragma unroll
                for (int j = 0; j < 63; ++j) {
                    asm volatile("" ::: "memory");
                    const float xj = X[j];
#pragma unroll
                    for (int i4 = ((j + 1) & ~3); i4 < 64; i4 += 4) {
                        const f32x4 m4 = *(const LAS f32x4*)(MT + j * 68 + i4);
#pragma unroll
                        for (int q = 0; q < 4; ++q) if (i4 + q > j) X[i4 + q] -= m4[q] * xj;
                    }
                }
                LAS float* dst = (c < 128) ? VF : WL;
#pragma unroll
                for (int i = 0; i < 64; ++i) dst[i * 128 + dcol] = X[i];
            }
            __syncthreads();
            {
                const int r = F.lane & 31, hh = F.lane >> 5;
                const float gl = s_gc[63];
                unsigned char* gf = GF + (size_t)ch * GREC;
                for (int f = F.wave; f < 56; f += 8) {
                    float v[8];
                    if (f < 16) { const int mt = f >> 3, ks = f & 7; const LAS float* src = WL + (32 * mt + r) * 128 + 16 * ks + 4 * hh;
#pragma unroll
                        for (int j = 0; j < 8; ++j) v[j] = -src[8 * (j >> 2) + (j & 3)]; }
                    else if (f < 32) { const int f2 = f - 16, mt = f2 >> 3, ks = f2 & 7, i = 32 * mt + r; const float e = s_egc[i]; const LAS bf16* src = QBl + i * QS + 16 * ks + 4 * hh;
#pragma unroll
                        for (int j = 0; j < 8; ++j) v[j] = bf2f(src[8 * (j >> 2) + (j & 3)]) * e; }
                    else if (f < 40) { const int f2 = f - 32, mt = f2 >> 2, ks = f2 & 3; const LAS bf16* src = QKM + (32 * mt + r) * 64 + 16 * ks + 4 * hh;
#pragma unroll
                        for (int j = 0; j < 8; ++j) v[j] = bf2f(src[8 * (j >> 2) + (j & 3)]); }
                    else { const int f2 = f - 40, mt = f2 >> 2, ks = f2 & 3, dd = 32 * mt + r;
#pragma unroll
                        for (int j = 0; j < 8; ++j) { const int i = 16 * ks + 8 * (j >> 2) + 4 * hh + (j & 3); v[j] = bf2f(KBl[i * QS + dd]) * __expf(gl - s_gc[i]); } }
                    u32x4 o; o.x = cvtpk(v[0], v[1]); o.y = cvtpk(v[2], v[3]); o.z = cvtpk(v[4], v[5]); o.w = cvtpk(v[6], v[7]);
                    *(u32x4*)(gf + f * 1024 + F.lane * 16) = o;
                }
                { const int sl = F.wave >> 1, it = F.wave & 1, col = 32 * sl + r;
                  unsigned uw[8];
#pragma unroll
                  for (int q = 0; q < 8; ++q) uw[q] = cvtpk(VF[(32 * it + crow(2 * q, hh)) * 128 + col], VF[(32 * it + crow(2 * q + 1, hh)) * 128 + col]);
                  u32x4* up = (u32x4*)(gf + 57344 + (size_t)((sl * 2 + it) * 64 + F.lane) * 32);
                  up[0] = (u32x4){uw[0], uw[1], uw[2], uw[3]}; up[1] = (u32x4){uw[4], uw[5], uw[6], uw[7]}; }
                if (F.tid == 0) EG[ch] = __expf(gl);
            }
            __syncthreads();
        }
    }
    SEAM(3);

    if (IN(4)) { PHASE_FRESH();
        if (F.G == 256 && (int)blockIdx.x >= BATCH * GH) {
            pg8::MapOrder S; S.init(HIN, WIN0, T, 5 * 256, D, F.G - BATCH * GH, (int)blockIdx.x - BATCH * GH); S.first = 23; S.nfirst = 5; S.extra = 28;
            pg8::EpiInProj E{PB, PBA};
            pg8::gemm_phase<pg8::EpiInProj, pg8::MapOrder>(F.lds, D, S, E, F.tid, F.wave);
        }
        for (int bh = blockIdx.x; bh < BATCH * GH; bh += F.G) {
            const int b = bh >> 3, hd = bh & 7, r = F.lane & 31, hh = F.lane >> 5, sl = F.wave;
            const unsigned char* g0 = GF + (size_t)(bh * 32) * GREC;
#define SCAN_BAR() do { LDS_WAIT(); __builtin_amdgcn_s_barrier(); asm volatile("" ::: "memory"); } while (0)
            if (F.wave >= 4) {
                const int t4 = F.tid - 256;
                const unsigned char* gl0 = g0 + opaque_off((size_t)t4 * 16);
                u32x4 ra[18], rb[18];
#pragma unroll
                for (int q = 0; q < 18; ++q) ra[q] = *(const u32x4*)(gl0 + (size_t)q * 4096);
#pragma unroll
                for (int q = 0; q < 18; ++q) *(LAS u32x4*)(F.lds + (t4 + 256 * q) * 16) = ra[q];
#pragma unroll
                for (int q = 0; q < 18; ++q) ra[q] = *(const u32x4*)(gl0 + (size_t)GREC + (size_t)q * 4096);
#pragma unroll
                for (int q = 0; q < 18; ++q) rb[q] = *(const u32x4*)(gl0 + (size_t)2 * GREC + (size_t)q * 4096);
                SCAN_BAR();
                for (int n = 0; n < NCHK; n += 2) {
                    const unsigned char* gn = g0 + opaque_off((size_t)(n + 3) * GREC + (size_t)t4 * 16);
#pragma unroll
                    for (int q = 0; q < 18; ++q) *(LAS u32x4*)(F.lds + GREC + (t4 + 256 * q) * 16) = ra[q];
                    if (n + 3 < NCHK) {
#pragma unroll
                        for (int q = 0; q < 18; ++q) ra[q] = *(const u32x4*)(gn + (size_t)q * 4096); }
                    SCAN_BAR();
                    if (n + 2 < NCHK) {
#pragma unroll
                        for (int q = 0; q < 18; ++q) *(LAS u32x4*)(F.lds + (t4 + 256 * q) * 16) = rb[q]; }
                    if (n + 4 < NCHK) {
#pragma unroll
                        for (int q = 0; q < 18; ++q) rb[q] = *(const u32x4*)(gn + (size_t)GREC + (size_t)q * 4096); }
                    SCAN_BAR();
                }
            } else {
                f32x16 S[4];
#pragma unroll
                for (int dt = 0; dt < 4; ++dt)
#pragma unroll
                    for (int i = 0; i < 16; ++i) S[dt][i] = 0.f;
                SCAN_BAR();
                for (int n = 0; n < NCHK; ++n) {
                    const int ch = bh * 32 + n;
                    const LAS unsigned char* buf = F.lds + (n & 1) * GREC + F.lane * 16;
                    const float eg = EG[ch];
                    bf16x8 Sb[8];
#pragma unroll
                    for (int dt = 0; dt < 4; ++dt) { Sb[2 * dt] = pack_acc(S[dt], 0); Sb[2 * dt + 1] = pack_acc(S[dt], 1); }
                    f32x16 vn[2];
#pragma unroll
                    for (int it = 0; it < 2; ++it) { const LAS u32x4* up = (const LAS u32x4*)(F.lds + (n & 1) * GREC + 57344 + ((sl * 2 + it) * 64 + F.lane) * 32);
                        const u32x4 u0 = up[0], u1 = up[1]; const unsigned uw[8] = {u0.x, u0.y, u0.z, u0.w, u1.x, u1.y, u1.z, u1.w};
#pragma unroll
                        for (int q = 0; q < 8; ++q) { vn[it][2 * q] = bflo(uw[q]); vn[it][2 * q + 1] = bfhi(uw[q]); } }
#pragma unroll
                    for (int it = 0; it < 2; ++it)
#pragma unroll
                        for (int ks = 0; ks < 8; ++ks) vn[it] = MFMA32(*(const LAS bf16x8*)(buf + (it * 8 + ks) * 1024), Sb[ks], vn[it]);
                    __builtin_amdgcn_sched_barrier(0);
                    f32x16 oa[2];
#pragma unroll
                    for (int it = 0; it < 2; ++it) {
#pragma unroll
                        for (int i = 0; i < 16; ++i) oa[it][i] = 0.f;
#pragma unroll
                        for (int ks = 0; ks < 8; ++ks) oa[it] = MFMA32(*(const LAS bf16x8*)(buf + (16 + it * 8 + ks) * 1024), Sb[ks], oa[it]);
                    }
                    __builtin_amdgcn_sched_barrier(0);
                    bf16x8 vb[4];
#pragma unroll
                    for (int it = 0; it < 2; ++it) { vb[2 * it] = pack_acc(vn[it], 0); vb[2 * it + 1] = pack_acc(vn[it], 1); }
                    __builtin_amdgcn_sched_barrier(0);
#pragma unroll
                    for (int it = 0; it < 2; ++it)
#pragma unroll
                        for (int ks = 0; ks < 4; ++ks) oa[it] = MFMA32(*(const LAS bf16x8*)(buf + (32 + it * 4 + ks) * 1024), vb[ks], oa[it]);
#pragma unroll
                    for (int it = 0; it < 2; ++it) {
#pragma unroll
                        for (int g4 = 0; g4 < 4; ++g4) { float* op = GO + opaque_off((size_t)(b * SEQ + n * CHK + 32 * it + 8 * g4 + 4 * hh) * 1024 + hd * 128 + sl * 32 + r);
#pragma unroll
                            for (int q = 0; q < 4; ++q) op[q * 1024] = oa[it][4 * g4 + q]; } }
                    __builtin_amdgcn_sched_barrier(0);
#pragma unroll
                    for (int dt = 0; dt < 4; ++dt) {
#pragma unroll
                        for (int i = 0; i < 16; ++i) S[dt][i] *= eg;
#pragma unroll
                        for (int ks = 0; ks < 4; ++ks) S[dt] = MFMA32(*(const LAS bf16x8*)(buf + (40 + dt * 4 + ks) * 1024), vb[ks], S[dt]);
                    }
                    SCAN_BAR();
                }
            }
#undef SCAN_BAR
            __syncthreads();
        }
    }
    SEAM(4);

    if (IN(5)) { PHASE_FRESH();
        for (int m = F.gw; m < T; m += F.NGW) {
            const int s = m & (SEQ - 1), c0 = F.lane * 16;
            const bf16* prow = PB + (size_t)m * NP;
            {
                const f32x4* op = (const f32x4*)(GO + (size_t)m * 1024 + c0);
                f32x4 o[4]; float ss = 0.f;
#pragma unroll
                for (int q = 0; q < 4; ++q) { o[q] = op[q]; ss += o[q][0] * o[q][0] + o[q][1] * o[q][1] + o[q][2] * o[q][2] + o[q][3] * o[q][3]; }
                ss += __shfl_xor(ss, 1); ss += __shfl_xor(ss, 2); ss += __shfl_xor(ss, 4);
                const float rms = rsqrtf(ss * (1.f / 128.f) + 1e-6f);
                const u32x4* zp = (const u32x4*)(prow + 3072 + c0); const u32x4 z0 = zp[0], z1 = zp[1];
                const unsigned zw[8] = {z0.x, z0.y, z0.z, z0.w, z1.x, z1.y, z1.z, z1.w};
                const f32x4* nwp = (const f32x4*)(gdn_norm_w + (c0 & 127));
                unsigned ow[8];
#pragma unroll
                for (int q = 0; q < 4; ++q) { const f32x4 nw = nwp[q];
                    const float y0 = o[q][0] * rms * nw[0] * silu_f(bflo(zw[2 * q])), y1 = o[q][1] * rms * nw[1] * silu_f(bfhi(zw[2 * q]));
                    const float y2 = o[q][2] * rms * nw[2] * silu_f(bflo(zw[2 * q + 1])), y3 = o[q][3] * rms * nw[3] * silu_f(bfhi(zw[2 * q + 1]));
                    ow[2 * q] = cvtpk(y0, y1); ow[2 * q + 1] = cvtpk(y2, y3); }
                u32x4* yp = (u32x4*)(YAB + (size_t)m * D + c0);
                yp[0] = (u32x4){ow[0], ow[1], ow[2], ow[3]}; yp[1] = (u32x4){ow[4], ow[5], ow[6], ow[7]};
            }
            {
                float accv[16];
#pragma unroll
                for (int q = 0; q < 16; ++q) accv[q] = 0.f;
#pragma unroll
                for (int j = 0; j < 3; ++j) {
                    if (s - 2 + j >= 0) {
                        const bf16* pr = prow + (ptrdiff_t)(j - 2) * NP;
                        const u32x4* cp = (const u32x4*)(pr + 5120 + c0); const u32x4* hp = (const u32x4*)(pr + 6144 + c0);
                        const u32x4 ca = cp[0], cb = cp[1], ha = hp[0], hb = hp[1];
                        const unsigned cw[8] = {ca.x, ca.y, ca.z, ca.w, cb.x, cb.y, cb.z, cb.w}, hw[8] = {ha.x, ha.y, ha.z, ha.w, hb.x, hb.y, hb.z, hb.w};
                        const f32x4* wp = (const f32x4*)(sc_conv_w + j * 1024 + c0);
#pragma unroll
                        for (int q = 0; q < 4; ++q) { const f32x4 w4 = wp[q];
                            accv[4 * q] += w4[0] * bflo(cw[2 * q]) * bflo(hw[2 * q]); accv[4 * q + 1] += w4[1] * bfhi(cw[2 * q]) * bfhi(hw[2 * q]);
                            accv[4 * q + 2] += w4[2] * bflo(cw[2 * q + 1]) * bflo(hw[2 * q + 1]); accv[4 * q + 3] += w4[3] * bfhi(cw[2 * q + 1]) * bfhi(hw[2 * q + 1]); }
                    }
                }
                const u32x4* bp = (const u32x4*)(prow + 4096 + c0); const u32x4 ba = bp[0], bb = bp[1];
                const unsigned bw[8] = {ba.x, ba.y, ba.z, ba.w, bb.x, bb.y, bb.z, bb.w};
                unsigned ow[8];
#pragma unroll
                for (int q = 0; q < 8; ++q) ow[q] = cvtpk(bflo(bw[q]) * accv[2 * q], bfhi(bw[q]) * accv[2 * q + 1]);
                u32x4* yp = (u32x4*)(YAB + (size_t)m * D + 1024 + c0);
                yp[0] = (u32x4){ow[0], ow[1], ow[2], ow[3]}; yp[1] = (u32x4){ow[4], ow[5], ow[6], ow[7]};
            }
        }
    }
    SEAM(5);

    if (IN(6)) { PHASE_FRESH();
        pg8::StaticOrder S; S.init(YAB, WOUT0, T, D, D, F.G, (int)blockIdx.x);
        pg8::EpiResid E{in_x, MOD + 2 * D, RB};
        pg8::gemm_phase<pg8::EpiResid, pg8::StaticOrder>(F.lds, D, S, E, F.tid, F.wave);
    }
    SEAM(6);

    if (IN(7)) { PHASE_FRESH(); ln_route_phase<0>(F, args); }
    if (IN(7) && IN(11)) { PHASE_FRESH(); xcd_barrier(bar, F.tid == 0); }


    moe_phases<0>(F, args, bar, lo, hi, TAB);

        if (IN(14)) { PHASE_FRESH();
            pg8::StaticOrder S; S.init(HIN, WMIN, T, NMLA, D, F.G, (int)blockIdx.x);
            pg8::EpiF32 E{C1, NMLA};
            pg8::gemm_phase<pg8::EpiF32, pg8::StaticOrder>(F.lds, D, S, E, F.tid, F.wave);
        }
        SEAM(14);
        if (IN(15)) { PHASE_FRESH();
            for (int m = F.gw; m < T; m += F.NGW) {
                const float* c1 = C1 + (size_t)m * NMLA;
#pragma unroll
                for (int part = 0; part < 2; ++part) {
                    const f32x4* p = (const f32x4*)(c1 + part * 512 + 8 * F.lane); const f32x4 a0 = p[0], a1 = p[1];
                    const float ss = wave_sum((a0[0] * a0[0] + a0[1] * a0[1]) + (a0[2] * a0[2] + a0[3] * a0[3]) + (a1[0] * a1[0] + a1[1] * a1[1]) + (a1[2] * a1[2] + a1[3] * a1[3]));
                    const float rn = rsqrtf(ss * (1.f / 512.f) + 1e-6f);
                    const f32x4* wp = (const f32x4*)((part == 0 ? mla_q_norm : mla_kv_norm) + 8 * F.lane); const f32x4 w0 = wp[0], w1 = wp[1];
                    u32x4 o; o.x = cvtpk(a0[0] * rn * w0[0], a0[1] * rn * w0[1]); o.y = cvtpk(a0[2] * rn * w0[2], a0[3] * rn * w0[3]);
                    o.z = cvtpk(a1[0] * rn * w1[0], a1[1] * rn * w1[1]); o.w = cvtpk(a1[2] * rn * w1[2], a1[3] * rn * w1[3]);
                    *(u32x4*)((part == 0 ? CQN : CKVN) + (size_t)m * 512 + 8 * F.lane) = o;
                }
                if (F.lane < 32) { const float x1 = c1[1024 + F.lane], x2 = c1[1056 + F.lane], cs = ROPE_C[(size_t)m * 32 + F.lane], sn = ROPE_S[(size_t)m * 32 + F.lane];
                    KPE[(size_t)m * 64 + F.lane] = x1 * cs - x2 * sn; KPE[(size_t)m * 64 + 32 + F.lane] = x1 * sn + x2 * cs; }
            }
        }
        SEAM(15);
        if (IN(16)) { PHASE_FRESH();
            { pg8::StaticOrder S; S.init(CQN, WUQ, T, 3072, 512, F.G, (int)blockIdx.x); pg8::EpiQup E{QB_};
              pg8::gemm_phase<pg8::EpiQup, pg8::StaticOrder>(F.lds, 512, S, E, F.tid, F.wave); }
            { pg8::StaticOrder S; S.init(CKVN, WUKV, T, 4096, 512, F.G, (int)blockIdx.x); pg8::EpiKVup E{KB_, VB_};
              pg8::gemm_phase<pg8::EpiKVup, pg8::StaticOrder>(F.lds, 512, S, E, F.tid, F.wave); }
        }
        SEAM(16);
        if (IN(17)) { PHASE_FRESH();
            for (int m = F.gw; m < T; m += F.NGW) {
                const int b = m / SEQ, s = m - b * SEQ, hd = F.lane >> 2, i0 = (F.lane & 3) * 8;
                const size_t rowoff = ((size_t)((b * MH + hd) * SEQ + s)) * QD + 128;
                bf16* qp = QB_ + rowoff;
                const u32x4 xa = *(const u32x4*)(qp + i0), xb = *(const u32x4*)(qp + 32 + i0);
                const f32x4* cp = (const f32x4*)(ROPE_C + (size_t)m * 32 + i0); const f32x4* sp = (const f32x4*)(ROPE_S + (size_t)m * 32 + i0);
                const f32x4 c0 = cp[0], c1v = cp[1], s0 = sp[0], s1 = sp[1];
                const float cs[8] = {c0[0], c0[1], c0[2], c0[3], c1v[0], c1v[1], c1v[2], c1v[3]}, sn[8] = {s0[0], s0[1], s0[2], s0[3], s1[0], s1[1], s1[2], s1[3]};
                const unsigned xaw[4] = {xa.x, xa.y, xa.z, xa.w}, xbw[4] = {xb.x, xb.y, xb.z, xb.w};
                unsigned o1[4], o2[4];
#pragma unroll
                for (int q = 0; q < 4; ++q) { const float a0 = bflo(xaw[q]), a1 = bfhi(xaw[q]), b0 = bflo(xbw[q]), b1 = bfhi(xbw[q]);
                    o1[q] = cvtpk(a0 * cs[2 * q] - b0 * sn[2 * q], a1 * cs[2 * q + 1] - b1 * sn[2 * q + 1]);
                    o2[q] = cvtpk(a0 * sn[2 * q] + b0 * cs[2 * q], a1 * sn[2 * q + 1] + b1 * cs[2 * q + 1]); }
                *(u32x4*)(qp + i0) = (u32x4){o1[0], o1[1], o1[2], o1[3]}; *(u32x4*)(qp + 32 + i0) = (u32x4){o2[0], o2[1], o2[2], o2[3]};
                const f32x4* kp = (const f32x4*)(KPE + (size_t)m * 64 + i0); const f32x4* kp2 = (const f32x4*)(KPE + (size_t)m * 64 + 32 + i0);
                const f32x4 k0 = kp[0], k1 = kp[1], k2 = kp2[0], k3 = kp2[1];
                bf16* kd = KB_ + rowoff;
                *(u32x4*)(kd + i0) = (u32x4){cvtpk(k0[0], k0[1]), cvtpk(k0[2], k0[3]), cvtpk(k1[0], k1[1]), cvtpk(k1[2], k1[3])};
                *(u32x4*)(kd + 32 + i0) = (u32x4){cvtpk(k2[0], k2[1]), cvtpk(k2[2], k2[3]), cvtpk(k3[0], k3[1]), cvtpk(k3[2], k3[3])};
            }
        }
        SEAM(17);
        if (IN(18)) { PHASE_FRESH();
            constexpr int KBUF = 64 * 400, VBUF = 64 * 320;
            LAS unsigned char* KL = F.lds; LAS unsigned char* VL = F.lds + 2 * KBUF;
            const int w = F.wave;
            for (int pi = blockIdx.x; pi < 256; pi += F.G) {
                const int bhh = pi >> 2, pp = pi & 3, b = bhh >> 4, hd = bhh & 15;
                const char* kg = (const char*)(KB_ + (size_t)bhh * SEQ * QD); const char* vg = (const char*)(VB_ + (size_t)b * SEQ * D + hd * 128);
                for (int half = 0; half < 2; ++half) {
                    PHASE_FRESH(); const int r = F.lane & 31, hh = F.lane >> 5;
                    const int qb = half == 0 ? 7 - pp : pp, q0 = qb * 256, ntile = 4 * (qb + 1), qrow = q0 + 32 * w + r;
                    bf16x8 qf[12];
                    { const bf16* qp = QB_ + ((size_t)bhh * SEQ + qrow) * QD + 8 * hh;
#pragma unroll
                      for (int ks = 0; ks < 12; ++ks) qf[ks] = *(const bf16x8*)(qp + 16 * ks); }
                    f32x16 oT[4];
#pragma unroll
                    for (int mt = 0; mt < 4; ++mt)
#pragma unroll
                        for (int i = 0; i < 16; ++i) oT[mt][i] = 0.f;
                    float mrun = -1e30f, lsum = 0.f;
                    u32x4 kst[3], vst[2];
#pragma unroll
                    for (int q = 0; q < 3; ++q) kst[q] = *(const u32x4*)(kg + (size_t)(F.tid + 512 * q) * 16);
#pragma unroll
                    for (int q = 0; q < 2; ++q) { const int p = F.tid + 512 * q; vst[q] = *(const u32x4*)(vg + (size_t)(p >> 4) * (D * 2) + (p & 15) * 16); }
#pragma unroll
                    for (int q = 0; q < 3; ++q) { const int p = F.tid + 512 * q; *(LAS u32x4*)(KL + (p / 24) * 400 + (p % 24) * 16) = kst[q]; }
#pragma unroll
                    for (int q = 0; q < 2; ++q) { const int p = F.tid + 512 * q; *(LAS u32x4*)(VL + (p >> 4) * 320 + (p & 15) * 16) = vst[q]; }
                    __syncthreads();
                    for (int kt = 0; kt < ntile; ++kt) {
                        const bool more = (kt + 1 < ntile); const int k0 = kt * 64;
                        if (more) {
                            const int k1 = k0 + 64;
#pragma unroll
                            for (int q = 0; q < 3; ++q) kst[q] = *(const u32x4*)(kg + (size_t)k1 * (QD * 2) + (size_t)(F.tid + 512 * q) * 16);
#pragma unroll
                            for (int q = 0; q < 2; ++q) { const int p = F.tid + 512 * q; vst[q] = *(const u32x4*)(vg + (size_t)(k1 + (p >> 4)) * (D * 2) + (p & 15) * 16); }
                        }
                        if (k0 <= q0 + 32 * w + 31) {
                            const LAS unsigned char* kb = KL + (kt & 1) * KBUF; const LAS unsigned char* vb_ = VL + (kt & 1) * VBUF;
                            f32x16 sT[2];
#pragma unroll
                            for (int kk = 0; kk < 2; ++kk) {
#pragma unroll
                                for (int i = 0; i < 16; ++i) sT[kk][i] = 0.f;
#pragma unroll
                                for (int ks = 0; ks < 12; ++ks) sT[kk] = MFMA32(*(const LAS bf16x8*)(kb + (32 * kk + r) * 400 + (16 * ks + 8 * hh) * 2), qf[ks], sT[kk]);
                            }
                            if (k0 + 63 > q0 + 32 * w) {
#pragma unroll
                                for (int kk = 0; kk < 2; ++kk)
#pragma unroll
                                    for (int reg = 0; reg < 16; ++reg) { const int key = k0 + 32 * kk + crow(reg, hh); if (key > qrow) sT[kk][reg] = -1e30f; }
                            }
                            float mloc = sT[0][0];
#pragma unroll
                            for (int kk = 0; kk < 2; ++kk)
#pragma unroll
                                for (int reg = 0; reg < 16; ++reg) mloc = fmaxf(mloc, sT[kk][reg]);
                            mloc = fmaxf(mloc, __shfl_xor(mloc, 32));
                            const float mnew = fmaxf(mrun, mloc), alpha = __builtin_amdgcn_exp2f(mrun - mnew);
                            float ps = 0.f;
#pragma unroll
                            for (int kk = 0; kk < 2; ++kk)
#pragma unroll
                                for (int reg = 0; reg < 16; ++reg) { const float pe = __builtin_amdgcn_exp2f(sT[kk][reg] - mnew); sT[kk][reg] = pe; ps += pe; }
                            lsum = lsum * alpha + ps; mrun = mnew;
#pragma unroll
                            for (int mt = 0; mt < 4; ++mt)
#pragma unroll
                                for (int i = 0; i < 16; ++i) oT[mt][i] *= alpha;
                            bf16x8 pb[4];
#pragma unroll
                            for (int kk = 0; kk < 2; ++kk) { pb[2 * kk] = pack_acc(sT[kk], 0); pb[2 * kk + 1] = pack_acc(sT[kk], 1); }
#pragma unroll
                            for (int mt = 0; mt < 4; ++mt)
#pragma unroll
                                for (int ks = 0; ks < 4; ++ks) {
                                const LAS unsigned char* vp = vb_ + (16 * ks + 4 * hh + ((F.lane & 15) >> 2)) * 320 + (32 * mt + 16 * ((F.lane >> 4) & 1) + 4 * (F.lane & 3)) * 2;
                                const s16x4 vlo = __builtin_bit_cast(s16x4, __builtin_amdgcn_ds_read_tr16_b64_v4i16((LAS v4i16_t*)vp));
                                const s16x4 vhi = __builtin_bit_cast(s16x4, __builtin_amdgcn_ds_read_tr16_b64_v4i16((LAS v4i16_t*)(vp + 8 * 320)));
                                const bf16x8 va = __builtin_shufflevector(vlo, vhi, 0, 1, 2, 3, 4, 5, 6, 7);
                                oT[mt] = MFMA32(va, pb[ks], oT[mt]); }
                        }
                        if (more) {
                            LAS unsigned char* kn = KL + ((kt + 1) & 1) * KBUF; LAS unsigned char* vn_ = VL + ((kt + 1) & 1) * VBUF;
#pragma unroll
                            for (int q = 0; q < 3; ++q) { const int p = F.tid + 512 * q; *(LAS u32x4*)(kn + (p / 24) * 400 + (p % 24) * 16) = kst[q]; }
#pragma unroll
                            for (int q = 0; q < 2; ++q) { const int p = F.tid + 512 * q; *(LAS u32x4*)(vn_ + (p >> 4) * 320 + (p & 15) * 16) = vst[q]; }
                        }
                        __syncthreads();
                    }
                    const float ltot = lsum + __shfl_xor(lsum, 32), inv = 1.f / ltot;
                    bf16* orow = YAB + (size_t)(b * SEQ + qrow) * D + hd * 128 + 4 * hh;
#pragma unroll
                    for (int mt = 0; mt < 4; ++mt)
#pragma unroll
                        for (int g4 = 0; g4 < 4; ++g4) { u32x2 o; o.x = cvtpk(oT[mt][4 * g4] * inv, oT[mt][4 * g4 + 1] * inv); o.y = cvtpk(oT[mt][4 * g4 + 2] * inv, oT[mt][4 * g4 + 3] * inv);
                            *(u32x2*)(orow + 32 * mt + 8 * g4) = o; }
                }
            }
        }
        SEAM(18);
        if (IN(19)) { PHASE_FRESH();
            pg8::StaticOrder S; S.init(YAB, WMOUT, T, D, D, F.G, (int)blockIdx.x);
            pg8::EpiResid E{XB, MOD + (size_t)4 * 12288 + 2 * D, RB};
            pg8::gemm_phase<pg8::EpiResid, pg8::StaticOrder>(F.lds, D, S, E, F.tid, F.wave);
        }
        SEAM(19);
        if (IN(20)) { PHASE_FRESH(); ln_route_phase<1>(F, args); }
        if (IN(20) && IN(24)) { PHASE_FRESH(); xcd_barrier(bar, F.tid == 0); }


    moe_phases<1>(F, args, bar, lo, hi, TAB);
#undef IN
#undef INL
#undef SEAM
#undef WSB
#undef in_x
#undef in_c
#undef in_pos
#undef ada_w
#undef ada_b
#undef ln_g
#undef ln_b
#undef hyb_w_in
#undef gdn_conv_w
#undef gdn_a_log
#undef gdn_dt_bias
#undef gdn_norm_w
#undef sc_conv_w
#undef hyb_w_out
#undef mla_w_in
#undef mla_q_norm
#undef mla_kv_norm
#undef mla_w_uq
#undef mla_w_ukv
#undef mla_w_out
#undef moe_router_g
#undef moe_bias_g
#undef moe_router_e
#undef moe_bias_e
#undef moe_w_gate
#undef moe_w_up
#undef moe_w_down
#undef MOD
#undef ROPE_C
#undef ROPE_S
#undef PBA
#undef LOGITS
#undef TOK_E
#undef TOK_POS
#undef TOK_GATE
#undef EG
#undef WIN0
#undef WOUT0
#undef WMIN
#undef WUQ
#undef WUKV
#undef WMOUT
#undef WRT
#undef WGU
#undef ADAP
#undef WDN
#undef HIN
#undef XA
#undef XB
#undef RB
#undef PB
#undef GF
#undef GU
#undef GO
#undef YAB
#undef LISTP
#undef HID
#undef YS
#undef C1
#undef CQN
#undef CKVN
#undef KPE
#undef QB_
#undef KB_
#undef VB_
#undef VT
}

extern "C" void kernel_launch(void* const* d_in, const int* in_sizes, int n_in, void* d_out, int out_size, void* d_ws, size_t ws_size, hipStream_t stream) {
    static int grid = 0;
    if (grid == 0) {
        if (n_in != 27 || in_sizes[0] != T * D || out_size != T * D || ws_size < WS_END) { fprintf(stderr, "kernel_launch: unexpected problem (n_in %d, in0 %d, out %d, ws %zu)\n", n_in, n_in > 0 ? in_sizes[0] : -1, out_size, ws_size); grid = -1; return; }
        int dev = 0, cus = 0, per_cu = 0;
        if (hipGetDevice(&dev) != hipSuccess || hipDeviceGetAttribute(&cus, hipDeviceAttributeMultiprocessorCount, dev) != hipSuccess) { grid = -1; return; }
        if (hipFuncSetAttribute((const void*)mega, hipFuncAttributeMaxDynamicSharedMemorySize, LDS_BYTES) != hipSuccess) { fprintf(stderr, "kernel_launch: hipFuncSetAttribute failed\n"); grid = -1; return; }
        if (hipOccupancyMaxActiveBlocksPerMultiprocessor(&per_cu, (const void*)mega, 512, LDS_BYTES) != hipSuccess || per_cu < 1) fprintf(stderr, "kernel_launch: occupancy query reports %d\n", per_cu);
        (void)hipGetLastError();
        grid = cus;
    }
    if (grid < 0) return;
    (void)hipMemsetAsync((char*)d_ws + WS_CTL, 0, CTL_ZERO_BYTES, stream);
    Args a{};
    for (int i = 0; i < 27; ++i) a.in[i] = d_in[i];
    a.out = (float*)d_out; a.ws = (unsigned char*)d_ws;
#if MK_ONE_LAUNCH
    a.ph_lo = 0; a.ph_hi = NPH;
    hipLaunchKernelGGL(mega, dim3(grid), dim3(512), LDS_BYTES, stream, a);
#else
    for (int k = 0; k < NPH; ++k) { a.ph_lo = k; a.ph_hi = k + 1; hipLaunchKernelGGL(mega, dim3(grid), dim3(512), LDS_BYTES, stream, a); }
#endif
}
```
